# Optimizing an MI355X kernel written in HIP

```python
import math
import jax, jax.numpy as jnp
from jax import lax
import numpy as np

D_MODEL = 2048
BATCH = 2
SEQ = 16384
DEPTH = 1

MEM_LEN = 256
RWKV_HEADS = 16
RWKV_HEAD_DIM = 64
RWKV_WIDTH = RWKV_HEADS * RWKV_HEAD_DIM
DECAY_LORA = 96
ICLR_LORA = 96
GATE_LORA = 256
FOX_HEADS = 8
FOX_HEAD_DIM = 64
FOX_WIDTH = FOX_HEADS * FOX_HEAD_DIM
MEM_HEADS = 4
MEM_HEAD_DIM = 128
MEM_WIDTH = MEM_HEADS * MEM_HEAD_DIM
MIX_WIDTH = RWKV_WIDTH + FOX_WIDTH + MEM_WIDTH
Q_BLOCK = 128
RWKV_PROJ_WIDTH = 3 * RWKV_WIDTH + DECAY_LORA + ICLR_LORA + GATE_LORA
FOX_PROJ_WIDTH = 3 * FOX_WIDTH + FOX_HEADS
IN_WIDTH = RWKV_PROJ_WIDTH + FOX_PROJ_WIDTH + MEM_WIDTH
N_EXPERTS = 32
TOP_K = 4
D_EXPERT = D_MODEL
SWIGLU_LIMIT = 7.0
SWIGLU_ALPHA = 1.702
MOE_BLOCK = 128
LN_EPS = 1e-5
RWKV_GN_EPS = 64e-5
DEEPNORM_ALPHA = (2 * DEPTH) ** 0.25
DEEPNORM_BETA = (8 * DEPTH) ** -0.25

kernel_name = "hybrid_rwkv7_fox_memxattn_moe_deepnorm"


def layer_norm(x, g, b, eps=LN_EPS):
    xf = x.astype(jnp.float32)
    mean = xf.mean(-1, keepdims=True)
    var = jnp.square(xf - mean).mean(-1, keepdims=True)
    y = (xf - mean) * lax.rsqrt(var + eps) * g.astype(jnp.float32) + b.astype(jnp.float32)
    return y.astype(x.dtype)


def token_shift_lerp(p, mu):
    prev = jnp.pad(p[:, :-1], ((0, 0), (1, 0), (0, 0)))
    return p + mu * (prev - p)


def rwkv7_scan(r, decay, k, v, a_vec, b_vec):
    Bq, T, H, N = r.shape
    xs = (jnp.moveaxis(r, 1, 0), jnp.moveaxis(decay, 1, 0), jnp.moveaxis(k, 1, 0),
          jnp.moveaxis(v, 1, 0), jnp.moveaxis(a_vec, 1, 0), jnp.moveaxis(b_vec, 1, 0))
    s0 = jnp.zeros((Bq, H, N, N), jnp.float32)

    def step(S, inp):
        r_t, w_t, k_t, v_t, a_t, b_t = inp
        sa = jnp.einsum('bhij,bhj->bhi', S, a_t)
        S = S * w_t[:, :, None, :] + sa[..., None] * b_t[:, :, None, :] + v_t[..., None] * k_t[:, :, None, :]
        return S, jnp.einsum('bhij,bhj->bhi', S, r_t)

    _, ys = lax.scan(step, s0, xs)
    return jnp.moveaxis(ys, 0, 1)


def rwkv7_group(p, mu, w0, w_decay_up, a0, w_iclr_up, w_gate_up, k_k, k_a, r_k, gn_g, gn_b):
    Bq, T, _ = p.shape
    f32 = jnp.float32
    ps = token_shift_lerp(p, mu).astype(f32)
    c0 = 3 * RWKV_WIDTH
    r = ps[..., :RWKV_WIDTH]
    k = ps[..., RWKV_WIDTH:2 * RWKV_WIDTH]
    v = ps[..., 2 * RWKV_WIDTH:c0]
    dw = ps[..., c0:c0 + DECAY_LORA]
    da = ps[..., c0 + DECAY_LORA:c0 + DECAY_LORA + ICLR_LORA]
    dg = ps[..., c0 + DECAY_LORA + ICLR_LORA:]
    w_log = -jax.nn.softplus(-(w0.astype(f32) + jnp.tanh(dw) @ w_decay_up.astype(f32))) - 0.5
    decay = jnp.exp(-jnp.exp(w_log))
    a = jax.nn.sigmoid(a0.astype(f32) + da @ w_iclr_up.astype(f32))
    g = jax.nn.sigmoid(dg) @ w_gate_up.astype(f32)
    shp = (Bq, T, RWKV_HEADS, RWKV_HEAD_DIM)
    kk = (k * k_k.astype(f32)).reshape(shp)
    kk = kk / jnp.maximum(jnp.linalg.norm(kk, axis=-1, keepdims=True), 1e-12)
    k = k * (1.0 + (a - 1.0) * k_a.astype(f32))
    rh, kh, vh, ah = r.reshape(shp), k.reshape(shp), v.reshape(shp), a.reshape(shp)
    y = rwkv7_scan(rh, decay.reshape(shp), kh, vh, -kk, kk * ah)
    mean = y.mean(-1, keepdims=True)
    var = jnp.square(y - mean).mean(-1, keepdims=True)
    y = ((y - mean) * lax.rsqrt(var + RWKV_GN_EPS)).reshape(Bq, T, RWKV_WIDTH)
    y = y * gn_g.astype(f32) + gn_b.astype(f32)
    bonus = (rh * kh * r_k.astype(f32)).sum(-1, keepdims=True) * vh
    y = y + bonus.reshape(Bq, T, RWKV_WIDTH)
    return y * g


def fox_attention(q, k, v, c):
    Bq, H, T, Dh = q.shape
    nb = T // Q_BLOCK
    scale = Dh ** -0.5

    def blocks(t):
        return jnp.moveaxis(t.reshape((Bq, H, nb, Q_BLOCK) + t.shape[3:]), 2, 0)

    qb, kb, vb, cb = blocks(q), blocks(k), blocks(v), blocks(c)
    offs = jnp.arange(Q_BLOCK)

    def one_query_block(args):
        i, qi, ci = args
        qpos = i * Q_BLOCK + offs

        def body(j, carry):
            m, l, acc = carry
            s = jnp.einsum('bhqd,bhkd->bhqk', qi, kb[j]) * scale + ci[..., :, None] - cb[j][..., None, :]
            causal = (j * Q_BLOCK + offs)[None, :] <= qpos[:, None]
            s = jnp.where(causal, s, -jnp.inf)
            m_new = jnp.maximum(m, s.max(-1))
            pr = jnp.exp(s - m_new[..., None])
            corr = jnp.exp(m - m_new)
            acc = acc * corr[..., None] + jnp.einsum('bhqk,bhkd->bhqd', pr, vb[j])
            return (m_new, l * corr + pr.sum(-1), acc)

        init = (jnp.full((Bq, H, Q_BLOCK), -jnp.inf, jnp.float32),
                jnp.zeros((Bq, H, Q_BLOCK), jnp.float32),
                jnp.zeros((Bq, H, Q_BLOCK, Dh), jnp.float32))
        _, l, acc = lax.fori_loop(0, i + 1, body, init)
        return acc / l[..., None]

    out = lax.map(one_query_block, (jnp.arange(nb), qb, cb))
    return jnp.moveaxis(out, 0, 2).reshape(Bq, H, T, Dh)


def fox_group(p, b_f):
    Bq, T, _ = p.shape
    f32 = jnp.float32
    pf = p.astype(f32)

    def heads(t):
        return t.reshape(Bq, T, FOX_HEADS, FOX_HEAD_DIM).transpose(0, 2, 1, 3)

    q = heads(pf[..., :FOX_WIDTH])
    k = heads(pf[..., FOX_WIDTH:2 * FOX_WIDTH])
    v = heads(pf[..., 2 * FOX_WIDTH:3 * FOX_WIDTH])
    log_f = jax.nn.log_sigmoid(pf[..., 3 * FOX_WIDTH:] + b_f.astype(f32))
    c = lax.cumsum(log_f, axis=1).transpose(0, 2, 1)
    o = fox_attention(q, k, v, c)
    return o.transpose(0, 2, 1, 3).reshape(Bq, T, FOX_WIDTH)


def memory_group(q_cols, mem_n, w_mem_kv):
    Bq, T, _ = q_cols.shape
    f32 = jnp.float32
    q = q_cols.astype(f32).reshape(Bq, T, MEM_HEADS, MEM_HEAD_DIM).transpose(0, 2, 1, 3)
    kv = (mem_n @ w_mem_kv).astype(f32)
    km = kv[..., :MEM_WIDTH].reshape(Bq, -1, MEM_HEADS, MEM_HEAD_DIM).transpose(0, 2, 1, 3)
    vm = kv[..., MEM_WIDTH:].reshape(Bq, -1, MEM_HEADS, MEM_HEAD_DIM).transpose(0, 2, 1, 3)
    s = jnp.einsum('bhtd,bhmd->bhtm', q, km) * (MEM_HEAD_DIM ** -0.5)
    o = jnp.einsum('bhtm,bhmd->bhtd', jax.nn.softmax(s, axis=-1), vm)
    return o.transpose(0, 2, 1, 3).reshape(Bq, T, MEM_WIDTH)


def moe_ffn(h, router_w, router_b, w1, b1, w2, b2):
    Bq, T, D = h.shape
    n = Bq * T
    hf = h.reshape(n, D)
    logits = (hf @ router_w + router_b).astype(jnp.float32)
    top_vals, top_idx = lax.top_k(logits, TOP_K)
    gates = jax.nn.softmax(top_vals, axis=-1)
    flat_e = top_idx.reshape(-1)
    flat_tok = jnp.repeat(jnp.arange(n, dtype=jnp.int32), TOP_K)
    flat_g = gates.reshape(-1)
    n_assign = n * TOP_K
    order = jnp.argsort(flat_e)
    sorted_e = flat_e[order]
    counts = jnp.bincount(flat_e, length=N_EXPERTS)
    padded = ((counts + MOE_BLOCK - 1) // MOE_BLOCK) * MOE_BLOCK
    start = jnp.cumsum(counts) - counts
    pend = jnp.cumsum(padded)
    pstart = pend - padded
    dest = pstart[sorted_e] + (jnp.arange(n_assign) - start[sorted_e])
    cap = n_assign + N_EXPERTS * MOE_BLOCK
    n_blocks = cap // MOE_BLOCK
    buf_tok = jnp.zeros((cap,), jnp.int32).at[dest].set(flat_tok[order])
    buf_gate = jnp.zeros((cap,), jnp.float32).at[dest].set(flat_g[order])
    block_e = jnp.clip(jnp.searchsorted(pend, jnp.arange(n_blocks) * MOE_BLOCK, side='right'), 0, N_EXPERTS - 1)

    def expert_block(args):
        tok, e, gate = args
        hb = hf[tok] @ w1[e] + b1[e]
        glu = jnp.minimum(hb[:, :D_EXPERT], SWIGLU_LIMIT)
        lin = jnp.clip(hb[:, D_EXPERT:], -SWIGLU_LIMIT, SWIGLU_LIMIT)
        act = (lin + 1.0) * glu * jax.nn.sigmoid(SWIGLU_ALPHA * glu)
        return (act @ w2[e] + b2[e]) * gate[:, None].astype(hf.dtype)

    yb = lax.map(expert_block, (buf_tok.reshape(n_blocks, MOE_BLOCK), block_e,
                                buf_gate.reshape(n_blocks, MOE_BLOCK)))
    out = jax.ops.segment_sum(yb.reshape(cap, D), buf_tok, num_segments=n)
    return out.reshape(Bq, T, D).astype(h.dtype)


def setup_inputs(seed: int = 0) -> dict:
    key = jax.random.key(seed)
    ks = jax.random.split(key, 32)
    f32 = jnp.float32
    L = DEPTH

    def nrm(k, shape, scale):
        return jax.random.normal(k, shape, f32) * scale

    return {
        "x": nrm(ks[0], (BATCH, SEQ, D_MODEL), 1.0),
        "mem": nrm(ks[1], (BATCH, MEM_LEN, D_MODEL), 1.0),
        "emb_ln_g": 1.0 + nrm(ks[2], (D_MODEL,), 0.02),
        "emb_ln_b": nrm(ks[3], (D_MODEL,), 0.01),
        "w_in": nrm(ks[4], (L, D_MODEL, IN_WIDTH), D_MODEL ** -0.5),
        "rwkv_mu": jax.random.uniform(ks[5], (L, RWKV_PROJ_WIDTH), f32),
        "rwkv_w0": jax.random.uniform(ks[6], (L, RWKV_WIDTH), f32, -6.0, -1.0),
        "rwkv_w_decay_up": nrm(ks[7], (L, DECAY_LORA, RWKV_WIDTH), DECAY_LORA ** -0.5),
        "rwkv_a0": nrm(ks[8], (L, RWKV_WIDTH), 0.5),
        "rwkv_w_iclr_up": nrm(ks[9], (L, ICLR_LORA, RWKV_WIDTH), ICLR_LORA ** -0.5),
        "rwkv_w_gate_up": nrm(ks[10], (L, GATE_LORA, RWKV_WIDTH), GATE_LORA ** -0.5),
        "rwkv_k_k": 0.85 + nrm(ks[11], (L, RWKV_WIDTH), 0.05),
        "rwkv_k_a": 1.0 + nrm(ks[12], (L, RWKV_WIDTH), 0.05),
        "rwkv_r_k": nrm(ks[13], (L, RWKV_HEADS, RWKV_HEAD_DIM), 0.1),
        "rwkv_gn_g": 1.0 + nrm(ks[14], (L, RWKV_WIDTH), 0.02),
        "rwkv_gn_b": nrm(ks[15], (L, RWKV_WIDTH), 0.01),
        "fox_b_f": jax.random.uniform(ks[16], (L, FOX_HEADS), f32, 1.0, 4.0),
        "mem_ln_g": 1.0 + nrm(ks[17], (D_MODEL,), 0.02),
        "mem_ln_b": nrm(ks[18], (D_MODEL,), 0.01),
        "w_mem_kv": nrm(ks[19], (L, D_MODEL, 2 * MEM_WIDTH), D_MODEL ** -0.5),
        "w_o": nrm(ks[20], (L, MIX_WIDTH, D_MODEL), MIX_WIDTH ** -0.5 * DEEPNORM_BETA),
        "ln1_g": 1.0 + nrm(ks[21], (L, D_MODEL), 0.02),
        "ln1_b": nrm(ks[22], (L, D_MODEL), 0.01),
        "router_w": nrm(ks[23], (L, D_MODEL, N_EXPERTS), D_MODEL ** -0.5),
        "router_b": nrm(ks[24], (L, N_EXPERTS), 0.01),
        "expert_w1": nrm(ks[25], (L, N_EXPERTS, D_MODEL, 2 * D_EXPERT), D_MODEL ** -0.5),
        "expert_b1": nrm(ks[26], (L, N_EXPERTS, 2 * D_EXPERT), 0.01),
        "expert_w2": nrm(ks[27], (L, N_EXPERTS, D_EXPERT, D_MODEL), D_EXPERT ** -0.5 * DEEPNORM_BETA),
        "expert_b2": nrm(ks[28], (L, N_EXPERTS, D_MODEL), 0.01),
        "ln2_g": 1.0 + nrm(ks[29], (L, D_MODEL), 0.02),
        "ln2_b": nrm(ks[30], (L, D_MODEL), 0.01),
    }


def reference(x, mem, emb_ln_g, emb_ln_b, w_in, rwkv_mu, rwkv_w0, rwkv_w_decay_up, rwkv_a0,
              rwkv_w_iclr_up, rwkv_w_gate_up, rwkv_k_k, rwkv_k_a, rwkv_r_k, rwkv_gn_g, rwkv_gn_b,
              fox_b_f, mem_ln_g, mem_ln_b, w_mem_kv, w_o, ln1_g, ln1_b, router_w, router_b,
              expert_w1, expert_b1, expert_w2, expert_b2, ln2_g, ln2_b):
    h = layer_norm(x, emb_ln_g, emb_ln_b)
    mem_n = layer_norm(mem, mem_ln_g, mem_ln_b)
    for l in range(DEPTH):
        p = h @ w_in[l]
        p_rwkv = p[..., :RWKV_PROJ_WIDTH]
        p_fox = p[..., RWKV_PROJ_WIDTH:RWKV_PROJ_WIDTH + FOX_PROJ_WIDTH]
        p_memq = p[..., RWKV_PROJ_WIDTH + FOX_PROJ_WIDTH:]
        y_rwkv = rwkv7_group(p_rwkv, rwkv_mu[l], rwkv_w0[l], rwkv_w_decay_up[l], rwkv_a0[l],
                             rwkv_w_iclr_up[l], rwkv_w_gate_up[l], rwkv_k_k[l], rwkv_k_a[l],
                             rwkv_r_k[l], rwkv_gn_g[l], rwkv_gn_b[l])
        y_fox = fox_group(p_fox, fox_b_f[l])
        y_mem = memory_group(p_memq, mem_n, w_mem_kv[l])
        mixed = jnp.concatenate([y_rwkv, y_fox, y_mem], axis=-1).astype(h.dtype) @ w_o[l]
        h = layer_norm(DEEPNORM_ALPHA * h + mixed, ln1_g[l], ln1_b[l])
        ffn = moe_ffn(h, router_w[l], router_b[l], expert_w1[l], expert_b1[l], expert_w2[l], expert_b2[l])
        h = layer_norm(DEEPNORM_ALPHA * h + ffn, ln2_g[l], ln2_b[l])
    return h.astype(x.dtype)
```

```cpp
#include <hip/hip_runtime.h>
#include <cstdio>
#include <cstdint>

namespace pg8 {
#define PG8_LAS __attribute__((address_space(3)))
typedef unsigned short bf16_t;
typedef short bf16x8 __attribute__((ext_vector_type(8)));
typedef float f32x4 __attribute__((ext_vector_type(4)));
typedef unsigned u32x4 __attribute__((ext_vector_type(4)));
typedef unsigned u32x2 __attribute__((ext_vector_type(2)));
constexpr int BM = 256, BK = 64, HALF = 128, HTB = HALF * BK * 2  , STAGE_BYTES = 8 * HTB, NXCD = 8, WGM = 8;

__host__ __device__ __forceinline__ int lds_byte(int r, int c) { const int st = (r >> 4) * 2 + (c >> 5), rr = r & 15, cc = c & 31, ob = rr * 64 + cc * 2; return st * 1024 + (ob ^ (((ob >> 9) & 1) << 5)); }
__host__ __device__ __forceinline__ void stage_rc(int b, int& R, int& C) { const int st = b / 1024, sb = b % 1024, swz = sb ^ (((sb >> 9) & 1) << 5); R = (st >> 1) * 16 + swz / 64; C = (st & 1) * 32 + (swz % 64) / 2; }
__host__ __device__ __forceinline__ int perm32(int rho) { const int n = rho >> 4, i = rho & 15; return 8 * (i >> 2) + 4 * n + (i & 3); }

struct Unit { int pm, pn; };
struct Gemm { const bf16_t* A; const bf16_t* Bt; int M, N, K; };

struct StaticOrder {
    int nM, nN, nwg, G, c;
    __host__ __device__ void init(int M, int N, int G_, int c_) { nM = M / BM; nN = N / BM; nwg = nM * nN; G = G_; c = c_; }
    __host__ __device__ bool next(int i, Unit& u) const {
        const long L = (long)i * G + c; if (L >= nwg) return false;
        int wgid = (int)L; { const int q = nwg / NXCD, r = nwg % NXCD, xcd = wgid % NXCD, off = wgid / NXCD; wgid = (xcd < r ? xcd * (q + 1) : r * (q + 1) + (xcd - r) * q) + off; }
        const int nig = WGM * nN, gid = wgid / nig, fm = gid * WGM, gsz = (nM - fm) < WGM ? (nM - fm) : WGM;
        u.pm = fm + ((wgid % nig) % gsz); u.pn = (wgid % nig) / gsz; return true;
    }
    __device__ __forceinline__ int arow(const Unit& u, int r) const { return u.pm * BM + r; }
};
struct MoeOrder {
    const int* tile_e; const int* tok; int ntiles, ncol, G, c;
    __device__ __forceinline__ bool next(int i, Unit& u) const {
        const long L = (long)i * G + c; if (L >= (long)ntiles * ncol) return false;
        const int rt = (int)(L / ncol), ct = (int)(L % ncol);
        u.pm = rt; u.pn = __builtin_amdgcn_readfirstlane(tile_e[rt]) * ncol + ct; return true;
    }
    __device__ __forceinline__ int arow(const Unit& u, int r) const { return tok ? tok[u.pm * BM + r] : u.pm * BM + r; }
};

__device__ __forceinline__ unsigned cvt_pk_bf16(float lo, float hi) { unsigned r; asm volatile("v_cvt_pk_bf16_f32 %0, %1, %2" : "=v"(r) : "v"(lo), "v"(hi)); return r; }
__device__ __forceinline__ float bf_lo(unsigned w) { return __builtin_bit_cast(float, w << 16); }
__device__ __forceinline__ float bf_hi(unsigned w) { return __builtin_bit_cast(float, w & 0xffff0000u); }

struct EpiBf16 {
    static constexpr bool PERM = true;
    bf16_t* O; int ldc;
    __device__ __forceinline__ void operator()(const f32x4 (&acc)[2][2][4][2], const Unit& u, int wr, int wc, int fr, int fq) const {
        const int row0 = u.pm * BM + wr * 64 + fr; const int col0 = u.pn * BM + wc * 32 + 8 * fq;
#pragma unroll
        for (int ai = 0; ai < 2; ++ai)
#pragma unroll
            for (int m = 0; m < 4; ++m) { bf16_t* rowp = O + (size_t)(row0 + ai * HALF + m * 16) * ldc + col0;
#pragma unroll
                for (int bj = 0; bj < 2; ++bj) { const f32x4 v0 = acc[ai][bj][m][0], v1 = acc[ai][bj][m][1];
                    u32x4 w; w.x = cvt_pk_bf16(v0[0], v0[1]); w.y = cvt_pk_bf16(v0[2], v0[3]); w.z = cvt_pk_bf16(v1[0], v1[1]); w.w = cvt_pk_bf16(v1[2], v1[3]);
                    *(u32x4*)(rowp + bj * HALF) = w; } }
    }
};
struct EpiResF32 {
    static constexpr bool PERM = false;
    float* C; const bf16_t* R; int ldc; float alpha;
    __device__ __forceinline__ void operator()(const f32x4 (&acc)[2][2][4][2], const Unit& u, int wr, int wc, int fr, int fq) const {
        const int row0 = u.pm * BM + wr * 64 + fr, col0 = u.pn * BM + wc * 32 + 4 * fq;
#pragma unroll
        for (int ai = 0; ai < 2; ++ai)
#pragma unroll
            for (int m = 0; m < 4; ++m) { const size_t ro = (size_t)(row0 + ai * HALF + m * 16) * ldc + col0;
#pragma unroll
                for (int bj = 0; bj < 2; ++bj)
#pragma unroll
                    for (int n = 0; n < 2; ++n) { const u32x2 rr = *(const u32x2*)(R + ro + bj * HALF + n * 16);
                        f32x4 o = acc[ai][bj][m][n]; o[0] += alpha * bf_lo(rr.x); o[1] += alpha * bf_hi(rr.x); o[2] += alpha * bf_lo(rr.y); o[3] += alpha * bf_hi(rr.y);
                        *(f32x4*)(C + ro + bj * HALF + n * 16) = o; } }
    }
};
struct EpiSwiglu {
    static constexpr bool PERM = true;
    bf16_t* O; const float* b1;
    __device__ __forceinline__ void operator()(const f32x4 (&acc)[2][2][4][2], const Unit& u, int wr, int wc, int fr, int fq) const {
        const int e = u.pn >> 4, ct = u.pn & 15;
        const int row0 = u.pm * BM + wr * 64 + fr; const int cl = ct * 128 + wc * 32 + 8 * fq;
        const float* bg = b1 + (size_t)e * 4096 + cl; const float* bl = bg + 2048;
        f32x4 vg[2], vl[2];
#pragma unroll
        for (int n = 0; n < 2; ++n) { vg[n] = *(const f32x4*)(bg + 4 * n); vl[n] = *(const f32x4*)(bl + 4 * n); }
#pragma unroll
        for (int ai = 0; ai < 2; ++ai)
#pragma unroll
            for (int m = 0; m < 4; ++m) { bf16_t* rowp = O + (size_t)(row0 + ai * HALF + m * 16) * 2048 + cl;
                float a[8];
#pragma unroll
                for (int n = 0; n < 2; ++n)
#pragma unroll
                    for (int i = 0; i < 4; ++i) { float g = acc[ai][0][m][n][i] + vg[n][i], l = acc[ai][1][m][n][i] + vl[n][i];
                        g = fminf(g, 7.0f); l = fminf(fmaxf(l, -7.0f), 7.0f);
                        const float sg = __builtin_amdgcn_rcpf(1.0f + __builtin_amdgcn_exp2f(-1.702f * 1.4426950408889634f * g));
                        a[n * 4 + i] = (l + 1.0f) * g * sg; }
                u32x4 w; w.x = cvt_pk_bf16(a[0], a[1]); w.y = cvt_pk_bf16(a[2], a[3]); w.z = cvt_pk_bf16(a[4], a[5]); w.w = cvt_pk_bf16(a[6], a[7]);
                *(u32x4*)rowp = w; }
    }
};
struct EpiGate {
    static constexpr bool PERM = true;
    bf16_t* O; const float* b2; const float* gate;
    __device__ __forceinline__ void operator()(const f32x4 (&acc)[2][2][4][2], const Unit& u, int wr, int wc, int fr, int fq) const {
        const int e = u.pn >> 3, ct = u.pn & 7;
        const int row0 = u.pm * BM + wr * 64 + fr; const int cl = ct * 256 + wc * 32 + 8 * fq;
        const float* bb = b2 + (size_t)e * 2048 + cl;
        f32x4 bv[2][2];
#pragma unroll
        for (int bj = 0; bj < 2; ++bj)
#pragma unroll
            for (int n = 0; n < 2; ++n) bv[bj][n] = *(const f32x4*)(bb + bj * HALF + 4 * n);
#pragma unroll
        for (int ai = 0; ai < 2; ++ai)
#pragma unroll
            for (int m = 0; m < 4; ++m) { const int row = row0 + ai * HALF + m * 16; const float gt = gate[row]; bf16_t* rowp = O + (size_t)row * 2048 + cl;
#pragma unroll
                for (int bj = 0; bj < 2; ++bj) { const f32x4 v0 = (acc[ai][bj][m][0] + bv[bj][0]) * gt, v1 = (acc[ai][bj][m][1] + bv[bj][1]) * gt;
                    u32x4 w; w.x = cvt_pk_bf16(v0[0], v0[1]); w.y = cvt_pk_bf16(v0[2], v0[3]); w.z = cvt_pk_bf16(v1[0], v1[1]); w.w = cvt_pk_bf16(v1[2], v1[3]);
                    *(u32x4*)(rowp + bj * HALF) = w; } }
    }
};

template <class Epi, class Sched, bool ALIGN_EPI = true>
__device__ __forceinline__ void gemm_phase(PG8_LAS unsigned char* lds, const Gemm g, const Sched& S, const Epi& E) {
    const int tid = threadIdx.x, wid = __builtin_amdgcn_readfirstlane(tid >> 6), lane = tid & 63, wr = wid >> 2, wc = wid & 3, fr = lane & 15, fq = lane >> 4;
    const int K = g.K, nt = K / BK;
    int RA[2]; unsigned cA2[2], voffB[2];
#pragma unroll
    for (int i = 0; i < 2; ++i) { int R, C; stage_rc(tid * 16 + i * 8192, R, C); const int Rb = Epi::PERM ? ((R & ~31) + perm32(R & 31)) : R;
        RA[i] = R; cA2[i] = (unsigned)C * 2u; voffB[i] = (unsigned)(Rb * K + C) * 2u; }
    const size_t kstep = (size_t)(BK * 2);
    const size_t hstep = (size_t)HALF * K * 2;
    const size_t tstep = 2 * hstep;
    const unsigned ldsw = (unsigned)wid * 1024u;
    const int aoff = lds_byte(wr * 64 + fr, fq * 8), boff = lds_byte(wc * 32 + fr, fq * 8);
#define PG8_SA(b, h) (((b) * 2 + (h)) * HTB)
#define PG8_SB(b, h) ((4 + (b) * 2 + (h)) * HTB)
#define PG8_STAGE(bufoff, gbase, voff) do { _Pragma("unroll") for (int _i = 0; _i < 2; ++_i) \
        __builtin_amdgcn_global_load_lds((const unsigned*)((const char*)(gbase) + (voff)[_i]), (PG8_LAS unsigned*)(lds + (bufoff) + ldsw + _i * 8192), 16, 0, 0); } while (0)
#define PG8_LDA(dst, b, h) do { _Pragma("unroll") for (int m = 0; m < 4; ++m) _Pragma("unroll") for (int k = 0; k < 2; ++k) dst[m][k] = *(const PG8_LAS bf16x8*)(lds + PG8_SA(b, h) + aoff + m * 2048 + k * 1024); } while (0)
#define PG8_LDB(dst, b, h) do { _Pragma("unroll") for (int n = 0; n < 2; ++n) _Pragma("unroll") for (int k = 0; k < 2; ++k) dst[n][k] = *(const PG8_LAS bf16x8*)(lds + PG8_SB(b, h) + boff + n * 2048 + k * 1024); } while (0)
#define PG8_MMA(ai, bj, At, Bt) do { __builtin_amdgcn_s_setprio(1); _Pragma("unroll") for (int m = 0; m < 4; ++m) _Pragma("unroll") for (int n = 0; n < 2; ++n) _Pragma("unroll") for (int k = 0; k < 2; ++k) \
        acc[ai][bj][m][n] = __builtin_amdgcn_mfma_f32_16x16x32_bf16(Bt[n][k], At[m][k], acc[ai][bj][m][n], 0, 0, 0); __builtin_amdgcn_s_setprio(0); } while (0)
#define PG8_WAIT_V(n) asm volatile("s_waitcnt vmcnt(" #n ")" ::: "memory")
#define PG8_WAIT_L(n) asm volatile("s_waitcnt lgkmcnt(" #n ")" ::: "memory")
#define PG8_BAR __builtin_amdgcn_s_barrier()
#define PG8_SCHED __builtin_amdgcn_sched_barrier(0)
#define PG8_AOFF(dst, u) do { _Pragma("unroll") for (int _h = 0; _h < 2; ++_h) _Pragma("unroll") for (int _i = 0; _i < 2; ++_i) \
        dst[_h][_i] = (unsigned)S.arow(u, _h * HALF + RA[_i]) * (unsigned)(K * 2) + cA2[_i]; } while (0)
    Unit cur, nxt; int ui = 0;
    if (!S.next(0, cur)) return;
    unsigned offC[2][2], offN[2][2];
    PG8_AOFF(offC, cur);
    asm volatile("s_waitcnt vmcnt(0)" ::: "memory");
    f32x4 acc[2][2][4][2];
#pragma unroll
    for (int a = 0; a < 2; ++a)
#pragma unroll
        for (int b = 0; b < 2; ++b)
#pragma unroll
            for (int m = 0; m < 4; ++m)
#pragma unroll
                for (int n = 0; n < 2; ++n) acc[a][b][m][n] = (f32x4){0.f, 0.f, 0.f, 0.f};
    bf16x8 At[4][2], B0[2][2], B1[2][2];
    const char* gA = (const char*)g.A; const char* cB = (const char*)g.Bt + (size_t)cur.pn * tstep;
    PG8_STAGE(PG8_SB(0, 0), cB, voffB); PG8_STAGE(PG8_SB(0, 1), cB + hstep, voffB); PG8_STAGE(PG8_SA(0, 0), gA, offC[0]); PG8_STAGE(PG8_SA(0, 1), gA, offC[1]);
    if (wr == 1) PG8_BAR;
    PG8_WAIT_V(2); PG8_BAR;
    PG8_STAGE(PG8_SB(1, 0), cB + kstep, voffB); PG8_STAGE(PG8_SA(1, 0), gA + kstep, offC[0]); PG8_STAGE(PG8_SB(1, 1), cB + hstep + kstep, voffB);
    PG8_WAIT_V(6); PG8_BAR;
    for (;;) {
        const bool has_next = S.next(ui + 1, nxt);
        if (has_next) { PG8_AOFF(offN, nxt); }
        else {
#pragma unroll
            for (int h = 0; h < 2; ++h)
#pragma unroll
                for (int i = 0; i < 2; ++i) offN[h][i] = offC[h][i]; }
        const char* nB = has_next ? (const char*)g.Bt + (size_t)nxt.pn * tstep : cB;
        for (int t = 0; t < nt; t += 2) {
            const bool last = (t == nt - 2);
            const char* a1 = gA + (size_t)(t + 1) * kstep;
            const char* a2 = last ? gA : gA + (size_t)(t + 2) * kstep; const char* b2 = last ? nB : cB + (size_t)(t + 2) * kstep;
            const char* a3 = a2 + kstep; const char* b3 = b2 + kstep;
            unsigned o2[2][2];
#pragma unroll
            for (int h = 0; h < 2; ++h)
#pragma unroll
                for (int i = 0; i < 2; ++i) o2[h][i] = last ? offN[h][i] : offC[h][i];
            PG8_LDB(B0, 0, 0); PG8_LDB(B1, 0, 1); PG8_SCHED; PG8_LDA(At, 0, 0); PG8_STAGE(PG8_SA(1, 1), a1, offC[1]);
            PG8_WAIT_V(8); PG8_WAIT_L(0); PG8_BAR; PG8_MMA(0, 0, At, B0); PG8_MMA(0, 1, At, B1); PG8_BAR; PG8_SCHED;
            PG8_LDA(At, 0, 1); PG8_STAGE(PG8_SB(0, 0), b2, voffB); PG8_STAGE(PG8_SB(0, 1), b2 + hstep, voffB); PG8_STAGE(PG8_SA(0, 0), a2, o2[0]);
            PG8_WAIT_V(8); PG8_WAIT_L(0); PG8_BAR; PG8_MMA(1, 0, At, B0); PG8_MMA(1, 1, At, B1); PG8_BAR; PG8_SCHED;
            PG8_LDB(B0, 1, 0); PG8_LDB(B1, 1, 1); PG8_SCHED; PG8_LDA(At, 1, 0); PG8_STAGE(PG8_SA(0, 1), a2, o2[1]);
            PG8_WAIT_V(8); PG8_WAIT_L(0); PG8_BAR; PG8_MMA(0, 0, At, B0); PG8_MMA(0, 1, At, B1); PG8_BAR; PG8_SCHED;
            PG8_LDA(At, 1, 1); PG8_STAGE(PG8_SB(1, 0), b3, voffB); PG8_STAGE(PG8_SB(1, 1), b3 + hstep, voffB); PG8_STAGE(PG8_SA(1, 0), a3, o2[0]);
            PG8_WAIT_V(8); PG8_WAIT_L(0); PG8_BAR; PG8_MMA(1, 0, At, B0); PG8_MMA(1, 1, At, B1); PG8_BAR; PG8_SCHED;
        }
        if constexpr (ALIGN_EPI) { if (wr == 0) PG8_BAR; }
        E(acc, cur, wr, wc, fr, fq);
        if (!has_next) break;
#pragma unroll
        for (int a = 0; a < 2; ++a)
#pragma unroll
            for (int b = 0; b < 2; ++b)
#pragma unroll
                for (int m = 0; m < 4; ++m)
#pragma unroll
                    for (int n = 0; n < 2; ++n) acc[a][b][m][n] = (f32x4){0.f, 0.f, 0.f, 0.f};
        cur = nxt; cB = nB; ++ui;
#pragma unroll
        for (int h = 0; h < 2; ++h)
#pragma unroll
            for (int i = 0; i < 2; ++i) offC[h][i] = offN[h][i];
        if constexpr (ALIGN_EPI) { if (wr == 1) PG8_BAR; }
    }
    PG8_WAIT_V(0);
    if constexpr (!ALIGN_EPI) { if (wr == 0) PG8_BAR; }
    PG8_BAR;
#undef PG8_SA
#undef PG8_SB
#undef PG8_STAGE
#undef PG8_LDA
#undef PG8_LDB
#undef PG8_MMA
#undef PG8_WAIT_V
#undef PG8_WAIT_L
#undef PG8_BAR
#undef PG8_SCHED
#undef PG8_AOFF
}
}
#define GAS __attribute__((address_space(1)))
#define LAS __attribute__((address_space(3)))
typedef unsigned short bf16;
typedef unsigned v4u __attribute__((ext_vector_type(4)));
typedef float f32x4 __attribute__((ext_vector_type(4)));
typedef short bf16x8 __attribute__((ext_vector_type(8)));
typedef GAS unsigned gu32;
typedef GAS unsigned long long gu64;
#define RLX_AGENT __ATOMIC_RELAXED, __HIP_MEMORY_SCOPE_AGENT
#define LDS_WAIT() asm volatile("s_waitcnt lgkmcnt(0)" ::: "memory")
#define VM_WAIT() asm volatile("s_waitcnt vmcnt(0)" ::: "memory")
__device__ __forceinline__ unsigned long long rt() { return __builtin_amdgcn_s_memrealtime(); }
__device__ __forceinline__ unsigned f2bf(float f) { unsigned u = __builtin_bit_cast(unsigned, f); return (u + 0x7fffu + ((u >> 16) & 1u)) >> 16; }
__device__ __forceinline__ unsigned pk2(float lo, float hi) { return f2bf(lo) | (f2bf(hi) << 16); }

#define XB_TMO      128
#define XB_XCNT(j)  (256  + 64 * (j))
#define XB_XSUB(j)  (1280 + 64 * (j))
#define XB_XGEN(j)  (2304 + 64 * (j))
#define XB_TOP      3328
#define XB_TOPGEN   3392
#define XCD_BAR_WORDS 3456
#define XB_SPIN_CAP (1u << 18)

__device__ __forceinline__ unsigned xb_ld(unsigned* p)              { return __hip_atomic_load(p, __ATOMIC_RELAXED, __HIP_MEMORY_SCOPE_AGENT); }
__device__ __forceinline__ unsigned xb_add(unsigned* p, unsigned v) { return __hip_atomic_fetch_add(p, v, __ATOMIC_RELAXED, __HIP_MEMORY_SCOPE_AGENT); }
__device__ __forceinline__ unsigned xb_xcc_id() { return (unsigned)__builtin_amdgcn_s_getreg((3 << 11) | 20) & 0xFu; }
#define XB_SPIN(cond, bar) do { unsigned _sp = 0; while (cond) { __builtin_amdgcn_s_sleep(1); \
    if ((++_sp & 255u) == 0u) { if (xb_ld(&(bar)[XB_TMO])) break; if (_sp > XB_SPIN_CAP) { atomicAdd(&(bar)[XB_TMO], 1u); break; } } } } while (0)

struct XcdBarrier {
    unsigned* bar; unsigned x;
    volatile LAS unsigned* st;
};

__device__ __forceinline__ XcdBarrier xcd_barrier_post(unsigned* bar, volatile LAS unsigned* st) {
    XcdBarrier b; b.bar = bar; b.x = xb_xcc_id(); b.st = st;
    if (threadIdx.x == 0) (void)xb_add(&bar[XB_XCNT(b.x)], 1u);
    return b;
}
__device__ __forceinline__ void xcd_barrier_complete(unsigned* bar, unsigned x, unsigned& nloc, unsigned& nx) {
    const unsigned G = gridDim.x * gridDim.y * gridDim.z;
    unsigned sum, cnt, mine, sp = 0u;
    for (;;) {
        sum = 0u; cnt = 0u; mine = 0u;
#pragma unroll
        for (unsigned j = 0; j < 16; ++j) { const unsigned c = xb_ld(&bar[XB_XCNT(j)]); sum += c; cnt += (c > 0u) ? 1u : 0u; mine = (j == x) ? c : mine; }
        if (sum == G) break;
        __builtin_amdgcn_s_sleep(1);
        if ((++sp & 255u) == 0u) { if (xb_ld(&bar[XB_TMO])) break; if (sp > XB_SPIN_CAP) { atomicAdd(&bar[XB_TMO], 1u); break; } }
    }
    nloc = mine > 0u ? mine : 1u; nx = cnt > 0u ? cnt : 1u;
}

__device__ __forceinline__ void xcd_barrier(const XcdBarrier& b) {
    asm volatile("s_waitcnt vmcnt(0)" ::: "memory");
    __syncthreads();
    if (threadIdx.x == 0) {
        unsigned* bar = b.bar;
        __builtin_amdgcn_s_waitcnt(0);
        unsigned nloc = b.st[0], nx = b.st[1];
        if (nloc == 0u) { xcd_barrier_complete(bar, b.x, nloc, nx); b.st[0] = nloc; b.st[1] = nx; }
        const unsigned old = xb_add(&bar[XB_XSUB(b.x)], 1u);
        const unsigned gen = old / nloc;
        if (old + 1u == (gen + 1u) * nloc) {
            __builtin_amdgcn_fence(__ATOMIC_RELEASE, "agent");
            asm volatile("s_waitcnt vmcnt(0)" ::: "memory");
            const unsigned og = xb_add(&bar[XB_TOP], 1u);
            const unsigned tg = og / nx;
            if (og + 1u == (tg + 1u) * nx) xb_add(&bar[XB_TOPGEN], 1u);
            else XB_SPIN(xb_ld(&bar[XB_TOPGEN]) == tg, bar);
            __builtin_amdgcn_fence(__ATOMIC_ACQUIRE, "agent");
            xb_add(&bar[XB_XGEN(b.x)], 1u);
            asm volatile("s_waitcnt vmcnt(0)" ::: "memory");
        } else {
            XB_SPIN(xb_ld(&bar[XB_XGEN(b.x)]) == gen, bar);
            __builtin_amdgcn_fence(__ATOMIC_ACQUIRE, "agent");
            asm volatile("s_waitcnt vmcnt(0)" ::: "memory");
        }
    }
    __syncthreads();
}


constexpr int NB = 2, T = 16384, NTOK = NB * T, D = 2048;
constexpr int PW = 5632;
constexpr int C_R = 0, C_K = 1024, C_V = 2048, C_DW = 3072, C_DA = 3168, C_DG = 3264, C_FQ = 3520, C_FK = 4032, C_FV = 4544, C_FF = 5056, C_MQ = 5064, IN_W = 5576;
constexpr int NE = 32, CAP = 131072 + 8192, MAXT = CAP / 256;
constexpr int MEM_LEN = 256;
constexpr float LN_EPS = 1e-5f, GN_EPS = 64e-5f, ALPHA = 1.189207115002721f, LOG2E = 1.4426950408889634f;
constexpr int NWAVES = 8, NTHR = 512;

constexpr size_t MiB = 1u << 20;
constexpr size_t WS_CTL = 0, CTL_ZERO_BYTES = 1 * MiB;
constexpr size_t WS_WI = 2 * MiB, WS_WO = 24 * MiB, WS_WKV = 32 * MiB, WS_RWT = 36 * MiB, WS_MEMN = 37 * MiB, WS_KVM = 39 * MiB, WS_C = 40 * MiB  ;
constexpr size_t WS_ROUTE = 42 * MiB;
constexpr size_t RT_TOPI = WS_ROUTE, RT_TOPG = RT_TOPI + 512 * 1024, RT_POS = RT_TOPG + 512 * 1024, RT_CNT = RT_POS + 512 * 1024, RT_TOK = RT_CNT + 64 * 1024, RT_GATE = RT_TOK + 1024 * 1024, RT_TILE = RT_GATE + 1024 * 1024;
constexpr size_t WS_W1 = 48 * MiB, WS_W2 = 560 * MiB, WS_H0 = 816 * MiB, WS_H1 = 944 * MiB, WS_MIX = 1072 * MiB, WS_Z1 = 1200 * MiB, WS_P = 1456 * MiB;
constexpr size_t WS_RW = 1808 * MiB, RW_ARR = 128 * MiB;
constexpr size_t WS_ACT = 2960 * MiB, WS_Y = 3504 * MiB, WS_END = 4048 * MiB;
constexpr int CW_BAR = 4096;

constexpr int LDS_BYTES = 147456, MISC_OFF = LDS_BYTES - 256;

struct Args { const float* in[31]; float* out; unsigned char* ws; int ph_lo, ph_hi; };

__device__ __forceinline__ float wave_sum(float v) {
#pragma unroll
    for (int o = 1; o < 64; o <<= 1) v += __shfl_xor(v, o);
    return v;
}
__device__ __forceinline__ float bfl(unsigned w) { return __builtin_bit_cast(float, w << 16); }
__device__ __forceinline__ float bfh(unsigned w) { return __builtin_bit_cast(float, w & 0xffff0000u); }
__device__ __forceinline__ float bf1(bf16 h) { return __builtin_bit_cast(float, (unsigned)h << 16); }
__device__ __forceinline__ float sigmoidf_(float x) { return 1.0f / (1.0f + __expf(-x)); }

__device__ __forceinline__ void ln_row(f32x4 (&v)[8], const float* g, const float* b, float eps, int lane) {
    float s = 0.f;
#pragma unroll
    for (int j = 0; j < 8; ++j) s += (v[j].x + v[j].y) + (v[j].z + v[j].w);
    const float mean = wave_sum(s) * (1.f / D); float s2 = 0.f;
#pragma unroll
    for (int j = 0; j < 8; ++j) { v[j] = v[j] - mean; s2 += (v[j].x * v[j].x + v[j].y * v[j].y) + (v[j].z * v[j].z + v[j].w * v[j].w); }
    const float rstd = 1.f / sqrtf(wave_sum(s2) * (1.f / D) + eps);
#pragma unroll
    for (int j = 0; j < 8; ++j) { const f32x4 gg = *(const f32x4*)(g + 4 * lane + 256 * j), bb = *(const f32x4*)(b + 4 * lane + 256 * j); v[j] = v[j] * rstd * gg + bb; }
}
__device__ __forceinline__ void store_row_bf16(bf16* orow, const f32x4 (&v)[8], int lane) {
#pragma unroll
    for (int j = 0; j < 8; ++j) { pg8::u32x2 w; w.x = pk2(v[j].x, v[j].y); w.y = pk2(v[j].z, v[j].w); *(pg8::u32x2*)(orow + 4 * lane + 256 * j) = w; }
}

template <class RowMap>
__device__ __forceinline__ void transpose_item(const float* W, int ldw, int nvalid, int K, bf16* WT, const RowMap& rm, LAS float* scr, int k0, int n0, int lane) {
#pragma unroll 4
    for (int it = 0; it < 16; ++it) { const int k = 4 * it + (lane >> 4), nl = 4 * (lane & 15), n = n0 + nl;
        f32x4 v = (f32x4){0.f, 0.f, 0.f, 0.f}; if (n < nvalid) v = *(const f32x4*)(W + (size_t)(k0 + k) * ldw + n);
        LAS float* s = scr + k * 65 + nl; s[0] = v.x; s[1] = v.y; s[2] = v.z; s[3] = v.w; }
    LDS_WAIT(); asm volatile("" ::: "memory");
    const int c = lane & 7;
#pragma unroll
    for (int j = 0; j < 8; ++j) { const int nl = 8 * j + (lane >> 3); const LAS float* s = scr + (8 * c) * 65 + nl;
        v4u o; o.x = pk2(s[0 * 65], s[1 * 65]); o.y = pk2(s[2 * 65], s[3 * 65]); o.z = pk2(s[4 * 65], s[5 * 65]); o.w = pk2(s[6 * 65], s[7 * 65]);
        *(v4u*)(WT + (size_t)rm(n0 + nl) * K + k0 + 8 * c) = o; }
    LDS_WAIT(); asm volatile("" ::: "memory");
}
struct RmId { int off; __device__ __forceinline__ int operator()(int n) const { return off + n; } };
struct RmW1 { int off; __device__ __forceinline__ int operator()(int n) const { const int l = n >= 2048, c = n - 2048 * l; return off + (c >> 7) * 256 + 128 * l + (c & 127); } };

__device__ __forceinline__ void p0_prologue(const Args& A, LAS unsigned char* lds, int vcu, int G, int wave, int lane) {
    unsigned char* ws = A.ws;
    LAS float* scr = (LAS float*)(lds + wave * 16640);
    const int gw = vcu * NWAVES + wave, NGW = G * NWAVES;
    constexpr int I_WI = 32 * 88, I_WO = 32 * 32, I_WKV = 32 * 16, I_W1 = 32 * 32 * 64, I_W2 = 32 * 32 * 32;
    constexpr int NITEMS = I_WI + I_WO + I_WKV + I_W1 + I_W2;
    for (int it = gw; it < NITEMS; it += NGW) {
        int r = it;
        if (r < I_WI) { transpose_item(A.in[4], IN_W, IN_W, D, (bf16*)(ws + WS_WI), RmId{0}, scr, 64 * (r / 88), 64 * (r % 88), lane); continue; } r -= I_WI;
        if (r < I_WO) { transpose_item(A.in[20], D, D, D, (bf16*)(ws + WS_WO), RmId{0}, scr, 64 * (r / 32), 64 * (r % 32), lane); continue; } r -= I_WO;
        if (r < I_WKV) { transpose_item(A.in[19], 1024, 1024, D, (bf16*)(ws + WS_WKV), RmId{0}, scr, 64 * (r / 16), 64 * (r % 16), lane); continue; } r -= I_WKV;
        if (r < I_W1) { const int e = r / 2048, q = r % 2048; transpose_item(A.in[25] + (size_t)e * D * 4096, 4096, 4096, D, (bf16*)(ws + WS_W1), RmW1{e * 4096}, scr, 64 * (q / 64), 64 * (q % 64), lane); continue; } r -= I_W1;
        { const int e = r / 1024, q = r % 1024; transpose_item(A.in[27] + (size_t)e * D * D, D, D, D, (bf16*)(ws + WS_W2), RmId{e * D}, scr, 64 * (q / 32), 64 * (q % 32), lane); }
    }
    { float* rwt = (float*)(ws + WS_RWT); const float* rw = A.in[23];
      for (int i = gw * 64 + lane; i < D * NE; i += NGW * 64) { const int e = i / D, d = i % D; rwt[i] = rw[d * NE + e]; } }
    for (int m = gw; m < NTOK + NB * MEM_LEN; m += NGW) {
        const bool ismem = m >= NTOK; const int r = ismem ? m - NTOK : m;
        const float* xr = (ismem ? A.in[1] : A.in[0]) + (size_t)r * D;
        f32x4 v[8];
#pragma unroll
        for (int j = 0; j < 8; ++j) v[j] = *(const f32x4*)(xr + 4 * lane + 256 * j);
        ln_row(v, ismem ? A.in[17] : A.in[2], ismem ? A.in[18] : A.in[3], LN_EPS, lane);
        store_row_bf16((bf16*)(ws + (ismem ? WS_MEMN : WS_H0)) + (size_t)r * D, v, lane);
    }
}

__device__ __forceinline__ void p2_rwkv_prep(const Args& A, LAS unsigned char* lds, int vcu, int G, int tid, int wave, int lane) {
    unsigned char* ws = A.ws;
    const bf16* P = (const bf16*)(ws + WS_P);
    const float* mu = A.in[5];
    LAS float* LIN = (LAS float*)lds;
    float* aR = (float*)(ws + WS_RW), *aDEC = aR + (size_t)NTOK * 1024, *aK2 = aDEC + (size_t)NTOK * 1024, *aV = aK2 + (size_t)NTOK * 1024, *aAV = aV + (size_t)NTOK * 1024,
          *aBV = aAV + (size_t)NTOK * 1024, *aG = aBV + (size_t)NTOK * 1024, *aBO = aG + (size_t)NTOK * 1024;
    for (int tile = vcu; tile < NTOK / 16; tile += G) {
        const int row0 = tile * 16;
        __syncthreads();
        for (int idx = tid; idx < 16 * 448; idx += NTHR) {
            const int tk = idx / 448, k = idx % 448, row = row0 + tk, col = C_DW + k;
            const float pt = bf1(P[(size_t)row * PW + col]); const float pp = (row % T) ? bf1(P[(size_t)(row - 1) * PW + col]) : 0.f;
            const float ps = pt + mu[col] * (pp - pt);
            LIN[k * 16 + tk] = k < 96 ? tanhf(ps) : (k < 192 ? ps : sigmoidf_(ps));
        }
        __syncthreads();
        for (int hh = 0; hh < 2; ++hh) {
            const int h = wave * 2 + hh, col = h * 64 + lane;
            float aw[16], aa[16], ag[16];
#pragma unroll
            for (int i = 0; i < 16; ++i) { aw[i] = 0.f; aa[i] = 0.f; ag[i] = 0.f; }
            const float* Wd = A.in[7] + col; const float* Wa = A.in[9] + col; const float* Wg = A.in[10] + col;
            for (int k = 0; k < 96; ++k) { const float w = Wd[k * 1024]; const LAS f32x4* x = (const LAS f32x4*)(LIN + k * 16);
#pragma unroll
                for (int q = 0; q < 4; ++q) { const f32x4 xv = x[q]; aw[4 * q] += w * xv.x; aw[4 * q + 1] += w * xv.y; aw[4 * q + 2] += w * xv.z; aw[4 * q + 3] += w * xv.w; } }
            for (int k = 0; k < 96; ++k) { const float w = Wa[k * 1024]; const LAS f32x4* x = (const LAS f32x4*)(LIN + (96 + k) * 16);
#pragma unroll
                for (int q = 0; q < 4; ++q) { const f32x4 xv = x[q]; aa[4 * q] += w * xv.x; aa[4 * q + 1] += w * xv.y; aa[4 * q + 2] += w * xv.z; aa[4 * q + 3] += w * xv.w; } }
            for (int k = 0; k < 256; ++k) { const float w = Wg[k * 1024]; const LAS f32x4* x = (const LAS f32x4*)(LIN + (192 + k) * 16);
#pragma unroll
                for (int q = 0; q < 4; ++q) { const f32x4 xv = x[q]; ag[4 * q] += w * xv.x; ag[4 * q + 1] += w * xv.y; ag[4 * q + 2] += w * xv.z; ag[4 * q + 3] += w * xv.w; } }
            const float w0 = A.in[6][col], a0 = A.in[8][col], kkw = A.in[11][col], kaw = A.in[12][col], rkw = A.in[13][col];
            const float mur = mu[C_R + col], muk = mu[C_K + col], muv = mu[C_V + col];
#pragma unroll
            for (int i = 0; i < 16; ++i) {
                const int row = row0 + i; const bf16* pr = P + (size_t)row * PW; const bool hp = (row % T) != 0; const bf16* pq = pr - PW;
                float r = bf1(pr[C_R + col]), k = bf1(pr[C_K + col]), v = bf1(pr[C_V + col]);
                const float r1 = hp ? bf1(pq[C_R + col]) : 0.f, k1 = hp ? bf1(pq[C_K + col]) : 0.f, v1 = hp ? bf1(pq[C_V + col]) : 0.f;
                r += mur * (r1 - r); k += muk * (k1 - k); v += muv * (v1 - v);
                const float xw = -(w0 + aw[i]);
                const float sp = fmaxf(xw, 0.f) + log1pf(__expf(-fabsf(xw)));
                const float dec = __expf(-__expf(-sp - 0.5f));
                const float a = sigmoidf_(a0 + aa[i]);
                float kk = k * kkw; const float nrm = sqrtf(wave_sum(kk * kk)); kk = kk / fmaxf(nrm, 1e-12f);
                const float k2 = k * (1.0f + (a - 1.0f) * kaw);
                const float bon = wave_sum(r * k2 * rkw) * v;
                const size_t o = (size_t)row * 1024 + col;
                aR[o] = r; aDEC[o] = dec; aK2[o] = k2; aV[o] = v; aAV[o] = -kk; aBV[o] = kk * a; aG[o] = ag[i]; aBO[o] = bon;
            }
        }
    }
}
__device__ __forceinline__ void p2_fox_cumsum(const Args& A, LAS unsigned char* lds, int vcu, int G, int tid) {
    const bf16* P = (const bf16*)(A.ws + WS_P); double* C = (double*)(A.ws + WS_C);
    LAS double* part = (LAS double*)(lds + 32768);
    for (int bh = vcu; bh < 16; bh += G) {
        const int b = bh >> 3, h = bh & 7; const float bf = A.in[16][h];
        float lf[32]; double s = 0.0;
#pragma unroll
        for (int i = 0; i < 32; ++i) { const float x = bf1(P[(size_t)(b * T + tid * 32 + i) * PW + C_FF + h]) + bf;
            lf[i] = -(fmaxf(-x, 0.f) + log1pf(__expf(-fabsf(x)))); s += (double)lf[i]; }
        __syncthreads();
        part[tid] = s;
        __syncthreads();
        double pre = 0.0;
        for (int j = 0; j < tid; ++j) pre += part[j];
        double* c = C + (size_t)bh * T + tid * 32;
#pragma unroll
        for (int i = 0; i < 32; ++i) { pre += (double)lf[i]; c[i] = pre; }
    }
}

__device__ __forceinline__ int crow(int r, int hi) { return (r & 3) + 8 * (r >> 2) + 4 * hi; }
typedef float f32x16 __attribute__((ext_vector_type(16)));
typedef short s16x4 __attribute__((ext_vector_type(4)));
template <int DH, bool FOX>
__device__ __forceinline__ void attn_unit(const bf16* Qp, int qpitch, const bf16* Kp, const bf16* Vp, int kvpitch, bf16* Op, int opitch, int q0, int jlo, int jhi,
                                          const double* cseq, float scale2, LAS unsigned char* lds, int tid, int wave, int lane) {
    constexpr int KROW = (DH + 8) * 2, VROW = 144, NP = DH / 64;
    LAS unsigned char* KS = lds; LAS unsigned char* VT = lds + 64 * KROW; LAS float* CB = (LAS float*)(VT + DH * VROW); LAS float* WSF = CB + 64 + wave * 32;
    const int r32 = lane & 31, hi = lane >> 5;
    bf16x8 qr[DH / 16];
#pragma unroll
    for (int d0 = 0; d0 < DH / 16; ++d0) qr[d0] = *(const bf16x8*)(Qp + (size_t)(32 * wave + r32) * qpitch + d0 * 16 + hi * 8);
    f32x16 o[DH / 32];
#pragma unroll
    for (int d = 0; d < DH / 32; ++d)
#pragma unroll
        for (int r = 0; r < 16; ++r) o[d][r] = 0.f;
    float m = -1e30f, l = 0.f;
    const int qpos = q0 + 32 * wave + r32;
    double cref = 0.0; if (FOX) cref = cseq[q0];
    v4u kreg[NP], vreg[NP]; float cbv = 0.f;
#define ATT_LOAD(j) do { _Pragma("unroll") for (int p = 0; p < NP; ++p) { const int idx = tid + p * NTHR, row = idx / (DH / 8), ch = idx % (DH / 8); \
        kreg[p] = *(const v4u*)(Kp + (size_t)((j) * 64 + row) * kvpitch + ch * 8); vreg[p] = *(const v4u*)(Vp + (size_t)((j) * 64 + row) * kvpitch + ch * 8); } \
        if (FOX && tid < 64) cbv = (float)(cref - cseq[(j) * 64 + tid]) * LOG2E; } while (0)
    ATT_LOAD(jlo);
    for (int j = jlo; j < jhi; ++j) {
        __syncthreads();
#pragma unroll
        for (int p = 0; p < NP; ++p) { const int idx = tid + p * NTHR, row = idx / (DH / 8), ch = idx % (DH / 8);
            *(LAS v4u*)(KS + row * KROW + ch * 16) = kreg[p];
            LAS bf16* vt = (LAS bf16*)(VT + (ch * 8) * VROW + row * 2);
            const unsigned w0 = vreg[p].x, w1 = vreg[p].y, w2 = vreg[p].z, w3 = vreg[p].w;
            vt[0 * (VROW / 2)] = (bf16)w0; vt[1 * (VROW / 2)] = (bf16)(w0 >> 16); vt[2 * (VROW / 2)] = (bf16)w1; vt[3 * (VROW / 2)] = (bf16)(w1 >> 16);
            vt[4 * (VROW / 2)] = (bf16)w2; vt[5 * (VROW / 2)] = (bf16)(w2 >> 16); vt[6 * (VROW / 2)] = (bf16)w3; vt[7 * (VROW / 2)] = (bf16)(w3 >> 16); }
        if (FOX && tid < 64) CB[tid] = cbv;
        __syncthreads();
        if (j + 1 < jhi) ATT_LOAD(j + 1);
        f32x16 p[2];
#pragma unroll
        for (int kh = 0; kh < 2; ++kh) {
#pragma unroll
            for (int r = 0; r < 16; ++r) p[kh][r] = 0.f;
#pragma unroll
            for (int d0 = 0; d0 < DH / 16; ++d0) { const bf16x8 a = *(const LAS bf16x8*)(KS + (32 * kh + r32) * KROW + (16 * d0 + 8 * hi) * 2);
                p[kh] = __builtin_amdgcn_mfma_f32_32x32x16_bf16(a, qr[d0], p[kh], 0, 0, 0); }
        }
        const bool diag = FOX && (j * 64 + 63 > q0);
        float mx = -1e30f;
#pragma unroll
        for (int kh = 0; kh < 2; ++kh)
#pragma unroll
            for (int g = 0; g < 4; ++g) { f32x4 cb = (f32x4){0.f, 0.f, 0.f, 0.f}; if (FOX) cb = *(const LAS f32x4*)(CB + 32 * kh + 8 * g + 4 * hi);
#pragma unroll
                for (int i = 0; i < 4; ++i) { const int r = 4 * g + i; float v = p[kh][r] * scale2 + cb[i];
                    if (diag && (j * 64 + 32 * kh + 8 * g + 4 * hi + i > qpos)) v = -1e30f;
                    p[kh][r] = v; mx = fmaxf(mx, v); } }
        mx = fmaxf(mx, __shfl_xor(mx, 32));
        const float mn = fmaxf(m, mx), corr = __builtin_amdgcn_exp2f(m - mn); m = mn;
        float ls = 0.f;
#pragma unroll
        for (int kh = 0; kh < 2; ++kh)
#pragma unroll
            for (int r = 0; r < 16; ++r) { const float e = __builtin_amdgcn_exp2f(p[kh][r] - mn); p[kh][r] = e; ls += e; }
        l = l * corr + ls;
        if (__any(corr != 1.0f)) {
            if (hi == 0) WSF[r32] = corr;
#pragma unroll
            for (int g = 0; g < 4; ++g) { const f32x4 c4 = *(const LAS f32x4*)(WSF + 8 * g + 4 * hi);
#pragma unroll
                for (int d = 0; d < DH / 32; ++d) { o[d][4 * g] *= c4.x; o[d][4 * g + 1] *= c4.y; o[d][4 * g + 2] *= c4.z; o[d][4 * g + 3] *= c4.w; } }
        }
        bf16x8 pa[4];
#pragma unroll
        for (int s = 0; s < 4; ++s) { const int kh = s >> 1, b8 = 8 * (s & 1); v4u w;
            w.x = pg8::cvt_pk_bf16(p[kh][b8 + 0], p[kh][b8 + 1]); w.y = pg8::cvt_pk_bf16(p[kh][b8 + 2], p[kh][b8 + 3]);
            w.z = pg8::cvt_pk_bf16(p[kh][b8 + 4], p[kh][b8 + 5]); w.w = pg8::cvt_pk_bf16(p[kh][b8 + 6], p[kh][b8 + 7]);
            pa[s] = __builtin_bit_cast(bf16x8, w); }
#pragma unroll
        for (int d = 0; d < DH / 32; ++d)
#pragma unroll
            for (int s = 0; s < 4; ++s) { const LAS unsigned char* vp = VT + (32 * d + r32) * VROW + (16 * s + 4 * hi) * 2;
                const s16x4 lo = *(const LAS s16x4*)vp, hh = *(const LAS s16x4*)(vp + 16);
                const bf16x8 vf = (bf16x8){lo[0], lo[1], lo[2], lo[3], hh[0], hh[1], hh[2], hh[3]};
                o[d] = __builtin_amdgcn_mfma_f32_32x32x16_bf16(pa[s], vf, o[d], 0, 0, 0); }
    }
#undef ATT_LOAD
    l += __shfl_xor(l, 32);
    if (hi == 0) WSF[r32] = 1.0f / l;
    float rli[16];
#pragma unroll
    for (int g = 0; g < 4; ++g) { const f32x4 c4 = *(const LAS f32x4*)(WSF + 8 * g + 4 * hi); rli[4 * g] = c4.x; rli[4 * g + 1] = c4.y; rli[4 * g + 2] = c4.z; rli[4 * g + 3] = c4.w; }
#pragma unroll
    for (int r = 0; r < 16; ++r) { bf16* orow = Op + (size_t)(32 * wave + crow(r, hi)) * opitch + r32;
#pragma unroll
        for (int d = 0; d < DH / 32; ++d) orow[32 * d] = (bf16)f2bf(o[d][r] * rli[r]); }
    __syncthreads();
}

__device__ __forceinline__ void p3_scan(const Args& A, LAS unsigned char* lds, int bh, int lane) {
    const float* aR = (const float*)(A.ws + WS_RW), *aDEC = aR + (size_t)NTOK * 1024, *aK2 = aDEC + (size_t)NTOK * 1024, *aV = aK2 + (size_t)NTOK * 1024, *aAV = aV + (size_t)NTOK * 1024,
                *aBV = aAV + (size_t)NTOK * 1024; float* aY = (float*)(A.ws + WS_RW) + (size_t)8 * NTOK * 1024;
    const int b = bh >> 4, h = bh & 15;
    size_t o = (size_t)b * T * 1024 + h * 64 + lane;
    LAS float* buf = (LAS float*)lds;
    float S[64];
#pragma unroll
    for (int j = 0; j < 64; ++j) S[j] = 0.f;
    float ra = aAV[o], rw = aDEC[o], rb = aBV[o], rk = aK2[o], rr = aR[o], rv = aV[o];
    for (int t = 0; t < T; ++t) {
        LAS float* cb = buf + (t & 1) * 320;
        cb[lane] = ra; cb[64 + lane] = rw; cb[128 + lane] = rb; cb[192 + lane] = rk; cb[256 + lane] = rr;
        const float v = rv; const size_t oc = o; o += 1024;
        if (t + 1 < T) { ra = aAV[o]; rw = aDEC[o]; rb = aBV[o]; rk = aK2[o]; rr = aR[o]; rv = aV[o]; }
        float sa = 0.f;
#pragma unroll
        for (int q = 0; q < 16; ++q) { const f32x4 a4 = *(const LAS f32x4*)(cb + 4 * q); sa += S[4 * q] * a4.x + S[4 * q + 1] * a4.y + S[4 * q + 2] * a4.z + S[4 * q + 3] * a4.w; }
        float y = 0.f;
#pragma unroll
        for (int q = 0; q < 16; ++q) { const f32x4 w4 = *(const LAS f32x4*)(cb + 64 + 4 * q), b4 = *(const LAS f32x4*)(cb + 128 + 4 * q), k4 = *(const LAS f32x4*)(cb + 192 + 4 * q), r4 = *(const LAS f32x4*)(cb + 256 + 4 * q);
            S[4 * q] = S[4 * q] * w4.x + (sa * b4.x + v * k4.x); S[4 * q + 1] = S[4 * q + 1] * w4.y + (sa * b4.y + v * k4.y);
            S[4 * q + 2] = S[4 * q + 2] * w4.z + (sa * b4.z + v * k4.z); S[4 * q + 3] = S[4 * q + 3] * w4.w + (sa * b4.w + v * k4.w);
            y += S[4 * q] * r4.x + S[4 * q + 1] * r4.y + S[4 * q + 2] * r4.z + S[4 * q + 3] * r4.w; }
        aY[oc] = y;
    }
}
__device__ __forceinline__ void p3_attention(const Args& A, LAS unsigned char* lds, int idx0, int stride, int tid, int wave, int lane) {
    unsigned char* ws = A.ws; const bf16* P = (const bf16*)(ws + WS_P); bf16* MIX = (bf16*)(ws + WS_MIX); const bf16* KVM = (const bf16*)(ws + WS_KVM); const double* C = (const double*)(ws + WS_C);
    for (int u = idx0; u < 1024; u += stride) {
        if (u < 512) {
            const int bh = u >> 5, s = u & 31, b = bh >> 3, h = bh & 7;
            for (int w = 0; w < 2; ++w) { const int qb = w ? 63 - s : s, q0 = qb * 256; const size_t rowb = (size_t)b * T;
                attn_unit<64, true>(P + (rowb + q0) * PW + C_FQ + h * 64, PW, P + rowb * PW + C_FK + h * 64, P + rowb * PW + C_FV + h * 64, PW,
                                    MIX + (rowb + q0) * D + 1024 + h * 64, D, q0, 0, q0 / 64 + 4, C + (size_t)bh * T, 0.125f * LOG2E, lds, tid, wave, lane); }
        } else {
            const int v = u - 512, b = v >> 8, h = (v >> 6) & 3, qb = v & 63, q0 = qb * 256; const size_t rowb = (size_t)b * T;
            attn_unit<128, false>(P + (rowb + q0) * PW + C_MQ + h * 128, PW, KVM + (size_t)b * MEM_LEN * 1024 + h * 128, KVM + (size_t)b * MEM_LEN * 1024 + 512 + h * 128, 1024,
                                  MIX + (rowb + q0) * D + 1536 + h * 128, D, q0, 0, 4, nullptr, 0.08838834764831845f * LOG2E, lds, tid, wave, lane);
        }
    }
}
__device__ __forceinline__ void p3b_finalize(const Args& A, int vcu, int G, int wave, int lane) {
    const float* base = (const float*)(A.ws + WS_RW); const float* aG = base + (size_t)6 * NTOK * 1024, *aBO = base + (size_t)7 * NTOK * 1024, *aY = base + (size_t)8 * NTOK * 1024;
    bf16* MIX = (bf16*)(A.ws + WS_MIX);
    const int gw = vcu * NWAVES + wave, NGW = G * NWAVES;
    for (int it = gw; it < NTOK * 16; it += NGW) {
        const int row = it >> 4, h = it & 15, col = h * 64 + lane; const size_t o = (size_t)row * 1024 + col;
        const float y = aY[o]; const float mean = wave_sum(y) * (1.f / 64.f); const float dv = y - mean; const float var = wave_sum(dv * dv) * (1.f / 64.f);
        const float yn = dv * (1.0f / sqrtf(var + GN_EPS)) * A.in[14][col] + A.in[15][col];
        MIX[(size_t)row * D + col] = (bf16)f2bf((yn + aBO[o]) * aG[o]);
    }
}

__device__ __forceinline__ void p5_ln_router(const Args& A, LAS unsigned char* lds, int vcu, int G, int tid, int wave, int lane) {
    unsigned char* ws = A.ws; const float* Z1 = (const float*)(ws + WS_Z1); bf16* H1 = (bf16*)(ws + WS_H1); const float* RWT = (const float*)(ws + WS_RWT);
    int* TOPI = (int*)(ws + RT_TOPI); float* TOPG = (float*)(ws + RT_TOPG); int* CNT = (int*)(ws + RT_CNT);
    LAS int* hist = (LAS int*)lds;
    for (int batch = vcu; batch < NTOK / 128; batch += G) {
        __syncthreads();
        if (tid < NE) hist[tid] = 0;
        __syncthreads();
        for (int pr = 0; pr < 8; ++pr) {
            const int row0 = batch * 128 + wave * 16 + pr * 2;
            f32x4 v0[8], v1[8];
#pragma unroll
            for (int j = 0; j < 8; ++j) { v0[j] = *(const f32x4*)(Z1 + (size_t)row0 * D + 4 * lane + 256 * j); v1[j] = *(const f32x4*)(Z1 + (size_t)(row0 + 1) * D + 4 * lane + 256 * j); }
            ln_row(v0, A.in[21], A.in[22], LN_EPS, lane); ln_row(v1, A.in[21], A.in[22], LN_EPS, lane);
            store_row_bf16(H1 + (size_t)row0 * D, v0, lane); store_row_bf16(H1 + (size_t)(row0 + 1) * D, v1, lane);
            float lg = 0.f;
#pragma unroll 1
            for (int eb = 0; eb < NE; eb += 4) {
                float pl[8];
#pragma unroll
                for (int e = 0; e < 4; ++e) { float s0 = 0.f, s1 = 0.f;
#pragma unroll
                    for (int j = 0; j < 8; ++j) { const f32x4 w = *(const f32x4*)(RWT + (size_t)(eb + e) * D + 4 * lane + 256 * j);
                        s0 += v0[j].x * w.x + v0[j].y * w.y + v0[j].z * w.z + v0[j].w * w.w; s1 += v1[j].x * w.x + v1[j].y * w.y + v1[j].z * w.z + v1[j].w * w.w; }
                    pl[e] = s0; pl[4 + e] = s1; }
#pragma unroll
                for (int st = 0; st < 3; ++st) { const int half = 4 >> st; const bool up = (lane & half) != 0;
#pragma unroll
                    for (int i = 0; i < half; ++i) { const float keep = up ? pl[i + half] : pl[i], give = up ? pl[i] : pl[i + half]; pl[i] = keep + __shfl_xor(give, half); } }
                float tot = pl[0]; tot += __shfl_xor(tot, 8); tot += __shfl_xor(tot, 16); tot += __shfl_xor(tot, 32);
                const float mine = __shfl(tot, (lane & 3) + 4 * (lane >> 5));
                if (((lane & 31) >> 2) == (eb >> 2)) lg = mine;
            }
            const float logit = lg + A.in[24][lane & 31];
            float tv[4]; int ti[4]; float cur = logit;
#pragma unroll
            for (int k = 0; k < 4; ++k) { float bv = cur; int bi = lane & 31;
#pragma unroll
                for (int o = 1; o < 32; o <<= 1) { const float ov = __shfl_xor(bv, o); const int oi = __shfl_xor(bi, o); if (ov > bv || (ov == bv && oi < bi)) { bv = ov; bi = oi; } }
                tv[k] = bv; ti[k] = bi; if ((lane & 31) == bi) cur = -INFINITY; }
            const float e0 = 1.f, e1 = __expf(tv[1] - tv[0]), e2 = __expf(tv[2] - tv[0]), e3 = __expf(tv[3] - tv[0]); const float inv = 1.f / (e0 + e1 + e2 + e3);
            if ((lane & 31) < 4) { const int k = lane & 3, row = row0 + (lane >> 5);
                const int ei = k == 0 ? ti[0] : k == 1 ? ti[1] : k == 2 ? ti[2] : ti[3]; const float gv = (k == 0 ? e0 : k == 1 ? e1 : k == 2 ? e2 : e3) * inv;
                TOPI[row * 4 + k] = ei; TOPG[row * 4 + k] = gv; __hip_atomic_fetch_add(hist + ei, 1, __ATOMIC_RELAXED, __HIP_MEMORY_SCOPE_WORKGROUP); }
        }
        __syncthreads();
        if (tid < NE) CNT[batch * NE + tid] = hist[tid];
    }
}
__device__ __forceinline__ void p6_positions(const Args& A, LAS unsigned char* lds, int vcu, int G, int tid) {
    unsigned char* ws = A.ws; const int* TOPI = (const int*)(ws + RT_TOPI); const float* TOPG = (const float*)(ws + RT_TOPG); const int* CNT = (const int*)(ws + RT_CNT);
    int* POS = (int*)(ws + RT_POS); int* BTOK = (int*)(ws + RT_TOK); float* BGATE = (float*)(ws + RT_GATE); int* TILE = (int*)(ws + RT_TILE);
    LAS int* sh = (LAS int*)lds;
    for (int batch = vcu; batch < NTOK / 128; batch += G) {
        __syncthreads();
        { const int e = tid & 31, seg = tid >> 5; int sb = 0, st = 0;
          for (int q = 0; q < 16; ++q) { const int bb = seg * 16 + q; const int c = CNT[bb * NE + e]; st += c; if (bb < batch) sb += c; }
          sh[tid] = sb; sh[1152 + tid] = st; }
        sh[640 + tid] = TOPI[batch * 512 + tid];
        __syncthreads();
        if (tid < NE) { int sb = 0, st = 0; for (int s = 0; s < 16; ++s) { sb += sh[s * 32 + tid]; st += sh[1152 + s * 32 + tid]; } sh[512 + tid] = sb; sh[544 + tid] = st; }
        __syncthreads();
        if (tid == 0) { int acc = 0; for (int e = 0; e < NE; ++e) { sh[576 + e] = acc; acc += (sh[544 + e] + 255) >> 8; } sh[576 + NE] = acc; }
        __syncthreads();
        { const int e = sh[640 + tid]; int rank = 0; for (int j = 0; j < tid; ++j) rank += (sh[640 + j] == e) ? 1 : 0;
          const int dest = sh[576 + e] * 256 + sh[512 + e] + rank;
          BTOK[dest] = batch * 128 + (tid >> 2); BGATE[dest] = TOPG[batch * 512 + tid]; POS[batch * 512 + tid] = dest; }
        if (batch < NE) { const int e = batch; const int lo = sh[576 + e] * 256 + sh[544 + e], hi = sh[576 + e + 1] * 256;
            for (int i = lo + tid; i < hi; i += NTHR) { BTOK[i] = 0; BGATE[i] = 0.f; }
            for (int rt = sh[576 + e] + tid; rt < sh[576 + e + 1]; rt += NTHR) TILE[rt] = e; }
        if (batch == 0 && tid == 0) TILE[MAXT] = sh[576 + NE];
    }
}
__device__ __forceinline__ void p9_final(const Args& A, int vcu, int G, int wave, int lane) {
    unsigned char* ws = A.ws; const bf16* H1 = (const bf16*)(ws + WS_H1); const bf16* Y = (const bf16*)(ws + WS_Y); const int* POS = (const int*)(ws + RT_POS);
    const int gw = vcu * NWAVES + wave, NGW = G * NWAVES;
    for (int row = gw; row < NTOK; row += NGW) {
        f32x4 v[8]; const int p0 = POS[row * 4], p1 = POS[row * 4 + 1], p2 = POS[row * 4 + 2], p3 = POS[row * 4 + 3];
#pragma unroll
        for (int j = 0; j < 8; ++j) { const int c = 4 * lane + 256 * j;
            const pg8::u32x2 h = *(const pg8::u32x2*)(H1 + (size_t)row * D + c), y0 = *(const pg8::u32x2*)(Y + (size_t)p0 * D + c), y1 = *(const pg8::u32x2*)(Y + (size_t)p1 * D + c),
                             y2 = *(const pg8::u32x2*)(Y + (size_t)p2 * D + c), y3 = *(const pg8::u32x2*)(Y + (size_t)p3 * D + c);
            v[j].x = ALPHA * bfl(h.x) + ((bfl(y0.x) + bfl(y1.x)) + (bfl(y2.x) + bfl(y3.x))); v[j].y = ALPHA * bfh(h.x) + ((bfh(y0.x) + bfh(y1.x)) + (bfh(y2.x) + bfh(y3.x)));
            v[j].z = ALPHA * bfl(h.y) + ((bfl(y0.y) + bfl(y1.y)) + (bfl(y2.y) + bfl(y3.y))); v[j].w = ALPHA * bfh(h.y) + ((bfh(y0.y) + bfh(y1.y)) + (bfh(y2.y) + bfh(y3.y))); }
        ln_row(v, A.in[29], A.in[30], LN_EPS, lane);
#pragma unroll
        for (int j = 0; j < 8; ++j) *(f32x4*)(A.out + (size_t)row * D + 4 * lane + 256 * j) = v[j];
    }
}

constexpr int NPH = 11;
template <int PLO, int PHI>
__global__ void __launch_bounds__(NTHR, 2) fwd_kernel(Args args) {
    extern __shared__ __attribute__((aligned(16))) unsigned char lds_raw[];
    LAS unsigned char* lds = (LAS unsigned char*)lds_raw;
    const int tid = threadIdx.x, lane = tid & 63, wave = __builtin_amdgcn_readfirstlane(tid >> 6);
    const int G = gridDim.x; const int bx = blockIdx.x; const int vcu = (G % 8 == 0) ? (bx % 8) * (G / 8) + bx / 8 : bx;
    volatile LAS unsigned* MISC = (volatile LAS unsigned*)(lds + MISC_OFF);
    if (tid < 64) MISC[tid] = 0u;
    __syncthreads();
    unsigned char* ws = args.ws;
    unsigned* ctl = (unsigned*)(ws + WS_CTL);
    constexpr int lo = PLO, hi = PHI;
    XcdBarrier bar; bar.bar = ctl + CW_BAR; bar.x = 0; bar.st = nullptr;
    if (hi - lo > 1) bar = xcd_barrier_post(ctl + CW_BAR, MISC + 8);
#define IN(k) (lo <= (k) && (k) < hi)
#define SEAM(k) do { if constexpr (IN(k) && IN((k) + 1)) xcd_barrier(bar); } while (0)

    if constexpr (IN(0)) { p0_prologue(args, lds, vcu, G, wave, lane); }
    SEAM(0);
    if constexpr (IN(1)) {
        pg8::Gemm g{(const bf16*)(ws + WS_H0), (const bf16*)(ws + WS_WI), NTOK, PW, D}; pg8::StaticOrder S; S.init(NTOK, PW, G, bx);
        pg8::EpiBf16 E{(bf16*)(ws + WS_P), PW};
        pg8::gemm_phase<pg8::EpiBf16, pg8::StaticOrder>(lds, g, S, E);
    }
    SEAM(1);
    if constexpr (IN(2)) {
        { pg8::Gemm g{(const bf16*)(ws + WS_MEMN), (const bf16*)(ws + WS_WKV), NB * MEM_LEN, 1024, D}; pg8::StaticOrder S; S.init(NB * MEM_LEN, 1024, G, bx);
          pg8::EpiBf16 E{(bf16*)(ws + WS_KVM), 1024};
          pg8::gemm_phase<pg8::EpiBf16, pg8::StaticOrder>(lds, g, S, E); }
        __syncthreads();
        p2_fox_cumsum(args, lds, (vcu + G - 16) % G, G, tid);
        __syncthreads();
        p2_rwkv_prep(args, lds, vcu, G, tid, wave, lane);
    }
    SEAM(2);
    if constexpr (IN(3)) {
        if (G >= 64) { if (bx < 32) { if (wave == 0) p3_scan(args, lds, bx, lane); } else p3_attention(args, lds, bx - 32, G - 32, tid, wave, lane); }
        else { p3_attention(args, lds, bx, G, tid, wave, lane); if (wave == 0) for (int q = bx; q < 32; q += G) p3_scan(args, lds, q, lane); }
    }
    SEAM(3);
    if constexpr (IN(4)) { p3b_finalize(args, vcu, G, wave, lane); }
    SEAM(4);
    if constexpr (IN(5)) {
        pg8::Gemm g{(const bf16*)(ws + WS_MIX), (const bf16*)(ws + WS_WO), NTOK, D, D}; pg8::StaticOrder S; S.init(NTOK, D, G, bx);
        pg8::EpiResF32 E{(float*)(ws + WS_Z1), (const bf16*)(ws + WS_H0), D, ALPHA};
        pg8::gemm_phase<pg8::EpiResF32, pg8::StaticOrder>(lds, g, S, E);
    }
    SEAM(5);
    if constexpr (IN(6)) { p5_ln_router(args, lds, vcu, G, tid, wave, lane); }
    SEAM(6);
    if constexpr (IN(7)) { p6_positions(args, lds, vcu, G, tid); }
    SEAM(7);
    if constexpr (IN(8)) {
        const int* TILE = (const int*)(ws + RT_TILE); const int ntiles = __builtin_amdgcn_readfirstlane(TILE[MAXT]);
        pg8::Gemm g{(const bf16*)(ws + WS_H1), (const bf16*)(ws + WS_W1), CAP, NE * 4096, D};
        pg8::MoeOrder S{TILE, (const int*)(ws + RT_TOK), ntiles, 16, G, bx};
        pg8::EpiSwiglu E{(bf16*)(ws + WS_ACT), args.in[26]};
        pg8::gemm_phase<pg8::EpiSwiglu, pg8::MoeOrder>(lds, g, S, E);
    }
    SEAM(8);
    if constexpr (IN(9)) {
        const int* TILE = (const int*)(ws + RT_TILE); const int ntiles = __builtin_amdgcn_readfirstlane(TILE[MAXT]);
        pg8::Gemm g{(const bf16*)(ws + WS_ACT), (const bf16*)(ws + WS_W2), CAP, NE * D, D};
        pg8::MoeOrder S{TILE, nullptr, ntiles, 8, G, bx};
        pg8::EpiGate E{(bf16*)(ws + WS_Y), args.in[28], (const float*)(ws + RT_GATE)};
        pg8::gemm_phase<pg8::EpiGate, pg8::MoeOrder>(lds, g, S, E);
    }
    SEAM(9);
    if constexpr (IN(10)) { p9_final(args, vcu, G, wave, lane); }
#undef IN
#undef SEAM
}

template <int P> static void launch_phase(int grid, hipStream_t stream, const Args& a) {
    static bool init = false;
    if (!init) { (void)hipFuncSetAttribute((const void*)fwd_kernel<P, P + 1>, hipFuncAttributeMaxDynamicSharedMemorySize, LDS_BYTES); init = true; }
    hipLaunchKernelGGL((fwd_kernel<P, P + 1>), dim3(grid), dim3(NTHR), LDS_BYTES, stream, a);
}
extern "C" void kernel_launch(void* const* d_in, const int* in_sizes, int n_in, void* d_out, int out_size, void* d_ws, size_t ws_size, hipStream_t stream) {
    static int grid = 0;
    if (grid == 0) {
        if (n_in != 31 || out_size != NTOK * D || ws_size < WS_END) { fprintf(stderr, "kernel_launch: unexpected shapes (n_in %d out %d ws %zu, need %zu)\n", n_in, out_size, ws_size, (size_t)WS_END); grid = -1; return; }
        int dev = 0, cus = 0;
        if (hipGetDevice(&dev) != hipSuccess || hipDeviceGetAttribute(&cus, hipDeviceAttributeMultiprocessorCount, dev) != hipSuccess) { grid = -1; return; }
        grid = cus;
    }
    if (grid < 0) return;
    (void)hipMemsetAsync((char*)d_ws + WS_CTL, 0, CTL_ZERO_BYTES, stream);
    Args a{};
    for (int i = 0; i < 31; ++i) a.in[i] = (const float*)d_in[i];
    a.out = (float*)d_out; a.ws = (unsigned char*)d_ws;
    launch_phase<0>(grid, stream, a); launch_phase<1>(grid, stream, a); launch_phase<2>(grid, stream, a); launch_phase<3>(grid, stream, a);
    launch_phase<4>(grid, stream, a); launch_phase<5>(grid, stream, a); launch_phase<6>(grid, stream, a); launch_phase<7>(grid, stream, a);
    launch_phase<8>(grid, stream, a); launch_phase<9>(grid, stream, a); launch_phase<10>(grid, stream, a);
}
```

```cpp
#define ONE_LAUNCH 1
#include <hip/hip_runtime.h>
#include <cstdio>
#include <cstdint>

namespace pg8 {
#define PG8_LAS __attribute__((address_space(3)))
typedef unsigned short bf16_t;
typedef short bf16x8 __attribute__((ext_vector_type(8)));
typedef float f32x4 __attribute__((ext_vector_type(4)));
typedef unsigned u32x4 __attribute__((ext_vector_type(4)));
typedef unsigned u32x2 __attribute__((ext_vector_type(2)));
typedef int v4i32 __attribute__((ext_vector_type(4)));
typedef int v8i32 __attribute__((ext_vector_type(8)));
constexpr int SCALE_W = 0x79797979, SCALE_A = 0x7f7f7f7f;
constexpr int BM = 256, BK = 64, HALF = 128, HTB = HALF * BK * 2  , STAGE_BYTES = 8 * HTB, NXCD = 8, WGM = 8;

__host__ __device__ __forceinline__ int lds_byte(int r, int c) { const int st = (r >> 4) * 2 + (c >> 5), rr = r & 15, cc = c & 31, ob = rr * 64 + cc * 2; return st * 1024 + (ob ^ (((ob >> 9) & 1) << 5)); }
__host__ __device__ __forceinline__ void stage_rc(int b, int& R, int& C) { const int st = b / 1024, sb = b % 1024, swz = sb ^ (((sb >> 9) & 1) << 5); R = (st >> 1) * 16 + swz / 64; C = (st & 1) * 32 + (swz % 64) / 2; }
__host__ __device__ __forceinline__ int perm32(int rho) { const int n = rho >> 4, i = rho & 15; return 8 * (i >> 2) + 4 * n + (i & 3); }

struct Unit { int pm, pn; };
struct Gemm { const bf16_t* A; const bf16_t* Bt; int M, N, K; };

struct StaticOrder {
    int nM, nN, nwg, G, c;
    __host__ __device__ void init(int M, int N, int G_, int c_) { nM = M / BM; nN = N / BM; nwg = nM * nN; G = G_; c = c_; }
    __host__ __device__ bool next(int i, Unit& u) const {
        const long L = (long)i * G + c; if (L >= nwg) return false;
        int wgid = (int)L; { const int q = nwg / NXCD, r = nwg % NXCD, xcd = wgid % NXCD, off = wgid / NXCD; wgid = (xcd < r ? xcd * (q + 1) : r * (q + 1) + (xcd - r) * q) + off; }
        const int nig = WGM * nN, gid = wgid / nig, fm = gid * WGM, gsz = (nM - fm) < WGM ? (nM - fm) : WGM;
        u.pm = fm + ((wgid % nig) % gsz); u.pn = (wgid % nig) / gsz; return true;
    }
    static constexpr bool GATHER = false;
    __device__ __forceinline__ int arow(const Unit& u, int r) const { return u.pm * BM + r; }
};
struct QueueOrder {
    int nM, nN, nwg, x; unsigned* qhead; volatile PG8_LAS int* slot; mutable int pend;
    __device__ void init(int M, int N, int x_, unsigned* q_, volatile PG8_LAS int* s_, int pend_) { nM = M / BM; nN = N / BM; nwg = nM * nN; x = x_; qhead = q_; slot = s_; pend = pend_; }
    __device__ __forceinline__ int pop() const { return 8 * (int)__hip_atomic_fetch_add(qhead + 64 * x, 1u, __ATOMIC_RELAXED, __HIP_MEMORY_SCOPE_AGENT) + x; }
    __device__ __forceinline__ bool next(int i, Unit& u) const {
        const int L = __builtin_amdgcn_readfirstlane(slot[i % 3]);
        if (threadIdx.x == 0) { slot[(i + 2) % 3] = pend; pend = pop(); }
        if (L >= nwg) return false;
        int wgid = L; { const int q = nwg / NXCD, r = nwg % NXCD, xcd = wgid % NXCD, off = wgid / NXCD; wgid = (xcd < r ? xcd * (q + 1) : r * (q + 1) + (xcd - r) * q) + off; }
        const int nig = WGM * nN, gid = wgid / nig, fm = gid * WGM, gsz = (nM - fm) < WGM ? (nM - fm) : WGM;
        u.pm = fm + ((wgid % nig) % gsz); u.pn = (wgid % nig) / gsz; return true;
    }
    static constexpr bool GATHER = false;
    __device__ __forceinline__ int arow(const Unit& u, int r) const { return u.pm * BM + r; }
};
template <bool GATHER_> struct MoeOrder {
    static constexpr bool GATHER = GATHER_;
    const int* tile_e; const int* tok; int ntiles, ncol, G, c;
    __device__ __forceinline__ bool next(int i, Unit& u) const {
        int rt, ct;
        if ((G & 7) == 0 && ((G >> 3) % ncol) == 0) {
            const int R = G / ncol, x = c & 7, j = c >> 3;
            rt = i * R + x * (R >> 3) + j / ncol; ct = j % ncol; if (rt >= ntiles) return false;
        } else { const long L = (long)i * G + c; if (L >= (long)ntiles * ncol) return false; rt = (int)(L / ncol); ct = (int)(L % ncol); }
        u.pm = rt; u.pn = __builtin_amdgcn_readfirstlane(tile_e[rt]) * ncol + ct; return true;
    }
    __device__ __forceinline__ int arow(const Unit& u, int r) const { return (GATHER_ && tok) ? tok[u.pm * BM + r] : u.pm * BM + r; }
};

typedef float f32x2_t __attribute__((ext_vector_type(2))); typedef __bf16 bf16x2_t __attribute__((ext_vector_type(2)));
__device__ __forceinline__ unsigned cvt_pk_bf16(float lo, float hi) { const f32x2_t v = {lo, hi}; const bf16x2_t b = __builtin_convertvector(v, bf16x2_t); return __builtin_bit_cast(unsigned, b); }
__device__ __forceinline__ float bf_lo(unsigned w) { return __builtin_bit_cast(float, w << 16); }
__device__ __forceinline__ float bf_hi(unsigned w) { return __builtin_bit_cast(float, w & 0xffff0000u); }

__device__ __forceinline__ unsigned pk4_fp8(float a, float b, float c, float d) { unsigned w = 0u; w = __builtin_amdgcn_cvt_pk_fp8_f32(a, b, w, false); w = __builtin_amdgcn_cvt_pk_fp8_f32(c, d, w, true); return w; }
template <class T> __device__ __forceinline__ T* sbase(T* p) { asm volatile("" : "+s"(p)); return p; }
__device__ __forceinline__ unsigned vopaque(unsigned v) { asm volatile("" : "+v"(v)); return v; }
struct EpiBf16 {
    static constexpr bool PERM = true;
    bf16_t* O; int ldc;
    __device__ __forceinline__ void operator()(const f32x4 (&acc)[2][2][4][2], const Unit& u, int wr, int wc, int fr, int fq) const {
        const unsigned lo = vopaque(((unsigned)(wr * 64 + fr) * (unsigned)ldc + (unsigned)(wc * 32 + 8 * fq)) * 2u);
#pragma unroll
        for (int ai = 0; ai < 2; ++ai)
#pragma unroll
            for (int m = 0; m < 4; ++m) { char* rb = (char*)sbase(O + (size_t)(u.pm * BM + ai * HALF + m * 16) * ldc + u.pn * BM);
#pragma unroll
                for (int bj = 0; bj < 2; ++bj) { const f32x4 v0 = acc[ai][bj][m][0], v1 = acc[ai][bj][m][1];
                    u32x4 w; w.x = cvt_pk_bf16(v0[0], v0[1]); w.y = cvt_pk_bf16(v0[2], v0[3]); w.z = cvt_pk_bf16(v1[0], v1[1]); w.w = cvt_pk_bf16(v1[2], v1[3]);
                    *(u32x4*)(rb + bj * HALF * 2 + lo) = w; } }
    }
};
struct EpiResBf16 {
    static constexpr bool PERM = true;
    bf16_t* C; const bf16_t* R; int ldc; float alpha;
    __device__ __forceinline__ void operator()(const f32x4 (&acc)[2][2][4][2], const Unit& u, int wr, int wc, int fr, int fq) const {
        const unsigned lo = vopaque(((unsigned)(wr * 64 + fr) * (unsigned)ldc + (unsigned)(wc * 32 + 8 * fq)) * 2u);
#pragma unroll
        for (int ai = 0; ai < 2; ++ai)
#pragma unroll
            for (int m = 0; m < 4; ++m) { const size_t ro = (size_t)(u.pm * BM + ai * HALF + m * 16) * ldc + u.pn * BM; char* cb = (char*)sbase(C + ro); const char* rb = (const char*)sbase(R + ro);
#pragma unroll
                for (int bj = 0; bj < 2; ++bj) { const u32x4 rr = *(const u32x4*)(rb + bj * HALF * 2 + lo); const f32x4 v0 = acc[ai][bj][m][0], v1 = acc[ai][bj][m][1];
                    u32x4 w; w.x = cvt_pk_bf16(v0[0] + alpha * bf_lo(rr.x), v0[1] + alpha * bf_hi(rr.x)); w.y = cvt_pk_bf16(v0[2] + alpha * bf_lo(rr.y), v0[3] + alpha * bf_hi(rr.y));
                    w.z = cvt_pk_bf16(v1[0] + alpha * bf_lo(rr.z), v1[1] + alpha * bf_hi(rr.z)); w.w = cvt_pk_bf16(v1[2] + alpha * bf_lo(rr.w), v1[3] + alpha * bf_hi(rr.w));
                    *(u32x4*)(cb + bj * HALF * 2 + lo) = w; } }
    }
};
struct EpiSwiglu {
    static constexpr bool PERM = true;
    unsigned char* O; const float* b1;
    __device__ __forceinline__ void operator()(const f32x4 (&acc)[2][2][4][2], const Unit& u, int wr, int wc, int fr, int fq) const {
        const int e = u.pn >> 4, ct = u.pn & 15;
        const unsigned lc = vopaque((unsigned)(wc * 32 + 8 * fq)), lo = vopaque((unsigned)(wr * 64 + fr) * 2048u) + lc;
        const char* bg = (const char*)sbase(b1 + (size_t)e * 4096 + ct * 128); const char* bl = (const char*)sbase(b1 + (size_t)e * 4096 + 2048 + ct * 128);
        f32x4 vg[2], vl[2];
#pragma unroll
        for (int n = 0; n < 2; ++n) { vg[n] = *(const f32x4*)(bg + n * 16 + lc * 4u); vl[n] = *(const f32x4*)(bl + n * 16 + lc * 4u); }
#pragma unroll
        for (int ai = 0; ai < 2; ++ai)
#pragma unroll
            for (int m = 0; m < 4; ++m) { unsigned char* rb = sbase(O + (size_t)(u.pm * BM + ai * HALF + m * 16) * 2048 + ct * 128);
                float a[8];
#pragma unroll
                for (int n = 0; n < 2; ++n)
#pragma unroll
                    for (int i = 0; i < 4; ++i) { float g = acc[ai][0][m][n][i] + vg[n][i], l = acc[ai][1][m][n][i] + vl[n][i];
                        g = fminf(g, 7.0f); l = fminf(fmaxf(l, -7.0f), 7.0f);
                        const float sg = __builtin_amdgcn_rcpf(1.0f + __builtin_amdgcn_exp2f(-1.702f * 1.4426950408889634f * g));
                        a[n * 4 + i] = (l + 1.0f) * g * sg; }
                u32x2 w; w.x = pk4_fp8(a[0], a[1], a[2], a[3]); w.y = pk4_fp8(a[4], a[5], a[6], a[7]);
                *(u32x2*)(rb + lo) = w; }
    }
};
struct EpiGate {
    static constexpr bool PERM = true;
    unsigned char* O; const float* b2; const float* gate;
    __device__ __forceinline__ void operator()(const f32x4 (&acc)[2][2][4][2], const Unit& u, int wr, int wc, int fr, int fq) const {
        const int e = u.pn >> 3, ct = u.pn & 7;
        const unsigned lr = vopaque((unsigned)(wr * 64 + fr)), lc = vopaque((unsigned)(wc * 32 + 8 * fq)), lo = lr * 2048u + lc;
        const char* bb = (const char*)sbase(b2 + (size_t)e * 2048 + ct * 256);
#pragma unroll
        for (int ai = 0; ai < 2; ++ai)
#pragma unroll
            for (int m = 0; m < 4; ++m) { const int rg = u.pm * BM + ai * HALF + m * 16; const float gt = 64.0f * *(const float*)((const char*)sbase(gate + rg) + lr * 4u);
                unsigned char* rb = sbase(O + (size_t)rg * 2048 + ct * 256);
#pragma unroll
                for (int bj = 0; bj < 2; ++bj) { const f32x4 c0 = *(const f32x4*)(bb + bj * HALF * 4 + lc * 4u), c1 = *(const f32x4*)(bb + bj * HALF * 4 + 16 + lc * 4u);
                    const f32x4 v0 = (acc[ai][bj][m][0] + c0) * gt, v1 = (acc[ai][bj][m][1] + c1) * gt;
                    u32x2 w; w.x = pk4_fp8(v0[0], v0[1], v0[2], v0[3]); w.y = pk4_fp8(v1[0], v1[1], v1[2], v1[3]);
                    *(u32x2*)(rb + bj * HALF + lo) = w; } }
    }
};

template <class Epi, class Sched, bool ALIGN_EPI = true, bool FP8 = false>
__device__ __forceinline__ void gemm_phase(PG8_LAS unsigned char* lds, const Gemm g, const Sched& S, const Epi& E) {
    int tid = threadIdx.x; asm volatile("" : "+v"(tid));
    const int wid = __builtin_amdgcn_readfirstlane(tid >> 6), lane = tid & 63, wr = wid >> 2, wc = wid & 3, fr = lane & 15, fq = lane >> 4;
    const int K = g.K, nt = K / BK;
    int RA[2]; unsigned cA2[2], voffB[2];
#pragma unroll
    for (int i = 0; i < 2; ++i) { int R, C; stage_rc(tid * 16 + i * 8192, R, C); const int Rb = Epi::PERM ? ((R & ~31) + perm32(R & 31)) : R;
        RA[i] = R; cA2[i] = (unsigned)C * 2u; voffB[i] = (unsigned)(Rb * K + C) * 2u; }
    const size_t kstep = (size_t)(BK * 2);
    const size_t hstep = (size_t)HALF * K * 2;
    const size_t tstep = 2 * hstep;
    const unsigned ldsw = (unsigned)wid * 1024u;
    const int aoff = lds_byte(wr * 64 + fr, fq * 8), boff = lds_byte(wc * 32 + fr, fq * 8);
#define PG8_SA(b, h) (((b) * 2 + (h)) * HTB)
#define PG8_SB(b, h) ((4 + (b) * 2 + (h)) * HTB)
#define PG8_STAGE(bufoff, gbase, voff) do { const char* _gb = (const char*)(gbase); asm volatile("" : "+s"(_gb)); _Pragma("unroll") for (int _i = 0; _i < 2; ++_i) { \
        unsigned _vo = (voff)[_i]; asm volatile("" : "+v"(_vo));     \
        __builtin_amdgcn_global_load_lds((const unsigned*)(_gb + _vo), (PG8_LAS unsigned*)(lds + (bufoff) + ldsw + _i * 8192), 16, 0, 0); } } while (0)
#define PG8_LD32(p) __builtin_shufflevector(*(const PG8_LAS v4i32*)(p), *(const PG8_LAS v4i32*)((p) + 1024), 0, 1, 2, 3, 4, 5, 6, 7)
#define PG8_LDA(dst, b, h) do { _Pragma("unroll") for (int m = 0; m < 4; ++m) dst[m] = PG8_LD32(lds + PG8_SA(b, h) + aoff + m * 2048); } while (0)
#define PG8_LDB(dst, b, h) do { _Pragma("unroll") for (int n = 0; n < 2; ++n) dst[n] = PG8_LD32(lds + PG8_SB(b, h) + boff + n * 2048); } while (0)
#define PG8_H0(x) __builtin_bit_cast(bf16x8, __builtin_shufflevector(x, x, 0, 1, 2, 3))
#define PG8_H1(x) __builtin_bit_cast(bf16x8, __builtin_shufflevector(x, x, 4, 5, 6, 7))
#define PG8_MMA(ai, bj, At, Bt) do { __builtin_amdgcn_s_setprio(1); _Pragma("unroll") for (int m = 0; m < 4; ++m) _Pragma("unroll") for (int n = 0; n < 2; ++n) { \
        if constexpr (FP8) acc[ai][bj][m][n] = __builtin_amdgcn_mfma_scale_f32_16x16x128_f8f6f4(Bt[n], At[m], acc[ai][bj][m][n], 0, 0, 0, SCALE_W, 0, SCALE_A); \
        else { acc[ai][bj][m][n] = __builtin_amdgcn_mfma_f32_16x16x32_bf16(PG8_H0(Bt[n]), PG8_H0(At[m]), acc[ai][bj][m][n], 0, 0, 0); \
               acc[ai][bj][m][n] = __builtin_amdgcn_mfma_f32_16x16x32_bf16(PG8_H1(Bt[n]), PG8_H1(At[m]), acc[ai][bj][m][n], 0, 0, 0); } } \
        __builtin_amdgcn_s_setprio(0); } while (0)
#define PG8_WAIT_V(n) asm volatile("s_waitcnt vmcnt(" #n ")" ::: "memory")
#define PG8_WAIT_L(n) asm volatile("s_waitcnt lgkmcnt(" #n ")" ::: "memory")
#define PG8_BAR __builtin_amdgcn_s_barrier()
#define PG8_SCHED __builtin_amdgcn_sched_barrier(0)
#define PG8_AOFF(dst, u) do { _Pragma("unroll") for (int _h = 0; _h < 2; ++_h) _Pragma("unroll") for (int _i = 0; _i < 2; ++_i) \
        dst[_h][_i] = (unsigned)S.arow(u, _h * HALF + RA[_i]) * (unsigned)(K * 2) + cA2[_i]; } while (0)
    Unit cur, nxt; int ui = 0;
    if (!S.next(0, cur)) return;
    constexpr bool GA = Sched::GATHER;
    unsigned offC[2][2], offN[2][2];
    const char* gA = (const char*)g.A; const char* nA = gA;
    if constexpr (GA) { PG8_AOFF(offC, cur); asm volatile("s_waitcnt vmcnt(0)" ::: "memory"); }
    else {
#pragma unroll
        for (int i = 0; i < 2; ++i) { offC[0][i] = (unsigned)RA[i] * (unsigned)(K * 2) + cA2[i]; offC[1][i] = offC[0][i] + (unsigned)hstep; }
        gA += (size_t)cur.pm * tstep; }
    f32x4 acc[2][2][4][2];
#pragma unroll
    for (int a = 0; a < 2; ++a)
#pragma unroll
        for (int b = 0; b < 2; ++b)
#pragma unroll
            for (int m = 0; m < 4; ++m)
#pragma unroll
                for (int n = 0; n < 2; ++n) acc[a][b][m][n] = (f32x4){0.f, 0.f, 0.f, 0.f};
    v8i32 At[4], B0[2], B1[2];
    const char* cB = (const char*)g.Bt + (size_t)cur.pn * tstep;
    PG8_STAGE(PG8_SB(0, 0), cB, voffB); PG8_STAGE(PG8_SB(0, 1), cB + hstep, voffB); PG8_STAGE(PG8_SA(0, 0), gA, offC[0]); PG8_STAGE(PG8_SA(0, 1), gA, offC[1]);
    if (wr == 1) PG8_BAR;
    PG8_WAIT_V(2); PG8_BAR;
    PG8_STAGE(PG8_SB(1, 0), cB + kstep, voffB); PG8_STAGE(PG8_SA(1, 0), gA + kstep, offC[0]); PG8_STAGE(PG8_SB(1, 1), cB + hstep + kstep, voffB);
    PG8_WAIT_V(6); PG8_BAR;
    for (;;) {
        const bool has_next = S.next(ui + 1, nxt);
        if constexpr (GA) {
            if (has_next) { PG8_AOFF(offN, nxt); }
            else {
#pragma unroll
                for (int h = 0; h < 2; ++h)
#pragma unroll
                    for (int i = 0; i < 2; ++i) offN[h][i] = offC[h][i]; }
        } else { nA = has_next ? (const char*)g.A + (size_t)nxt.pm * tstep : gA; }
        const char* nB = has_next ? (const char*)g.Bt + (size_t)nxt.pn * tstep : cB;
        for (int t = 0; t < nt; t += 2) {
            const bool last = (t == nt - 2);
            const char* a1 = gA + (size_t)(t + 1) * kstep;
            const char* a2 = last ? nA : gA + (size_t)(t + 2) * kstep; const char* b2 = last ? nB : cB + (size_t)(t + 2) * kstep;
            const char* a3 = a2 + kstep; const char* b3 = b2 + kstep;
            PG8_LDB(B0, 0, 0); PG8_LDB(B1, 0, 1); PG8_SCHED; PG8_LDA(At, 0, 0); PG8_STAGE(PG8_SA(1, 1), a1, offC[1]);
            if constexpr (GA) { if (last) {
#pragma unroll
                for (int h = 0; h < 2; ++h)
#pragma unroll
                    for (int i = 0; i < 2; ++i) offC[h][i] = offN[h][i]; } }
            PG8_WAIT_V(8); PG8_WAIT_L(0); PG8_BAR; PG8_MMA(0, 0, At, B0); PG8_MMA(0, 1, At, B1); PG8_BAR; PG8_SCHED;
            PG8_LDA(At, 0, 1); PG8_STAGE(PG8_SB(0, 0), b2, voffB); PG8_STAGE(PG8_SB(0, 1), b2 + hstep, voffB); PG8_STAGE(PG8_SA(0, 0), a2, offC[0]);
            PG8_WAIT_V(8); PG8_WAIT_L(0); PG8_BAR; PG8_MMA(1, 0, At, B0); PG8_MMA(1, 1, At, B1); PG8_BAR; PG8_SCHED;
            PG8_LDB(B0, 1, 0); PG8_LDB(B1, 1, 1); PG8_SCHED; PG8_LDA(At, 1, 0); PG8_STAGE(PG8_SA(0, 1), a2, offC[1]);
            PG8_WAIT_V(8); PG8_WAIT_L(0); PG8_BAR; PG8_MMA(0, 0, At, B0); PG8_MMA(0, 1, At, B1); PG8_BAR; PG8_SCHED;
            PG8_LDA(At, 1, 1); PG8_STAGE(PG8_SB(1, 0), b3, voffB); PG8_STAGE(PG8_SB(1, 1), b3 + hstep, voffB); PG8_STAGE(PG8_SA(1, 0), a3, offC[0]);
            PG8_WAIT_V(8); PG8_WAIT_L(0); PG8_BAR; PG8_MMA(1, 0, At, B0); PG8_MMA(1, 1, At, B1); PG8_BAR; PG8_SCHED;
        }
        if constexpr (ALIGN_EPI) { if (wr == 0) PG8_BAR; }
        E(acc, cur, wr, wc, fr, fq);
        if (!has_next) break;
#pragma unroll
        for (int a = 0; a < 2; ++a)
#pragma unroll
            for (int b = 0; b < 2; ++b)
#pragma unroll
                for (int m = 0; m < 4; ++m)
#pragma unroll
                    for (int n = 0; n < 2; ++n) acc[a][b][m][n] = (f32x4){0.f, 0.f, 0.f, 0.f};
        cur = nxt; cB = nB; ++ui; if constexpr (!GA) gA = nA;
        if constexpr (ALIGN_EPI) { if (wr == 1) PG8_BAR; }
    }
    PG8_WAIT_V(0);
    if constexpr (!ALIGN_EPI) { if (wr == 0) PG8_BAR; }
    PG8_BAR;
#undef PG8_SA
#undef PG8_SB
#undef PG8_STAGE
#undef PG8_LDA
#undef PG8_LDB
#undef PG8_LD32
#undef PG8_H0
#undef PG8_H1
#undef PG8_MMA
#undef PG8_WAIT_V
#undef PG8_WAIT_L
#undef PG8_BAR
#undef PG8_SCHED
#undef PG8_AOFF
}
}
#define GAS __attribute__((address_space(1)))
#define LAS __attribute__((address_space(3)))
typedef unsigned short bf16;
typedef unsigned v4u __attribute__((ext_vector_type(4)));
typedef float f32x4 __attribute__((ext_vector_type(4)));
typedef short bf16x8 __attribute__((ext_vector_type(8)));
typedef GAS unsigned gu32;
typedef GAS unsigned long long gu64;
#define RLX_AGENT __ATOMIC_RELAXED, __HIP_MEMORY_SCOPE_AGENT
#define LDS_WAIT() asm volatile("s_waitcnt lgkmcnt(0)" ::: "memory")
#define VM_WAIT() asm volatile("s_waitcnt vmcnt(0)" ::: "memory")
__device__ __forceinline__ unsigned long long rt() { return __builtin_amdgcn_s_memrealtime(); }
__device__ __forceinline__ unsigned pk2(float lo, float hi) { return pg8::cvt_pk_bf16(lo, hi); }
__device__ __forceinline__ unsigned f2bf(float f) { return pg8::cvt_pk_bf16(f, 0.f) & 0xffffu; }

#define XB_TMO      128
#define XB_XCNT(j)  (256  + 64 * (j))
#define XB_XSUB(j)  (1280 + 64 * (j))
#define XB_XGEN(j)  (2304 + 64 * (j))
#define XB_TOP      3328
#define XB_TOPGEN   3392
#define XCD_BAR_WORDS 3456
#define XB_SPIN_CAP (1u << 18)

__device__ __forceinline__ unsigned xb_ld(unsigned* p)              { return __hip_atomic_load(p, __ATOMIC_RELAXED, __HIP_MEMORY_SCOPE_AGENT); }
__device__ __forceinline__ unsigned xb_add(unsigned* p, unsigned v) { return __hip_atomic_fetch_add(p, v, __ATOMIC_RELAXED, __HIP_MEMORY_SCOPE_AGENT); }
__device__ __forceinline__ unsigned xb_xcc_id() { return (unsigned)__builtin_amdgcn_s_getreg((3 << 11) | 20) & 0xFu; }
#define XB_SPIN(cond, bar) do { unsigned _sp = 0; while (cond) { __builtin_amdgcn_s_sleep(1); \
    if ((++_sp & 255u) == 0u) { if (xb_ld(&(bar)[XB_TMO])) break; if (_sp > XB_SPIN_CAP) { atomicAdd(&(bar)[XB_TMO], 1u); break; } } } } while (0)

struct XcdBarrier {
    unsigned* bar; unsigned x;
    volatile LAS unsigned* st;
};

__device__ __forceinline__ XcdBarrier xcd_barrier_post(unsigned* bar, volatile LAS unsigned* st) {
    XcdBarrier b; b.bar = bar; b.x = xb_xcc_id(); b.st = st;
    if (threadIdx.x == 0) (void)xb_add(&bar[XB_XCNT(b.x)], 1u);
    return b;
}
__device__ __forceinline__ void xcd_barrier_complete(unsigned* bar, unsigned x, unsigned& nloc, unsigned& nx) {
    const unsigned G = gridDim.x * gridDim.y * gridDim.z;
    unsigned sum, cnt, mine, sp = 0u;
    for (;;) {
        sum = 0u; cnt = 0u; mine = 0u;
#pragma unroll
        for (unsigned j = 0; j < 16; ++j) { const unsigned c = xb_ld(&bar[XB_XCNT(j)]); sum += c; cnt += (c > 0u) ? 1u : 0u; mine = (j == x) ? c : mine; }
        if (sum == G) break;
        __builtin_amdgcn_s_sleep(1);
        if ((++sp & 255u) == 0u) { if (xb_ld(&bar[XB_TMO])) break; if (sp > XB_SPIN_CAP) { atomicAdd(&bar[XB_TMO], 1u); break; } }
    }
    nloc = mine > 0u ? mine : 1u; nx = cnt > 0u ? cnt : 1u;
}

__device__ __forceinline__ void xcd_barrier(const XcdBarrier& b) {
    asm volatile("s_waitcnt vmcnt(0)" ::: "memory");
    __syncthreads();
    if (threadIdx.x == 0) {
        unsigned* bar = b.bar;
        __builtin_amdgcn_s_waitcnt(0);
        unsigned nloc = b.st[0], nx = b.st[1];
        if (nloc == 0u) { xcd_barrier_complete(bar, b.x, nloc, nx); b.st[0] = nloc; b.st[1] = nx; }
        const unsigned old = xb_add(&bar[XB_XSUB(b.x)], 1u);
        const unsigned gen = old / nloc;
        if (old + 1u == (gen + 1u) * nloc) {
            __builtin_amdgcn_fence(__ATOMIC_RELEASE, "agent");
            asm volatile("s_waitcnt vmcnt(0)" ::: "memory");
            const unsigned og = xb_add(&bar[XB_TOP], 1u);
            const unsigned tg = og / nx;
            if (og + 1u == (tg + 1u) * nx) xb_add(&bar[XB_TOPGEN], 1u);
            else XB_SPIN(xb_ld(&bar[XB_TOPGEN]) == tg, bar);
            __builtin_amdgcn_fence(__ATOMIC_ACQUIRE, "agent");
            xb_add(&bar[XB_XGEN(b.x)], 1u);
            asm volatile("s_waitcnt vmcnt(0)" ::: "memory");
        } else {
            XB_SPIN(xb_ld(&bar[XB_XGEN(b.x)]) == gen, bar);
            __builtin_amdgcn_fence(__ATOMIC_ACQUIRE, "agent");
            asm volatile("s_waitcnt vmcnt(0)" ::: "memory");
        }
    }
    __syncthreads();
}


constexpr int NB = 2, T = 16384, NTOK = NB * T, D = 2048;
constexpr int PW = 5632;
constexpr int C_R = 0, C_K = 1024, C_V = 2048, C_DW = 3072, C_DA = 3168, C_DG = 3264, C_FQ = 3520, C_FK = 4032, C_FV = 4544, C_FF = 5056, C_MQ = 5064, IN_W = 5576;
constexpr int NE = 32, CAP = 131072 + 8192, MAXT = CAP / 256;
constexpr int MEM_LEN = 256;
constexpr float LN_EPS = 1e-5f, GN_EPS = 64e-5f, ALPHA = 1.189207115002721f, LOG2E = 1.4426950408889634f;
constexpr int NWAVES = 8, NTHR = 512;

constexpr size_t MiB = 1u << 20;
constexpr size_t WS_CTL = 0, CTL_ZERO_BYTES = 1 * MiB;
constexpr size_t WS_WI = 2 * MiB, WS_WO = 24 * MiB, WS_WKV = 32 * MiB, WS_RWT = 36 * MiB, WS_MEMN = 37 * MiB, WS_KVM = 39 * MiB, WS_C = 40 * MiB  ;
constexpr size_t WS_ROUTE = 42 * MiB;
constexpr size_t RT_TOPI = WS_ROUTE, RT_TOPG = RT_TOPI + 512 * 1024, RT_POS = RT_TOPG + 512 * 1024, RT_CNT = RT_POS + 512 * 1024, RT_TOK = RT_CNT + 64 * 1024, RT_GATE = RT_TOK + 1024 * 1024, RT_TILE = RT_GATE + 1024 * 1024;
constexpr size_t WS_W1 = 48 * MiB, WS_W2 = 560 * MiB, WS_H0 = 816 * MiB, WS_H1 = 944 * MiB, WS_MIX = 1072 * MiB, WS_Z1 = 1200 * MiB, WS_P = 1456 * MiB;
constexpr size_t WS_RW = 1808 * MiB, RW_ARR = 128 * MiB;
constexpr size_t WS_ACT = 2960 * MiB, WS_Y = 3504 * MiB, WS_END = 4048 * MiB;
constexpr size_t WS_WLT = 46 * MiB;
constexpr size_t WS_H1Q = 304 * MiB;
constexpr size_t WS_FOXB = 47 * MiB;
constexpr float FOX_SKIP = 30.0f;
constexpr int CW_BAR = 4096;
constexpr int CW_KMAX = 2048;
constexpr int CW_QUEUE = 2112;
constexpr int CW_XQ = 2176;
constexpr int CW_GQ = 2304;
constexpr int CW_A0Q = 2240;
constexpr int NG_INPROJ = 192;

constexpr int LDS_BYTES = 163840, MISC_OFF = LDS_BYTES - 256;

struct Args { const float* in[31]; float* out; unsigned char* ws; int ph_lo, ph_hi; };

__device__ __forceinline__ float wave_sum(float v) {
#pragma unroll
    for (int o = 1; o < 64; o <<= 1) v += __shfl_xor(v, o);
    return v;
}
__device__ __forceinline__ float bfl(unsigned w) { return __builtin_bit_cast(float, w << 16); }
__device__ __forceinline__ float bfh(unsigned w) { return __builtin_bit_cast(float, w & 0xffff0000u); }
__device__ __forceinline__ float bf1(bf16 h) { return __builtin_bit_cast(float, (unsigned)h << 16); }
__device__ __forceinline__ float sigmoidf_(float x) { return 1.0f / (1.0f + __expf(-x)); }

__device__ __forceinline__ void ln_row(f32x4 (&v)[8], const float* g, const float* b, float eps, int lane) {
    float s = 0.f;
#pragma unroll
    for (int j = 0; j < 8; ++j) s += (v[j].x + v[j].y) + (v[j].z + v[j].w);
    const float mean = wave_sum(s) * (1.f / D); float s2 = 0.f;
#pragma unroll
    for (int j = 0; j < 8; ++j) { v[j] = v[j] - mean; s2 += (v[j].x * v[j].x + v[j].y * v[j].y) + (v[j].z * v[j].z + v[j].w * v[j].w); }
    const float rstd = 1.f / sqrtf(wave_sum(s2) * (1.f / D) + eps);
#pragma unroll
    for (int j = 0; j < 8; ++j) { const f32x4 gg = *(const f32x4*)(g + 4 * lane + 256 * j), bb = *(const f32x4*)(b + 4 * lane + 256 * j); v[j] = v[j] * rstd * gg + bb; }
}
__device__ __forceinline__ void store_row_bf16(bf16* orow, const f32x4 (&v)[8], int lane) {
#pragma unroll
    for (int j = 0; j < 8; ++j) { pg8::u32x2 w; w.x = pk2(v[j].x, v[j].y); w.y = pk2(v[j].z, v[j].w); *(pg8::u32x2*)(orow + 4 * lane + 256 * j) = w; }
}

template <class RowMap>
__device__ __forceinline__ void transpose_item(const float* W, int ldw, int nvalid, int K, bf16* WT, const RowMap& rm, LAS float* scr, int k0, int n0, int lane) {
#pragma unroll 4
    for (int it = 0; it < 16; ++it) { const int k = 4 * it + (lane >> 4), nl = 4 * (lane & 15), n = n0 + nl;
        f32x4 v = (f32x4){0.f, 0.f, 0.f, 0.f}; if (n < nvalid) v = *(const f32x4*)(W + (size_t)(k0 + k) * ldw + n);
        LAS float* s = scr + k * 65 + nl; s[0] = v.x; s[1] = v.y; s[2] = v.z; s[3] = v.w; }
    LDS_WAIT(); asm volatile("" ::: "memory");
    const int c = lane & 7;
#pragma unroll
    for (int j = 0; j < 8; ++j) { const int nl = 8 * j + (lane >> 3); const LAS float* s = scr + (8 * c) * 65 + nl;
        v4u o; o.x = pk2(s[0 * 65], s[1 * 65]); o.y = pk2(s[2 * 65], s[3 * 65]); o.z = pk2(s[4 * 65], s[5 * 65]); o.w = pk2(s[6 * 65], s[7 * 65]);
        *(v4u*)(WT + (size_t)rm(n0 + nl) * K + k0 + 8 * c) = o; }
    LDS_WAIT(); asm volatile("" ::: "memory");
}
template <class RowMap>
__device__ __forceinline__ void transpose_item_fp8(const float* W, int ldw, int K, unsigned char* WT, const RowMap& rm, LAS float* scr, int k0, int n0, int lane) {
#pragma unroll 4
    for (int it = 0; it < 16; ++it) { const int k = 4 * it + (lane >> 4), nl = 4 * (lane & 15);
        const f32x4 v = *(const f32x4*)(W + (size_t)(k0 + k) * ldw + n0 + nl);
        LAS float* s = scr + k * 65 + nl; s[0] = v.x; s[1] = v.y; s[2] = v.z; s[3] = v.w; }
    LDS_WAIT(); asm volatile("" ::: "memory");
    const int c = lane & 3;
#pragma unroll
    for (int j = 0; j < 4; ++j) { const int nl = 16 * j + (lane >> 2); const LAS float* s = scr + (16 * c) * 65 + nl;
        v4u o; o.x = pg8::pk4_fp8(64.f * s[0 * 65], 64.f * s[1 * 65], 64.f * s[2 * 65], 64.f * s[3 * 65]); o.y = pg8::pk4_fp8(64.f * s[4 * 65], 64.f * s[5 * 65], 64.f * s[6 * 65], 64.f * s[7 * 65]);
        o.z = pg8::pk4_fp8(64.f * s[8 * 65], 64.f * s[9 * 65], 64.f * s[10 * 65], 64.f * s[11 * 65]); o.w = pg8::pk4_fp8(64.f * s[12 * 65], 64.f * s[13 * 65], 64.f * s[14 * 65], 64.f * s[15 * 65]);
        *(v4u*)(WT + (size_t)rm(n0 + nl) * K + k0 + 16 * c) = o; }
    LDS_WAIT(); asm volatile("" ::: "memory");
}
struct XItem { const float* W; unsigned char* WT; int ldw, k0, n0, rowoff, isw1; };
__device__ __forceinline__ XItem xitem(const Args& A, unsigned char* ws, int r) {
    XItem x; constexpr int I1 = 32 * 32 * 64;
    if (r < I1) { const int e = r >> 11, q = r & 2047; x.W = A.in[25] + (size_t)e * D * 4096; x.WT = ws + WS_W1; x.ldw = 4096; x.k0 = 64 * (q >> 6); x.n0 = 64 * (q & 63); x.rowoff = e * 4096; x.isw1 = 1; }
    else { const int r2 = r - I1, e = r2 >> 10, q = r2 & 1023; x.W = A.in[27] + (size_t)e * D * D; x.WT = ws + WS_W2; x.ldw = D; x.k0 = 64 * (q >> 5); x.n0 = 64 * (q & 31); x.rowoff = e * D; x.isw1 = 0; }
    return x;
}
__device__ __forceinline__ void xload(f32x4 (&v)[16], const XItem& x, int lane) {
#pragma unroll
    for (int it = 0; it < 16; ++it) v[it] = *(const f32x4*)(x.W + (size_t)(x.k0 + 4 * it + (lane >> 4)) * x.ldw + x.n0 + 4 * (lane & 15));
}
__device__ __forceinline__ void xstore(const f32x4 (&v)[16], const XItem& x, LAS float* scr, int lane) {
#pragma unroll
    for (int it = 0; it < 16; ++it) { LAS float* s = scr + (4 * it + (lane >> 4)) * 65 + 4 * (lane & 15); s[0] = v[it].x; s[1] = v[it].y; s[2] = v[it].z; s[3] = v[it].w; }
    LDS_WAIT(); asm volatile("" ::: "memory");
    const int c = lane & 3;
#pragma unroll
    for (int j = 0; j < 4; ++j) { const int nl = 16 * j + (lane >> 2), n = x.n0 + nl; const LAS float* s = scr + (16 * c) * 65 + nl;
        int row; if (x.isw1) { const int l = n >= 2048, cc = n - 2048 * l; row = (cc >> 7) * 256 + 128 * l + (cc & 127); } else row = n;
        v4u o; o.x = pg8::pk4_fp8(64.f * s[0 * 65], 64.f * s[1 * 65], 64.f * s[2 * 65], 64.f * s[3 * 65]); o.y = pg8::pk4_fp8(64.f * s[4 * 65], 64.f * s[5 * 65], 64.f * s[6 * 65], 64.f * s[7 * 65]);
        o.z = pg8::pk4_fp8(64.f * s[8 * 65], 64.f * s[9 * 65], 64.f * s[10 * 65], 64.f * s[11 * 65]); o.w = pg8::pk4_fp8(64.f * s[12 * 65], 64.f * s[13 * 65], 64.f * s[14 * 65], 64.f * s[15 * 65]);
        *(v4u*)(x.WT + (size_t)(x.rowoff + row) * D + x.k0 + 16 * c) = o; }
    LDS_WAIT(); asm volatile("" ::: "memory");
}
struct RmId { int off; __device__ __forceinline__ int operator()(int n) const { return off + n; } };
struct RmW1 { int off; __device__ __forceinline__ int operator()(int n) const { const int l = n >= 2048, c = n - 2048 * l; return off + (c >> 7) * 256 + 128 * l + (c & 127); } };

constexpr int I_XALL = 32 * 32 * 64 + 32 * 32 * 32;
__device__ __forceinline__ void conv_pull_loop(const Args& A, LAS unsigned char* lds, int tid, int wave, int lane) {
    unsigned char* ws = A.ws; unsigned* ctl = (unsigned*)(ws + WS_CTL); LAS float* scr = (LAS float*)(lds + wave * 16640); LAS int* qs = (LAS int*)(lds + 8 * 16640);
    for (;;) {
        __syncthreads();
        if (tid == 0) qs[0] = (int)__hip_atomic_fetch_add(ctl + CW_XQ, 16u, __ATOMIC_RELAXED, __HIP_MEMORY_SCOPE_AGENT);
        __syncthreads();
        const int base = qs[0]; if (base >= I_XALL) break;
        f32x4 va[16], vb[16]; const int i0 = base + wave, i1 = base + 8 + wave;
        const XItem xa = xitem(A, ws, min(i0, I_XALL - 1)), xb = xitem(A, ws, min(i1, I_XALL - 1));
        xload(va, xa, lane); xload(vb, xb, lane);
        if (i0 < I_XALL) xstore(va, xa, scr, lane);
        if (i1 < I_XALL) xstore(vb, xb, scr, lane);
    }
}
__device__ __forceinline__ void p0_prologue(const Args& A, LAS unsigned char* lds, int vcu, int G, int wave, int lane) {
    unsigned char* ws = A.ws;
    LAS float* scr = (LAS float*)(lds + wave * 16640);
    const int gw = vcu * NWAVES + wave, NGW = G * NWAVES;
    constexpr int I_WI = 32 * 88, I_WO = 32 * 32, I_WKV = 32 * 16;
    constexpr int NITEMS = I_WI + I_WO + I_WKV;
    for (int it = gw; it < NITEMS; it += NGW) {
        int r = it;
        if (r < I_WI) { transpose_item(A.in[4], IN_W, IN_W, D, (bf16*)(ws + WS_WI), RmId{0}, scr, 64 * (r / 88), 64 * (r % 88), lane); continue; } r -= I_WI;
        if (r < I_WO) { transpose_item(A.in[20], D, D, D, (bf16*)(ws + WS_WO), RmId{0}, scr, 64 * (r / 32), 64 * (r % 32), lane); continue; } r -= I_WO;
        transpose_item(A.in[19], 1024, 1024, D, (bf16*)(ws + WS_WKV), RmId{0}, scr, 64 * (r / 16), 64 * (r % 16), lane);
    }
    { bf16* wlt = (bf16*)(ws + WS_WLT);
      for (int i = gw * 64 + lane; i < 1024 * 448; i += NGW * 64) { const int ch = i / 448, k = i % 448;
          const float v = k < 96 ? A.in[7][k * 1024 + ch] : (k < 192 ? A.in[9][(k - 96) * 1024 + ch] : A.in[10][(k - 192) * 1024 + ch]); wlt[i] = (bf16)f2bf(v); } }
    { bf16* rwf = (bf16*)(ws + WS_RWT); const float* rw = A.in[23];
      for (int i = gw * 64 + lane; i < 64 * 2 * 2 * 64 * 8; i += NGW * 64) { const int e = i & 7, ln = (i >> 3) & 63, hl = (i >> 9) & 1, nt = (i >> 10) & 1, sidx = i >> 11;
          const float w = rw[(32 * sidx + 8 * (ln >> 4) + e) * NE + 16 * nt + (ln & 15)]; const unsigned hb = f2bf(w); const float hf = __builtin_bit_cast(float, hb << 16);
          rwf[i] = (bf16)(hl ? f2bf(w - hf) : hb); } }
    for (int m = gw; m < NTOK + NB * MEM_LEN; m += NGW) {
        const bool ismem = m >= NTOK; const int r = ismem ? m - NTOK : m;
        const float* xr = (ismem ? A.in[1] : A.in[0]) + (size_t)r * D;
        f32x4 v[8];
#pragma unroll
        for (int j = 0; j < 8; ++j) v[j] = *(const f32x4*)(xr + 4 * lane + 256 * j);
        ln_row(v, ismem ? A.in[17] : A.in[2], ismem ? A.in[18] : A.in[3], LN_EPS, lane);
        store_row_bf16((bf16*)(ws + (ismem ? WS_MEMN : WS_H0)) + (size_t)r * D, v, lane);
    }
}

__device__ __forceinline__ void p2_fox_cumsum(const Args& A, LAS unsigned char* lds, int vcu, int G, int tid) {
    const bf16* P = (const bf16*)(A.ws + WS_P); double* C = (double*)(A.ws + WS_C);
    LAS double* part = (LAS double*)(lds + 32768);
    for (int bh = vcu; bh < 16; bh += G) {
        const int b = bh >> 3, h = bh & 7; const float bf = A.in[16][h];
        float lf[32]; double s = 0.0;
#pragma unroll
        for (int i = 0; i < 32; ++i) { const float x = bf1(P[(size_t)(b * T + tid * 32 + i) * PW + C_FF + h]) + bf;
            lf[i] = -(fmaxf(-x, 0.f) + log1pf(__expf(-fabsf(x)))); s += (double)lf[i]; }
        __syncthreads();
        part[tid] = s;
        __syncthreads();
        double pre = 0.0;
        for (int j = 0; j < tid; ++j) pre += part[j];
        double* c = C + (size_t)bh * T + tid * 32;
#pragma unroll
        for (int i = 0; i < 32; ++i) { pre += (double)lf[i]; c[i] = pre; }
    }
}
__device__ __forceinline__ void p2_fox_norms(const Args& A, LAS unsigned char* lds, int vcu, int G, int tid, int wave, int lane) {
    const bf16* P = (const bf16*)(A.ws + WS_P); float* FOXB = (float*)(A.ws + WS_FOXB); unsigned* ctl = (unsigned*)(A.ws + WS_CTL);
    LAS float* red = (LAS float*)(lds + 40960);
    for (int u = vcu; u < 1024; u += G) {
        const int bh = u >> 6, qb = u & 63, b = bh >> 3, h = bh & 7; const int tk = tid & 255, isk = tid >> 8;
        const bf16* pr = P + (size_t)(b * T + qb * 256 + tk) * PW + (isk ? C_FK : C_FQ) + h * 64;
        float n2 = 0.f;
#pragma unroll
        for (int v = 0; v < 8; ++v) { const v4u x = *(const v4u*)(pr + v * 8); const unsigned w[4] = {x.x, x.y, x.z, x.w};
#pragma unroll
            for (int e = 0; e < 4; ++e) { const float a0 = bfl(w[e]), a1 = bfh(w[e]); n2 += a0 * a0 + a1 * a1; } }
#pragma unroll
        for (int o = 1; o < 64; o <<= 1) n2 = fmaxf(n2, __shfl_xor(n2, o));
        __syncthreads();
        if (lane == 0) red[wave] = n2;
        __syncthreads();
        if (tid == 0) { FOXB[bh * 80 + qb] = fmaxf(fmaxf(red[0], red[1]), fmaxf(red[2], red[3]));
            __hip_atomic_fetch_max(ctl + CW_KMAX + bh, __float_as_uint(fmaxf(fmaxf(red[4], red[5]), fmaxf(red[6], red[7]))), __ATOMIC_RELAXED, __HIP_MEMORY_SCOPE_AGENT); }
    }
}

__device__ __forceinline__ int crow(int r, int hi) { return (r & 3) + 8 * (r >> 2) + 4 * hi; }
typedef float f32x16 __attribute__((ext_vector_type(16)));
typedef short s16x4 __attribute__((ext_vector_type(4)));
typedef short v4i16_t __attribute__((ext_vector_type(4)));
template <int DH, bool FOX>
__device__ __forceinline__ void attn_unit(const bf16* Qp, int qpitch, const bf16* Kp, const bf16* Vp, int kvpitch, bf16* Op, int opitch, int q0, int jlo, int jhi,
                                          const double* cseq, float scale2, LAS unsigned char* lds, int tid, int wave, int lane) {
    constexpr int KROW = (DH + 8) * 2, VROW = DH * 2 + 64, NP = DH / 64;
    LAS unsigned char* KS = lds; LAS unsigned char* VT = lds + 64 * KROW; LAS float* CB = (LAS float*)(VT + 64 * VROW); LAS float* WSF = (LAS float*)(lds + 2 * (64 * KROW + 64 * VROW + 256)) + wave * 32;
    const int r32 = lane & 31, hi = lane >> 5;
    bf16x8 qr[DH / 16];
#pragma unroll
    for (int d0 = 0; d0 < DH / 16; ++d0) qr[d0] = *(const bf16x8*)(Qp + (size_t)(32 * wave + r32) * qpitch + d0 * 16 + hi * 8);
    f32x16 o[DH / 32];
#pragma unroll
    for (int d = 0; d < DH / 32; ++d)
#pragma unroll
        for (int r = 0; r < 16; ++r) o[d][r] = 0.f;
    float m = -1e30f, l = 0.f;
    const int qpos = q0 + 32 * wave + r32;
    double cref = 0.0; if (FOX) cref = cseq[q0];
    v4u kreg[NP], vreg[NP]; float cbv = 0.f;
#define ATT_LOAD(j) do { _Pragma("unroll") for (int p = 0; p < NP; ++p) { const int idx = tid + p * NTHR, row = idx / (DH / 8), ch = idx % (DH / 8); \
        kreg[p] = *(const v4u*)(Kp + (size_t)((j) * 64 + row) * kvpitch + ch * 8); vreg[p] = *(const v4u*)(Vp + (size_t)((j) * 64 + row) * kvpitch + ch * 8); } \
        if (FOX && tid < 64) cbv = (float)(cref - cseq[(j) * 64 + tid]) * LOG2E; } while (0)
    constexpr bool PREF = (DH == 64);
    constexpr int TILEB = 64 * KROW + 64 * VROW + 256;
#define ATT_STORE(bufo) do { _Pragma("unroll") for (int p = 0; p < NP; ++p) { const int idx = tid + p * NTHR, row = idx / (DH / 8), ch = idx % (DH / 8); \
        *(LAS v4u*)(KS + (bufo) + row * KROW + ch * 16) = kreg[p]; *(LAS v4u*)(VT + (bufo) + row * VROW + ch * 16) = vreg[p]; } \
        if (FOX && tid < 64) *(LAS float*)((LAS unsigned char*)CB + (bufo) + tid * 4) = cbv; } while (0)
    if (PREF) { ATT_LOAD(jlo); __syncthreads(); ATT_STORE(0); __syncthreads(); }
    for (int j = jlo; j < jhi; ++j) {
        const int bo = PREF ? ((j - jlo) & 1) * TILEB : 0;
        if (PREF) { if (j + 1 < jhi) ATT_LOAD(j + 1); }
        else { __syncthreads();
#pragma unroll
            for (int p = 0; p < NP; ++p) { const int idx = tid + p * NTHR, row = idx / (DH / 8), ch = idx % (DH / 8);
                kreg[0] = *(const v4u*)(Kp + (size_t)(j * 64 + row) * kvpitch + ch * 8); vreg[0] = *(const v4u*)(Vp + (size_t)(j * 64 + row) * kvpitch + ch * 8);
                *(LAS v4u*)(KS + row * KROW + ch * 16) = kreg[0]; *(LAS v4u*)(VT + row * VROW + ch * 16) = vreg[0]; }
            __syncthreads(); }
        f32x16 p[2];
#pragma unroll
        for (int kh = 0; kh < 2; ++kh) {
#pragma unroll
            for (int r = 0; r < 16; ++r) p[kh][r] = 0.f;
#pragma unroll
            for (int d0 = 0; d0 < DH / 16; ++d0) { const bf16x8 a = *(const LAS bf16x8*)(KS + bo + (32 * kh + r32) * KROW + (16 * d0 + 8 * hi) * 2);
                p[kh] = __builtin_amdgcn_mfma_f32_32x32x16_bf16(a, qr[d0], p[kh], 0, 0, 0); }
        }
        const bool diag = FOX && (j * 64 + 63 > q0);
        float mx = -1e30f;
        if (diag) {
#pragma unroll
            for (int kh = 0; kh < 2; ++kh)
#pragma unroll
                for (int g = 0; g < 4; ++g) { const f32x4 cb = *(const LAS f32x4*)((const LAS unsigned char*)CB + bo + (32 * kh + 8 * g + 4 * hi) * 4);
#pragma unroll
                    for (int i = 0; i < 4; ++i) { const int r = 4 * g + i; float v = p[kh][r] * scale2 + cb[i];
                        if (j * 64 + 32 * kh + 8 * g + 4 * hi + i > qpos) v = -1e30f;
                        p[kh][r] = v; mx = fmaxf(mx, v); } }
        } else {
#pragma unroll
            for (int kh = 0; kh < 2; ++kh)
#pragma unroll
                for (int g = 0; g < 4; ++g) { f32x4 cb = (f32x4){0.f, 0.f, 0.f, 0.f}; if (FOX) cb = *(const LAS f32x4*)((const LAS unsigned char*)CB + bo + (32 * kh + 8 * g + 4 * hi) * 4);
#pragma unroll
                    for (int i = 0; i < 4; ++i) { const int r = 4 * g + i; const float v = p[kh][r] * scale2 + cb[i]; p[kh][r] = v; mx = fmaxf(mx, v); } }
        }
        mx = fmaxf(mx, __shfl_xor(mx, 32));
        const float mn = fmaxf(m, mx), corr = __builtin_amdgcn_exp2f(m - mn); m = mn;
        float ls = 0.f;
#pragma unroll
        for (int kh = 0; kh < 2; ++kh)
#pragma unroll
            for (int r = 0; r < 16; ++r) { const float e = __builtin_amdgcn_exp2f(p[kh][r] - mn); p[kh][r] = e; ls += e; }
        l = l * corr + ls;
        if (__any(corr != 1.0f)) {
            if (hi == 0) WSF[r32] = corr;
#pragma unroll
            for (int g = 0; g < 4; ++g) { const f32x4 c4 = *(const LAS f32x4*)(WSF + 8 * g + 4 * hi);
#pragma unroll
                for (int d = 0; d < DH / 32; ++d) { o[d][4 * g] *= c4.x; o[d][4 * g + 1] *= c4.y; o[d][4 * g + 2] *= c4.z; o[d][4 * g + 3] *= c4.w; } }
        }
        bf16x8 pa[4];
#pragma unroll
        for (int s = 0; s < 4; ++s) { const int kh = s >> 1, b8 = 8 * (s & 1); v4u w;
            w.x = pg8::cvt_pk_bf16(p[kh][b8 + 0], p[kh][b8 + 1]); w.y = pg8::cvt_pk_bf16(p[kh][b8 + 2], p[kh][b8 + 3]);
            w.z = pg8::cvt_pk_bf16(p[kh][b8 + 4], p[kh][b8 + 5]); w.w = pg8::cvt_pk_bf16(p[kh][b8 + 6], p[kh][b8 + 7]);
            pa[s] = __builtin_bit_cast(bf16x8, w); }
#pragma unroll
        for (int d = 0; d < DH / 32; ++d)
#pragma unroll
            for (int s = 0; s < 4; ++s) { const LAS unsigned char* vp = VT + bo + (16 * s + 4 * hi + ((lane & 15) >> 2)) * VROW + (32 * d + 16 * ((lane >> 4) & 1) + 4 * (lane & 3)) * 2;
                const s16x4 lo = __builtin_bit_cast(s16x4, __builtin_amdgcn_ds_read_tr16_b64_v4i16((LAS v4i16_t*)vp)), hh = __builtin_bit_cast(s16x4, __builtin_amdgcn_ds_read_tr16_b64_v4i16((LAS v4i16_t*)(vp + 8 * VROW)));
                const bf16x8 vf = (bf16x8){lo[0], lo[1], lo[2], lo[3], hh[0], hh[1], hh[2], hh[3]};
                o[d] = __builtin_amdgcn_mfma_f32_32x32x16_bf16(pa[s], vf, o[d], 0, 0, 0); }
        if (PREF) { if (j + 1 < jhi) ATT_STORE(TILEB - bo); __syncthreads(); }
    }
#undef ATT_LOAD
#undef ATT_STORE
    l += __shfl_xor(l, 32);
    if (hi == 0) WSF[r32] = 1.0f / l;
    float rli[16];
#pragma unroll
    for (int g = 0; g < 4; ++g) { const f32x4 c4 = *(const LAS f32x4*)(WSF + 8 * g + 4 * hi); rli[4 * g] = c4.x; rli[4 * g + 1] = c4.y; rli[4 * g + 2] = c4.z; rli[4 * g + 3] = c4.w; }
#pragma unroll
    for (int r = 0; r < 16; ++r) { bf16* orow = Op + (size_t)(32 * wave + crow(r, hi)) * opitch + r32;
#pragma unroll
        for (int d = 0; d < DH / 32; ++d) orow[32 * d] = (bf16)f2bf(o[d][r] * rli[r]); }
    __syncthreads();
}

__device__ __forceinline__ void p3_attention(const Args& A, LAS unsigned char* lds, int tid, int wave, int lane) {
    unsigned char* ws = A.ws; const bf16* P = (const bf16*)(ws + WS_P); bf16* MIX = (bf16*)(ws + WS_MIX); const bf16* KVM = (const bf16*)(ws + WS_KVM); const double* C = (const double*)(ws + WS_C);
    unsigned* ctl = (unsigned*)(ws + WS_CTL); LAS int* sj = (LAS int*)(lds + 65536);
    for (;;) {
        __syncthreads();
        if (tid == 0) sj[1] = (int)__hip_atomic_fetch_add(ctl + CW_QUEUE, 1u, __ATOMIC_RELAXED, __HIP_MEMORY_SCOPE_AGENT);
        __syncthreads();
        const int u = sj[1];
        if (u >= 1536) break;
        if (u < 1024) {
#ifndef NO_FOX
            const int bh = u & 15, qb = 63 - (u >> 4), b = bh >> 3, h = bh & 7, q0 = qb * 256; const double* cs = C + (size_t)bh * T; const float* fb = (const float*)(ws + WS_FOXB) + bh * 80; const size_t rowb = (size_t)b * T;
            if (tid == 0) sj[0] = q0 / 64;
            __syncthreads();
            if (tid < q0 / 64) { const float bound = 0.25f * sqrtf(fb[qb] * __uint_as_float(ctl[CW_KMAX + bh])) + FOX_SKIP; if ((float)(cs[q0] - cs[tid * 64 + 63]) + bound >= 0.f) __hip_atomic_fetch_min(sj, tid, __ATOMIC_RELAXED, __HIP_MEMORY_SCOPE_WORKGROUP); }
            __syncthreads();
            const int jlo = sj[0];
            attn_unit<64, true>(P + (rowb + q0) * PW + C_FQ + h * 64, PW, P + rowb * PW + C_FK + h * 64, P + rowb * PW + C_FV + h * 64, PW,
                                MIX + (rowb + q0) * D + 1024 + h * 64, D, q0, jlo, q0 / 64 + 4, cs, 0.125f * LOG2E, lds, tid, wave, lane);
#endif
        } else {
#ifndef NO_MEMATT
            const int v = u - 1024, b = v >> 8, h = (v >> 6) & 3, qb = v & 63, q0 = qb * 256; const size_t rowb = (size_t)b * T;
            attn_unit<128, false>(P + (rowb + q0) * PW + C_MQ + h * 128, PW, KVM + (size_t)b * MEM_LEN * 1024 + h * 128, KVM + (size_t)b * MEM_LEN * 1024 + 512 + h * 128, 1024,
                                  MIX + (rowb + q0) * D + 1536 + h * 128, D, q0, 0, 4, nullptr, 0.08838834764831845f * LOG2E, lds, tid, wave, lane);
#endif
        }
    }
}

constexpr size_t AIN_BYTES = 73728, REC_BYTES = 62464;
constexpr size_t WS_AIN = WS_RW, WS_REC = WS_AIN + 576 * MiB, WS_YRAW = WS_REC + 488 * MiB, WS_G1 = 368 * MiB, WS_G2 = 432 * MiB;
static_assert(WS_YRAW + 64 * MiB <= WS_ACT && 8192 * REC_BYTES <= 488 * MiB && 8192 * AIN_BYTES <= 576 * MiB && WS_G2 + 64 * MiB <= WS_W2, "rwkv workspace");
constexpr int AIN_LD = 0, AIN_R = 16384, AIN_K2 = 24576, AIN_V = 32768, AIN_AV = 40960, AIN_BV = 49152, AIN_G1 = 57344, AIN_G2 = 65536;
constexpr int A0_IN = 29184, A0_INW = 13200, A0_ROWB = 400;
constexpr int REC_W = 0, REC_RT = 9216, REC_ARB = 18432, REC_BGT = 27648, REC_U0 = 36864, REC_Y0 = 45056, REC_M0 = 53248, REC_GC = 61440;
typedef float f32x4_t __attribute__((ext_vector_type(4)));

__device__ __forceinline__ float softplusf_(float x) { return fmaxf(x, 0.f) + log1pf(__expf(-fabsf(x))); }
__device__ __forceinline__ float xsum16_32(float v) { v += __shfl_xor(v, 16); v += __shfl_xor(v, 32); return v; }

__device__ __forceinline__ float fsigmoid(float x) { return __builtin_amdgcn_rcpf(1.0f + __builtin_amdgcn_exp2f(-LOG2E * x)); }
__device__ __forceinline__ float fsoftplus(float x) { return fmaxf(x, 0.f) + 0.6931471805599453f * __builtin_amdgcn_logf(1.0f + __builtin_amdgcn_exp2f(-LOG2E * fabsf(x))); }
struct A0Par { f32x4 mur, muk, muv, a0, kkw, kaw, rkw, w0, gng, gnb; };
template <bool FULL> __device__ __forceinline__ void a0_loadpar(A0Par& p, const Args& A, const float* mu, int col) {
    p.mur = *(const f32x4*)(mu + C_R + col); p.muk = *(const f32x4*)(mu + C_K + col); p.muv = *(const f32x4*)(mu + C_V + col);
    p.a0 = *(const f32x4*)(A.in[8] + col); p.kkw = *(const f32x4*)(A.in[11] + col); p.kaw = *(const f32x4*)(A.in[12] + col); p.rkw = *(const f32x4*)(A.in[13] + col);
    if constexpr (FULL) { p.w0 = *(const f32x4*)(A.in[6] + col); p.gng = *(const f32x4*)(A.in[14] + col); p.gnb = *(const f32x4*)(A.in[15] + col); }
}
template <bool FULL>
__device__ __forceinline__ void a0_mfma(f32x4 (&acc)[2][3], const bf16x8* wf, LAS unsigned char* lds, int c16, int g) {
    constexpr int KS0 = FULL ? 0 : 3, KS1 = FULL ? 14 : 6;
#pragma unroll
    for (int tt = 0; tt < 2; ++tt)
#pragma unroll
        for (int o = 0; o < 3; ++o) acc[tt][o] = (f32x4){0.f, 0.f, 0.f, 0.f};
#pragma unroll
    for (int ks = KS0; ks < KS1; ++ks) { const int o = ks < 3 ? 0 : (ks < 6 ? 1 : 2);
#pragma unroll
        for (int tt = 0; tt < 2; ++tt) { const bf16x8 b = *(const LAS bf16x8*)(lds + (16 * tt + c16) * 912 + (32 * ks + 8 * g) * 2);
            acc[tt][o] = __builtin_amdgcn_mfma_f32_16x16x32_bf16(wf[ks - KS0], b, acc[tt][o], 0, 0, 0); } }
}
template <bool FULL>
__device__ __forceinline__ void a0_ct(const f32x4 (&acc)[2][3], const A0Par& p, const LAS unsigned char* inw, unsigned char* blk,
                                      int tl0, int ct, int c16, int g, float (&ssk)[2], float (&ssb)[2]) {
#pragma unroll
    for (int tt = 0; tt < 2; ++tt) {
        const LAS unsigned char* pc = inw + (1 + 16 * tt + c16) * A0_ROWB + (16 * ct + 4 * g) * 2;
        const pg8::u32x2 r0 = *(const LAS pg8::u32x2*)pc, k0 = *(const LAS pg8::u32x2*)(pc + 128), v0 = *(const LAS pg8::u32x2*)(pc + 256);
        const pg8::u32x2 r1 = *(const LAS pg8::u32x2*)(pc - A0_ROWB), k1 = *(const LAS pg8::u32x2*)(pc - A0_ROWB + 128), v1 = *(const LAS pg8::u32x2*)(pc - A0_ROWB + 256);
        float rr[4], kk[4], vv[4];
        { const float ra[4] = {bfl(r0.x), bfh(r0.x), bfl(r0.y), bfh(r0.y)}, rb[4] = {bfl(r1.x), bfh(r1.x), bfl(r1.y), bfh(r1.y)};
          const float ka[4] = {bfl(k0.x), bfh(k0.x), bfl(k0.y), bfh(k0.y)}, kb[4] = {bfl(k1.x), bfh(k1.x), bfl(k1.y), bfh(k1.y)};
          const float va[4] = {bfl(v0.x), bfh(v0.x), bfl(v0.y), bfh(v0.y)}, vb[4] = {bfl(v1.x), bfh(v1.x), bfl(v1.y), bfh(v1.y)};
#pragma unroll
          for (int r = 0; r < 4; ++r) { rr[r] = ra[r] + p.mur[r] * (rb[r] - ra[r]); kk[r] = ka[r] + p.muk[r] * (kb[r] - ka[r]); vv[r] = va[r] + p.muv[r] * (vb[r] - va[r]); } }
        float aa[4], k2[4], kc[4];
#pragma unroll
        for (int r = 0; r < 4; ++r) { aa[r] = fsigmoid(p.a0[r] + acc[tt][1][r]); kc[r] = kk[r] * p.kkw[r]; k2[r] = kk[r] * (1.0f + (aa[r] - 1.0f) * p.kaw[r]); }
        if constexpr (!FULL) {
#pragma unroll
            for (int r = 0; r < 4; ++r) { ssk[tt] += kc[r] * kc[r]; ssb[tt] += rr[r] * k2[r] * p.rkw[r]; }
        } else {
            const int e0 = (ct * 64 + tl0 + 16 * tt + c16) * 16 + 4 * g;
            f32x4 ld; float av[4], bv[4], g1[4], g2[4];
#pragma unroll
            for (int r = 0; r < 4; ++r) { const float sp = fsoftplus(-(p.w0[r] + acc[tt][0][r])); ld[r] = -__builtin_amdgcn_exp2f(-LOG2E * (sp + 0.5f));
                const float kn = kc[r] * ssk[tt]; av[r] = -kn; bv[r] = kn * aa[r]; const float gg = acc[tt][2][r]; g1[r] = p.gng[r] * gg; g2[r] = (p.gnb[r] + ssb[tt] * vv[r]) * gg; }
            *(f32x4*)(blk + AIN_LD + e0 * 4) = ld;
            *(pg8::u32x2*)(blk + AIN_R + e0 * 2) = (pg8::u32x2){pk2(rr[0], rr[1]), pk2(rr[2], rr[3])};
            *(pg8::u32x2*)(blk + AIN_K2 + e0 * 2) = (pg8::u32x2){pk2(k2[0], k2[1]), pk2(k2[2], k2[3])};
            *(pg8::u32x2*)(blk + AIN_V + e0 * 2) = (pg8::u32x2){pk2(vv[0], vv[1]), pk2(vv[2], vv[3])};
            *(pg8::u32x2*)(blk + AIN_AV + e0 * 2) = (pg8::u32x2){pk2(av[0], av[1]), pk2(av[2], av[3])};
            *(pg8::u32x2*)(blk + AIN_BV + e0 * 2) = (pg8::u32x2){pk2(bv[0], bv[1]), pk2(bv[2], bv[3])};
            *(pg8::u32x2*)(blk + AIN_G1 + e0 * 2) = (pg8::u32x2){pk2(g1[0], g1[1]), pk2(g1[2], g1[3])};
            *(pg8::u32x2*)(blk + AIN_G2 + e0 * 2) = (pg8::u32x2){pk2(g2[0], g2[1]), pk2(g2[2], g2[3])};
        }
        asm volatile("" ::: "memory");
    }
}
template <int PV = 0>
__device__ __forceinline__ void p2_rwkv_tok(const Args& A, LAS unsigned char* lds, int vcu, int G, int tid, int wave, int lane) {
    unsigned char* ws = A.ws; const bf16* P = (const bf16*)(ws + WS_P); const bf16* WLT = (const bf16*)(ws + WS_WLT); const float* mu = A.in[5];
    unsigned char* AIN = ws + WS_AIN;
    const int c16 = lane & 15, g = lane >> 4;
    for (int tile = vcu; tile < NTOK / 32; tile += G) {
        const int row0 = tile * 32;
        __syncthreads();
        int tidv = tid; asm volatile("" : "+v"(tidv));
        {
#pragma unroll
            for (int bt = 0; bt < 2; ++bt) {
            v4u pt[2], pp[2]; f32x4 m0[2], m1[2];
#pragma unroll
            for (int i = 0; i < 2; ++i) { const int idx = min(tidv + NTHR * (2 * bt + i), 32 * 56 - 1), tk = idx / 56, vec = idx % 56, row = row0 + tk, col = C_DW + vec * 8;
                pt[i] = *(const v4u*)(P + (size_t)row * PW + col); pp[i] = *(const v4u*)(P + (size_t)(row - ((row % T) ? 1 : 0)) * PW + col);
                m0[i] = *(const f32x4*)(mu + col); m1[i] = *(const f32x4*)(mu + col + 4); }
#pragma unroll
            for (int i = 0; i < 2; ++i) { const int idx = tidv + NTHR * (2 * bt + i), idc = min(idx, 32 * 56 - 1), tk = idc / 56, vec = idc % 56, row = row0 + tk; const bool hp = (row % T) != 0;
                float x[8]; const unsigned tw[4] = {pt[i].x, pt[i].y, pt[i].z, pt[i].w}, pw[4] = {pp[i].x, pp[i].y, pp[i].z, pp[i].w}; const float mm[8] = {m0[i].x, m0[i].y, m0[i].z, m0[i].w, m1[i].x, m1[i].y, m1[i].z, m1[i].w};
#pragma unroll
                for (int e = 0; e < 8; ++e) { const float a = (e & 1) ? bfh(tw[e >> 1]) : bfl(tw[e >> 1]); float b = (e & 1) ? bfh(pw[e >> 1]) : bfl(pw[e >> 1]); b = hp ? b : 0.f; const float ps = a + mm[e] * (b - a);
                    x[e] = vec < 12 ? 2.0f * fsigmoid(2.0f * ps) - 1.0f : (vec < 24 ? ps : fsigmoid(ps)); }
                v4u o; o.x = pk2(x[0], x[1]); o.y = pk2(x[2], x[3]); o.z = pk2(x[4], x[5]); o.w = pk2(x[6], x[7]);
                if (idx < 32 * 56) *(LAS v4u*)(lds + tk * 912 + vec * 16) = o; }
            asm volatile("" ::: "memory"); }
        }
        __syncthreads();
#pragma unroll 1
        for (int hh = 0; hh < 2; ++hh) {
            const int h = wave * 2 + hh;
            LAS unsigned char* inw = lds + A0_IN + wave * A0_INW;
            { const bool first = (row0 % T) == 0; int lanev = lane; asm volatile("" : "+v"(lanev));
#pragma unroll
              for (int bt = 0; bt < 2; ++bt) { v4u x[7];
#pragma unroll
                for (int i = 0; i < 7; ++i) { const int idx = lanev + 64 * (7 * bt + i), seg = min(idx >> 3, 98), pc = idx & 7, r = seg / 3, a = seg - 3 * r, grow = row0 - 1 + r + ((first && r == 0) ? 1 : 0);
                    x[i] = *(const v4u*)(P + (size_t)grow * PW + a * 1024 + h * 64 + pc * 8); }
#pragma unroll
                for (int i = 0; i < 7; ++i) { const int idx = lanev + 64 * (7 * bt + i), seg = idx >> 3, pc = idx & 7, r = seg / 3, a = seg - 3 * r;
                    const v4u z = (v4u){0u, 0u, 0u, 0u}; if (seg < 99) *(LAS v4u*)(inw + r * A0_ROWB + a * 128 + pc * 16) = (first && r == 0) ? z : x[i]; }
                asm volatile("" ::: "memory"); } }
            const int tpos0 = row0 % T, b = row0 / T; unsigned char* blk = AIN + (size_t)((b * 16 + h) * 256 + (tpos0 >> 6)) * AIN_BYTES; const int tl0 = tpos0 & 63;
            float ssk[2] = {0.f, 0.f}, ssb[2] = {0.f, 0.f};
            const bf16* wbase = WLT + (size_t)(h * 64 + c16) * 448 + 8 * g; const int colb = h * 64 + 4 * g;
            if constexpr (PV != 2) { bf16x8 w0[3]; A0Par pn;
#pragma unroll
              for (int ks = 0; ks < 3; ++ks) w0[ks] = *(const bf16x8*)(wbase + 32 * (3 + ks));
              a0_loadpar<false>(pn, A, mu, colb);
#pragma unroll 1
              for (int ct = 0; ct < 4; ++ct) { f32x4 acc[2][3]; a0_mfma<false>(acc, w0, lds, c16, g); const A0Par p = pn;
                  if (ct < 3) {
#pragma unroll
                      for (int ks = 0; ks < 3; ++ks) w0[ks] = *(const bf16x8*)(wbase + (size_t)(ct + 1) * 16 * 448 + 32 * (3 + ks));
                      a0_loadpar<false>(pn, A, mu, colb + 16 * (ct + 1)); }
                  asm volatile("" ::: "memory");
                  a0_ct<false>(acc, p, inw, blk, tl0, ct, c16, g, ssk, ssb); asm volatile("" ::: "memory"); } }
#pragma unroll
            for (int tt = 0; tt < 2; ++tt) { ssk[tt] = 1.0f / fmaxf(sqrtf(xsum16_32(ssk[tt])), 1e-12f); ssb[tt] = xsum16_32(ssb[tt]); }
            if constexpr (PV != 0) { if (ssk[0] + ssb[1] == 1234.5f) *(float*)blk = ssk[0]; }
            if constexpr (PV == 0) { bf16x8 w1[14]; A0Par pn;
#pragma unroll
              for (int ks = 0; ks < 14; ++ks) w1[ks] = *(const bf16x8*)(wbase + 32 * ks);
              a0_loadpar<true>(pn, A, mu, colb);
#pragma unroll 1
              for (int ct = 0; ct < 4; ++ct) { f32x4 acc[2][3]; a0_mfma<true>(acc, w1, lds, c16, g); const A0Par p = pn;
                  if (ct < 3) {
#pragma unroll
                      for (int ks = 0; ks < 14; ++ks) w1[ks] = *(const bf16x8*)(wbase + (size_t)(ct + 1) * 16 * 448 + 32 * ks);
                      a0_loadpar<true>(pn, A, mu, colb + 16 * (ct + 1)); }
                  asm volatile("" ::: "memory");
                  a0_ct<true>(acc, p, inw, blk, tl0, ct, c16, g, ssk, ssb);
                  asm volatile("" ::: "memory"); } }
        }
    }
}

constexpr int LA_CL = 0, LA_AS = 16640, LA_BS = 25856, LA_KS = 35072, LA_RS = 44288, LA_KGT = 53504, LA_BGT = 62720, LA_VT = 71936, LA_NS = 81152, LA_XU = 98560, LA_WS = 115968, LA_TOT = 125184, LA_SCR = 126208, LA_TS = 134400;
__device__ __forceinline__ f32x16 gtile32(LAS unsigned char* lds, int offA, int si, int offB, int ti, int r32, int hi) {
    f32x16 c;
#pragma unroll
    for (int r = 0; r < 16; ++r) c[r] = 0.f;
#pragma unroll
    for (int ks = 0; ks < 4; ++ks) { const bf16x8 a = *(const LAS bf16x8*)(lds + offA + (32 * si + r32) * 144 + (16 * ks + 8 * hi) * 2), b = *(const LAS bf16x8*)(lds + offB + (32 * ti + r32) * 144 + (16 * ks + 8 * hi) * 2);
        c = __builtin_amdgcn_mfma_f32_32x32x16_bf16(a, b, c, 0, 0, 0); }
    return c;
}
template <bool INCL> __device__ __forceinline__ void mask_lower(f32x16& c, int r32, int hi) {
#pragma unroll
    for (int r = 0; r < 16; ++r) { const int s = crow(r, hi); if (INCL ? (s > r32) : (s >= r32)) c[r] = 0.f; }
}
__device__ __forceinline__ float xcomb(float v) {
    { auto r = __builtin_amdgcn_permlane16_swap(__float_as_uint(v), __float_as_uint(v), false, false); v = __uint_as_float(r[0]) + __uint_as_float(r[1]); }
    { auto r = __builtin_amdgcn_permlane32_swap(__float_as_uint(v), __float_as_uint(v), false, false); v = __uint_as_float(r[0]) + __uint_as_float(r[1]); }
    return v;
}
__device__ __forceinline__ void gv_acc(f32x16& o, const f32x16& G, LAS unsigned char* lds, int si, int ib, int r32, int hi) {
#pragma unroll
    for (int sp = 0; sp < 2; ++sp) { v4u w; const int b8 = 8 * sp;
        w.x = pg8::cvt_pk_bf16(G[b8 + 0], G[b8 + 1]); w.y = pg8::cvt_pk_bf16(G[b8 + 2], G[b8 + 3]); w.z = pg8::cvt_pk_bf16(G[b8 + 4], G[b8 + 5]); w.w = pg8::cvt_pk_bf16(G[b8 + 6], G[b8 + 7]);
        const LAS unsigned char* vp = lds + LA_VT + (32 * ib + r32) * 144 + (32 * si + 16 * sp + 4 * hi) * 2;
        const s16x4 lo = *(const LAS s16x4*)vp, hh = *(const LAS s16x4*)(vp + 16);
        o = __builtin_amdgcn_mfma_f32_32x32x16_bf16(__builtin_bit_cast(bf16x8, w), (bf16x8){lo[0], lo[1], lo[2], lo[3], hh[0], hh[1], hh[2], hh[3]}, o, 0, 0, 0); }
}
__device__ __forceinline__ void p3_rwkv_chunk(const Args& A, LAS unsigned char* lds, int vcu, int G, int tid, int wave, int lane) {
    unsigned char* ws = A.ws;
    LAS float* CL = (LAS float*)(lds + LA_CL); LAS float* TOT = (LAS float*)(lds + LA_TOT);
    const int t = tid >> 3, j0 = (tid & 7) * 8;
    const int e0 = ((j0 >> 4) * 64 + t) * 16 + (j0 & 15);
    f32x4 l0, l1; v4u vr, vk, vv, va, vb;
#define PA_LOAD_LD(ucx) do { const unsigned char* blk_ = ws + WS_AIN + (size_t)(ucx) * AIN_BYTES; l0 = *(const f32x4*)(blk_ + AIN_LD + e0 * 4); l1 = *(const f32x4*)(blk_ + AIN_LD + (e0 + 4) * 4); } while (0)
#define PA_LOAD(ucx) do { const unsigned char* blk_ = ws + WS_AIN + (size_t)(ucx) * AIN_BYTES; \
        vr = *(const v4u*)(blk_ + AIN_R + e0 * 2); vk = *(const v4u*)(blk_ + AIN_K2 + e0 * 2); vv = *(const v4u*)(blk_ + AIN_V + e0 * 2); \
        va = *(const v4u*)(blk_ + AIN_AV + e0 * 2); vb = *(const v4u*)(blk_ + AIN_BV + e0 * 2); } while (0)
    PA_LOAD_LD(min(vcu, 8191));
    for (int uc = vcu; uc < 8192; uc += G) {
        unsigned char* rec = ws + WS_REC + (size_t)uc * REC_BYTES;
        __syncthreads();
        PA_LOAD(uc);
        { LAS float* c = CL + t * 65 + j0; c[0] = l0.x; c[1] = l0.y; c[2] = l0.z; c[3] = l0.w; c[4] = l1.x; c[5] = l1.y; c[6] = l1.z; c[7] = l1.w; }
        __syncthreads();
        float xs[16];
        if (tid < 256) { const int j = tid & 63, q = tid >> 6; float run = 0.f;
#pragma unroll
            for (int e = 0; e < 16; ++e) { run += CL[(16 * q + e) * 65 + j]; xs[e] = run; }
            TOT[q * 64 + j] = run; }
        __syncthreads();
        if (tid < 256) { const int j = tid & 63, q = tid >> 6; float off = 0.f; for (int qq = 0; qq < q; ++qq) off += TOT[qq * 64 + j];
#pragma unroll
            for (int e = 0; e < 16; ++e) CL[(16 * q + e) * 65 + j] = off + xs[e]; }
        __syncthreads();
        {   const unsigned wr[4] = {vr.x, vr.y, vr.z, vr.w}, wk[4] = {vk.x, vk.y, vk.z, vk.w}, wv[4] = {vv.x, vv.y, vv.z, vv.w}, wa[4] = {va.x, va.y, va.z, va.w}, wb[4] = {vb.x, vb.y, vb.z, vb.w};
            float at[8], bt[8], kt[8], rt_[8], kg[8], bg[8], gc[8];
#pragma unroll
            for (int e = 0; e < 8; ++e) { const float ct = CL[t * 65 + j0 + e], cp = t ? CL[(t - 1) * 65 + j0 + e] : 0.f, cL = CL[63 * 65 + j0 + e];
                const float r_ = (e & 1) ? bfh(wr[e >> 1]) : bfl(wr[e >> 1]), k_ = (e & 1) ? bfh(wk[e >> 1]) : bfl(wk[e >> 1]), a_ = (e & 1) ? bfh(wa[e >> 1]) : bfl(wa[e >> 1]), b_ = (e & 1) ? bfh(wb[e >> 1]) : bfl(wb[e >> 1]);
                const float eg = __expf(ct), egi = __expf(-ct), ep = __expf(cp), eL = __expf(cL - ct);
                at[e] = a_ * ep; bt[e] = b_ * egi; kt[e] = k_ * egi; rt_[e] = r_ * eg; kg[e] = k_ * eL; bg[e] = b_ * eL; gc[e] = __expf(cL); }
            v4u o;
            o.x = pk2(at[0], at[1]); o.y = pk2(at[2], at[3]); o.z = pk2(at[4], at[5]); o.w = pk2(at[6], at[7]); *(LAS v4u*)(lds + LA_AS + t * 144 + j0 * 2) = o;
            o.x = pk2(bt[0], bt[1]); o.y = pk2(bt[2], bt[3]); o.z = pk2(bt[4], bt[5]); o.w = pk2(bt[6], bt[7]); *(LAS v4u*)(lds + LA_BS + t * 144 + j0 * 2) = o;
            o.x = pk2(kt[0], kt[1]); o.y = pk2(kt[2], kt[3]); o.z = pk2(kt[4], kt[5]); o.w = pk2(kt[6], kt[7]); *(LAS v4u*)(lds + LA_KS + t * 144 + j0 * 2) = o;
            o.x = pk2(rt_[0], rt_[1]); o.y = pk2(rt_[2], rt_[3]); o.z = pk2(rt_[4], rt_[5]); o.w = pk2(rt_[6], rt_[7]); *(LAS v4u*)(lds + LA_RS + t * 144 + j0 * 2) = o;
            *(v4u*)(rec + REC_RT + t * 144 + j0 * 2) = o;
#pragma unroll
            for (int e = 0; e < 8; ++e) { *(LAS bf16*)(lds + LA_KGT + (j0 + e) * 144 + t * 2) = (bf16)f2bf(kg[e]); *(LAS bf16*)(lds + LA_BGT + (j0 + e) * 144 + t * 2) = (bf16)f2bf(bg[e]);
                *(LAS bf16*)(lds + LA_VT + (j0 + e) * 144 + t * 2) = (bf16)((e & 1) ? (wv[e >> 1] >> 16) : (wv[e >> 1] & 0xffffu)); }
            if (t == 63) { *(f32x4*)(rec + REC_GC + j0 * 4) = (f32x4){gc[0], gc[1], gc[2], gc[3]}; *(f32x4*)(rec + REC_GC + (j0 + 4) * 4) = (f32x4){gc[4], gc[5], gc[6], gc[7]}; }
        }
        __syncthreads();
        int lanep = lane; asm volatile("" : "+v"(lanep));
        const int r32 = lanep & 31, hi = lanep >> 5, c16 = lanep & 15, g = lanep >> 4;
        if (wave < 4) {
            const int ib = wave & 1; const bool isY = wave >= 2; const int offX = isY ? LA_RS : LA_AS;
            f32x16 o;
#pragma unroll
            for (int r = 0; r < 16; ++r) o[r] = 0.f;
            { f32x16 Gt = gtile32(lds, LA_KS, 0, offX, 1, r32, hi); gv_acc(o, Gt, lds, 0, ib, r32, hi); }
            { f32x16 Gt = gtile32(lds, LA_KS, 1, offX, 1, r32, hi); if (isY) mask_lower<true>(Gt, r32, hi); else mask_lower<false>(Gt, r32, hi); gv_acc(o, Gt, lds, 1, ib, r32, hi); }
            if (!isY) {
#pragma unroll
                for (int r = 0; r < 16; ++r) *(LAS float*)(lds + LA_XU + ((32 + crow(r, hi)) * 68 + 32 * ib + r32) * 4) = o[r];
            } else {
#pragma unroll
                for (int u = 0; u < 4; ++u) { const int m = 2 + (u >> 1), lp = (r32 & 15) + 16 * (2 * (u & 1) + hi), vs = 2 * ib + (r32 >> 4);
                    *(pg8::u32x2*)(rec + REC_Y0 + ((vs * 4 + m) * 64 + lp) * 8) = (pg8::u32x2){pk2(o[4 * u], o[4 * u + 1]), pk2(o[4 * u + 2], o[4 * u + 3])}; }
            }
        } else if (wave < 6) {
            const bool isY = wave == 5; const int offX = isY ? LA_RS : LA_AS;
            f32x16 Gt = gtile32(lds, LA_KS, 0, offX, 0, r32, hi); if (isY) mask_lower<true>(Gt, r32, hi); else mask_lower<false>(Gt, r32, hi);
#pragma unroll
            for (int ib = 0; ib < 2; ++ib) { f32x16 o;
#pragma unroll
                for (int r = 0; r < 16; ++r) o[r] = 0.f;
                gv_acc(o, Gt, lds, 0, ib, r32, hi);
                if (!isY) {
#pragma unroll
                    for (int r = 0; r < 16; ++r) *(LAS float*)(lds + LA_XU + (crow(r, hi) * 68 + 32 * ib + r32) * 4) = o[r];
                } else {
#pragma unroll
                    for (int u = 0; u < 4; ++u) { const int m = (u >> 1), lp = (r32 & 15) + 16 * (2 * (u & 1) + hi), vs = 2 * ib + (r32 >> 4);
                        *(pg8::u32x2*)(rec + REC_Y0 + ((vs * 4 + m) * 64 + lp) * 8) = (pg8::u32x2){pk2(o[4 * u], o[4 * u + 1]), pk2(o[4 * u + 2], o[4 * u + 3])}; }
                } }
            const int hf = wave - 4;
#pragma unroll
            for (int jj = 0; jj < 2; ++jj)
#pragma unroll
                for (int vs = 0; vs < 4; ++vs) { const int jt = 2 * hf + jj; f32x4 acc = (f32x4){0.f, 0.f, 0.f, 0.f};
#pragma unroll
                    for (int ks = 0; ks < 2; ++ks) { const bf16x8 a = *(const LAS bf16x8*)(lds + LA_KGT + (16 * jt + c16) * 144 + (32 * ks + 8 * g) * 2), b = *(const LAS bf16x8*)(lds + LA_VT + (16 * vs + c16) * 144 + (32 * ks + 8 * g) * 2);
                        acc = __builtin_amdgcn_mfma_f32_16x16x32_bf16(a, b, acc, 0, 0, 0); }
                    *(pg8::u32x2*)(rec + REC_M0 + ((vs * 4 + jt) * 64 + lane) * 8) = (pg8::u32x2){pk2(acc[0], acc[1]), pk2(acc[2], acc[3])}; }
        } else {
            const bool isR = wave == 7; const int offX = isR ? LA_RS : LA_AS;
#pragma unroll
            for (int k = 0; k < 3; ++k) { const int si = k == 2 ? 1 : 0, ti = k == 0 ? 0 : 1;
                f32x16 Gt = gtile32(lds, LA_BS, si, offX, ti, r32, hi);
                if (si == ti) { if (isR) mask_lower<true>(Gt, r32, hi); else mask_lower<false>(Gt, r32, hi); }
#pragma unroll
                for (int u = 0; u < 4; ++u) {
                    if (!isR) *(LAS f32x4*)(lds + LA_NS + (32 * ti + r32) * 272 + (32 * si + 8 * u + 4 * hi) * 4) = (f32x4){Gt[4 * u], Gt[4 * u + 1], Gt[4 * u + 2], Gt[4 * u + 3]};
                    else *(pg8::u32x2*)(rec + REC_ARB + (32 * ti + r32) * 144 + (32 * si + 8 * u + 4 * hi) * 2) = (pg8::u32x2){pk2(Gt[4 * u], Gt[4 * u + 1]), pk2(Gt[4 * u + 2], Gt[4 * u + 3])}; }
            }
            if (isR) { const v4u z = (v4u){0u, 0u, 0u, 0u}; *(v4u*)(rec + REC_ARB + r32 * 144 + (32 + 16 * hi) * 2) = z; *(v4u*)(rec + REC_ARB + r32 * 144 + (40 + 16 * hi) * 2) = z; }
        }
        __syncthreads();
        const v4u vg1 = *(const v4u*)(ws + WS_AIN + (size_t)uc * AIN_BYTES + AIN_G1 + e0 * 2), vg2 = *(const v4u*)(ws + WS_AIN + (size_t)uc * AIN_BYTES + AIN_G2 + e0 * 2);
        PA_LOAD_LD(min(uc + G, 8191));
        if (wave < 4 && lane < 16) { const int bb = wave; float tc[16];
#pragma unroll
            for (int t2 = 0; t2 < 16; ++t2) { float v = (t2 == lane) ? 1.f : 0.f;
#pragma unroll
                for (int s4 = 0; s4 < (t2 + 3) / 4; ++s4) { const f32x4 n4 = *(const LAS f32x4*)(lds + LA_NS + (16 * bb + t2) * 272 + (16 * bb + 4 * s4) * 4);
#pragma unroll
                    for (int e = 0; e < 4; ++e) if (4 * s4 + e < t2) v += n4[e] * tc[4 * s4 + e]; }
                tc[t2] = v; *(LAS float*)(lds + LA_TS + ((bb * 16 + t2) * 16 + lane) * 4) = v; if ((t2 & 3) == 3) asm volatile("" ::: "memory"); } }
        __syncthreads();
        {   const bool isW = wave < 4; const int colw = 16 * (wave & 3) + c16;
            LAS float* RS = (LAS float*)(lds + LA_SCR + wave * 1024);
#pragma unroll 1
            for (int bb = 0; bb < 4; ++bb) {
                f32x4 acc;
#pragma unroll
                for (int r = 0; r < 4; ++r) acc[r] = isW ? bf1(*(const LAS bf16*)(lds + LA_AS + (16 * bb + 4 * g + r) * 144 + colw * 2)) : *(const LAS float*)(lds + LA_XU + ((16 * bb + 4 * g + r) * 68 + colw) * 4);
#pragma unroll 4
                for (int kk = 0; kk < 4 * bb; ++kk) { const float av = *(const LAS float*)(lds + LA_NS + (16 * bb + c16) * 272 + (4 * kk + g) * 4);
                    const float bv = isW ? CL[(4 * kk + g) * 65 + colw] : *(const LAS float*)(lds + LA_XU + ((4 * kk + g) * 68 + colw) * 4);
                    acc = __builtin_amdgcn_mfma_f32_16x16x4f32(av, bv, acc, 0, 0, 0); }
#pragma unroll
                for (int r = 0; r < 4; ++r) RS[(4 * g + r) * 16 + c16] = acc[r];
                f32x4 xa = (f32x4){0.f, 0.f, 0.f, 0.f};
#pragma unroll
                for (int kk = 0; kk < 4; ++kk) { const float av = *(const LAS float*)(lds + LA_TS + ((bb * 16 + c16) * 16 + 4 * kk + g) * 4); const float bv = RS[(4 * kk + g) * 16 + c16];
                    xa = __builtin_amdgcn_mfma_f32_16x16x4f32(av, bv, xa, 0, 0, 0); }
#pragma unroll
                for (int r = 0; r < 4; ++r) { if (isW) CL[(16 * bb + 4 * g + r) * 65 + colw] = xa[r]; else *(LAS float*)(lds + LA_XU + ((16 * bb + 4 * g + r) * 68 + colw) * 4) = xa[r]; }
                if (isW) {
#pragma unroll
                    for (int r = 0; r < 4; ++r) *(LAS bf16*)(lds + LA_WS + (16 * bb + 4 * g + r) * 144 + colw * 2) = (bf16)f2bf(xa[r]);
                } else *(pg8::u32x2*)(rec + REC_U0 + (((wave & 3) * 4 + bb) * 64 + lane) * 8) = (pg8::u32x2){pk2(xa[0], xa[1]), pk2(xa[2], xa[3])};
            }
        }
        __syncthreads();
        { const int bh = uc >> 8, row = (bh >> 4) * T + (uc & 255) * 64 + t; const size_t go = (size_t)row * 1024 + (bh & 15) * 64 + j0;
          *(v4u*)((bf16*)(ws + WS_G1) + go) = vg1; *(v4u*)((bf16*)(ws + WS_G2) + go) = vg2; }
        for (int i = tid; i < 576; i += NTHR) { *(v4u*)(rec + REC_W + i * 16) = *(const LAS v4u*)(lds + LA_WS + i * 16); *(v4u*)(rec + REC_BGT + i * 16) = *(const LAS v4u*)(lds + LA_BGT + i * 16); }
    }
}

#undef PA_LOAD
#undef PA_LOAD_LD
__device__ __forceinline__ bf16x8 afrag16(const LAS unsigned char* base, int row, int s, int g) {
    const LAS unsigned char* p = base + row * 144 + (32 * s + 4 * g) * 2; const s16x4 lo = *(const LAS s16x4*)p, hh = *(const LAS s16x4*)(p + 32);
    return (bf16x8){lo[0], lo[1], lo[2], lo[3], hh[0], hh[1], hh[2], hh[3]};
}
__device__ __forceinline__ bf16x8 pack_cc(const f32x4& a, const f32x4& b) { v4u w; w.x = pg8::cvt_pk_bf16(a[0], a[1]); w.y = pg8::cvt_pk_bf16(a[2], a[3]); w.z = pg8::cvt_pk_bf16(b[0], b[1]); w.w = pg8::cvt_pk_bf16(b[2], b[3]); return __builtin_bit_cast(bf16x8, w); }
__device__ __forceinline__ f32x4 cfrag(const LAS unsigned char* base, int vs, int m, int lane) { const pg8::u32x2 u = *(const LAS pg8::u32x2*)(base + ((vs * 4 + m) * 64 + lane) * 8); return (f32x4){bfl(u.x), bfh(u.x), bfl(u.y), bfh(u.y)}; }
constexpr int B_SLOT = 50176, B_NP = 49;
__device__ __forceinline__ void b_issue(const unsigned char* rec, LAS unsigned char* slot, int pair, int lw, int lane) {
    for (int p = lw; p < B_NP; p += 4) {
        const int src = p < 36 ? p * 1024 : (p < 48 ? REC_U0 + ((p - 36) >> 2) * 8192 + (2 * pair) * 2048 + ((p - 36) & 3) * 1024 : REC_GC);
        __builtin_amdgcn_global_load_lds((const unsigned*)(rec + src + lane * 16), (LAS unsigned*)(slot + p * 1024), 16, 0, 0); }
}
__device__ __forceinline__ void p4_rwkv_seq(const Args& A, LAS unsigned char* lds, int q, int wave, int lane) {
    unsigned char* ws = A.ws; const int bh = q >> 1, pair = q & 1, vs = 2 * pair + (wave & 1);
    const unsigned char* REC = ws + WS_REC + (size_t)bh * 256 * REC_BYTES; bf16* YR = (bf16*)(ws + WS_YRAW);
    const int b = bh >> 4, h = bh & 15, c16 = lane & 15, g = lane >> 4, lw = wave - 4;
    if (wave >= 4) { b_issue(REC, lds, pair, lw, lane); b_issue(REC + REC_BYTES, lds + B_SLOT, pair, lw, lane);
        if (lw == 0) asm volatile("s_waitcnt vmcnt(13)" ::: "memory"); else asm volatile("s_waitcnt vmcnt(12)" ::: "memory"); }
    __syncthreads();
    f32x4 H[4];
#pragma unroll
    for (int jt = 0; jt < 4; ++jt) H[jt] = (f32x4){0.f, 0.f, 0.f, 0.f};
#pragma unroll 1
    for (int c = 0; c < 256; ++c) {
        const LAS unsigned char* buf = lds + (c % 3) * B_SLOT;
        if (wave >= 4) {
            if (c + 2 < 256) { b_issue(REC + (size_t)(c + 2) * REC_BYTES, lds + ((c + 2) % 3) * B_SLOT, pair, lw, lane);
                if (lw == 0) asm volatile("s_waitcnt vmcnt(13)" ::: "memory"); else asm volatile("s_waitcnt vmcnt(12)" ::: "memory"); }
            else asm volatile("s_waitcnt vmcnt(0)" ::: "memory");
        } else if (wave < 2) {
            const LAS unsigned char* qb = buf + 36864 + (wave & 1) * 2048;
            bf16x8 hb[2]; hb[0] = pack_cc(H[0], H[1]); hb[1] = pack_cc(H[2], H[3]);
            f32x4 U[4];
#pragma unroll
            for (int m = 0; m < 4; ++m) { U[m] = cfrag(qb, 0, m, lane);
#pragma unroll
                for (int s = 0; s < 2; ++s) U[m] = __builtin_amdgcn_mfma_f32_16x16x32_bf16(afrag16(buf + REC_W, 16 * m + c16, s, g), hb[s], U[m], 0, 0, 0); }
            bf16x8 ub[2]; ub[0] = pack_cc(U[0], U[1]); ub[1] = pack_cc(U[2], U[3]);
#pragma unroll
            for (int jt = 0; jt < 4; ++jt) { const f32x4 gc = *(const LAS f32x4*)(buf + 49152 + (16 * jt + 4 * g) * 4); f32x4 hn = H[jt] * gc + cfrag(qb + 8192, 0, jt, lane);
#pragma unroll
                for (int s = 0; s < 2; ++s) hn = __builtin_amdgcn_mfma_f32_16x16x32_bf16(afrag16(buf + REC_BGT, 16 * jt + c16, s, g), ub[s], hn, 0, 0, 0);
                H[jt] = hn; }
#pragma unroll
            for (int m = 0; m < 4; ++m) { f32x4 y = cfrag(qb + 4096, 0, m, lane);
#pragma unroll
                for (int s = 0; s < 2; ++s) y = __builtin_amdgcn_mfma_f32_16x16x32_bf16(afrag16(buf + REC_RT, 16 * m + c16, s, g), hb[s], y, 0, 0, 0);
#pragma unroll
                for (int s = 0; s < 2; ++s) y = __builtin_amdgcn_mfma_f32_16x16x32_bf16(afrag16(buf + REC_ARB, 16 * m + c16, s, g), ub[s], y, 0, 0, 0);
                bf16* yp = YR + (size_t)(b * T + 64 * c + 16 * m + 4 * g) * 1024 + h * 64 + 16 * vs + c16;
                yp[0] = (bf16)f2bf(y[0]); yp[1024] = (bf16)f2bf(y[1]); yp[2048] = (bf16)f2bf(y[2]); yp[3072] = (bf16)f2bf(y[3]); }
        }
        __syncthreads();
    }
}
__device__ __forceinline__ void p5_rwkv_final(const Args& A, int vcu, int G, int wave, int lane) {
    const bf16* YR = (const bf16*)(A.ws + WS_YRAW); const bf16* G1 = (const bf16*)(A.ws + WS_G1); const bf16* G2 = (const bf16*)(A.ws + WS_G2); bf16* MIX = (bf16*)(A.ws + WS_MIX);
    const int gw = vcu * NWAVES + wave, NGW = G * NWAVES, pr = lane >> 3, oct = lane & 7;
    for (int it0 = gw * 8 + pr; it0 < NTOK * 16; it0 += NGW * 8 * 4) {
        v4u y[4], a[4], c[4];
#pragma unroll
        for (int k = 0; k < 4; ++k) { const int it = min(it0 + k * NGW * 8, NTOK * 16 - 1); const size_t o = (size_t)(it >> 4) * 1024 + (it & 15) * 64 + oct * 8;
            y[k] = *(const v4u*)(YR + o); a[k] = *(const v4u*)(G1 + o); c[k] = *(const v4u*)(G2 + o); }
#pragma unroll
        for (int k = 0; k < 4; ++k) { const int it = it0 + k * NGW * 8;
            const unsigned yw[4] = {y[k].x, y[k].y, y[k].z, y[k].w}, aw[4] = {a[k].x, a[k].y, a[k].z, a[k].w}, cw[4] = {c[k].x, c[k].y, c[k].z, c[k].w};
            float v[8]; float sm = 0.f;
#pragma unroll
            for (int e = 0; e < 4; ++e) { v[2 * e] = bfl(yw[e]); v[2 * e + 1] = bfh(yw[e]); sm += v[2 * e] + v[2 * e + 1]; }
            sm += __shfl_xor(sm, 1); sm += __shfl_xor(sm, 2); sm += __shfl_xor(sm, 4);
            const float mean = sm * (1.f / 64.f); float sq = 0.f;
#pragma unroll
            for (int e = 0; e < 8; ++e) { v[e] -= mean; sq += v[e] * v[e]; }
            sq += __shfl_xor(sq, 1); sq += __shfl_xor(sq, 2); sq += __shfl_xor(sq, 4);
            const float rstd = 1.0f / sqrtf(sq * (1.f / 64.f) + GN_EPS);
            v4u o4; unsigned ow[4];
#pragma unroll
            for (int e = 0; e < 4; ++e) ow[e] = pk2(v[2 * e] * rstd * bfl(aw[e]) + bfl(cw[e]), v[2 * e + 1] * rstd * bfh(aw[e]) + bfh(cw[e]));
            o4.x = ow[0]; o4.y = ow[1]; o4.z = ow[2]; o4.w = ow[3];
            if (it < NTOK * 16) *(v4u*)(MIX + (size_t)(it >> 4) * D + (it & 15) * 64 + oct * 8) = o4; }
    }
}

__device__ __forceinline__ void p5_ln_router(const Args& A, LAS unsigned char* lds, int vcu, int G, int tid, int wave, int lane) {
    unsigned char* ws = A.ws; const bf16* Z1 = (const bf16*)(ws + WS_Z1); bf16* H1 = (bf16*)(ws + WS_H1); const bf16* RWF = (const bf16*)(ws + WS_RWT);
    int* TOPI = (int*)(ws + RT_TOPI); float* TOPG = (float*)(ws + RT_TOPG); int* CNT = (int*)(ws + RT_CNT);
    LAS int* hist = (LAS int*)lds; const int c16 = lane & 15, g = lane >> 4;
    const float* gam = A.in[21]; const float* bet = A.in[22];
    for (int batch = vcu; batch < NTOK / 128; batch += G) {
        __syncthreads();
        if (tid < NE) hist[tid] = 0;
        __syncthreads();
        const int row0 = batch * 128 + wave * 16; const bf16* zr = Z1 + (size_t)(row0 + c16) * D + 8 * g;
        float sm = 0.f, sq = 0.f;
#pragma unroll 8
        for (int sx = 0; sx < 64; ++sx) { const v4u z = *(const v4u*)(zr + 32 * sx); const unsigned zw[4] = {z.x, z.y, z.z, z.w};
#pragma unroll
            for (int e = 0; e < 4; ++e) { const float a = bfl(zw[e]), b = bfh(zw[e]); sm += a + b; sq += a * a + b * b; } }
        sm += __shfl_xor(sm, 16); sm += __shfl_xor(sm, 32); sq += __shfl_xor(sq, 16); sq += __shfl_xor(sq, 32);
        const float mean = sm * (1.f / D); const float rstd = 1.0f / sqrtf(fmaxf(sq * (1.f / D) - mean * mean, 0.f) + LN_EPS);
        f32x4 acc[2]; acc[0] = (f32x4){0.f, 0.f, 0.f, 0.f}; acc[1] = acc[0];
        bf16* hr = H1 + (size_t)(row0 + c16) * D + 8 * g; unsigned char* hq = ws + WS_H1Q + (size_t)(row0 + c16) * D + 8 * g;
#pragma unroll 2
        for (int sx = 0; sx < 64; ++sx) { const v4u z = *(const v4u*)(zr + 32 * sx); const f32x4 a = (f32x4){bfl(z.x), bfh(z.x), bfl(z.y), bfh(z.y)}, b = (f32x4){bfl(z.z), bfh(z.z), bfl(z.w), bfh(z.w)};
            const f32x4 g0 = *(const f32x4*)(gam + 32 * sx + 8 * g), g1 = *(const f32x4*)(gam + 32 * sx + 8 * g + 4), b0 = *(const f32x4*)(bet + 32 * sx + 8 * g), b1 = *(const f32x4*)(bet + 32 * sx + 8 * g + 4);
            const f32x4 h0 = (a - mean) * rstd * g0 + b0, h1 = (b - mean) * rstd * g1 + b1;
            v4u hi; hi.x = pg8::cvt_pk_bf16(h0.x, h0.y); hi.y = pg8::cvt_pk_bf16(h0.z, h0.w); hi.z = pg8::cvt_pk_bf16(h1.x, h1.y); hi.w = pg8::cvt_pk_bf16(h1.z, h1.w);
            *(v4u*)(hr + 32 * sx) = hi;
            *(pg8::u32x2*)(hq + 32 * sx) = (pg8::u32x2){pg8::pk4_fp8(h0.x, h0.y, h0.z, h0.w), pg8::pk4_fp8(h1.x, h1.y, h1.z, h1.w)};
            v4u lo; lo.x = pg8::cvt_pk_bf16(h0.x - bfl(hi.x), h0.y - bfh(hi.x)); lo.y = pg8::cvt_pk_bf16(h0.z - bfl(hi.y), h0.w - bfh(hi.y));
            lo.z = pg8::cvt_pk_bf16(h1.x - bfl(hi.z), h1.y - bfh(hi.z)); lo.w = pg8::cvt_pk_bf16(h1.z - bfl(hi.w), h1.w - bfh(hi.w));
            const bf16x8 ah = __builtin_bit_cast(bf16x8, hi), al = __builtin_bit_cast(bf16x8, lo);
#pragma unroll
            for (int nt = 0; nt < 2; ++nt) { const bf16* fp = RWF + ((size_t)((sx * 2 + nt) * 2) * 64 + lane) * 8; const bf16x8 wh = *(const bf16x8*)fp, wl = *(const bf16x8*)(fp + 512);
                acc[nt] = __builtin_amdgcn_mfma_f32_16x16x32_bf16(ah, wh, acc[nt], 0, 0, 0); acc[nt] = __builtin_amdgcn_mfma_f32_16x16x32_bf16(ah, wl, acc[nt], 0, 0, 0);
                acc[nt] = __builtin_amdgcn_mfma_f32_16x16x32_bf16(al, wh, acc[nt], 0, 0, 0); } }
        const float bia0 = A.in[24][c16], bia1 = A.in[24][16 + c16];
#pragma unroll
        for (int r = 0; r < 4; ++r) {
            float v0 = acc[0][r] + bia0, v1 = acc[1][r] + bia1; float tv[4]; int ti[4];
#pragma unroll
            for (int k = 0; k < 4; ++k) { float bv = v0; int bi = c16; if (v1 > bv) { bv = v1; bi = 16 + c16; }
#pragma unroll
                for (int o = 1; o < 16; o <<= 1) { const float ov = __shfl_xor(bv, o); const int oi = __shfl_xor(bi, o); if (ov > bv || (ov == bv && oi < bi)) { bv = ov; bi = oi; } }
                tv[k] = bv; ti[k] = bi; if (bi == c16) v0 = -INFINITY; if (bi == 16 + c16) v1 = -INFINITY; }
            const float e1 = __expf(tv[1] - tv[0]), e2 = __expf(tv[2] - tv[0]), e3 = __expf(tv[3] - tv[0]); const float inv = 1.f / (1.f + e1 + e2 + e3);
            if (c16 < 4) { const int row = row0 + 4 * g + r; const int ei = c16 == 0 ? ti[0] : c16 == 1 ? ti[1] : c16 == 2 ? ti[2] : ti[3]; const float gv = (c16 == 0 ? 1.f : c16 == 1 ? e1 : c16 == 2 ? e2 : e3) * inv;
                TOPI[row * 4 + c16] = ei; TOPG[row * 4 + c16] = gv; __hip_atomic_fetch_add(hist + ei, 1, __ATOMIC_RELAXED, __HIP_MEMORY_SCOPE_WORKGROUP); }
        }
        __syncthreads();
        if (tid < NE) CNT[batch * NE + tid] = hist[tid];
    }
}
__device__ __forceinline__ void p6_positions(const Args& A, LAS unsigned char* lds, int vcu, int G, int tid) {
    unsigned char* ws = A.ws; const int* TOPI = (const int*)(ws + RT_TOPI); const float* TOPG = (const float*)(ws + RT_TOPG); const int* CNT = (const int*)(ws + RT_CNT);
    int* POS = (int*)(ws + RT_POS); int* BTOK = (int*)(ws + RT_TOK); float* BGATE = (float*)(ws + RT_GATE); int* TILE = (int*)(ws + RT_TILE);
    LAS int* sh = (LAS int*)lds;
    for (int batch = vcu; batch < NTOK / 128; batch += G) {
        __syncthreads();
        { const int e = tid & 31, seg = tid >> 5; int sb = 0, st = 0;
          for (int q = 0; q < 16; ++q) { const int bb = seg * 16 + q; const int c = CNT[bb * NE + e]; st += c; if (bb < batch) sb += c; }
          sh[tid] = sb; sh[1152 + tid] = st; }
        sh[640 + tid] = TOPI[batch * 512 + tid];
        __syncthreads();
        if (tid < NE) { int sb = 0, st = 0; for (int s = 0; s < 16; ++s) { sb += sh[s * 32 + tid]; st += sh[1152 + s * 32 + tid]; } sh[512 + tid] = sb; sh[544 + tid] = st; }
        __syncthreads();
        if (tid == 0) { int acc = 0; for (int e = 0; e < NE; ++e) { sh[576 + e] = acc; acc += (sh[544 + e] + 255) >> 8; } sh[576 + NE] = acc; }
        __syncthreads();
        { const int e = sh[640 + tid]; int rank = 0; for (int j = 0; j < tid; ++j) rank += (sh[640 + j] == e) ? 1 : 0;
          const int dest = sh[576 + e] * 256 + sh[512 + e] + rank;
          BTOK[dest] = batch * 128 + (tid >> 2); BGATE[dest] = TOPG[batch * 512 + tid]; POS[batch * 512 + tid] = dest; }
        if (batch < NE) { const int e = batch; const int lo = sh[576 + e] * 256 + sh[544 + e], hi = sh[576 + e + 1] * 256;
            for (int i = lo + tid; i < hi; i += NTHR) { BTOK[i] = 0; BGATE[i] = 0.f; }
            for (int rt = sh[576 + e] + tid; rt < sh[576 + e + 1]; rt += NTHR) TILE[rt] = e; }
        if (batch == 0 && tid == 0) TILE[MAXT] = sh[576 + NE];
    }
}
template <int I> __device__ __forceinline__ float fp8f_(unsigned w) { return __builtin_amdgcn_cvt_f32_fp8((int)w, I); }
#define fp8f(w, i) fp8f_<i>(w)
__device__ __forceinline__ void p9_final(const Args& A, int vcu, int G, int wave, int lane) {
    unsigned char* ws = A.ws; const bf16* H1 = (const bf16*)(ws + WS_H1); const unsigned char* Y = ws + WS_Y; const int* POS = (const int*)(ws + RT_POS);
    const int gw = vcu * NWAVES + wave, NGW = G * NWAVES;
    for (int row = gw; row < NTOK; row += NGW) {
        int lq = lane; asm volatile("" : "+v"(lq));
        f32x4 v[8]; const int p0 = POS[row * 4], p1 = POS[row * 4 + 1], p2 = POS[row * 4 + 2], p3 = POS[row * 4 + 3];
#pragma unroll
        for (int j = 0; j < 8; ++j) { const int c = 4 * lq + 256 * j;
            const pg8::u32x2 h = *(const pg8::u32x2*)(H1 + (size_t)row * D + c);
            const unsigned y0 = *(const unsigned*)(Y + (size_t)p0 * D + c), y1 = *(const unsigned*)(Y + (size_t)p1 * D + c), y2 = *(const unsigned*)(Y + (size_t)p2 * D + c), y3 = *(const unsigned*)(Y + (size_t)p3 * D + c);
            const float s = 1.0f / 64.0f;
            v[j].x = ALPHA * bfl(h.x) + s * ((fp8f(y0, 0) + fp8f(y1, 0)) + (fp8f(y2, 0) + fp8f(y3, 0))); v[j].y = ALPHA * bfh(h.x) + s * ((fp8f(y0, 1) + fp8f(y1, 1)) + (fp8f(y2, 1) + fp8f(y3, 1)));
            v[j].z = ALPHA * bfl(h.y) + s * ((fp8f(y0, 2) + fp8f(y1, 2)) + (fp8f(y2, 2) + fp8f(y3, 2))); v[j].w = ALPHA * bfh(h.y) + s * ((fp8f(y0, 3) + fp8f(y1, 3)) + (fp8f(y2, 3) + fp8f(y3, 3))); }
        ln_row(v, A.in[29], A.in[30], LN_EPS, lane);
#pragma unroll
        for (int j = 0; j < 8; ++j) *(f32x4*)(A.out + (size_t)row * D + 4 * lq + 256 * j) = v[j];
    }
}

constexpr int NPH = 12;
template <int PLO, int PHI>
__global__ void __launch_bounds__(NTHR, 2) fwd_kernel(Args args) {
    extern __shared__ __attribute__((aligned(16))) unsigned char lds_raw[];
    LAS unsigned char* lds = (LAS unsigned char*)lds_raw;
    const int tid = threadIdx.x, lane = tid & 63, wave = __builtin_amdgcn_readfirstlane(tid >> 6);
    const int G = gridDim.x; const int bx = blockIdx.x; const int vcu = (G % 8 == 0) ? (bx % 8) * (G / 8) + bx / 8 : bx;
    volatile LAS unsigned* MISC = (volatile LAS unsigned*)(lds + MISC_OFF);
    if (tid < 64) MISC[tid] = 0u;
    __syncthreads();
    unsigned char* ws = args.ws;
    unsigned* ctl = (unsigned*)(ws + WS_CTL);
    constexpr int lo = PLO, hi = PHI;
    XcdBarrier bar; bar.bar = ctl + CW_BAR; bar.x = 0; bar.st = nullptr;
    if (hi - lo > 1) bar = xcd_barrier_post(ctl + CW_BAR, MISC + 8);
#define IN(k) (lo <= (k) && (k) < hi)
#define SEAM(k) do { if constexpr (IN(k) && IN((k) + 1)) xcd_barrier(bar); } while (0)

    if constexpr (IN(0)) { p0_prologue(args, lds, vcu, G, wave, lane); }
#if defined(REP_PHASE)
    if constexpr (REP_PHASE == 0) { __syncthreads();
    if constexpr (IN(0)) { p0_prologue(args, lds, vcu, G, wave, lane); }
    }
#endif
    SEAM(0);
    if constexpr (IN(1)) {
        const int ng = (G == 256) ? NG_INPROJ : G;
        if (bx >= ng) { pg8::Gemm g{(const bf16*)(ws + WS_MEMN), (const bf16*)(ws + WS_WKV), NB * MEM_LEN, 1024, D}; pg8::StaticOrder S; S.init(NB * MEM_LEN, 1024, G - ng, bx - ng);
            pg8::EpiBf16 E{(bf16*)(ws + WS_KVM), 1024};
            pg8::gemm_phase<pg8::EpiBf16, pg8::StaticOrder>(lds, g, S, E);
            conv_pull_loop(args, lds, tid, wave, lane); }
        {   volatile LAS int* slot = (volatile LAS int*)(lds + 131072 + 1024); pg8::QueueOrder S; S.init(NTOK, PW, bx & 7, ctl + CW_GQ, slot, 0);
            __syncthreads();
            if (tid == 0) { slot[0] = S.pop(); slot[1] = S.pop(); S.pend = S.pop(); }
            __syncthreads();
            pg8::Gemm g{(const bf16*)(ws + WS_H0), (const bf16*)(ws + WS_WI), NTOK, PW, D};
            pg8::EpiBf16 E{(bf16*)(ws + WS_P), PW};
            pg8::gemm_phase<pg8::EpiBf16, pg8::QueueOrder>(lds, g, S, E); }
        if (bx < ng) conv_pull_loop(args, lds, tid, wave, lane);
    }
#if defined(REP_PHASE)
    if constexpr (REP_PHASE == 1) { __syncthreads();
    if constexpr (IN(1)) {
        pg8::Gemm g{(const bf16*)(ws + WS_H0), (const bf16*)(ws + WS_WI), NTOK, PW, D}; pg8::StaticOrder S; S.init(NTOK, PW, G, bx);
        pg8::EpiBf16 E{(bf16*)(ws + WS_P), PW};
        pg8::gemm_phase<pg8::EpiBf16, pg8::StaticOrder>(lds, g, S, E);
    }
    }
#endif
    SEAM(1);
    if constexpr (IN(2)) {
        if (G != 256) { pg8::Gemm g{(const bf16*)(ws + WS_MEMN), (const bf16*)(ws + WS_WKV), NB * MEM_LEN, 1024, D}; pg8::StaticOrder S; S.init(NB * MEM_LEN, 1024, G, bx);
          pg8::EpiBf16 E{(bf16*)(ws + WS_KVM), 1024};
          pg8::gemm_phase<pg8::EpiBf16, pg8::StaticOrder>(lds, g, S, E); }
        __syncthreads();
        p2_fox_cumsum(args, lds, (vcu + G - 16) % G, G, tid);
        __syncthreads();
        p2_fox_norms(args, lds, vcu, G, tid, wave, lane);
        __syncthreads();
        p2_rwkv_tok(args, lds, vcu, G, tid, wave, lane);
#if defined(REP_SUB)
        __syncthreads();
        if constexpr (REP_SUB == 0) p2_rwkv_tok(args, lds, vcu, G, tid, wave, lane);
        if constexpr (REP_SUB == 11) p2_rwkv_tok<1>(args, lds, vcu, G, tid, wave, lane);
        if constexpr (REP_SUB == 12) p2_rwkv_tok<2>(args, lds, vcu, G, tid, wave, lane);
        if constexpr (REP_SUB == 1) p2_fox_norms(args, lds, vcu, G, tid, wave, lane);
        if constexpr (REP_SUB == 2) p2_fox_cumsum(args, lds, (vcu + G - 16) % G, G, tid);
        if constexpr (REP_SUB == 3) { pg8::Gemm g{(const bf16*)(ws + WS_MEMN), (const bf16*)(ws + WS_WKV), NB * MEM_LEN, 1024, D}; pg8::StaticOrder S; S.init(NB * MEM_LEN, 1024, G, bx);
          pg8::EpiBf16 E{(bf16*)(ws + WS_KVM), 1024};
          pg8::gemm_phase<pg8::EpiBf16, pg8::StaticOrder>(lds, g, S, E); }
#endif
    }
#if defined(REP_PHASE)
    if constexpr (REP_PHASE == 2) { __syncthreads();
    if constexpr (IN(2)) {
        { pg8::Gemm g{(const bf16*)(ws + WS_MEMN), (const bf16*)(ws + WS_WKV), NB * MEM_LEN, 1024, D}; pg8::StaticOrder S; S.init(NB * MEM_LEN, 1024, G, bx);
          pg8::EpiBf16 E{(bf16*)(ws + WS_KVM), 1024};
          pg8::gemm_phase<pg8::EpiBf16, pg8::StaticOrder>(lds, g, S, E); }
        __syncthreads();
        p2_fox_cumsum(args, lds, (vcu + G - 16) % G, G, tid);
        __syncthreads();
        p2_fox_norms(args, lds, vcu, G, tid, wave, lane);
        __syncthreads();
        p2_rwkv_tok(args, lds, vcu, G, tid, wave, lane);
    }
    }
#endif
    SEAM(2);
    if constexpr (IN(3)) { p3_rwkv_chunk(args, lds, vcu, G, tid, wave, lane); }
#if defined(REP_PHASE)
    if constexpr (REP_PHASE == 3) { __syncthreads();
    if constexpr (IN(3)) { p3_rwkv_chunk(args, lds, vcu, G, tid, wave, lane); }
    }
#endif
    SEAM(3);
    if constexpr (IN(4)) {
        for (int q = vcu; q < 64; q += G) { __syncthreads(); p4_rwkv_seq(args, lds, q, wave, lane); }
        p3_attention(args, lds, tid, wave, lane);
    }
#if defined(REP_PHASE)
    if constexpr (REP_PHASE == 4) { __syncthreads();
    if constexpr (IN(4)) {
        for (int q = vcu; q < 64; q += G) { __syncthreads(); p4_rwkv_seq(args, lds, q, wave, lane); }
        p3_attention(args, lds, tid, wave, lane);
    }
    }
#endif
    SEAM(4);
    if constexpr (IN(5)) { p5_rwkv_final(args, vcu, G, wave, lane); }
#if defined(REP_PHASE)
    if constexpr (REP_PHASE == 5) { __syncthreads();
    if constexpr (IN(5)) { p5_rwkv_final(args, vcu, G, wave, lane); }
    }
#endif
    SEAM(5);
    if constexpr (IN(6)) {
        pg8::Gemm g{(const bf16*)(ws + WS_MIX), (const bf16*)(ws + WS_WO), NTOK, D, D}; pg8::StaticOrder S; S.init(NTOK, D, G, bx);
        pg8::EpiResBf16 E{(bf16*)(ws + WS_Z1), (const bf16*)(ws + WS_H0), D, ALPHA};
        pg8::gemm_phase<pg8::EpiResBf16, pg8::StaticOrder>(lds, g, S, E);
    }
#if defined(REP_PHASE)
    if constexpr (REP_PHASE == 6) { __syncthreads();
    if constexpr (IN(6)) {
        pg8::Gemm g{(const bf16*)(ws + WS_MIX), (const bf16*)(ws + WS_WO), NTOK, D, D}; pg8::StaticOrder S; S.init(NTOK, D, G, bx);
        pg8::EpiResBf16 E{(bf16*)(ws + WS_Z1), (const bf16*)(ws + WS_H0), D, ALPHA};
        pg8::gemm_phase<pg8::EpiResBf16, pg8::StaticOrder>(lds, g, S, E);
    }
    }
#endif
    SEAM(6);
    if constexpr (IN(7)) { p5_ln_router(args, lds, vcu, G, tid, wave, lane); }
#if defined(REP_PHASE)
    if constexpr (REP_PHASE == 7) { __syncthreads();
    if constexpr (IN(7)) { p5_ln_router(args, lds, vcu, G, tid, wave, lane); }
    }
#endif
    SEAM(7);
    if constexpr (IN(8)) { p6_positions(args, lds, vcu, G, tid); }
#if defined(REP_PHASE)
    if constexpr (REP_PHASE == 8) { __syncthreads();
    if constexpr (IN(8)) { p6_positions(args, lds, vcu, G, tid); }
    }
#endif
    SEAM(8);
    if constexpr (IN(9)) {
        const int* TILE = (const int*)(ws + RT_TILE); const int ntiles = __builtin_amdgcn_readfirstlane(TILE[MAXT]);
        pg8::Gemm g{(const bf16*)(ws + WS_H1Q), (const bf16*)(ws + WS_W1), CAP, NE * 4096, D / 2};
        pg8::MoeOrder<true> S{TILE, (const int*)(ws + RT_TOK), ntiles, 16, G, bx};
        pg8::EpiSwiglu E{ws + WS_ACT, args.in[26]};
        pg8::gemm_phase<pg8::EpiSwiglu, pg8::MoeOrder<true>, true, true>(lds, g, S, E);
    }
#if defined(REP_PHASE)
    if constexpr (REP_PHASE == 9) { __syncthreads();
    if constexpr (IN(9)) {
        const int* TILE = (const int*)(ws + RT_TILE); const int ntiles = __builtin_amdgcn_readfirstlane(TILE[MAXT]);
        pg8::Gemm g{(const bf16*)(ws + WS_H1Q), (const bf16*)(ws + WS_W1), CAP, NE * 4096, D / 2};
        pg8::MoeOrder<true> S{TILE, (const int*)(ws + RT_TOK), ntiles, 16, G, bx};
        pg8::EpiSwiglu E{ws + WS_ACT, args.in[26]};
        pg8::gemm_phase<pg8::EpiSwiglu, pg8::MoeOrder<true>, true, true>(lds, g, S, E);
    }
    }
#endif
    SEAM(9);
    if constexpr (IN(10)) {
        const int* TILE = (const int*)(ws + RT_TILE); const int ntiles = __builtin_amdgcn_readfirstlane(TILE[MAXT]);
        pg8::Gemm g{(const bf16*)(ws + WS_ACT), (const bf16*)(ws + WS_W2), CAP, NE * D, D / 2};
        pg8::MoeOrder<true> S{TILE, nullptr, ntiles, 8, G, bx};
        pg8::EpiGate E{ws + WS_Y, args.in[28], (const float*)(ws + RT_GATE)};
        pg8::gemm_phase<pg8::EpiGate, pg8::MoeOrder<true>, true, true>(lds, g, S, E);
    }
#if defined(REP_PHASE)
    if constexpr (REP_PHASE == 10) { __syncthreads();
    if constexpr (IN(10)) {
        const int* TILE = (const int*)(ws + RT_TILE); const int ntiles = __builtin_amdgcn_readfirstlane(TILE[MAXT]);
        pg8::Gemm g{(const bf16*)(ws + WS_ACT), (const bf16*)(ws + WS_W2), CAP, NE * D, D / 2};
        pg8::MoeOrder<true> S{TILE, nullptr, ntiles, 8, G, bx};
        pg8::EpiGate E{ws + WS_Y, args.in[28], (const float*)(ws + RT_GATE)};
        pg8::gemm_phase<pg8::EpiGate, pg8::MoeOrder<true>, true, true>(lds, g, S, E);
    }
    }
#endif
    SEAM(10);
    if constexpr (IN(11)) { p9_final(args, vcu, G, wave, lane); }
#if defined(REP_PHASE)
    if constexpr (REP_PHASE == 11) { __syncthreads();
    if constexpr (IN(11)) { p9_final(args, vcu, G, wave, lane); }
    }
#endif
#undef IN
#undef SEAM
}

template <int P> static void launch_phase(int grid, hipStream_t stream, const Args& a) {
    static bool init = false;
    if (!init) { (void)hipFuncSetAttribute((const void*)fwd_kernel<P, P + 1>, hipFuncAttributeMaxDynamicSharedMemorySize, LDS_BYTES); init = true; }
    hipLaunchKernelGGL((fwd_kernel<P, P + 1>), dim3(grid), dim3(NTHR), LDS_BYTES, stream, a);
}
extern "C" void kernel_launch(void* const* d_in, const int* in_sizes, int n_in, void* d_out, int out_size, void* d_ws, size_t ws_size, hipStream_t stream) {
    static int grid = 0;
    if (grid == 0) {
        if (n_in != 31 || out_size != NTOK * D || ws_size < WS_END) { fprintf(stderr, "kernel_launch: unexpected shapes (n_in %d out %d ws %zu, need %zu)\n", n_in, out_size, ws_size, (size_t)WS_END); grid = -1; return; }
        int dev = 0, cus = 0;
        if (hipGetDevice(&dev) != hipSuccess || hipDeviceGetAttribute(&cus, hipDeviceAttributeMultiprocessorCount, dev) != hipSuccess) { grid = -1; return; }
        grid = cus;
    }
    if (grid < 0) return;
    (void)hipMemsetAsync((char*)d_ws + WS_CTL, 0, CTL_ZERO_BYTES, stream);
    Args a{};
    for (int i = 0; i < 31; ++i) a.in[i] = (const float*)d_in[i];
    a.out = (float*)d_out; a.ws = (unsigned char*)d_ws;
#ifdef ONE_LAUNCH
    { static bool init = false; if (!init) { (void)hipFuncSetAttribute((const void*)fwd_kernel<0, NPH>, hipFuncAttributeMaxDynamicSharedMemorySize, LDS_BYTES); init = true; }
      hipLaunchKernelGGL((fwd_kernel<0, NPH>), dim3(grid), dim3(NTHR), LDS_BYTES, stream, a); }
#else
    launch_phase<0>(grid, stream, a); launch_phase<1>(grid, stream, a); launch_phase<2>(grid, stream, a); launch_phase<3>(grid, stream, a);
    launch_phase<4>(grid, stream, a); launch_phase<5>(grid, stream, a); launch_phase<6>(grid, stream, a); launch_phase<7>(grid, stream, a);
    launch_phase<8>(grid, stream, a); launch_phase<9>(grid, stream, a); launch_phase<10>(grid, stream, a); launch_phase<11>(grid, stream, a);
#endif
}
```

```cpp
#define ONE_LAUNCH 1
#include <hip/hip_runtime.h>
#include <cstdio>
#include <cstdint>

namespace pg8 {
#define PG8_LAS __attribute__((address_space(3)))
typedef unsigned short bf16_t;
typedef short bf16x8 __attribute__((ext_vector_type(8)));
typedef float f32x4 __attribute__((ext_vector_type(4)));
typedef unsigned u32x4 __attribute__((ext_vector_type(4)));
typedef unsigned u32x2 __attribute__((ext_vector_type(2)));
typedef int v4i32 __attribute__((ext_vector_type(4)));
typedef int v8i32 __attribute__((ext_vector_type(8)));
constexpr int SCALE_W = 0x79797979, SCALE_A = 0x7f7f7f7f;
constexpr int BM = 256, BK = 64, HALF = 128, HTB = HALF * BK * 2  , STAGE_BYTES = 8 * HTB, NXCD = 8, WGM = 8;

__host__ __device__ __forceinline__ int lds_byte(int r, int c) { const int st = (r >> 4) * 2 + (c >> 5), rr = r & 15, cc = c & 31, ob = rr * 64 + cc * 2; return st * 1024 + (ob ^ (((ob >> 9) & 1) << 5)); }
__host__ __device__ __forceinline__ void stage_rc(int b, int& R, int& C) { const int st = b / 1024, sb = b % 1024, swz = sb ^ (((sb >> 9) & 1) << 5); R = (st >> 1) * 16 + swz / 64; C = (st & 1) * 32 + (swz % 64) / 2; }
__host__ __device__ __forceinline__ int perm32(int rho) { const int n = rho >> 4, i = rho & 15; return 8 * (i >> 2) + 4 * n + (i & 3); }

struct Unit { int pm, pn; };
struct Gemm { const bf16_t* A; const bf16_t* Bt; int M, N, K; };

struct StaticOrder {
    int nM, nN, nwg, G, c;
    __host__ __device__ void init(int M, int N, int G_, int c_) { nM = M / BM; nN = N / BM; nwg = nM * nN; G = G_; c = c_; }
    __host__ __device__ bool next(int i, Unit& u) const {
        const long L = (long)i * G + c; if (L >= nwg) return false;
        int wgid = (int)L; { const int q = nwg / NXCD, r = nwg % NXCD, xcd = wgid % NXCD, off = wgid / NXCD; wgid = (xcd < r ? xcd * (q + 1) : r * (q + 1) + (xcd - r) * q) + off; }
        const int nig = WGM * nN, gid = wgid / nig, fm = gid * WGM, gsz = (nM - fm) < WGM ? (nM - fm) : WGM;
        u.pm = fm + ((wgid % nig) % gsz); u.pn = (wgid % nig) / gsz; return true;
    }
    static constexpr bool GATHER = false;
    __device__ __forceinline__ int arow(const Unit& u, int r) const { return u.pm * BM + r; }
};
struct QueueOrder {
    int nM, nN, nwg, x; unsigned* qhead; volatile PG8_LAS int* slot; mutable int pend;
    __device__ void init(int M, int N, int x_, unsigned* q_, volatile PG8_LAS int* s_, int pend_) { nM = M / BM; nN = N / BM; nwg = nM * nN; x = x_; qhead = q_; slot = s_; pend = pend_; }
    __device__ __forceinline__ int pop() const { return 8 * (int)__hip_atomic_fetch_add(qhead + 64 * x, 1u, __ATOMIC_RELAXED, __HIP_MEMORY_SCOPE_AGENT) + x; }
    __device__ __forceinline__ bool next(int i, Unit& u) const {
        const int L = __builtin_amdgcn_readfirstlane(slot[i % 3]);
        if (threadIdx.x == 0) { slot[(i + 2) % 3] = pend; pend = pop(); }
        if (L >= nwg) return false;
        int wgid = L; { const int q = nwg / NXCD, r = nwg % NXCD, xcd = wgid % NXCD, off = wgid / NXCD; wgid = (xcd < r ? xcd * (q + 1) : r * (q + 1) + (xcd - r) * q) + off; }
        const int nig = WGM * nN, gid = wgid / nig, fm = gid * WGM, gsz = (nM - fm) < WGM ? (nM - fm) : WGM;
        u.pm = fm + ((wgid % nig) % gsz); u.pn = (wgid % nig) / gsz; return true;
    }
    static constexpr bool GATHER = false;
    __device__ __forceinline__ int arow(const Unit& u, int r) const { return u.pm * BM + r; }
};
template <bool GATHER_> struct MoeOrder {
    static constexpr bool GATHER = GATHER_;
    const PG8_LAS int* tile_e; const int* tok; int ntiles, ncol, G, c;
    __device__ __forceinline__ bool next(int i, Unit& u) const {
        int rt, ct;
        if ((G & 7) == 0 && ((G >> 3) % ncol) == 0) {
            const int R = G / ncol, x = c & 7, j = c >> 3;
            rt = i * R + x * (R >> 3) + j / ncol; ct = j % ncol; if (rt >= ntiles) return false;
        } else { const long L = (long)i * G + c; if (L >= (long)ntiles * ncol) return false; rt = (int)(L / ncol); ct = (int)(L % ncol); }
        u.pm = rt; u.pn = __builtin_amdgcn_readfirstlane(tile_e[rt]) * ncol + ct; return true;
    }
    __device__ __forceinline__ int arow(const Unit& u, int r) const { return (GATHER_ && tok) ? tok[u.pm * BM + r] : u.pm * BM + r; }
};

typedef float f32x2_t __attribute__((ext_vector_type(2))); typedef __bf16 bf16x2_t __attribute__((ext_vector_type(2)));
__device__ __forceinline__ unsigned cvt_pk_bf16(float lo, float hi) { const f32x2_t v = {lo, hi}; const bf16x2_t b = __builtin_convertvector(v, bf16x2_t); return __builtin_bit_cast(unsigned, b); }
__device__ __forceinline__ float bf_lo(unsigned w) { return __builtin_bit_cast(float, w << 16); }
__device__ __forceinline__ float bf_hi(unsigned w) { return __builtin_bit_cast(float, w & 0xffff0000u); }

__device__ __forceinline__ unsigned pk4_fp8(float a, float b, float c, float d) { unsigned w = 0u; w = __builtin_amdgcn_cvt_pk_fp8_f32(a, b, w, false); w = __builtin_amdgcn_cvt_pk_fp8_f32(c, d, w, true); return w; }
template <class T> __device__ __forceinline__ T* sbase(T* p) { asm volatile("" : "+s"(p)); return p; }
__device__ __forceinline__ unsigned vopaque(unsigned v) { asm volatile("" : "+v"(v)); return v; }
struct EpiBf16 {
    static constexpr bool PERM = true;
    bf16_t* O; int ldc;
    __device__ __forceinline__ void pre(const Unit&, int, int, int, int) const {}
    __device__ __forceinline__ void operator()(const f32x4 (&acc)[2][2][4][2], const Unit& u, int wr, int wc, int fr, int fq) const {
        const unsigned lo = vopaque(((unsigned)(wr * 64 + fr) * (unsigned)ldc + (unsigned)(wc * 32 + 8 * fq)) * 2u);
#pragma unroll
        for (int ai = 0; ai < 2; ++ai)
#pragma unroll
            for (int m = 0; m < 4; ++m) { char* rb = (char*)sbase(O + (size_t)(u.pm * BM + ai * HALF + m * 16) * ldc + u.pn * BM);
#pragma unroll
                for (int bj = 0; bj < 2; ++bj) { const f32x4 v0 = acc[ai][bj][m][0], v1 = acc[ai][bj][m][1];
                    u32x4 w; w.x = cvt_pk_bf16(v0[0], v0[1]); w.y = cvt_pk_bf16(v0[2], v0[3]); w.z = cvt_pk_bf16(v1[0], v1[1]); w.w = cvt_pk_bf16(v1[2], v1[3]);
                    *(u32x4*)(rb + bj * HALF * 2 + lo) = w; } }
    }
};
struct EpiResBf16 {
    static constexpr bool PERM = true;
    bf16_t* C; const bf16_t* R; int ldc; float alpha;
    __device__ __forceinline__ void pre(const Unit&, int, int, int, int) const {}
    __device__ __forceinline__ void operator()(const f32x4 (&acc)[2][2][4][2], const Unit& u, int wr, int wc, int fr, int fq) const {
        const unsigned lo = vopaque(((unsigned)(wr * 64 + fr) * (unsigned)ldc + (unsigned)(wc * 32 + 8 * fq)) * 2u);
#pragma unroll
        for (int ai = 0; ai < 2; ++ai)
#pragma unroll
            for (int m = 0; m < 4; ++m) { const size_t ro = (size_t)(u.pm * BM + ai * HALF + m * 16) * ldc + u.pn * BM; char* cb = (char*)sbase(C + ro); const char* rb = (const char*)sbase(R + ro);
#pragma unroll
                for (int bj = 0; bj < 2; ++bj) { const u32x4 rr = *(const u32x4*)(rb + bj * HALF * 2 + lo); const f32x4 v0 = acc[ai][bj][m][0], v1 = acc[ai][bj][m][1];
                    u32x4 w; w.x = cvt_pk_bf16(v0[0] + alpha * bf_lo(rr.x), v0[1] + alpha * bf_hi(rr.x)); w.y = cvt_pk_bf16(v0[2] + alpha * bf_lo(rr.y), v0[3] + alpha * bf_hi(rr.y));
                    w.z = cvt_pk_bf16(v1[0] + alpha * bf_lo(rr.z), v1[1] + alpha * bf_hi(rr.z)); w.w = cvt_pk_bf16(v1[2] + alpha * bf_lo(rr.w), v1[3] + alpha * bf_hi(rr.w));
                    *(u32x4*)(cb + bj * HALF * 2 + lo) = w; } }
    }
};
struct EpiSwiglu {
    static constexpr bool PERM = true;
    unsigned char* O; const float* b1;
    mutable f32x4 vg[2], vl[2];
    __device__ __forceinline__ void pre(const Unit& u, int wr, int wc, int fr, int fq) const {
        const int e = u.pn >> 4, ct = u.pn & 15; const unsigned lc = vopaque((unsigned)(wc * 32 + 8 * fq));
        const char* bg = (const char*)sbase(b1 + (size_t)e * 4096 + ct * 128); const char* bl = (const char*)sbase(b1 + (size_t)e * 4096 + 2048 + ct * 128);
#pragma unroll
        for (int n = 0; n < 2; ++n) { vg[n] = *(const f32x4*)(bg + n * 16 + lc * 4u); vl[n] = *(const f32x4*)(bl + n * 16 + lc * 4u); }
    }
    __device__ __forceinline__ void operator()(const f32x4 (&acc)[2][2][4][2], const Unit& u, int wr, int wc, int fr, int fq) const {
        const int ct = u.pn & 15;
        const unsigned lc = vopaque((unsigned)(wc * 32 + 8 * fq)), lo = vopaque((unsigned)(wr * 64 + fr) * 2048u) + lc;
#pragma unroll
        for (int ai = 0; ai < 2; ++ai)
#pragma unroll
            for (int m = 0; m < 4; ++m) { unsigned char* rb = sbase(O + (size_t)(u.pm * BM + ai * HALF + m * 16) * 2048 + ct * 128);
                float a[8];
#pragma unroll
                for (int n = 0; n < 2; ++n)
#pragma unroll
                    for (int i = 0; i < 4; ++i) { float g = acc[ai][0][m][n][i] + vg[n][i], l = acc[ai][1][m][n][i] + vl[n][i];
                        g = fminf(g, 7.0f); l = fminf(fmaxf(l, -7.0f), 7.0f);
                        const float sg = __builtin_amdgcn_rcpf(1.0f + __builtin_amdgcn_exp2f(-1.702f * 1.4426950408889634f * g));
                        a[n * 4 + i] = (l + 1.0f) * g * sg; }
                u32x2 w; w.x = pk4_fp8(a[0], a[1], a[2], a[3]); w.y = pk4_fp8(a[4], a[5], a[6], a[7]);
                *(u32x2*)(rb + lo) = w; }
    }
};
struct EpiGate {
    static constexpr bool PERM = true;
    unsigned char* O; const float* b2; const float* gate;
    mutable float gtv[8]; mutable f32x4 cb[2][2];
    __device__ __forceinline__ void pre(const Unit& u, int wr, int wc, int fr, int fq) const {
        const int e = u.pn >> 3, ct = u.pn & 7; const unsigned lr = vopaque((unsigned)(wr * 64 + fr)), lc = vopaque((unsigned)(wc * 32 + 8 * fq));
        const char* bb = (const char*)sbase(b2 + (size_t)e * 2048 + ct * 256);
#pragma unroll
        for (int bj = 0; bj < 2; ++bj) { cb[bj][0] = *(const f32x4*)(bb + bj * HALF * 4 + lc * 4u); cb[bj][1] = *(const f32x4*)(bb + bj * HALF * 4 + 16 + lc * 4u); }
#pragma unroll
        for (int q = 0; q < 8; ++q) gtv[q] = *(const float*)((const char*)sbase(gate + u.pm * BM + (q >> 2) * HALF + (q & 3) * 16) + lr * 4u);
    }
    __device__ __forceinline__ void operator()(const f32x4 (&acc)[2][2][4][2], const Unit& u, int wr, int wc, int fr, int fq) const {
        const int ct = u.pn & 7;
        const unsigned lr = vopaque((unsigned)(wr * 64 + fr)), lc = vopaque((unsigned)(wc * 32 + 8 * fq)), lo = lr * 2048u + lc;
#pragma unroll
        for (int ai = 0; ai < 2; ++ai)
#pragma unroll
            for (int m = 0; m < 4; ++m) { const int rg = u.pm * BM + ai * HALF + m * 16; const float gt = 64.0f * gtv[ai * 4 + m];
                unsigned char* rb = sbase(O + (size_t)rg * 2048 + ct * 256);
#pragma unroll
                for (int bj = 0; bj < 2; ++bj) { const f32x4 c0 = cb[bj][0], c1 = cb[bj][1];
                    const f32x4 v0 = (acc[ai][bj][m][0] + c0) * gt, v1 = (acc[ai][bj][m][1] + c1) * gt;
                    u32x2 w; w.x = pk4_fp8(v0[0], v0[1], v0[2], v0[3]); w.y = pk4_fp8(v1[0], v1[1], v1[2], v1[3]);
                    *(u32x2*)(rb + bj * HALF + lo) = w; } }
    }
};

template <class Epi, class Sched, bool ALIGN_EPI = true, bool FP8 = false>
__device__ __forceinline__ void gemm_phase(PG8_LAS unsigned char* lds, const Gemm g, const Sched& S, const Epi& E) {
    int tid = threadIdx.x; asm volatile("" : "+v"(tid));
    const int wid = __builtin_amdgcn_readfirstlane(tid >> 6), lane = tid & 63, wr = wid >> 2, wc = wid & 3, fr = lane & 15, fq = lane >> 4;
    const int K = g.K, nt = K / BK;
    int RA[2]; unsigned cA2[2], voffB[2];
#pragma unroll
    for (int i = 0; i < 2; ++i) { int R, C; stage_rc(tid * 16 + i * 8192, R, C); const int Rb = Epi::PERM ? ((R & ~31) + perm32(R & 31)) : R;
        RA[i] = R; cA2[i] = (unsigned)C * 2u; voffB[i] = (unsigned)(Rb * K + C) * 2u; }
    const size_t kstep = (size_t)(BK * 2);
    const size_t hstep = (size_t)HALF * K * 2;
    const size_t tstep = 2 * hstep;
    const unsigned ldsw = (unsigned)wid * 1024u;
    const int aoff = lds_byte(wr * 64 + fr, fq * 8), boff = lds_byte(wc * 32 + fr, fq * 8);
#define PG8_SA(b, h) (((b) * 2 + (h)) * HTB)
#define PG8_SB(b, h) ((4 + (b) * 2 + (h)) * HTB)
#define PG8_STAGE(bufoff, gbase, voff) do { const char* _gb = (const char*)(gbase); asm volatile("" : "+s"(_gb)); _Pragma("unroll") for (int _i = 0; _i < 2; ++_i) { \
        unsigned _vo = (voff)[_i]; asm volatile("" : "+v"(_vo));     \
        __builtin_amdgcn_global_load_lds((const unsigned*)(_gb + _vo), (PG8_LAS unsigned*)(lds + (bufoff) + ldsw + _i * 8192), 16, 0, 0); } } while (0)
#define PG8_LD32(p) __builtin_shufflevector(*(const PG8_LAS v4i32*)(p), *(const PG8_LAS v4i32*)((p) + 1024), 0, 1, 2, 3, 4, 5, 6, 7)
#define PG8_LDA(dst, b, h) do { _Pragma("unroll") for (int m = 0; m < 4; ++m) dst[m] = PG8_LD32(lds + PG8_SA(b, h) + aoff + m * 2048); } while (0)
#define PG8_LDB(dst, b, h) do { _Pragma("unroll") for (int n = 0; n < 2; ++n) dst[n] = PG8_LD32(lds + PG8_SB(b, h) + boff + n * 2048); } while (0)
#define PG8_H0(x) __builtin_bit_cast(bf16x8, __builtin_shufflevector(x, x, 0, 1, 2, 3))
#define PG8_H1(x) __builtin_bit_cast(bf16x8, __builtin_shufflevector(x, x, 4, 5, 6, 7))
#define PG8_MMA(ai, bj, At, Bt) do { __builtin_amdgcn_s_setprio(1); _Pragma("unroll") for (int m = 0; m < 4; ++m) _Pragma("unroll") for (int n = 0; n < 2; ++n) { \
        if constexpr (FP8) acc[ai][bj][m][n] = __builtin_amdgcn_mfma_scale_f32_16x16x128_f8f6f4(Bt[n], At[m], acc[ai][bj][m][n], 0, 0, 0, SCALE_W, 0, SCALE_A); \
        else { acc[ai][bj][m][n] = __builtin_amdgcn_mfma_f32_16x16x32_bf16(PG8_H0(Bt[n]), PG8_H0(At[m]), acc[ai][bj][m][n], 0, 0, 0); \
               acc[ai][bj][m][n] = __builtin_amdgcn_mfma_f32_16x16x32_bf16(PG8_H1(Bt[n]), PG8_H1(At[m]), acc[ai][bj][m][n], 0, 0, 0); } } \
        __builtin_amdgcn_s_setprio(0); } while (0)
#define PG8_WAIT_V(n) asm volatile("s_waitcnt vmcnt(" #n ")" ::: "memory")
#define PG8_WAIT_L(n) asm volatile("s_waitcnt lgkmcnt(" #n ")" ::: "memory")
#define PG8_BAR __builtin_amdgcn_s_barrier()
#define PG8_SCHED __builtin_amdgcn_sched_barrier(0)
#define PG8_AOFF(dst, u) do { _Pragma("unroll") for (int _h = 0; _h < 2; ++_h) _Pragma("unroll") for (int _i = 0; _i < 2; ++_i) \
        dst[_h][_i] = (unsigned)S.arow(u, _h * HALF + RA[_i]) * (unsigned)(K * 2) + cA2[_i]; } while (0)
    Unit cur, nxt; int ui = 0;
    if (!S.next(0, cur)) return;
    constexpr bool GA = Sched::GATHER;
    unsigned offC[2][2], offN[2][2];
    const char* gA = (const char*)g.A; const char* nA = gA;
    int rawN[2][2]; Unit nn; bool has_nn = false;
#define PG8_ARAW(dst, u) do { _Pragma("unroll") for (int _h = 0; _h < 2; ++_h) _Pragma("unroll") for (int _i = 0; _i < 2; ++_i) dst[_h][_i] = S.arow(u, _h * HALF + RA[_i]); } while (0)
    if constexpr (GA) { PG8_AOFF(offC, cur); has_nn = S.next(1, nn); if (has_nn) PG8_ARAW(rawN, nn); asm volatile("s_waitcnt vmcnt(0)" ::: "memory"); }
    else {
#pragma unroll
        for (int i = 0; i < 2; ++i) { offC[0][i] = (unsigned)RA[i] * (unsigned)(K * 2) + cA2[i]; offC[1][i] = offC[0][i] + (unsigned)hstep; }
        gA += (size_t)cur.pm * tstep; }
    E.pre(cur, wr, wc, fr, fq);
    f32x4 acc[2][2][4][2];
#pragma unroll
    for (int a = 0; a < 2; ++a)
#pragma unroll
        for (int b = 0; b < 2; ++b)
#pragma unroll
            for (int m = 0; m < 4; ++m)
#pragma unroll
                for (int n = 0; n < 2; ++n) acc[a][b][m][n] = (f32x4){0.f, 0.f, 0.f, 0.f};
    v8i32 At[4], B0[2], B1[2];
    const char* cB = (const char*)g.Bt + (size_t)cur.pn * tstep;
    PG8_STAGE(PG8_SB(0, 0), cB, voffB); PG8_STAGE(PG8_SB(0, 1), cB + hstep, voffB); PG8_STAGE(PG8_SA(0, 0), gA, offC[0]); PG8_STAGE(PG8_SA(0, 1), gA, offC[1]);
    if (wr == 1) PG8_BAR;
    PG8_WAIT_V(2); PG8_BAR;
    PG8_STAGE(PG8_SB(1, 0), cB + kstep, voffB); PG8_STAGE(PG8_SA(1, 0), gA + kstep, offC[0]); PG8_STAGE(PG8_SB(1, 1), cB + hstep + kstep, voffB);
    PG8_WAIT_V(6); PG8_BAR;
    for (;;) {
        bool has_next;
        if constexpr (GA) {
            has_next = has_nn; nxt = nn;
#pragma unroll
            for (int h = 0; h < 2; ++h)
#pragma unroll
                for (int i = 0; i < 2; ++i) offN[h][i] = has_next ? (unsigned)rawN[h][i] * (unsigned)(K * 2) + cA2[i] : offC[h][i];
            has_nn = S.next(ui + 2, nn); if (has_nn) PG8_ARAW(rawN, nn);
        } else { has_next = S.next(ui + 1, nxt); nA = has_next ? (const char*)g.A + (size_t)nxt.pm * tstep : gA; }
        const char* nB = has_next ? (const char*)g.Bt + (size_t)nxt.pn * tstep : cB;
        for (int t = 0; t < nt; t += 2) {
            const bool last = (t == nt - 2);
            const char* a1 = gA + (size_t)(t + 1) * kstep;
            const char* a2 = last ? nA : gA + (size_t)(t + 2) * kstep; const char* b2 = last ? nB : cB + (size_t)(t + 2) * kstep;
            const char* a3 = a2 + kstep; const char* b3 = b2 + kstep;
            PG8_LDB(B0, 0, 0); PG8_LDB(B1, 0, 1); PG8_SCHED; PG8_LDA(At, 0, 0); PG8_STAGE(PG8_SA(1, 1), a1, offC[1]);
            if constexpr (GA) { if (last) {
#pragma unroll
                for (int h = 0; h < 2; ++h)
#pragma unroll
                    for (int i = 0; i < 2; ++i) offC[h][i] = offN[h][i]; } }
            PG8_WAIT_V(8); PG8_WAIT_L(0); PG8_BAR; PG8_MMA(0, 0, At, B0); PG8_MMA(0, 1, At, B1); PG8_BAR; PG8_SCHED;
            PG8_LDA(At, 0, 1); PG8_STAGE(PG8_SB(0, 0), b2, voffB); PG8_STAGE(PG8_SB(0, 1), b2 + hstep, voffB); PG8_STAGE(PG8_SA(0, 0), a2, offC[0]);
            PG8_WAIT_V(8); PG8_WAIT_L(0); PG8_BAR; PG8_MMA(1, 0, At, B0); PG8_MMA(1, 1, At, B1); PG8_BAR; PG8_SCHED;
            PG8_LDB(B0, 1, 0); PG8_LDB(B1, 1, 1); PG8_SCHED; PG8_LDA(At, 1, 0); PG8_STAGE(PG8_SA(0, 1), a2, offC[1]);
            PG8_WAIT_V(8); PG8_WAIT_L(0); PG8_BAR; PG8_MMA(0, 0, At, B0); PG8_MMA(0, 1, At, B1); PG8_BAR; PG8_SCHED;
            PG8_LDA(At, 1, 1); PG8_STAGE(PG8_SB(1, 0), b3, voffB); PG8_STAGE(PG8_SB(1, 1), b3 + hstep, voffB); PG8_STAGE(PG8_SA(1, 0), a3, offC[0]);
            PG8_WAIT_V(8); PG8_WAIT_L(0); PG8_BAR; PG8_MMA(1, 0, At, B0); PG8_MMA(1, 1, At, B1); PG8_BAR; PG8_SCHED;
        }
        if constexpr (ALIGN_EPI) { if (wr == 0) PG8_BAR; }
        E(acc, cur, wr, wc, fr, fq);
        if (!has_next) break;
#pragma unroll
        for (int a = 0; a < 2; ++a)
#pragma unroll
            for (int b = 0; b < 2; ++b)
#pragma unroll
                for (int m = 0; m < 4; ++m)
#pragma unroll
                    for (int n = 0; n < 2; ++n) acc[a][b][m][n] = (f32x4){0.f, 0.f, 0.f, 0.f};
        cur = nxt; cB = nB; ++ui; if constexpr (!GA) gA = nA;
        E.pre(cur, wr, wc, fr, fq);
        if constexpr (ALIGN_EPI) { if (wr == 1) PG8_BAR; }
    }
    PG8_WAIT_V(0);
    if constexpr (!ALIGN_EPI) { if (wr == 0) PG8_BAR; }
    PG8_BAR;
#undef PG8_SA
#undef PG8_SB
#undef PG8_STAGE
#undef PG8_LDA
#undef PG8_LDB
#undef PG8_LD32
#undef PG8_H0
#undef PG8_H1
#undef PG8_MMA
#undef PG8_WAIT_V
#undef PG8_WAIT_L
#undef PG8_BAR
#undef PG8_SCHED
#undef PG8_AOFF
#undef PG8_ARAW
}
}
#define GAS __attribute__((address_space(1)))
#define LAS __attribute__((address_space(3)))
typedef unsigned short bf16;
typedef unsigned v4u __attribute__((ext_vector_type(4)));
typedef float f32x4 __attribute__((ext_vector_type(4)));
typedef short bf16x8 __attribute__((ext_vector_type(8)));
typedef GAS unsigned gu32;
typedef GAS unsigned long long gu64;
#define RLX_AGENT __ATOMIC_RELAXED, __HIP_MEMORY_SCOPE_AGENT
#define LDS_WAIT() asm volatile("s_waitcnt lgkmcnt(0)" ::: "memory")
#define VM_WAIT() asm volatile("s_waitcnt vmcnt(0)" ::: "memory")
__device__ __forceinline__ unsigned long long rt() { return __builtin_amdgcn_s_memrealtime(); }
__device__ __forceinline__ unsigned pk2(float lo, float hi) { return pg8::cvt_pk_bf16(lo, hi); }
__device__ __forceinline__ unsigned f2bf(float f) { return pg8::cvt_pk_bf16(f, 0.f) & 0xffffu; }

#define XB_TMO      128
#define XB_XCNT(j)  (256  + 64 * (j))
#define XB_XSUB(j)  (1280 + 64 * (j))
#define XB_XGEN(j)  (2304 + 64 * (j))
#define XB_TOP      3328
#define XB_TOPGEN   3392
#define XCD_BAR_WORDS 3456
#define XB_SPIN_CAP (1u << 18)

__device__ __forceinline__ unsigned xb_ld(unsigned* p)              { return __hip_atomic_load(p, __ATOMIC_RELAXED, __HIP_MEMORY_SCOPE_AGENT); }
__device__ __forceinline__ unsigned xb_add(unsigned* p, unsigned v) { return __hip_atomic_fetch_add(p, v, __ATOMIC_RELAXED, __HIP_MEMORY_SCOPE_AGENT); }
__device__ __forceinline__ unsigned xb_xcc_id() { return (unsigned)__builtin_amdgcn_s_getreg((3 << 11) | 20) & 0xFu; }
#define XB_SPIN(cond, bar) do { unsigned _sp = 0; while (cond) { __builtin_amdgcn_s_sleep(1); \
    if ((++_sp & 255u) == 0u) { if (xb_ld(&(bar)[XB_TMO])) break; if (_sp > XB_SPIN_CAP) { atomicAdd(&(bar)[XB_TMO], 1u); break; } } } } while (0)

struct XcdBarrier {
    unsigned* bar; unsigned x;
    volatile LAS unsigned* st;
};

__device__ __forceinline__ XcdBarrier xcd_barrier_post(unsigned* bar, volatile LAS unsigned* st) {
    XcdBarrier b; b.bar = bar; b.x = xb_xcc_id(); b.st = st;
    if (threadIdx.x == 0) (void)xb_add(&bar[XB_XCNT(b.x)], 1u);
    return b;
}
__device__ __forceinline__ void xcd_barrier_complete(unsigned* bar, unsigned x, unsigned& nloc, unsigned& nx) {
    const unsigned G = gridDim.x * gridDim.y * gridDim.z;
    unsigned sum, cnt, mine, sp = 0u;
    for (;;) {
        sum = 0u; cnt = 0u; mine = 0u;
#pragma unroll
        for (unsigned j = 0; j < 16; ++j) { const unsigned c = xb_ld(&bar[XB_XCNT(j)]); sum += c; cnt += (c > 0u) ? 1u : 0u; mine = (j == x) ? c : mine; }
        if (sum == G) break;
        __builtin_amdgcn_s_sleep(1);
        if ((++sp & 255u) == 0u) { if (xb_ld(&bar[XB_TMO])) break; if (sp > XB_SPIN_CAP) { atomicAdd(&bar[XB_TMO], 1u); break; } }
    }
    nloc = mine > 0u ? mine : 1u; nx = cnt > 0u ? cnt : 1u;
}

__device__ __forceinline__ void xcd_barrier(const XcdBarrier& b) {
    asm volatile("s_waitcnt vmcnt(0)" ::: "memory");
    __syncthreads();
    if (threadIdx.x == 0) {
        unsigned* bar = b.bar;
        __builtin_amdgcn_s_waitcnt(0);
        unsigned nloc = b.st[0], nx = b.st[1];
        if (nloc == 0u) { xcd_barrier_complete(bar, b.x, nloc, nx); b.st[0] = nloc; b.st[1] = nx; }
        const unsigned old = xb_add(&bar[XB_XSUB(b.x)], 1u);
        const unsigned gen = old / nloc;
        if (old + 1u == (gen + 1u) * nloc) {
            __builtin_amdgcn_fence(__ATOMIC_RELEASE, "agent");
            asm volatile("s_waitcnt vmcnt(0)" ::: "memory");
            const unsigned og = xb_add(&bar[XB_TOP], 1u);
            const unsigned tg = og / nx;
            if (og + 1u == (tg + 1u) * nx) xb_add(&bar[XB_TOPGEN], 1u);
            else XB_SPIN(xb_ld(&bar[XB_TOPGEN]) == tg, bar);
            __builtin_amdgcn_fence(__ATOMIC_ACQUIRE, "agent");
            xb_add(&bar[XB_XGEN(b.x)], 1u);
            asm volatile("s_waitcnt vmcnt(0)" ::: "memory");
        } else {
            XB_SPIN(xb_ld(&bar[XB_XGEN(b.x)]) == gen, bar);
            __builtin_amdgcn_fence(__ATOMIC_ACQUIRE, "agent");
            asm volatile("s_waitcnt vmcnt(0)" ::: "memory");
        }
    }
    __syncthreads();
}


constexpr int NB = 2, T = 16384, NTOK = NB * T, D = 2048;
constexpr int PW = 5632;
constexpr int C_R = 0, C_K = 1024, C_V = 2048, C_DW = 3072, C_DA = 3168, C_DG = 3264, C_FQ = 3520, C_FK = 4032, C_FV = 4544, C_FF = 5056, C_MQ = 5064, IN_W = 5576;
constexpr int NE = 32, CAP = 131072 + 8192, MAXT = CAP / 256;
constexpr int MEM_LEN = 256;
constexpr float LN_EPS = 1e-5f, GN_EPS = 64e-5f, ALPHA = 1.189207115002721f, LOG2E = 1.4426950408889634f;
constexpr int NWAVES = 8, NTHR = 512;

constexpr size_t MiB = 1u << 20;
constexpr size_t WS_CTL = 0, CTL_ZERO_BYTES = 1 * MiB;
constexpr size_t WS_WI = 2 * MiB, WS_WO = 24 * MiB, WS_WKV = 32 * MiB, WS_RWT = 36 * MiB, WS_MEMN = 37 * MiB, WS_KVM = 39 * MiB, WS_C = 40 * MiB  ;
constexpr size_t WS_ROUTE = 42 * MiB;
constexpr size_t RT_TOPI = WS_ROUTE, RT_TOPG = RT_TOPI + 512 * 1024, RT_POS = RT_TOPG + 512 * 1024, RT_CNT = RT_POS + 512 * 1024, RT_TOK = RT_CNT + 64 * 1024, RT_GATE = RT_TOK + 1024 * 1024, RT_TILE = RT_GATE + 1024 * 1024;
constexpr size_t WS_W1 = 48 * MiB, WS_W2 = 560 * MiB, WS_H0 = 816 * MiB, WS_H1 = 944 * MiB, WS_MIX = 1072 * MiB, WS_Z1 = 1200 * MiB, WS_P = 1456 * MiB;
constexpr size_t WS_RW = 1808 * MiB, RW_ARR = 128 * MiB;
constexpr size_t WS_ACT = 2960 * MiB, WS_Y = 3504 * MiB, WS_END = 4048 * MiB;
constexpr size_t WS_WLT = 46 * MiB;
constexpr size_t WS_H1Q = 304 * MiB;
constexpr size_t WS_FOXB = 47 * MiB;
constexpr float FOX_SKIP = 30.0f;
constexpr int CW_BAR = 4096;
constexpr int CW_KMAX = 2048;
constexpr int CW_QUEUE = 2112;
constexpr int CW_XQ = 2176;
constexpr int CW_A0Q = 2240;
constexpr int NG_INPROJ = 192;

constexpr int LDS_BYTES = 147456, MISC_OFF = LDS_BYTES - 256;

struct Args { const float* in[31]; float* out; unsigned char* ws; int ph_lo, ph_hi; };

__device__ __forceinline__ float wave_sum(float v) {
#pragma unroll
    for (int o = 1; o < 64; o <<= 1) v += __shfl_xor(v, o);
    return v;
}
__device__ __forceinline__ float bfl(unsigned w) { return __builtin_bit_cast(float, w << 16); }
__device__ __forceinline__ float bfh(unsigned w) { return __builtin_bit_cast(float, w & 0xffff0000u); }
__device__ __forceinline__ float bf1(bf16 h) { return __builtin_bit_cast(float, (unsigned)h << 16); }
__device__ __forceinline__ float sigmoidf_(float x) { return 1.0f / (1.0f + __expf(-x)); }

__device__ __forceinline__ void ln_row(f32x4 (&v)[8], const float* g, const float* b, float eps, int lane) {
    float s = 0.f;
#pragma unroll
    for (int j = 0; j < 8; ++j) s += (v[j].x + v[j].y) + (v[j].z + v[j].w);
    const float mean = wave_sum(s) * (1.f / D); float s2 = 0.f;
#pragma unroll
    for (int j = 0; j < 8; ++j) { v[j] = v[j] - mean; s2 += (v[j].x * v[j].x + v[j].y * v[j].y) + (v[j].z * v[j].z + v[j].w * v[j].w); }
    const float rstd = 1.f / sqrtf(wave_sum(s2) * (1.f / D) + eps);
#pragma unroll
    for (int j = 0; j < 8; ++j) { const f32x4 gg = *(const f32x4*)(g + 4 * lane + 256 * j), bb = *(const f32x4*)(b + 4 * lane + 256 * j); v[j] = v[j] * rstd * gg + bb; }
}
__device__ __forceinline__ void store_row_bf16(bf16* orow, const f32x4 (&v)[8], int lane) {
#pragma unroll
    for (int j = 0; j < 8; ++j) { pg8::u32x2 w; w.x = pk2(v[j].x, v[j].y); w.y = pk2(v[j].z, v[j].w); *(pg8::u32x2*)(orow + 4 * lane + 256 * j) = w; }
}

template <class RowMap>
__device__ __forceinline__ void transpose_item(const float* W, int ldw, int nvalid, int K, bf16* WT, const RowMap& rm, LAS float* scr, int k0, int n0, int lane) {
#pragma unroll 4
    for (int it = 0; it < 16; ++it) { const int k = 4 * it + (lane >> 4), nl = 4 * (lane & 15), n = n0 + nl;
        f32x4 v = (f32x4){0.f, 0.f, 0.f, 0.f}; if (n < nvalid) v = *(const f32x4*)(W + (size_t)(k0 + k) * ldw + n);
        LAS float* s = scr + k * 65 + nl; s[0] = v.x; s[1] = v.y; s[2] = v.z; s[3] = v.w; }
    LDS_WAIT(); asm volatile("" ::: "memory");
    const int c = lane & 7;
#pragma unroll
    for (int j = 0; j < 8; ++j) { const int nl = 8 * j + (lane >> 3); const LAS float* s = scr + (8 * c) * 65 + nl;
        v4u o; o.x = pk2(s[0 * 65], s[1 * 65]); o.y = pk2(s[2 * 65], s[3 * 65]); o.z = pk2(s[4 * 65], s[5 * 65]); o.w = pk2(s[6 * 65], s[7 * 65]);
        *(v4u*)(WT + (size_t)rm(n0 + nl) * K + k0 + 8 * c) = o; }
    LDS_WAIT(); asm volatile("" ::: "memory");
}
template <class RowMap>
__device__ __forceinline__ void transpose_item_fp8(const float* W, int ldw, int K, unsigned char* WT, const RowMap& rm, LAS float* scr, int k0, int n0, int lane) {
#pragma unroll 4
    for (int it = 0; it < 16; ++it) { const int k = 4 * it + (lane >> 4), nl = 4 * (lane & 15);
        const f32x4 v = *(const f32x4*)(W + (size_t)(k0 + k) * ldw + n0 + nl);
        LAS float* s = scr + k * 65 + nl; s[0] = v.x; s[1] = v.y; s[2] = v.z; s[3] = v.w; }
    LDS_WAIT(); asm volatile("" ::: "memory");
    const int c = lane & 3;
#pragma unroll
    for (int j = 0; j < 4; ++j) { const int nl = 16 * j + (lane >> 2); const LAS float* s = scr + (16 * c) * 65 + nl;
        v4u o; o.x = pg8::pk4_fp8(64.f * s[0 * 65], 64.f * s[1 * 65], 64.f * s[2 * 65], 64.f * s[3 * 65]); o.y = pg8::pk4_fp8(64.f * s[4 * 65], 64.f * s[5 * 65], 64.f * s[6 * 65], 64.f * s[7 * 65]);
        o.z = pg8::pk4_fp8(64.f * s[8 * 65], 64.f * s[9 * 65], 64.f * s[10 * 65], 64.f * s[11 * 65]); o.w = pg8::pk4_fp8(64.f * s[12 * 65], 64.f * s[13 * 65], 64.f * s[14 * 65], 64.f * s[15 * 65]);
        *(v4u*)(WT + (size_t)rm(n0 + nl) * K + k0 + 16 * c) = o; }
    LDS_WAIT(); asm volatile("" ::: "memory");
}
struct XItem { const float* W; unsigned char* WT; int ldw, k0, n0, rowoff, isw1; };
__device__ __forceinline__ XItem xitem(const Args& A, unsigned char* ws, int r) {
    XItem x; constexpr int I1 = 32 * 32 * 64;
    if (r < I1) { const int e = r >> 11, q = r & 2047; x.W = A.in[25] + (size_t)e * D * 4096; x.WT = ws + WS_W1; x.ldw = 4096; x.k0 = 64 * (q >> 6); x.n0 = 64 * (q & 63); x.rowoff = e * 4096; x.isw1 = 1; }
    else { const int r2 = r - I1, e = r2 >> 10, q = r2 & 1023; x.W = A.in[27] + (size_t)e * D * D; x.WT = ws + WS_W2; x.ldw = D; x.k0 = 64 * (q >> 5); x.n0 = 64 * (q & 31); x.rowoff = e * D; x.isw1 = 0; }
    return x;
}
__device__ __forceinline__ void xload(f32x4 (&v)[16], const XItem& x, int lane) {
#pragma unroll
    for (int it = 0; it < 16; ++it) v[it] = *(const f32x4*)(x.W + (size_t)(x.k0 + 4 * it + (lane >> 4)) * x.ldw + x.n0 + 4 * (lane & 15));
}
__device__ __forceinline__ void xstore(const f32x4 (&v)[16], const XItem& x, LAS float* scr, int lane) {
#pragma unroll
    for (int it = 0; it < 16; ++it) { LAS float* s = scr + (4 * it + (lane >> 4)) * 65 + 4 * (lane & 15); s[0] = v[it].x; s[1] = v[it].y; s[2] = v[it].z; s[3] = v[it].w; }
    LDS_WAIT(); asm volatile("" ::: "memory");
    const int c = lane & 3;
#pragma unroll
    for (int j = 0; j < 4; ++j) { const int nl = 16 * j + (lane >> 2), n = x.n0 + nl; const LAS float* s = scr + (16 * c) * 65 + nl;
        int row; if (x.isw1) { const int l = n >= 2048, cc = n - 2048 * l; row = (cc >> 7) * 256 + 128 * l + (cc & 127); } else row = n;
        v4u o; o.x = pg8::pk4_fp8(64.f * s[0 * 65], 64.f * s[1 * 65], 64.f * s[2 * 65], 64.f * s[3 * 65]); o.y = pg8::pk4_fp8(64.f * s[4 * 65], 64.f * s[5 * 65], 64.f * s[6 * 65], 64.f * s[7 * 65]);
        o.z = pg8::pk4_fp8(64.f * s[8 * 65], 64.f * s[9 * 65], 64.f * s[10 * 65], 64.f * s[11 * 65]); o.w = pg8::pk4_fp8(64.f * s[12 * 65], 64.f * s[13 * 65], 64.f * s[14 * 65], 64.f * s[15 * 65]);
        *(v4u*)(x.WT + (size_t)(x.rowoff + row) * D + x.k0 + 16 * c) = o; }
    LDS_WAIT(); asm volatile("" ::: "memory");
}
struct RmId { int off; __device__ __forceinline__ int operator()(int n) const { return off + n; } };
struct RmW1 { int off; __device__ __forceinline__ int operator()(int n) const { const int l = n >= 2048, c = n - 2048 * l; return off + (c >> 7) * 256 + 128 * l + (c & 127); } };

constexpr int I_XALL = 32 * 32 * 64 + 32 * 32 * 32;
__device__ __forceinline__ void conv_pull_loop(const Args& A, LAS unsigned char* lds, int tid, int wave, int lane) {
    unsigned char* ws = A.ws; unsigned* ctl = (unsigned*)(ws + WS_CTL); LAS float* scr = (LAS float*)(lds + wave * 16640); LAS int* qs = (LAS int*)(lds + 8 * 16640);
    for (;;) {
        __syncthreads();
        if (tid == 0) qs[0] = (int)__hip_atomic_fetch_add(ctl + CW_XQ, 16u, __ATOMIC_RELAXED, __HIP_MEMORY_SCOPE_AGENT);
        __syncthreads();
        const int base = qs[0]; if (base >= I_XALL) break;
        f32x4 va[16], vb[16]; const int i0 = base + wave, i1 = base + 8 + wave;
        const XItem xa = xitem(A, ws, min(i0, I_XALL - 1)), xb = xitem(A, ws, min(i1, I_XALL - 1));
        xload(va, xa, lane); xload(vb, xb, lane);
        if (i0 < I_XALL) xstore(va, xa, scr, lane);
        if (i1 < I_XALL) xstore(vb, xb, scr, lane);
    }
}
__device__ __forceinline__ void p0_prologue(const Args& A, LAS unsigned char* lds, int vcu, int G, int wave, int lane) {
    unsigned char* ws = A.ws;
    LAS float* scr = (LAS float*)(lds + wave * 16640);
    const int gw = vcu * NWAVES + wave, NGW = G * NWAVES;
    constexpr int I_WI = 32 * 88, I_WO = 32 * 32, I_WKV = 32 * 16;
    constexpr int NITEMS = I_WI + I_WO + I_WKV;
    for (int it = gw; it < NITEMS; it += NGW) {
        int r = it;
        if (r < I_WI) { transpose_item(A.in[4], IN_W, IN_W, D, (bf16*)(ws + WS_WI), RmId{0}, scr, 64 * (r / 88), 64 * (r % 88), lane); continue; } r -= I_WI;
        if (r < I_WO) { transpose_item(A.in[20], D, D, D, (bf16*)(ws + WS_WO), RmId{0}, scr, 64 * (r / 32), 64 * (r % 32), lane); continue; } r -= I_WO;
        transpose_item(A.in[19], 1024, 1024, D, (bf16*)(ws + WS_WKV), RmId{0}, scr, 64 * (r / 16), 64 * (r % 16), lane);
    }
    { bf16* wlt = (bf16*)(ws + WS_WLT);
      for (int i = gw * 64 + lane; i < 1024 * 448; i += NGW * 64) { const int ch = i / 448, k = i % 448;
          const float v = k < 96 ? A.in[7][k * 1024 + ch] : (k < 192 ? A.in[9][(k - 96) * 1024 + ch] : A.in[10][(k - 192) * 1024 + ch]); wlt[i] = (bf16)f2bf(v); } }
    { bf16* rwf = (bf16*)(ws + WS_RWT); const float* rw = A.in[23];
      for (int i = gw * 64 + lane; i < 64 * 2 * 2 * 64 * 8; i += NGW * 64) { const int e = i & 7, ln = (i >> 3) & 63, hl = (i >> 9) & 1, nt = (i >> 10) & 1, sidx = i >> 11;
          const float w = rw[(32 * sidx + 8 * (ln >> 4) + e) * NE + 16 * nt + (ln & 15)]; const unsigned hb = f2bf(w); const float hf = __builtin_bit_cast(float, hb << 16);
          rwf[i] = (bf16)(hl ? f2bf(w - hf) : hb); } }
    for (int m = gw; m < NTOK + NB * MEM_LEN; m += NGW) {
        const bool ismem = m >= NTOK; const int r = ismem ? m - NTOK : m;
        const float* xr = (ismem ? A.in[1] : A.in[0]) + (size_t)r * D;
        f32x4 v[8];
#pragma unroll
        for (int j = 0; j < 8; ++j) v[j] = *(const f32x4*)(xr + 4 * lane + 256 * j);
        ln_row(v, ismem ? A.in[17] : A.in[2], ismem ? A.in[18] : A.in[3], LN_EPS, lane);
        store_row_bf16((bf16*)(ws + (ismem ? WS_MEMN : WS_H0)) + (size_t)r * D, v, lane);
    }
}

__device__ __forceinline__ void p2_fox_cumsum(const Args& A, LAS unsigned char* lds, int vcu, int G, int tid) {
    const bf16* P = (const bf16*)(A.ws + WS_P); double* C = (double*)(A.ws + WS_C);
    LAS double* part = (LAS double*)(lds + 32768);
    for (int bh = vcu; bh < 16; bh += G) {
        const int b = bh >> 3, h = bh & 7; const float bf = A.in[16][h];
        float lf[32]; double s = 0.0;
#pragma unroll
        for (int i = 0; i < 32; ++i) { const float x = bf1(P[(size_t)(b * T + tid * 32 + i) * PW + C_FF + h]) + bf;
            lf[i] = -(fmaxf(-x, 0.f) + log1pf(__expf(-fabsf(x)))); s += (double)lf[i]; }
        __syncthreads();
        part[tid] = s;
        __syncthreads();
        double pre = 0.0;
        for (int j = 0; j < tid; ++j) pre += part[j];
        double* c = C + (size_t)bh * T + tid * 32;
#pragma unroll
        for (int i = 0; i < 32; ++i) { pre += (double)lf[i]; c[i] = pre; }
    }
}
__device__ __forceinline__ void p2_fox_norms(const Args& A, LAS unsigned char* lds, int vcu, int G, int tid, int wave, int lane) {
    const bf16* P = (const bf16*)(A.ws + WS_P); float* FOXB = (float*)(A.ws + WS_FOXB); unsigned* ctl = (unsigned*)(A.ws + WS_CTL);
    LAS float* red = (LAS float*)(lds + 40960);
    for (int u = vcu; u < 1024; u += G) {
        const int bh = u >> 6, qb = u & 63, b = bh >> 3, h = bh & 7; const int tk = tid & 255, isk = tid >> 8;
        const bf16* pr = P + (size_t)(b * T + qb * 256 + tk) * PW + (isk ? C_FK : C_FQ) + h * 64;
        float n2 = 0.f;
#pragma unroll
        for (int v = 0; v < 8; ++v) { const v4u x = *(const v4u*)(pr + v * 8); const unsigned w[4] = {x.x, x.y, x.z, x.w};
#pragma unroll
            for (int e = 0; e < 4; ++e) { const float a0 = bfl(w[e]), a1 = bfh(w[e]); n2 += a0 * a0 + a1 * a1; } }
#pragma unroll
        for (int o = 1; o < 64; o <<= 1) n2 = fmaxf(n2, __shfl_xor(n2, o));
        __syncthreads();
        if (lane == 0) red[wave] = n2;
        __syncthreads();
        if (tid == 0) { FOXB[bh * 80 + qb] = fmaxf(fmaxf(red[0], red[1]), fmaxf(red[2], red[3]));
            __hip_atomic_fetch_max(ctl + CW_KMAX + bh, __float_as_uint(fmaxf(fmaxf(red[4], red[5]), fmaxf(red[6], red[7]))), __ATOMIC_RELAXED, __HIP_MEMORY_SCOPE_AGENT); }
    }
}

__device__ __forceinline__ int crow(int r, int hi) { return (r & 3) + 8 * (r >> 2) + 4 * hi; }
typedef float f32x16 __attribute__((ext_vector_type(16)));
typedef short s16x4 __attribute__((ext_vector_type(4)));
typedef short v4i16_t __attribute__((ext_vector_type(4)));
template <int DH, bool FOX>
__device__ __forceinline__ void attn_unit(const bf16* Qp, int qpitch, const bf16* Kp, const bf16* Vp, int kvpitch, bf16* Op, int opitch, int q0, int jlo, int jhi,
                                          const double* cseq, float scale2, LAS unsigned char* lds, int tid, int wave, int lane) {
    constexpr int KROW = (DH + 8) * 2, VROW = DH * 2 + 64, NP = DH / 64;
    LAS unsigned char* KS = lds; LAS unsigned char* VT = lds + 64 * KROW; LAS float* CB = (LAS float*)(VT + 64 * VROW); LAS float* WSF = (LAS float*)(lds + 2 * (64 * KROW + 64 * VROW + 256)) + wave * 32;
    const int r32 = lane & 31, hi = lane >> 5;
    bf16x8 qr[DH / 16];
#pragma unroll
    for (int d0 = 0; d0 < DH / 16; ++d0) qr[d0] = *(const bf16x8*)(Qp + (size_t)(32 * wave + r32) * qpitch + d0 * 16 + hi * 8);
    f32x16 o[DH / 32];
#pragma unroll
    for (int d = 0; d < DH / 32; ++d)
#pragma unroll
        for (int r = 0; r < 16; ++r) o[d][r] = 0.f;
    float m = -1e30f, l = 0.f;
    const int qpos = q0 + 32 * wave + r32;
    double cref = 0.0; if (FOX) cref = cseq[q0];
    v4u kreg[NP], vreg[NP]; float cbv = 0.f;
#define ATT_LOAD(j) do { _Pragma("unroll") for (int p = 0; p < NP; ++p) { const int idx = tid + p * NTHR, row = idx / (DH / 8), ch = idx % (DH / 8); \
        kreg[p] = *(const v4u*)(Kp + (size_t)((j) * 64 + row) * kvpitch + ch * 8); vreg[p] = *(const v4u*)(Vp + (size_t)((j) * 64 + row) * kvpitch + ch * 8); } \
        if (FOX && tid < 64) cbv = (float)(cref - cseq[(j) * 64 + tid]) * LOG2E; } while (0)
    constexpr bool PREF = (DH == 64);
    constexpr int TILEB = 64 * KROW + 64 * VROW + 256;
#define ATT_STORE(bufo) do { _Pragma("unroll") for (int p = 0; p < NP; ++p) { const int idx = tid + p * NTHR, row = idx / (DH / 8), ch = idx % (DH / 8); \
        *(LAS v4u*)(KS + (bufo) + row * KROW + ch * 16) = kreg[p]; *(LAS v4u*)(VT + (bufo) + row * VROW + ch * 16) = vreg[p]; } \
        if (FOX && tid < 64) *(LAS float*)((LAS unsigned char*)CB + (bufo) + tid * 4) = cbv; } while (0)
    if (PREF) { ATT_LOAD(jlo); __syncthreads(); ATT_STORE(0); __syncthreads(); }
    for (int j = jlo; j < jhi; ++j) {
        const int bo = PREF ? ((j - jlo) & 1) * TILEB : 0;
        if (PREF) { if (j + 1 < jhi) ATT_LOAD(j + 1); }
        else { __syncthreads();
#pragma unroll
            for (int p = 0; p < NP; ++p) { const int idx = tid + p * NTHR, row = idx / (DH / 8), ch = idx % (DH / 8);
                kreg[0] = *(const v4u*)(Kp + (size_t)(j * 64 + row) * kvpitch + ch * 8); vreg[0] = *(const v4u*)(Vp + (size_t)(j * 64 + row) * kvpitch + ch * 8);
                *(LAS v4u*)(KS + row * KROW + ch * 16) = kreg[0]; *(LAS v4u*)(VT + row * VROW + ch * 16) = vreg[0]; }
            __syncthreads(); }
        f32x16 p[2];
#pragma unroll
        for (int kh = 0; kh < 2; ++kh) {
#pragma unroll
            for (int r = 0; r < 16; ++r) p[kh][r] = 0.f;
#pragma unroll
            for (int d0 = 0; d0 < DH / 16; ++d0) { const bf16x8 a = *(const LAS bf16x8*)(KS + bo + (32 * kh + r32) * KROW + (16 * d0 + 8 * hi) * 2);
                p[kh] = __builtin_amdgcn_mfma_f32_32x32x16_bf16(a, qr[d0], p[kh], 0, 0, 0); }
        }
        const bool diag = FOX && (j * 64 + 63 > q0);
        float mx = -1e30f;
        if (diag) {
#pragma unroll
            for (int kh = 0; kh < 2; ++kh)
#pragma unroll
                for (int g = 0; g < 4; ++g) { const f32x4 cb = *(const LAS f32x4*)((const LAS unsigned char*)CB + bo + (32 * kh + 8 * g + 4 * hi) * 4);
#pragma unroll
                    for (int i = 0; i < 4; ++i) { const int r = 4 * g + i; float v = p[kh][r] * scale2 + cb[i];
                        if (j * 64 + 32 * kh + 8 * g + 4 * hi + i > qpos) v = -1e30f;
                        p[kh][r] = v; mx = fmaxf(mx, v); } }
        } else {
#pragma unroll
            for (int kh = 0; kh < 2; ++kh)
#pragma unroll
                for (int g = 0; g < 4; ++g) { f32x4 cb = (f32x4){0.f, 0.f, 0.f, 0.f}; if (FOX) cb = *(const LAS f32x4*)((const LAS unsigned char*)CB + bo + (32 * kh + 8 * g + 4 * hi) * 4);
#pragma unroll
                    for (int i = 0; i < 4; ++i) { const int r = 4 * g + i; const float v = p[kh][r] * scale2 + cb[i]; p[kh][r] = v; mx = fmaxf(mx, v); } }
        }
        mx = fmaxf(mx, __shfl_xor(mx, 32));
        const float mn = fmaxf(m, mx), corr = __builtin_amdgcn_exp2f(m - mn); m = mn;
        float ls = 0.f;
#pragma unroll
        for (int kh = 0; kh < 2; ++kh)
#pragma unroll
            for (int r = 0; r < 16; ++r) { const float e = __builtin_amdgcn_exp2f(p[kh][r] - mn); p[kh][r] = e; ls += e; }
        l = l * corr + ls;
        if (__any(corr != 1.0f)) {
            if (hi == 0) WSF[r32] = corr;
#pragma unroll
            for (int g = 0; g < 4; ++g) { const f32x4 c4 = *(const LAS f32x4*)(WSF + 8 * g + 4 * hi);
#pragma unroll
                for (int d = 0; d < DH / 32; ++d) { o[d][4 * g] *= c4.x; o[d][4 * g + 1] *= c4.y; o[d][4 * g + 2] *= c4.z; o[d][4 * g + 3] *= c4.w; } }
        }
        bf16x8 pa[4];
#pragma unroll
        for (int s = 0; s < 4; ++s) { const int kh = s >> 1, b8 = 8 * (s & 1); v4u w;
            w.x = pg8::cvt_pk_bf16(p[kh][b8 + 0], p[kh][b8 + 1]); w.y = pg8::cvt_pk_bf16(p[kh][b8 + 2], p[kh][b8 + 3]);
            w.z = pg8::cvt_pk_bf16(p[kh][b8 + 4], p[kh][b8 + 5]); w.w = pg8::cvt_pk_bf16(p[kh][b8 + 6], p[kh][b8 + 7]);
            pa[s] = __builtin_bit_cast(bf16x8, w); }
#pragma unroll
        for (int d = 0; d < DH / 32; ++d)
#pragma unroll
            for (int s = 0; s < 4; ++s) { const LAS unsigned char* vp = VT + bo + (16 * s + 4 * hi + ((lane & 15) >> 2)) * VROW + (32 * d + 16 * ((lane >> 4) & 1) + 4 * (lane & 3)) * 2;
                const s16x4 lo = __builtin_bit_cast(s16x4, __builtin_amdgcn_ds_read_tr16_b64_v4i16((LAS v4i16_t*)vp)), hh = __builtin_bit_cast(s16x4, __builtin_amdgcn_ds_read_tr16_b64_v4i16((LAS v4i16_t*)(vp + 8 * VROW)));
                const bf16x8 vf = (bf16x8){lo[0], lo[1], lo[2], lo[3], hh[0], hh[1], hh[2], hh[3]};
                o[d] = __builtin_amdgcn_mfma_f32_32x32x16_bf16(pa[s], vf, o[d], 0, 0, 0); }
        if (PREF) { if (j + 1 < jhi) ATT_STORE(TILEB - bo); __syncthreads(); }
    }
#undef ATT_LOAD
#undef ATT_STORE
    l += __shfl_xor(l, 32);
    if (hi == 0) WSF[r32] = 1.0f / l;
    float rli[16];
#pragma unroll
    for (int g = 0; g < 4; ++g) { const f32x4 c4 = *(const LAS f32x4*)(WSF + 8 * g + 4 * hi); rli[4 * g] = c4.x; rli[4 * g + 1] = c4.y; rli[4 * g + 2] = c4.z; rli[4 * g + 3] = c4.w; }
#pragma unroll
    for (int r = 0; r < 16; ++r) { bf16* orow = Op + (size_t)(32 * wave + crow(r, hi)) * opitch + r32;
#pragma unroll
        for (int d = 0; d < DH / 32; ++d) orow[32 * d] = (bf16)f2bf(o[d][r] * rli[r]); }
    __syncthreads();
}

__device__ __forceinline__ void p3_attention(const Args& A, LAS unsigned char* lds, int tid, int wave, int lane) {
    unsigned char* ws = A.ws; const bf16* P = (const bf16*)(ws + WS_P); bf16* MIX = (bf16*)(ws + WS_MIX); const bf16* KVM = (const bf16*)(ws + WS_KVM); const double* C = (const double*)(ws + WS_C);
    unsigned* ctl = (unsigned*)(ws + WS_CTL); LAS int* sj = (LAS int*)(lds + 65536);
    for (;;) {
        __syncthreads();
        if (tid == 0) sj[1] = (int)__hip_atomic_fetch_add(ctl + CW_QUEUE, 1u, __ATOMIC_RELAXED, __HIP_MEMORY_SCOPE_AGENT);
        __syncthreads();
        const int u = sj[1];
        if (u >= 1536) break;
        if (u < 1024) {
#ifndef NO_FOX
            const int bh = u & 15, qb = 63 - (u >> 4), b = bh >> 3, h = bh & 7, q0 = qb * 256; const double* cs = C + (size_t)bh * T; const float* fb = (const float*)(ws + WS_FOXB) + bh * 80; const size_t rowb = (size_t)b * T;
            if (tid == 0) sj[0] = q0 / 64;
            __syncthreads();
            if (tid < q0 / 64) { const float bound = 0.25f * sqrtf(fb[qb] * __uint_as_float(ctl[CW_KMAX + bh])) + FOX_SKIP; if ((float)(cs[q0] - cs[tid * 64 + 63]) + bound >= 0.f) __hip_atomic_fetch_min(sj, tid, __ATOMIC_RELAXED, __HIP_MEMORY_SCOPE_WORKGROUP); }
            __syncthreads();
            const int jlo = sj[0];
            attn_unit<64, true>(P + (rowb + q0) * PW + C_FQ + h * 64, PW, P + rowb * PW + C_FK + h * 64, P + rowb * PW + C_FV + h * 64, PW,
                                MIX + (rowb + q0) * D + 1024 + h * 64, D, q0, jlo, q0 / 64 + 4, cs, 0.125f * LOG2E, lds, tid, wave, lane);
#endif
        } else {
#ifndef NO_MEMATT
            const int v = u - 1024, b = v >> 8, h = (v >> 6) & 3, qb = v & 63, q0 = qb * 256; const size_t rowb = (size_t)b * T;
            attn_unit<128, false>(P + (rowb + q0) * PW + C_MQ + h * 128, PW, KVM + (size_t)b * MEM_LEN * 1024 + h * 128, KVM + (size_t)b * MEM_LEN * 1024 + 512 + h * 128, 1024,
                                  MIX + (rowb + q0) * D + 1536 + h * 128, D, q0, 0, 4, nullptr, 0.08838834764831845f * LOG2E, lds, tid, wave, lane);
#endif
        }
    }
}

constexpr size_t AIN_BYTES = 73728, REC_BYTES = 62464;
constexpr size_t WS_AIN = WS_RW, WS_REC = WS_AIN + 576 * MiB, WS_YRAW = WS_REC + 488 * MiB, WS_G1 = 368 * MiB, WS_G2 = 432 * MiB;
static_assert(WS_YRAW + 64 * MiB <= WS_ACT && 8192 * REC_BYTES <= 488 * MiB && 8192 * AIN_BYTES <= 576 * MiB && WS_G2 + 64 * MiB <= WS_W2, "rwkv workspace");
constexpr int AIN_LD = 0, AIN_R = 16384, AIN_K2 = 24576, AIN_V = 32768, AIN_AV = 40960, AIN_BV = 49152, AIN_G1 = 57344, AIN_G2 = 65536;
constexpr int A0_IN = 29184, A0_INW = 13200, A0_ROWB = 400;
constexpr int REC_W = 0, REC_RT = 9216, REC_ARB = 18432, REC_BGT = 27648, REC_U0 = 36864, REC_Y0 = 45056, REC_M0 = 53248, REC_GC = 61440;
typedef float f32x4_t __attribute__((ext_vector_type(4)));

__device__ __forceinline__ float softplusf_(float x) { return fmaxf(x, 0.f) + log1pf(__expf(-fabsf(x))); }
__device__ __forceinline__ float xsum16_32(float v) { v += __shfl_xor(v, 16); v += __shfl_xor(v, 32); return v; }

__device__ __forceinline__ float fsigmoid(float x) { return __builtin_amdgcn_rcpf(1.0f + __builtin_amdgcn_exp2f(-LOG2E * x)); }
__device__ __forceinline__ float fsoftplus(float x) { return fmaxf(x, 0.f) + 0.6931471805599453f * __builtin_amdgcn_logf(1.0f + __builtin_amdgcn_exp2f(-LOG2E * fabsf(x))); }
struct A0Par { f32x4 mur, muk, muv, a0, kkw, kaw, rkw, w0, gng, gnb; };
template <bool FULL> __device__ __forceinline__ void a0_loadpar(A0Par& p, const Args& A, const float* mu, int col) {
    p.mur = *(const f32x4*)(mu + C_R + col); p.muk = *(const f32x4*)(mu + C_K + col); p.muv = *(const f32x4*)(mu + C_V + col);
    p.a0 = *(const f32x4*)(A.in[8] + col); p.kkw = *(const f32x4*)(A.in[11] + col); p.kaw = *(const f32x4*)(A.in[12] + col); p.rkw = *(const f32x4*)(A.in[13] + col);
    if constexpr (FULL) { p.w0 = *(const f32x4*)(A.in[6] + col); p.gng = *(const f32x4*)(A.in[14] + col); p.gnb = *(const f32x4*)(A.in[15] + col); }
}
template <bool FULL>
__device__ __forceinline__ void a0_mfma(f32x4 (&acc)[2][3], const bf16x8* wf, LAS unsigned char* lds, int c16, int g) {
    constexpr int KS0 = FULL ? 0 : 3, KS1 = FULL ? 14 : 6;
#pragma unroll
    for (int tt = 0; tt < 2; ++tt)
#pragma unroll
        for (int o = 0; o < 3; ++o) acc[tt][o] = (f32x4){0.f, 0.f, 0.f, 0.f};
#pragma unroll
    for (int ks = KS0; ks < KS1; ++ks) { const int o = ks < 3 ? 0 : (ks < 6 ? 1 : 2);
#pragma unroll
        for (int tt = 0; tt < 2; ++tt) { const bf16x8 b = *(const LAS bf16x8*)(lds + (16 * tt + c16) * 912 + (32 * ks + 8 * g) * 2);
            acc[tt][o] = __builtin_amdgcn_mfma_f32_16x16x32_bf16(wf[ks - KS0], b, acc[tt][o], 0, 0, 0); } }
}
template <bool FULL>
__device__ __forceinline__ void a0_ct(const f32x4 (&acc)[2][3], const A0Par& p, const LAS unsigned char* inw, unsigned char* blk,
                                      int tl0, int ct, int c16, int g, float (&ssk)[2], float (&ssb)[2]) {
#pragma unroll
    for (int tt = 0; tt < 2; ++tt) {
        const LAS unsigned char* pc = inw + (1 + 16 * tt + c16) * A0_ROWB + (16 * ct + 4 * g) * 2;
        const pg8::u32x2 r0 = *(const LAS pg8::u32x2*)pc, k0 = *(const LAS pg8::u32x2*)(pc + 128), v0 = *(const LAS pg8::u32x2*)(pc + 256);
        const pg8::u32x2 r1 = *(const LAS pg8::u32x2*)(pc - A0_ROWB), k1 = *(const LAS pg8::u32x2*)(pc - A0_ROWB + 128), v1 = *(const LAS pg8::u32x2*)(pc - A0_ROWB + 256);
        float rr[4], kk[4], vv[4];
        { const float ra[4] = {bfl(r0.x), bfh(r0.x), bfl(r0.y), bfh(r0.y)}, rb[4] = {bfl(r1.x), bfh(r1.x), bfl(r1.y), bfh(r1.y)};
          const float ka[4] = {bfl(k0.x), bfh(k0.x), bfl(k0.y), bfh(k0.y)}, kb[4] = {bfl(k1.x), bfh(k1.x), bfl(k1.y), bfh(k1.y)};
          const float va[4] = {bfl(v0.x), bfh(v0.x), bfl(v0.y), bfh(v0.y)}, vb[4] = {bfl(v1.x), bfh(v1.x), bfl(v1.y), bfh(v1.y)};
#pragma unroll
          for (int r = 0; r < 4; ++r) { rr[r] = ra[r] + p.mur[r] * (rb[r] - ra[r]); kk[r] = ka[r] + p.muk[r] * (kb[r] - ka[r]); vv[r] = va[r] + p.muv[r] * (vb[r] - va[r]); } }
        float aa[4], k2[4], kc[4];
#pragma unroll
        for (int r = 0; r < 4; ++r) { aa[r] = fsigmoid(p.a0[r] + acc[tt][1][r]); kc[r] = kk[r] * p.kkw[r]; k2[r] = kk[r] * (1.0f + (aa[r] - 1.0f) * p.kaw[r]); }
        if constexpr (!FULL) {
#pragma unroll
            for (int r = 0; r < 4; ++r) { ssk[tt] += kc[r] * kc[r]; ssb[tt] += rr[r] * k2[r] * p.rkw[r]; }
        } else {
            const int e0 = (ct * 64 + tl0 + 16 * tt + c16) * 16 + 4 * g;
            f32x4 ld; float av[4], bv[4], g1[4], g2[4];
#pragma unroll
            for (int r = 0; r < 4; ++r) { const float sp = fsoftplus(-(p.w0[r] + acc[tt][0][r])); ld[r] = -__builtin_amdgcn_exp2f(-LOG2E * (sp + 0.5f));
                const float kn = kc[r] * ssk[tt]; av[r] = -kn; bv[r] = kn * aa[r]; const float gg = acc[tt][2][r]; g1[r] = p.gng[r] * gg; g2[r] = (p.gnb[r] + ssb[tt] * vv[r]) * gg; }
            *(f32x4*)(blk + AIN_LD + e0 * 4) = ld;
            *(pg8::u32x2*)(blk + AIN_R + e0 * 2) = (pg8::u32x2){pk2(rr[0], rr[1]), pk2(rr[2], rr[3])};
            *(pg8::u32x2*)(blk + AIN_K2 + e0 * 2) = (pg8::u32x2){pk2(k2[0], k2[1]), pk2(k2[2], k2[3])};
            *(pg8::u32x2*)(blk + AIN_V + e0 * 2) = (pg8::u32x2){pk2(vv[0], vv[1]), pk2(vv[2], vv[3])};
            *(pg8::u32x2*)(blk + AIN_AV + e0 * 2) = (pg8::u32x2){pk2(av[0], av[1]), pk2(av[2], av[3])};
            *(pg8::u32x2*)(blk + AIN_BV + e0 * 2) = (pg8::u32x2){pk2(bv[0], bv[1]), pk2(bv[2], bv[3])};
            *(pg8::u32x2*)(blk + AIN_G1 + e0 * 2) = (pg8::u32x2){pk2(g1[0], g1[1]), pk2(g1[2], g1[3])};
            *(pg8::u32x2*)(blk + AIN_G2 + e0 * 2) = (pg8::u32x2){pk2(g2[0], g2[1]), pk2(g2[2], g2[3])};
        }
        asm volatile("" ::: "memory");
    }
}
template <int PV = 0>
__device__ __forceinline__ void p2_rwkv_tok(const Args& A, LAS unsigned char* lds, int vcu, int G, int tid, int wave, int lane) {
    unsigned char* ws = A.ws; const bf16* P = (const bf16*)(ws + WS_P); const bf16* WLT = (const bf16*)(ws + WS_WLT); const float* mu = A.in[5];
    unsigned char* AIN = ws + WS_AIN;
    const int c16 = lane & 15, g = lane >> 4;
    for (int tile = vcu; tile < NTOK / 32; tile += G) {
        const int row0 = tile * 32;
        __syncthreads();
        int tidv = tid; asm volatile("" : "+v"(tidv));
        {
#pragma unroll
            for (int bt = 0; bt < 2; ++bt) {
            v4u pt[2], pp[2]; f32x4 m0[2], m1[2];
#pragma unroll
            for (int i = 0; i < 2; ++i) { const int idx = min(tidv + NTHR * (2 * bt + i), 32 * 56 - 1), tk = idx / 56, vec = idx % 56, row = row0 + tk, col = C_DW + vec * 8;
                pt[i] = *(const v4u*)(P + (size_t)row * PW + col); pp[i] = *(const v4u*)(P + (size_t)(row - ((row % T) ? 1 : 0)) * PW + col);
                m0[i] = *(const f32x4*)(mu + col); m1[i] = *(const f32x4*)(mu + col + 4); }
#pragma unroll
            for (int i = 0; i < 2; ++i) { const int idx = tidv + NTHR * (2 * bt + i), idc = min(idx, 32 * 56 - 1), tk = idc / 56, vec = idc % 56, row = row0 + tk; const bool hp = (row % T) != 0;
                float x[8]; const unsigned tw[4] = {pt[i].x, pt[i].y, pt[i].z, pt[i].w}, pw[4] = {pp[i].x, pp[i].y, pp[i].z, pp[i].w}; const float mm[8] = {m0[i].x, m0[i].y, m0[i].z, m0[i].w, m1[i].x, m1[i].y, m1[i].z, m1[i].w};
#pragma unroll
                for (int e = 0; e < 8; ++e) { const float a = (e & 1) ? bfh(tw[e >> 1]) : bfl(tw[e >> 1]); float b = (e & 1) ? bfh(pw[e >> 1]) : bfl(pw[e >> 1]); b = hp ? b : 0.f; const float ps = a + mm[e] * (b - a);
                    x[e] = vec < 12 ? 2.0f * fsigmoid(2.0f * ps) - 1.0f : (vec < 24 ? ps : fsigmoid(ps)); }
                v4u o; o.x = pk2(x[0], x[1]); o.y = pk2(x[2], x[3]); o.z = pk2(x[4], x[5]); o.w = pk2(x[6], x[7]);
                if (idx < 32 * 56) *(LAS v4u*)(lds + tk * 912 + vec * 16) = o; }
            asm volatile("" ::: "memory"); }
        }
        __syncthreads();
#pragma unroll 1
        for (int hh = 0; hh < 2; ++hh) {
            const int h = wave * 2 + hh;
            LAS unsigned char* inw = lds + A0_IN + wave * A0_INW;
            { const bool first = (row0 % T) == 0; int lanev = lane; asm volatile("" : "+v"(lanev));
#pragma unroll
              for (int bt = 0; bt < 2; ++bt) { v4u x[7];
#pragma unroll
                for (int i = 0; i < 7; ++i) { const int idx = lanev + 64 * (7 * bt + i), seg = min(idx >> 3, 98), pc = idx & 7, r = seg / 3, a = seg - 3 * r, grow = row0 - 1 + r + ((first && r == 0) ? 1 : 0);
                    x[i] = *(const v4u*)(P + (size_t)grow * PW + a * 1024 + h * 64 + pc * 8); }
#pragma unroll
                for (int i = 0; i < 7; ++i) { const int idx = lanev + 64 * (7 * bt + i), seg = idx >> 3, pc = idx & 7, r = seg / 3, a = seg - 3 * r;
                    const v4u z = (v4u){0u, 0u, 0u, 0u}; if (seg < 99) *(LAS v4u*)(inw + r * A0_ROWB + a * 128 + pc * 16) = (first && r == 0) ? z : x[i]; }
                asm volatile("" ::: "memory"); } }
            const int tpos0 = row0 % T, b = row0 / T; unsigned char* blk = AIN + (size_t)((b * 16 + h) * 256 + (tpos0 >> 6)) * AIN_BYTES; const int tl0 = tpos0 & 63;
            float ssk[2] = {0.f, 0.f}, ssb[2] = {0.f, 0.f};
            const bf16* wbase = WLT + (size_t)(h * 64 + c16) * 448 + 8 * g; const int colb = h * 64 + 4 * g;
            if constexpr (PV != 2) { bf16x8 w0[3]; A0Par pn;
#pragma unroll
              for (int ks = 0; ks < 3; ++ks) w0[ks] = *(const bf16x8*)(wbase + 32 * (3 + ks));
              a0_loadpar<false>(pn, A, mu, colb);
#pragma unroll 1
              for (int ct = 0; ct < 4; ++ct) { f32x4 acc[2][3]; a0_mfma<false>(acc, w0, lds, c16, g); const A0Par p = pn;
                  if (ct < 3) {
#pragma unroll
                      for (int ks = 0; ks < 3; ++ks) w0[ks] = *(const bf16x8*)(wbase + (size_t)(ct + 1) * 16 * 448 + 32 * (3 + ks));
                      a0_loadpar<false>(pn, A, mu, colb + 16 * (ct + 1)); }
                  asm volatile("" ::: "memory");
                  a0_ct<false>(acc, p, inw, blk, tl0, ct, c16, g, ssk, ssb); asm volatile("" ::: "memory"); } }
#pragma unroll
            for (int tt = 0; tt < 2; ++tt) { ssk[tt] = 1.0f / fmaxf(sqrtf(xsum16_32(ssk[tt])), 1e-12f); ssb[tt] = xsum16_32(ssb[tt]); }
            if constexpr (PV != 0) { if (ssk[0] + ssb[1] == 1234.5f) *(float*)blk = ssk[0]; }
            if constexpr (PV == 0) { bf16x8 w1[14]; A0Par pn;
#pragma unroll
              for (int ks = 0; ks < 14; ++ks) w1[ks] = *(const bf16x8*)(wbase + 32 * ks);
              a0_loadpar<true>(pn, A, mu, colb);
#pragma unroll 1
              for (int ct = 0; ct < 4; ++ct) { f32x4 acc[2][3]; a0_mfma<true>(acc, w1, lds, c16, g); const A0Par p = pn;
                  if (ct < 3) {
#pragma unroll
                      for (int ks = 0; ks < 14; ++ks) w1[ks] = *(const bf16x8*)(wbase + (size_t)(ct + 1) * 16 * 448 + 32 * ks);
                      a0_loadpar<true>(pn, A, mu, colb + 16 * (ct + 1)); }
                  asm volatile("" ::: "memory");
                  a0_ct<true>(acc, p, inw, blk, tl0, ct, c16, g, ssk, ssb);
                  asm volatile("" ::: "memory"); } }
        }
    }
}

constexpr int LA_CL = 0, LA_AS = 16640, LA_BS = 25856, LA_KS = 35072, LA_RS = 44288, LA_KGT = 53504, LA_BGT = 62720, LA_VT = 71936, LA_NS = 81152, LA_XU = 98560, LA_WS = 115968, LA_TOT = 125184, LA_SCR = 126208, LA_TS = 134400;
__device__ __forceinline__ f32x16 gtile32(LAS unsigned char* lds, int offA, int si, int offB, int ti, int r32, int hi) {
    f32x16 c;
#pragma unroll
    for (int r = 0; r < 16; ++r) c[r] = 0.f;
#pragma unroll
    for (int ks = 0; ks < 4; ++ks) { const bf16x8 a = *(const LAS bf16x8*)(lds + offA + (32 * si + r32) * 144 + (16 * ks + 8 * hi) * 2), b = *(const LAS bf16x8*)(lds + offB + (32 * ti + r32) * 144 + (16 * ks + 8 * hi) * 2);
        c = __builtin_amdgcn_mfma_f32_32x32x16_bf16(a, b, c, 0, 0, 0); }
    return c;
}
template <bool INCL> __device__ __forceinline__ void mask_lower(f32x16& c, int r32, int hi) {
#pragma unroll
    for (int r = 0; r < 16; ++r) { const int s = crow(r, hi); if (INCL ? (s > r32) : (s >= r32)) c[r] = 0.f; }
}
__device__ __forceinline__ float xcomb(float v) {
    { auto r = __builtin_amdgcn_permlane16_swap(__float_as_uint(v), __float_as_uint(v), false, false); v = __uint_as_float(r[0]) + __uint_as_float(r[1]); }
    { auto r = __builtin_amdgcn_permlane32_swap(__float_as_uint(v), __float_as_uint(v), false, false); v = __uint_as_float(r[0]) + __uint_as_float(r[1]); }
    return v;
}
__device__ __forceinline__ void gv_acc(f32x16& o, const f32x16& G, LAS unsigned char* lds, int si, int ib, int r32, int hi) {
#pragma unroll
    for (int sp = 0; sp < 2; ++sp) { v4u w; const int b8 = 8 * sp;
        w.x = pg8::cvt_pk_bf16(G[b8 + 0], G[b8 + 1]); w.y = pg8::cvt_pk_bf16(G[b8 + 2], G[b8 + 3]); w.z = pg8::cvt_pk_bf16(G[b8 + 4], G[b8 + 5]); w.w = pg8::cvt_pk_bf16(G[b8 + 6], G[b8 + 7]);
        const LAS unsigned char* vp = lds + LA_VT + (32 * ib + r32) * 144 + (32 * si + 16 * sp + 4 * hi) * 2;
        const s16x4 lo = *(const LAS s16x4*)vp, hh = *(const LAS s16x4*)(vp + 16);
        o = __builtin_amdgcn_mfma_f32_32x32x16_bf16(__builtin_bit_cast(bf16x8, w), (bf16x8){lo[0], lo[1], lo[2], lo[3], hh[0], hh[1], hh[2], hh[3]}, o, 0, 0, 0); }
}
__device__ __forceinline__ void p3_rwkv_chunk(const Args& A, LAS unsigned char* lds, int vcu, int G, int tid, int wave, int lane) {
    unsigned char* ws = A.ws;
    const int r32 = lane & 31, hi = lane >> 5, c16 = lane & 15, g = lane >> 4;
    LAS float* CL = (LAS float*)(lds + LA_CL); LAS float* TOT = (LAS float*)(lds + LA_TOT);
    const int t = tid >> 3, j0 = (tid & 7) * 8;
    const int e0 = ((j0 >> 4) * 64 + t) * 16 + (j0 & 15);
    f32x4 l0, l1; v4u vr, vk, vv, va, vb;
#define PA_LOAD_LD(ucx) do { const unsigned char* blk_ = ws + WS_AIN + (size_t)(ucx) * AIN_BYTES; l0 = *(const f32x4*)(blk_ + AIN_LD + e0 * 4); l1 = *(const f32x4*)(blk_ + AIN_LD + (e0 + 4) * 4); } while (0)
#define PA_LOAD(ucx) do { const unsigned char* blk_ = ws + WS_AIN + (size_t)(ucx) * AIN_BYTES; \
        vr = *(const v4u*)(blk_ + AIN_R + e0 * 2); vk = *(const v4u*)(blk_ + AIN_K2 + e0 * 2); vv = *(const v4u*)(blk_ + AIN_V + e0 * 2); \
        va = *(const v4u*)(blk_ + AIN_AV + e0 * 2); vb = *(const v4u*)(blk_ + AIN_BV + e0 * 2); } while (0)
    PA_LOAD_LD(min(vcu, 8191));
    for (int uc = vcu; uc < 8192; uc += G) {
        unsigned char* rec = ws + WS_REC + (size_t)uc * REC_BYTES;
        __syncthreads();
        PA_LOAD(uc);
        { LAS float* c = CL + t * 65 + j0; c[0] = l0.x; c[1] = l0.y; c[2] = l0.z; c[3] = l0.w; c[4] = l1.x; c[5] = l1.y; c[6] = l1.z; c[7] = l1.w; }
        __syncthreads();
        float xs[16];
        if (tid < 256) { const int j = tid & 63, q = tid >> 6; float run = 0.f;
#pragma unroll
            for (int e = 0; e < 16; ++e) { run += CL[(16 * q + e) * 65 + j]; xs[e] = run; }
            TOT[q * 64 + j] = run; }
        __syncthreads();
        if (tid < 256) { const int j = tid & 63, q = tid >> 6; float off = 0.f; for (int qq = 0; qq < q; ++qq) off += TOT[qq * 64 + j];
#pragma unroll
            for (int e = 0; e < 16; ++e) CL[(16 * q + e) * 65 + j] = off + xs[e]; }
        __syncthreads();
        {   const unsigned wr[4] = {vr.x, vr.y, vr.z, vr.w}, wk[4] = {vk.x, vk.y, vk.z, vk.w}, wv[4] = {vv.x, vv.y, vv.z, vv.w}, wa[4] = {va.x, va.y, va.z, va.w}, wb[4] = {vb.x, vb.y, vb.z, vb.w};
            float at[8], bt[8], kt[8], rt_[8], kg[8], bg[8], gc[8];
#pragma unroll
            for (int e = 0; e < 8; ++e) { const float ct = CL[t * 65 + j0 + e], cp = t ? CL[(t - 1) * 65 + j0 + e] : 0.f, cL = CL[63 * 65 + j0 + e];
                const float r_ = (e & 1) ? bfh(wr[e >> 1]) : bfl(wr[e >> 1]), k_ = (e & 1) ? bfh(wk[e >> 1]) : bfl(wk[e >> 1]), a_ = (e & 1) ? bfh(wa[e >> 1]) : bfl(wa[e >> 1]), b_ = (e & 1) ? bfh(wb[e >> 1]) : bfl(wb[e >> 1]);
                const float eg = __expf(ct), egi = __expf(-ct), ep = __expf(cp), eL = __expf(cL - ct);
                at[e] = a_ * ep; bt[e] = b_ * egi; kt[e] = k_ * egi; rt_[e] = r_ * eg; kg[e] = k_ * eL; bg[e] = b_ * eL; gc[e] = __expf(cL); }
            v4u o;
            o.x = pk2(at[0], at[1]); o.y = pk2(at[2], at[3]); o.z = pk2(at[4], at[5]); o.w = pk2(at[6], at[7]); *(LAS v4u*)(lds + LA_AS + t * 144 + j0 * 2) = o;
            o.x = pk2(bt[0], bt[1]); o.y = pk2(bt[2], bt[3]); o.z = pk2(bt[4], bt[5]); o.w = pk2(bt[6], bt[7]); *(LAS v4u*)(lds + LA_BS + t * 144 + j0 * 2) = o;
            o.x = pk2(kt[0], kt[1]); o.y = pk2(kt[2], kt[3]); o.z = pk2(kt[4], kt[5]); o.w = pk2(kt[6], kt[7]); *(LAS v4u*)(lds + LA_KS + t * 144 + j0 * 2) = o;
            o.x = pk2(rt_[0], rt_[1]); o.y = pk2(rt_[2], rt_[3]); o.z = pk2(rt_[4], rt_[5]); o.w = pk2(rt_[6], rt_[7]); *(LAS v4u*)(lds + LA_RS + t * 144 + j0 * 2) = o;
            *(v4u*)(rec + REC_RT + t * 144 + j0 * 2) = o;
#pragma unroll
            for (int e = 0; e < 8; ++e) { *(LAS bf16*)(lds + LA_KGT + (j0 + e) * 144 + t * 2) = (bf16)f2bf(kg[e]); *(LAS bf16*)(lds + LA_BGT + (j0 + e) * 144 + t * 2) = (bf16)f2bf(bg[e]);
                *(LAS bf16*)(lds + LA_VT + (j0 + e) * 144 + t * 2) = (bf16)((e & 1) ? (wv[e >> 1] >> 16) : (wv[e >> 1] & 0xffffu)); }
            if (t == 63) { *(f32x4*)(rec + REC_GC + j0 * 4) = (f32x4){gc[0], gc[1], gc[2], gc[3]}; *(f32x4*)(rec + REC_GC + (j0 + 4) * 4) = (f32x4){gc[4], gc[5], gc[6], gc[7]}; }
        }
        __syncthreads();
        if (wave < 4) {
            const int ib = wave & 1; const bool isY = wave >= 2; const int offX = isY ? LA_RS : LA_AS;
            f32x16 o;
#pragma unroll
            for (int r = 0; r < 16; ++r) o[r] = 0.f;
            { f32x16 Gt = gtile32(lds, LA_KS, 0, offX, 1, r32, hi); gv_acc(o, Gt, lds, 0, ib, r32, hi); }
            { f32x16 Gt = gtile32(lds, LA_KS, 1, offX, 1, r32, hi); if (isY) mask_lower<true>(Gt, r32, hi); else mask_lower<false>(Gt, r32, hi); gv_acc(o, Gt, lds, 1, ib, r32, hi); }
            if (!isY) {
#pragma unroll
                for (int r = 0; r < 16; ++r) *(LAS float*)(lds + LA_XU + ((32 + crow(r, hi)) * 68 + 32 * ib + r32) * 4) = o[r];
            } else {
#pragma unroll
                for (int u = 0; u < 4; ++u) { const int m = 2 + (u >> 1), lp = (r32 & 15) + 16 * (2 * (u & 1) + hi), vs = 2 * ib + (r32 >> 4);
                    *(pg8::u32x2*)(rec + REC_Y0 + ((vs * 4 + m) * 64 + lp) * 8) = (pg8::u32x2){pk2(o[4 * u], o[4 * u + 1]), pk2(o[4 * u + 2], o[4 * u + 3])}; }
            }
        } else if (wave < 6) {
            const bool isY = wave == 5; const int offX = isY ? LA_RS : LA_AS;
            f32x16 Gt = gtile32(lds, LA_KS, 0, offX, 0, r32, hi); if (isY) mask_lower<true>(Gt, r32, hi); else mask_lower<false>(Gt, r32, hi);
#pragma unroll
            for (int ib = 0; ib < 2; ++ib) { f32x16 o;
#pragma unroll
                for (int r = 0; r < 16; ++r) o[r] = 0.f;
                gv_acc(o, Gt, lds, 0, ib, r32, hi);
                if (!isY) {
#pragma unroll
                    for (int r = 0; r < 16; ++r) *(LAS float*)(lds + LA_XU + (crow(r, hi) * 68 + 32 * ib + r32) * 4) = o[r];
                } else {
#pragma unroll
                    for (int u = 0; u < 4; ++u) { const int m = (u >> 1), lp = (r32 & 15) + 16 * (2 * (u & 1) + hi), vs = 2 * ib + (r32 >> 4);
                        *(pg8::u32x2*)(rec + REC_Y0 + ((vs * 4 + m) * 64 + lp) * 8) = (pg8::u32x2){pk2(o[4 * u], o[4 * u + 1]), pk2(o[4 * u + 2], o[4 * u + 3])}; }
                } }
            const int hf = wave - 4;
#pragma unroll
            for (int jj = 0; jj < 2; ++jj)
#pragma unroll
                for (int vs = 0; vs < 4; ++vs) { const int jt = 2 * hf + jj; f32x4 acc = (f32x4){0.f, 0.f, 0.f, 0.f};
#pragma unroll
                    for (int ks = 0; ks < 2; ++ks) { const bf16x8 a = *(const LAS bf16x8*)(lds + LA_KGT + (16 * jt + c16) * 144 + (32 * ks + 8 * g) * 2), b = *(const LAS bf16x8*)(lds + LA_VT + (16 * vs + c16) * 144 + (32 * ks + 8 * g) * 2);
                        acc = __builtin_amdgcn_mfma_f32_16x16x32_bf16(a, b, acc, 0, 0, 0); }
                    *(pg8::u32x2*)(rec + REC_M0 + ((vs * 4 + jt) * 64 + lane) * 8) = (pg8::u32x2){pk2(acc[0], acc[1]), pk2(acc[2], acc[3])}; }
        } else {
            const bool isR = wave == 7; const int offX = isR ? LA_RS : LA_AS;
#pragma unroll
            for (int k = 0; k < 3; ++k) { const int si = k == 2 ? 1 : 0, ti = k == 0 ? 0 : 1;
                f32x16 Gt = gtile32(lds, LA_BS, si, offX, ti, r32, hi);
                if (si == ti) { if (isR) mask_lower<true>(Gt, r32, hi); else mask_lower<false>(Gt, r32, hi); }
#pragma unroll
                for (int u = 0; u < 4; ++u) {
                    if (!isR) *(LAS f32x4*)(lds + LA_NS + (32 * ti + r32) * 272 + (32 * si + 8 * u + 4 * hi) * 4) = (f32x4){Gt[4 * u], Gt[4 * u + 1], Gt[4 * u + 2], Gt[4 * u + 3]};
                    else *(pg8::u32x2*)(rec + REC_ARB + (32 * ti + r32) * 144 + (32 * si + 8 * u + 4 * hi) * 2) = (pg8::u32x2){pk2(Gt[4 * u], Gt[4 * u + 1]), pk2(Gt[4 * u + 2], Gt[4 * u + 3])}; }
            }
            if (isR) { const v4u z = (v4u){0u, 0u, 0u, 0u}; *(v4u*)(rec + REC_ARB + r32 * 144 + (32 + 16 * hi) * 2) = z; *(v4u*)(rec + REC_ARB + r32 * 144 + (40 + 16 * hi) * 2) = z; }
        }
        __syncthreads();
        const v4u vg1 = *(const v4u*)(ws + WS_AIN + (size_t)uc * AIN_BYTES + AIN_G1 + e0 * 2), vg2 = *(const v4u*)(ws + WS_AIN + (size_t)uc * AIN_BYTES + AIN_G2 + e0 * 2);
        PA_LOAD_LD(min(uc + G, 8191));
        if (wave < 4 && lane < 16) { const int bb = wave; float tc[16];
#pragma unroll
            for (int t2 = 0; t2 < 16; ++t2) { float v = (t2 == lane) ? 1.f : 0.f;
#pragma unroll
                for (int s4 = 0; s4 < (t2 + 3) / 4; ++s4) { const f32x4 n4 = *(const LAS f32x4*)(lds + LA_NS + (16 * bb + t2) * 272 + (16 * bb + 4 * s4) * 4);
#pragma unroll
                    for (int e = 0; e < 4; ++e) if (4 * s4 + e < t2) v += n4[e] * tc[4 * s4 + e]; }
                tc[t2] = v; *(LAS float*)(lds + LA_TS + ((bb * 16 + t2) * 16 + lane) * 4) = v; if ((t2 & 3) == 3) asm volatile("" ::: "memory"); } }
        __syncthreads();
        {   const bool isW = wave < 4; const int colw = 16 * (wave & 3) + c16;
            LAS float* RS = (LAS float*)(lds + LA_SCR + wave * 1024);
#pragma unroll 1
            for (int bb = 0; bb < 4; ++bb) {
                f32x4 acc;
#pragma unroll
                for (int r = 0; r < 4; ++r) acc[r] = isW ? bf1(*(const LAS bf16*)(lds + LA_AS + (16 * bb + 4 * g + r) * 144 + colw * 2)) : *(const LAS float*)(lds + LA_XU + ((16 * bb + 4 * g + r) * 68 + colw) * 4);
#pragma unroll 4
                for (int kk = 0; kk < 4 * bb; ++kk) { const float av = *(const LAS float*)(lds + LA_NS + (16 * bb + c16) * 272 + (4 * kk + g) * 4);
                    const float bv = isW ? CL[(4 * kk + g) * 65 + colw] : *(const LAS float*)(lds + LA_XU + ((4 * kk + g) * 68 + colw) * 4);
                    acc = __builtin_amdgcn_mfma_f32_16x16x4f32(av, bv, acc, 0, 0, 0); }
#pragma unroll
                for (int r = 0; r < 4; ++r) RS[(4 * g + r) * 16 + c16] = acc[r];
                f32x4 xa = (f32x4){0.f, 0.f, 0.f, 0.f};
#pragma unroll
                for (int kk = 0; kk < 4; ++kk) { const float av = *(const LAS float*)(lds + LA_TS + ((bb * 16 + c16) * 16 + 4 * kk + g) * 4); const float bv = RS[(4 * kk + g) * 16 + c16];
                    xa = __builtin_amdgcn_mfma_f32_16x16x4f32(av, bv, xa, 0, 0, 0); }
#pragma unroll
                for (int r = 0; r < 4; ++r) { if (isW) CL[(16 * bb + 4 * g + r) * 65 + colw] = xa[r]; else *(LAS float*)(lds + LA_XU + ((16 * bb + 4 * g + r) * 68 + colw) * 4) = xa[r]; }
                if (isW) {
#pragma unroll
                    for (int r = 0; r < 4; ++r) *(LAS bf16*)(lds + LA_WS + (16 * bb + 4 * g + r) * 144 + colw * 2) = (bf16)f2bf(xa[r]);
                } else *(pg8::u32x2*)(rec + REC_U0 + (((wave & 3) * 4 + bb) * 64 + lane) * 8) = (pg8::u32x2){pk2(xa[0], xa[1]), pk2(xa[2], xa[3])};
            }
        }
        __syncthreads();
        { const int bh = uc >> 8, row = (bh >> 4) * T + (uc & 255) * 64 + t; const size_t go = (size_t)row * 1024 + (bh & 15) * 64 + j0;
          *(v4u*)((bf16*)(ws + WS_G1) + go) = vg1; *(v4u*)((bf16*)(ws + WS_G2) + go) = vg2; }
        for (int i = tid; i < 576; i += NTHR) { *(v4u*)(rec + REC_W + i * 16) = *(const LAS v4u*)(lds + LA_WS + i * 16); *(v4u*)(rec + REC_BGT + i * 16) = *(const LAS v4u*)(lds + LA_BGT + i * 16); }
    }
}

#undef PA_LOAD
#undef PA_LOAD_LD
__device__ __forceinline__ bf16x8 afrag16(const LAS unsigned char* base, int row, int s, int g) {
    const LAS unsigned char* p = base + row * 144 + (32 * s + 4 * g) * 2; const s16x4 lo = *(const LAS s16x4*)p, hh = *(const LAS s16x4*)(p + 32);
    return (bf16x8){lo[0], lo[1], lo[2], lo[3], hh[0], hh[1], hh[2], hh[3]};
}
__device__ __forceinline__ bf16x8 pack_cc(const f32x4& a, const f32x4& b) { v4u w; w.x = pg8::cvt_pk_bf16(a[0], a[1]); w.y = pg8::cvt_pk_bf16(a[2], a[3]); w.z = pg8::cvt_pk_bf16(b[0], b[1]); w.w = pg8::cvt_pk_bf16(b[2], b[3]); return __builtin_bit_cast(bf16x8, w); }
__device__ __forceinline__ f32x4 cfrag(const LAS unsigned char* base, int vs, int m, int lane) { const pg8::u32x2 u = *(const LAS pg8::u32x2*)(base + ((vs * 4 + m) * 64 + lane) * 8); return (f32x4){bfl(u.x), bfh(u.x), bfl(u.y), bfh(u.y)}; }
constexpr int B_SLOT = 44032, B_NP = 43;
__device__ __forceinline__ void b_issue(const unsigned char* rec, LAS unsigned char* slot, int vs, int lw, int lane) {
    for (int p = lw; p < B_NP; p += 4) {
        const int src = p < 36 ? p * 1024 : (p < 42 ? REC_U0 + ((p - 36) >> 1) * 8192 + vs * 2048 + ((p - 36) & 1) * 1024 : REC_GC);
        __builtin_amdgcn_global_load_lds((const unsigned*)(rec + src + lane * 16), (LAS unsigned*)(slot + p * 1024), 16, 0, 0); }
}
__device__ __forceinline__ void p4_rwkv_seq(const Args& A, LAS unsigned char* lds, int q, int wave, int lane) {
    unsigned char* ws = A.ws; const int bh = q >> 2, vs = q & 3;
    const unsigned char* REC = ws + WS_REC + (size_t)bh * 256 * REC_BYTES; bf16* YR = (bf16*)(ws + WS_YRAW);
    const int b = bh >> 4, h = bh & 15, c16 = lane & 15, g = lane >> 4, lw = wave - 4;
    const bool many = ((B_NP - 1 - lw) / 4 + 1) == 11;
    if (wave >= 4) { b_issue(REC, lds, vs, lw, lane); b_issue(REC + REC_BYTES, lds + B_SLOT, vs, lw, lane);
        if (many) asm volatile("s_waitcnt vmcnt(11)" ::: "memory"); else asm volatile("s_waitcnt vmcnt(10)" ::: "memory"); }
    __syncthreads();
    f32x4 H[4];
#pragma unroll
    for (int jt = 0; jt < 4; ++jt) H[jt] = (f32x4){0.f, 0.f, 0.f, 0.f};
#pragma unroll 1
    for (int c = 0; c < 256; ++c) {
        const LAS unsigned char* buf = lds + (c % 3) * B_SLOT;
        if (wave >= 4) {
            if (c + 2 < 256) { b_issue(REC + (size_t)(c + 2) * REC_BYTES, lds + ((c + 2) % 3) * B_SLOT, vs, lw, lane);
                if (many) asm volatile("s_waitcnt vmcnt(11)" ::: "memory"); else asm volatile("s_waitcnt vmcnt(10)" ::: "memory"); }
            else asm volatile("s_waitcnt vmcnt(0)" ::: "memory");
        } else if (wave == 0) {
            const LAS unsigned char* qb = buf + 36864;
            bf16x8 hb[2]; hb[0] = pack_cc(H[0], H[1]); hb[1] = pack_cc(H[2], H[3]);
            f32x4 U[4];
#pragma unroll
            for (int m = 0; m < 4; ++m) { U[m] = cfrag(qb, 0, m, lane);
#pragma unroll
                for (int s = 0; s < 2; ++s) U[m] = __builtin_amdgcn_mfma_f32_16x16x32_bf16(afrag16(buf + REC_W, 16 * m + c16, s, g), hb[s], U[m], 0, 0, 0); }
            bf16x8 ub[2]; ub[0] = pack_cc(U[0], U[1]); ub[1] = pack_cc(U[2], U[3]);
#pragma unroll
            for (int jt = 0; jt < 4; ++jt) { const f32x4 gc = *(const LAS f32x4*)(qb + 6144 + (16 * jt + 4 * g) * 4); f32x4 hn = H[jt] * gc + cfrag(qb + 4096, 0, jt, lane);
#pragma unroll
                for (int s = 0; s < 2; ++s) hn = __builtin_amdgcn_mfma_f32_16x16x32_bf16(afrag16(buf + REC_BGT, 16 * jt + c16, s, g), ub[s], hn, 0, 0, 0);
                H[jt] = hn; }
#pragma unroll
            for (int m = 0; m < 4; ++m) { f32x4 y = cfrag(qb + 2048, 0, m, lane);
#pragma unroll
                for (int s = 0; s < 2; ++s) y = __builtin_amdgcn_mfma_f32_16x16x32_bf16(afrag16(buf + REC_RT, 16 * m + c16, s, g), hb[s], y, 0, 0, 0);
#pragma unroll
                for (int s = 0; s < 2; ++s) y = __builtin_amdgcn_mfma_f32_16x16x32_bf16(afrag16(buf + REC_ARB, 16 * m + c16, s, g), ub[s], y, 0, 0, 0);
                bf16* yp = YR + (size_t)(b * T + 64 * c + 16 * m + 4 * g) * 1024 + h * 64 + 16 * vs + c16;
                yp[0] = (bf16)f2bf(y[0]); yp[1024] = (bf16)f2bf(y[1]); yp[2048] = (bf16)f2bf(y[2]); yp[3072] = (bf16)f2bf(y[3]); }
        }
        __syncthreads();
    }
}
__device__ __forceinline__ void p5_rwkv_final(const Args& A, int vcu, int G, int wave, int lane) {
    const bf16* YR = (const bf16*)(A.ws + WS_YRAW); const bf16* G1 = (const bf16*)(A.ws + WS_G1); const bf16* G2 = (const bf16*)(A.ws + WS_G2); bf16* MIX = (bf16*)(A.ws + WS_MIX);
    const int gw = vcu * NWAVES + wave, NGW = G * NWAVES, pr = lane >> 3, oct = lane & 7;
    for (int it0 = gw * 8 + pr; it0 < NTOK * 16; it0 += NGW * 8 * 4) {
        v4u y[4], a[4], c[4];
#pragma unroll
        for (int k = 0; k < 4; ++k) { const int it = min(it0 + k * NGW * 8, NTOK * 16 - 1); const size_t o = (size_t)(it >> 4) * 1024 + (it & 15) * 64 + oct * 8;
            y[k] = *(const v4u*)(YR + o); a[k] = *(const v4u*)(G1 + o); c[k] = *(const v4u*)(G2 + o); }
#pragma unroll
        for (int k = 0; k < 4; ++k) { const int it = it0 + k * NGW * 8;
            const unsigned yw[4] = {y[k].x, y[k].y, y[k].z, y[k].w}, aw[4] = {a[k].x, a[k].y, a[k].z, a[k].w}, cw[4] = {c[k].x, c[k].y, c[k].z, c[k].w};
            float v[8]; float sm = 0.f;
#pragma unroll
            for (int e = 0; e < 4; ++e) { v[2 * e] = bfl(yw[e]); v[2 * e + 1] = bfh(yw[e]); sm += v[2 * e] + v[2 * e + 1]; }
            sm += __shfl_xor(sm, 1); sm += __shfl_xor(sm, 2); sm += __shfl_xor(sm, 4);
            const float mean = sm * (1.f / 64.f); float sq = 0.f;
#pragma unroll
            for (int e = 0; e < 8; ++e) { v[e] -= mean; sq += v[e] * v[e]; }
            sq += __shfl_xor(sq, 1); sq += __shfl_xor(sq, 2); sq += __shfl_xor(sq, 4);
            const float rstd = 1.0f / sqrtf(sq * (1.f / 64.f) + GN_EPS);
            v4u o4; unsigned ow[4];
#pragma unroll
            for (int e = 0; e < 4; ++e) ow[e] = pk2(v[2 * e] * rstd * bfl(aw[e]) + bfl(cw[e]), v[2 * e + 1] * rstd * bfh(aw[e]) + bfh(cw[e]));
            o4.x = ow[0]; o4.y = ow[1]; o4.z = ow[2]; o4.w = ow[3];
            if (it < NTOK * 16) *(v4u*)(MIX + (size_t)(it >> 4) * D + (it & 15) * 64 + oct * 8) = o4; }
    }
}

__device__ __forceinline__ void p5_ln_router(const Args& A, LAS unsigned char* lds, int vcu, int G, int tid, int wave, int lane) {
    unsigned char* ws = A.ws; const bf16* Z1 = (const bf16*)(ws + WS_Z1); bf16* H1 = (bf16*)(ws + WS_H1); const bf16* RWF = (const bf16*)(ws + WS_RWT);
    int* TOPI = (int*)(ws + RT_TOPI); float* TOPG = (float*)(ws + RT_TOPG); int* CNT = (int*)(ws + RT_CNT);
    LAS int* hist = (LAS int*)lds; const int c16 = lane & 15, g = lane >> 4;
    const float* gam = A.in[21]; const float* bet = A.in[22];
    for (int batch = vcu; batch < NTOK / 128; batch += G) {
        __syncthreads();
        if (tid < NE) hist[tid] = 0;
        __syncthreads();
        const int row0 = batch * 128 + wave * 16; const bf16* zr = Z1 + (size_t)(row0 + c16) * D + 8 * g;
        float sm = 0.f, sq = 0.f;
#pragma unroll 8
        for (int sx = 0; sx < 64; ++sx) { const v4u z = *(const v4u*)(zr + 32 * sx); const unsigned zw[4] = {z.x, z.y, z.z, z.w};
#pragma unroll
            for (int e = 0; e < 4; ++e) { const float a = bfl(zw[e]), b = bfh(zw[e]); sm += a + b; sq += a * a + b * b; } }
        sm += __shfl_xor(sm, 16); sm += __shfl_xor(sm, 32); sq += __shfl_xor(sq, 16); sq += __shfl_xor(sq, 32);
        const float mean = sm * (1.f / D); const float rstd = 1.0f / sqrtf(fmaxf(sq * (1.f / D) - mean * mean, 0.f) + LN_EPS);
        f32x4 acc[2]; acc[0] = (f32x4){0.f, 0.f, 0.f, 0.f}; acc[1] = acc[0];
        bf16* hr = H1 + (size_t)(row0 + c16) * D + 8 * g; unsigned char* hq = ws + WS_H1Q + (size_t)(row0 + c16) * D + 8 * g;
#pragma unroll 2
        for (int sx = 0; sx < 64; ++sx) { const v4u z = *(const v4u*)(zr + 32 * sx); const f32x4 a = (f32x4){bfl(z.x), bfh(z.x), bfl(z.y), bfh(z.y)}, b = (f32x4){bfl(z.z), bfh(z.z), bfl(z.w), bfh(z.w)};
            const f32x4 g0 = *(const f32x4*)(gam + 32 * sx + 8 * g), g1 = *(const f32x4*)(gam + 32 * sx + 8 * g + 4), b0 = *(const f32x4*)(bet + 32 * sx + 8 * g), b1 = *(const f32x4*)(bet + 32 * sx + 8 * g + 4);
            const f32x4 h0 = (a - mean) * rstd * g0 + b0, h1 = (b - mean) * rstd * g1 + b1;
            v4u hi; hi.x = pg8::cvt_pk_bf16(h0.x, h0.y); hi.y = pg8::cvt_pk_bf16(h0.z, h0.w); hi.z = pg8::cvt_pk_bf16(h1.x, h1.y); hi.w = pg8::cvt_pk_bf16(h1.z, h1.w);
            *(v4u*)(hr + 32 * sx) = hi;
            *(pg8::u32x2*)(hq + 32 * sx) = (pg8::u32x2){pg8::pk4_fp8(h0.x, h0.y, h0.z, h0.w), pg8::pk4_fp8(h1.x, h1.y, h1.z, h1.w)};
            v4u lo; lo.x = pg8::cvt_pk_bf16(h0.x - bfl(hi.x), h0.y - bfh(hi.x)); lo.y = pg8::cvt_pk_bf16(h0.z - bfl(hi.y), h0.w - bfh(hi.y));
            lo.z = pg8::cvt_pk_bf16(h1.x - bfl(hi.z), h1.y - bfh(hi.z)); lo.w = pg8::cvt_pk_bf16(h1.z - bfl(hi.w), h1.w - bfh(hi.w));
            const bf16x8 ah = __builtin_bit_cast(bf16x8, hi), al = __builtin_bit_cast(bf16x8, lo);
#pragma unroll
            for (int nt = 0; nt < 2; ++nt) { const bf16* fp = RWF + ((size_t)((sx * 2 + nt) * 2) * 64 + lane) * 8; const bf16x8 wh = *(const bf16x8*)fp, wl = *(const bf16x8*)(fp + 512);
                acc[nt] = __builtin_amdgcn_mfma_f32_16x16x32_bf16(ah, wh, acc[nt], 0, 0, 0); acc[nt] = __builtin_amdgcn_mfma_f32_16x16x32_bf16(ah, wl, acc[nt], 0, 0, 0);
                acc[nt] = __builtin_amdgcn_mfma_f32_16x16x32_bf16(al, wh, acc[nt], 0, 0, 0); } }
        const float bia0 = A.in[24][c16], bia1 = A.in[24][16 + c16];
#pragma unroll
        for (int r = 0; r < 4; ++r) {
            float v0 = acc[0][r] + bia0, v1 = acc[1][r] + bia1; float tv[4]; int ti[4];
#pragma unroll
            for (int k = 0; k < 4; ++k) { float bv = v0; int bi = c16; if (v1 > bv) { bv = v1; bi = 16 + c16; }
#pragma unroll
                for (int o = 1; o < 16; o <<= 1) { const float ov = __shfl_xor(bv, o); const int oi = __shfl_xor(bi, o); if (ov > bv || (ov == bv && oi < bi)) { bv = ov; bi = oi; } }
                tv[k] = bv; ti[k] = bi; if (bi == c16) v0 = -INFINITY; if (bi == 16 + c16) v1 = -INFINITY; }
            const float e1 = __expf(tv[1] - tv[0]), e2 = __expf(tv[2] - tv[0]), e3 = __expf(tv[3] - tv[0]); const float inv = 1.f / (1.f + e1 + e2 + e3);
            if (c16 < 4) { const int row = row0 + 4 * g + r; const int ei = c16 == 0 ? ti[0] : c16 == 1 ? ti[1] : c16 == 2 ? ti[2] : ti[3]; const float gv = (c16 == 0 ? 1.f : c16 == 1 ? e1 : c16 == 2 ? e2 : e3) * inv;
                TOPI[row * 4 + c16] = ei; TOPG[row * 4 + c16] = gv; __hip_atomic_fetch_add(hist + ei, 1, __ATOMIC_RELAXED, __HIP_MEMORY_SCOPE_WORKGROUP); }
        }
        __syncthreads();
        if (tid < NE) CNT[batch * NE + tid] = hist[tid];
    }
}
__device__ __forceinline__ void p6_positions(const Args& A, LAS unsigned char* lds, int vcu, int G, int tid) {
    unsigned char* ws = A.ws; const int* TOPI = (const int*)(ws + RT_TOPI); const float* TOPG = (const float*)(ws + RT_TOPG); const int* CNT = (const int*)(ws + RT_CNT);
    int* POS = (int*)(ws + RT_POS); int* BTOK = (int*)(ws + RT_TOK); float* BGATE = (float*)(ws + RT_GATE); int* TILE = (int*)(ws + RT_TILE);
    LAS int* sh = (LAS int*)lds;
    for (int batch = vcu; batch < NTOK / 128; batch += G) {
        __syncthreads();
        { const int e = tid & 31, seg = tid >> 5; int sb = 0, st = 0;
          for (int q = 0; q < 16; ++q) { const int bb = seg * 16 + q; const int c = CNT[bb * NE + e]; st += c; if (bb < batch) sb += c; }
          sh[tid] = sb; sh[1152 + tid] = st; }
        sh[640 + tid] = TOPI[batch * 512 + tid];
        __syncthreads();
        if (tid < NE) { int sb = 0, st = 0; for (int s = 0; s < 16; ++s) { sb += sh[s * 32 + tid]; st += sh[1152 + s * 32 + tid]; } sh[512 + tid] = sb; sh[544 + tid] = st; }
        __syncthreads();
        if (tid == 0) { int acc = 0; for (int e = 0; e < NE; ++e) { sh[576 + e] = acc; acc += (sh[544 + e] + 255) >> 8; } sh[576 + NE] = acc; }
        __syncthreads();
        { const int e = sh[640 + tid]; int rank = 0; for (int j = 0; j < tid; ++j) rank += (sh[640 + j] == e) ? 1 : 0;
          const int dest = sh[576 + e] * 256 + sh[512 + e] + rank;
          BTOK[dest] = batch * 128 + (tid >> 2); BGATE[dest] = TOPG[batch * 512 + tid]; POS[batch * 512 + tid] = dest; }
        if (batch < NE) { const int e = batch; const int lo = sh[576 + e] * 256 + sh[544 + e], hi = sh[576 + e + 1] * 256;
            for (int i = lo + tid; i < hi; i += NTHR) { BTOK[i] = 0; BGATE[i] = 0.f; }
            for (int rt = sh[576 + e] + tid; rt < sh[576 + e + 1]; rt += NTHR) TILE[rt] = e; }
        if (batch == 0 && tid == 0) TILE[MAXT] = sh[576 + NE];
    }
}
template <int I> __device__ __forceinline__ float fp8f_(unsigned w) { return __builtin_amdgcn_cvt_f32_fp8((int)w, I); }
#define fp8f(w, i) fp8f_<i>(w)
__device__ __forceinline__ void p9_final(const Args& A, int vcu, int G, int wave, int lane) {
    unsigned char* ws = A.ws; const bf16* H1 = (const bf16*)(ws + WS_H1); const unsigned char* Y = ws + WS_Y; const int* POS = (const int*)(ws + RT_POS);
    const int gw = vcu * NWAVES + wave, NGW = G * NWAVES;
    for (int row = gw; row < NTOK; row += NGW) {
        f32x4 v[8]; const int p0 = POS[row * 4], p1 = POS[row * 4 + 1], p2 = POS[row * 4 + 2], p3 = POS[row * 4 + 3];
#pragma unroll
        for (int j = 0; j < 8; ++j) { const int c = 4 * lane + 256 * j;
            const pg8::u32x2 h = *(const pg8::u32x2*)(H1 + (size_t)row * D + c);
            const unsigned y0 = *(const unsigned*)(Y + (size_t)p0 * D + c), y1 = *(const unsigned*)(Y + (size_t)p1 * D + c), y2 = *(const unsigned*)(Y + (size_t)p2 * D + c), y3 = *(const unsigned*)(Y + (size_t)p3 * D + c);
            const float s = 1.0f / 64.0f;
            v[j].x = ALPHA * bfl(h.x) + s * ((fp8f(y0, 0) + fp8f(y1, 0)) + (fp8f(y2, 0) + fp8f(y3, 0))); v[j].y = ALPHA * bfh(h.x) + s * ((fp8f(y0, 1) + fp8f(y1, 1)) + (fp8f(y2, 1) + fp8f(y3, 1)));
            v[j].z = ALPHA * bfl(h.y) + s * ((fp8f(y0, 2) + fp8f(y1, 2)) + (fp8f(y2, 2) + fp8f(y3, 2))); v[j].w = ALPHA * bfh(h.y) + s * ((fp8f(y0, 3) + fp8f(y1, 3)) + (fp8f(y2, 3) + fp8f(y3, 3))); }
        ln_row(v, A.in[29], A.in[30], LN_EPS, lane);
#pragma unroll
        for (int j = 0; j < 8; ++j) *(f32x4*)(A.out + (size_t)row * D + 4 * lane + 256 * j) = v[j];
    }
}

constexpr int NPH = 12;
template <int PLO, int PHI>
__global__ void __launch_bounds__(NTHR, 2) fwd_kernel(Args args) {
    extern __shared__ __attribute__((aligned(16))) unsigned char lds_raw[];
    LAS unsigned char* lds = (LAS unsigned char*)lds_raw;
    const int tid = threadIdx.x, lane = tid & 63, wave = __builtin_amdgcn_readfirstlane(tid >> 6);
    const int G = gridDim.x; const int bx = blockIdx.x; const int vcu = (G % 8 == 0) ? (bx % 8) * (G / 8) + bx / 8 : bx;
    volatile LAS unsigned* MISC = (volatile LAS unsigned*)(lds + MISC_OFF);
    if (tid < 64) MISC[tid] = 0u;
    __syncthreads();
    unsigned char* ws = args.ws;
    unsigned* ctl = (unsigned*)(ws + WS_CTL);
    constexpr int lo = PLO, hi = PHI;
    XcdBarrier bar; bar.bar = ctl + CW_BAR; bar.x = 0; bar.st = nullptr;
    if (hi - lo > 1) bar = xcd_barrier_post(ctl + CW_BAR, MISC + 8);
#define IN(k) (lo <= (k) && (k) < hi)
#define SEAM(k) do { if constexpr (IN(k) && IN((k) + 1)) xcd_barrier(bar); } while (0)

    if constexpr (IN(0)) { p0_prologue(args, lds, vcu, G, wave, lane); }
#if defined(REP_PHASE)
    if constexpr (REP_PHASE == 0) { __syncthreads();
    if constexpr (IN(0)) { p0_prologue(args, lds, vcu, G, wave, lane); }
    }
#endif
    SEAM(0);
    if constexpr (IN(1)) {
        const int ng = (G == 256) ? NG_INPROJ : G;
        if (bx < ng) { pg8::Gemm g{(const bf16*)(ws + WS_H0), (const bf16*)(ws + WS_WI), NTOK, PW, D}; pg8::StaticOrder S; S.init(NTOK, PW, ng, bx);
            pg8::EpiBf16 E{(bf16*)(ws + WS_P), PW};
            pg8::gemm_phase<pg8::EpiBf16, pg8::StaticOrder>(lds, g, S, E); }
        else { pg8::Gemm g{(const bf16*)(ws + WS_MEMN), (const bf16*)(ws + WS_WKV), NB * MEM_LEN, 1024, D}; pg8::StaticOrder S; S.init(NB * MEM_LEN, 1024, G - ng, bx - ng);
            pg8::EpiBf16 E{(bf16*)(ws + WS_KVM), 1024};
            pg8::gemm_phase<pg8::EpiBf16, pg8::StaticOrder>(lds, g, S, E); }
        conv_pull_loop(args, lds, tid, wave, lane);
    }
#if defined(REP_PHASE)
    if constexpr (REP_PHASE == 1) { __syncthreads();
    if constexpr (IN(1)) {
        pg8::Gemm g{(const bf16*)(ws + WS_H0), (const bf16*)(ws + WS_WI), NTOK, PW, D}; pg8::StaticOrder S; S.init(NTOK, PW, G, bx);
        pg8::EpiBf16 E{(bf16*)(ws + WS_P), PW};
        pg8::gemm_phase<pg8::EpiBf16, pg8::StaticOrder>(lds, g, S, E);
    }
    }
#endif
    SEAM(1);
    if constexpr (IN(2)) {
        if (G != 256) { pg8::Gemm g{(const bf16*)(ws + WS_MEMN), (const bf16*)(ws + WS_WKV), NB * MEM_LEN, 1024, D}; pg8::StaticOrder S; S.init(NB * MEM_LEN, 1024, G, bx);
          pg8::EpiBf16 E{(bf16*)(ws + WS_KVM), 1024};
          pg8::gemm_phase<pg8::EpiBf16, pg8::StaticOrder>(lds, g, S, E); }
        __syncthreads();
        p2_fox_cumsum(args, lds, (vcu + G - 16) % G, G, tid);
        __syncthreads();
        p2_fox_norms(args, lds, vcu, G, tid, wave, lane);
        __syncthreads();
        p2_rwkv_tok(args, lds, vcu, G, tid, wave, lane);
#if defined(REP_SUB)
        __syncthreads();
        if constexpr (REP_SUB == 0) p2_rwkv_tok(args, lds, vcu, G, tid, wave, lane);
        if constexpr (REP_SUB == 11) p2_rwkv_tok<1>(args, lds, vcu, G, tid, wave, lane);
        if constexpr (REP_SUB == 12) p2_rwkv_tok<2>(args, lds, vcu, G, tid, wave, lane);
        if constexpr (REP_SUB == 1) p2_fox_norms(args, lds, vcu, G, tid, wave, lane);
        if constexpr (REP_SUB == 2) p2_fox_cumsum(args, lds, (vcu + G - 16) % G, G, tid);
        if constexpr (REP_SUB == 3) { pg8::Gemm g{(const bf16*)(ws + WS_MEMN), (const bf16*)(ws + WS_WKV), NB * MEM_LEN, 1024, D}; pg8::StaticOrder S; S.init(NB * MEM_LEN, 1024, G, bx);
          pg8::EpiBf16 E{(bf16*)(ws + WS_KVM), 1024};
          pg8::gemm_phase<pg8::EpiBf16, pg8::StaticOrder>(lds, g, S, E); }
#endif
    }
#if defined(REP_PHASE)
    if constexpr (REP_PHASE == 2) { __syncthreads();
    if constexpr (IN(2)) {
        { pg8::Gemm g{(const bf16*)(ws + WS_MEMN), (const bf16*)(ws + WS_WKV), NB * MEM_LEN, 1024, D}; pg8::StaticOrder S; S.init(NB * MEM_LEN, 1024, G, bx);
          pg8::EpiBf16 E{(bf16*)(ws + WS_KVM), 1024};
          pg8::gemm_phase<pg8::EpiBf16, pg8::StaticOrder>(lds, g, S, E); }
        __syncthreads();
        p2_fox_cumsum(args, lds, (vcu + G - 16) % G, G, tid);
        __syncthreads();
        p2_fox_norms(args, lds, vcu, G, tid, wave, lane);
        __syncthreads();
        p2_rwkv_tok(args, lds, vcu, G, tid, wave, lane);
    }
    }
#endif
    SEAM(2);
    if constexpr (IN(3)) { p3_rwkv_chunk(args, lds, vcu, G, tid, wave, lane); }
#if defined(REP_PHASE)
    if constexpr (REP_PHASE == 3) { __syncthreads();
    if constexpr (IN(3)) { p3_rwkv_chunk(args, lds, vcu, G, tid, wave, lane); }
    }
#endif
    SEAM(3);
    if constexpr (IN(4)) {
        for (int q = vcu; q < 128; q += G) { __syncthreads(); p4_rwkv_seq(args, lds, q, wave, lane); }
        p3_attention(args, lds, tid, wave, lane);
    }
#if defined(REP_PHASE)
    if constexpr (REP_PHASE == 4) { __syncthreads();
    if constexpr (IN(4)) {
        for (int q = vcu; q < 128; q += G) { __syncthreads(); p4_rwkv_seq(args, lds, q, wave, lane); }
        p3_attention(args, lds, tid, wave, lane);
    }
    }
#endif
    SEAM(4);
    if constexpr (IN(5)) { p5_rwkv_final(args, vcu, G, wave, lane); }
#if defined(REP_PHASE)
    if constexpr (REP_PHASE == 5) { __syncthreads();
    if constexpr (IN(5)) { p5_rwkv_final(args, vcu, G, wave, lane); }
    }
#endif
    SEAM(5);
    if constexpr (IN(6)) {
        pg8::Gemm g{(const bf16*)(ws + WS_MIX), (const bf16*)(ws + WS_WO), NTOK, D, D}; pg8::StaticOrder S; S.init(NTOK, D, G, bx);
        pg8::EpiResBf16 E{(bf16*)(ws + WS_Z1), (const bf16*)(ws + WS_H0), D, ALPHA};
        pg8::gemm_phase<pg8::EpiResBf16, pg8::StaticOrder>(lds, g, S, E);
    }
#if defined(REP_PHASE)
    if constexpr (REP_PHASE == 6) { __syncthreads();
    if constexpr (IN(6)) {
        pg8::Gemm g{(const bf16*)(ws + WS_MIX), (const bf16*)(ws + WS_WO), NTOK, D, D}; pg8::StaticOrder S; S.init(NTOK, D, G, bx);
        pg8::EpiResBf16 E{(bf16*)(ws + WS_Z1), (const bf16*)(ws + WS_H0), D, ALPHA};
        pg8::gemm_phase<pg8::EpiResBf16, pg8::StaticOrder>(lds, g, S, E);
    }
    }
#endif
    SEAM(6);
    if constexpr (IN(7)) { p5_ln_router(args, lds, vcu, G, tid, wave, lane); }
#if defined(REP_PHASE)
    if constexpr (REP_PHASE == 7) { __syncthreads();
    if constexpr (IN(7)) { p5_ln_router(args, lds, vcu, G, tid, wave, lane); }
    }
#endif
    SEAM(7);
    if constexpr (IN(8)) { p6_positions(args, lds, vcu, G, tid); }
#if defined(REP_PHASE)
    if constexpr (REP_PHASE == 8) { __syncthreads();
    if constexpr (IN(8)) { p6_positions(args, lds, vcu, G, tid); }
    }
#endif
    SEAM(8);
    if constexpr (IN(9)) {
        const int* TILE = (const int*)(ws + RT_TILE); const int ntiles = __builtin_amdgcn_readfirstlane(TILE[MAXT]);
        LAS int* tl = (LAS int*)(lds + 131072 + 2048); __syncthreads(); for (int i = tid; i < MAXT; i += NTHR) tl[i] = TILE[i]; __syncthreads();
        pg8::Gemm g{(const bf16*)(ws + WS_H1Q), (const bf16*)(ws + WS_W1), CAP, NE * 4096, D / 2};
        pg8::MoeOrder<true> S{tl, (const int*)(ws + RT_TOK), ntiles, 16, G, bx};
        pg8::EpiSwiglu E{ws + WS_ACT, args.in[26], {}, {}};
        pg8::gemm_phase<pg8::EpiSwiglu, pg8::MoeOrder<true>, true, true>(lds, g, S, E);
    }
#if defined(REP_PHASE)
    if constexpr (REP_PHASE == 9) { __syncthreads();
    if constexpr (IN(9)) {
        const int* TILE = (const int*)(ws + RT_TILE); const int ntiles = __builtin_amdgcn_readfirstlane(TILE[MAXT]);
        LAS int* tl = (LAS int*)(lds + 131072 + 2048); __syncthreads(); for (int i = tid; i < MAXT; i += NTHR) tl[i] = TILE[i]; __syncthreads();
        pg8::Gemm g{(const bf16*)(ws + WS_H1Q), (const bf16*)(ws + WS_W1), CAP, NE * 4096, D / 2};
        pg8::MoeOrder<true> S{tl, (const int*)(ws + RT_TOK), ntiles, 16, G, bx};
        pg8::EpiSwiglu E{ws + WS_ACT, args.in[26], {}, {}};
        pg8::gemm_phase<pg8::EpiSwiglu, pg8::MoeOrder<true>, true, true>(lds, g, S, E);
    }
    }
#endif
    SEAM(9);
    if constexpr (IN(10)) {
        const int* TILE = (const int*)(ws + RT_TILE); const int ntiles = __builtin_amdgcn_readfirstlane(TILE[MAXT]);
        LAS int* tl = (LAS int*)(lds + 131072 + 2048); __syncthreads(); for (int i = tid; i < MAXT; i += NTHR) tl[i] = TILE[i]; __syncthreads();
        pg8::Gemm g{(const bf16*)(ws + WS_ACT), (const bf16*)(ws + WS_W2), CAP, NE * D, D / 2};
        pg8::MoeOrder<true> S{tl, nullptr, ntiles, 8, G, bx};
        pg8::EpiGate E{ws + WS_Y, args.in[28], (const float*)(ws + RT_GATE), {}, {}};
        pg8::gemm_phase<pg8::EpiGate, pg8::MoeOrder<true>, true, true>(lds, g, S, E);
    }
#if defined(REP_PHASE)
    if constexpr (REP_PHASE == 10) { __syncthreads();
    if constexpr (IN(10)) {
        const int* TILE = (const int*)(ws + RT_TILE); const int ntiles = __builtin_amdgcn_readfirstlane(TILE[MAXT]);
        LAS int* tl = (LAS int*)(lds + 131072 + 2048); __syncthreads(); for (int i = tid; i < MAXT; i += NTHR) tl[i] = TILE[i]; __syncthreads();
        pg8::Gemm g{(const bf16*)(ws + WS_ACT), (const bf16*)(ws + WS_W2), CAP, NE * D, D / 2};
        pg8::MoeOrder<true> S{tl, nullptr, ntiles, 8, G, bx};
        pg8::EpiGate E{ws + WS_Y, args.in[28], (const float*)(ws + RT_GATE), {}, {}};
        pg8::gemm_phase<pg8::EpiGate, pg8::MoeOrder<true>, true, true>(lds, g, S, E);
    }
    }
#endif
    SEAM(10);
    if constexpr (IN(11)) { p9_final(args, vcu, G, wave, lane); }
#if defined(REP_PHASE)
    if constexpr (REP_PHASE == 11) { __syncthreads();
    if constexpr (IN(11)) { p9_final(args, vcu, G, wave, lane); }
    }
#endif
#undef IN
#undef SEAM
}

template <int P> static void launch_phase(int grid, hipStream_t stream, const Args& a) {
    static bool init = false;
    if (!init) { (void)hipFuncSetAttribute((const void*)fwd_kernel<P, P + 1>, hipFuncAttributeMaxDynamicSharedMemorySize, LDS_BYTES); init = true; }
    hipLaunchKernelGGL((fwd_kernel<P, P + 1>), dim3(grid), dim3(NTHR), LDS_BYTES, stream, a);
}
extern "C" void kernel_launch(void* const* d_in, const int* in_sizes, int n_in, void* d_out, int out_size, void* d_ws, size_t ws_size, hipStream_t stream) {
    static int grid = 0;
    if (grid == 0) {
        if (n_in != 31 || out_size != NTOK * D || ws_size < WS_END) { fprintf(stderr, "kernel_launch: unexpected shapes (n_in %d out %d ws %zu, need %zu)\n", n_in, out_size, ws_size, (size_t)WS_END); grid = -1; return; }
        int dev = 0, cus = 0;
        if (hipGetDevice(&dev) != hipSuccess || hipDeviceGetAttribute(&cus, hipDeviceAttributeMultiprocessorCount, dev) != hipSuccess) { grid = -1; return; }
        grid = cus;
    }
    if (grid < 0) return;
    (void)hipMemsetAsync((char*)d_ws + WS_CTL, 0, CTL_ZERO_BYTES, stream);
    Args a{};
    for (int i = 0; i < 31; ++i) a.in[i] = (const float*)d_in[i];
    a.out = (float*)d_out; a.ws = (unsigned char*)d_ws;
#ifdef ONE_LAUNCH
    { static bool init = false; if (!init) { (void)hipFuncSetAttribute((const void*)fwd_kernel<0, NPH>, hipFuncAttributeMaxDynamicSharedMemorySize, LDS_BYTES); init = true; }
      hipLaunchKernelGGL((fwd_kernel<0, NPH>), dim3(grid), dim3(NTHR), LDS_BYTES, stream, a); }
#else
    launch_phase<0>(grid, stream, a); launch_phase<1>(grid, stream, a); launch_phase<2>(grid, stream, a); launch_phase<3>(grid, stream, a);
    launch_phase<4>(grid, stream, a); launch_phase<5>(grid, stream, a); launch_phase<6>(grid, stream, a); launch_phase<7>(grid, stream, a);
    launch_phase<8>(grid, stream, a); launch_phase<9>(grid, stream, a); launch_phase<10>(grid, stream, a); launch_phase<11>(grid, stream, a);
#endif
}
```

```cpp
#define ONE_LAUNCH 1
#include <hip/hip_runtime.h>
#include <cstdio>
#include <cstdint>

namespace pg8 {
#define PG8_LAS __attribute__((address_space(3)))
typedef unsigned short bf16_t;
typedef short bf16x8 __attribute__((ext_vector_type(8)));
typedef float f32x4 __attribute__((ext_vector_type(4)));
typedef unsigned u32x4 __attribute__((ext_vector_type(4)));
typedef unsigned u32x2 __attribute__((ext_vector_type(2)));
typedef int v4i32 __attribute__((ext_vector_type(4)));
typedef int v8i32 __attribute__((ext_vector_type(8)));
constexpr int SCALE_W = 0x79797979, SCALE_A = 0x7f7f7f7f;
constexpr int BM = 256, BK = 64, HALF = 128, HTB = HALF * BK * 2  , STAGE_BYTES = 8 * HTB, NXCD = 8, WGM = 8;

__host__ __device__ __forceinline__ int lds_byte(int r, int c) { const int st = (r >> 4) * 2 + (c >> 5), rr = r & 15, cc = c & 31, ob = rr * 64 + cc * 2; return st * 1024 + (ob ^ (((ob >> 9) & 1) << 5)); }
__host__ __device__ __forceinline__ void stage_rc(int b, int& R, int& C) { const int st = b / 1024, sb = b % 1024, swz = sb ^ (((sb >> 9) & 1) << 5); R = (st >> 1) * 16 + swz / 64; C = (st & 1) * 32 + (swz % 64) / 2; }
__host__ __device__ __forceinline__ int perm32(int rho) { const int n = rho >> 4, i = rho & 15; return 8 * (i >> 2) + 4 * n + (i & 3); }

struct Unit { int pm, pn; };
struct Gemm { const bf16_t* A; const bf16_t* Bt; int M, N, K; };

struct StaticOrder {
    int nM, nN, nwg, G, c;
    __host__ __device__ void init(int M, int N, int G_, int c_) { nM = M / BM; nN = N / BM; nwg = nM * nN; G = G_; c = c_; }
    __host__ __device__ bool next(int i, Unit& u) const {
        const long L = (long)i * G + c; if (L >= nwg) return false;
        int wgid = (int)L; { const int q = nwg / NXCD, r = nwg % NXCD, xcd = wgid % NXCD, off = wgid / NXCD; wgid = (xcd < r ? xcd * (q + 1) : r * (q + 1) + (xcd - r) * q) + off; }
        const int nig = WGM * nN, gid = wgid / nig, fm = gid * WGM, gsz = (nM - fm) < WGM ? (nM - fm) : WGM;
        u.pm = fm + ((wgid % nig) % gsz); u.pn = (wgid % nig) / gsz; return true;
    }
    static constexpr bool GATHER = false;
    __device__ __forceinline__ int arow(const Unit& u, int r) const { return u.pm * BM + r; }
};
struct QueueOrder {
    int nM, nN, nwg, x; unsigned* qhead; volatile PG8_LAS int* slot; mutable int pend;
    __device__ void init(int M, int N, int x_, unsigned* q_, volatile PG8_LAS int* s_, int pend_) { nM = M / BM; nN = N / BM; nwg = nM * nN; x = x_; qhead = q_; slot = s_; pend = pend_; }
    __device__ __forceinline__ int pop() const { return 8 * (int)__hip_atomic_fetch_add(qhead + 64 * x, 1u, __ATOMIC_RELAXED, __HIP_MEMORY_SCOPE_AGENT) + x; }
    __device__ __forceinline__ bool next(int i, Unit& u) const {
        const int L = __builtin_amdgcn_readfirstlane(slot[i % 3]);
        if (threadIdx.x == 0) { slot[(i + 2) % 3] = pend; pend = pop(); }
        if (L >= nwg) return false;
        int wgid = L; { const int q = nwg / NXCD, r = nwg % NXCD, xcd = wgid % NXCD, off = wgid / NXCD; wgid = (xcd < r ? xcd * (q + 1) : r * (q + 1) + (xcd - r) * q) + off; }
        const int nig = WGM * nN, gid = wgid / nig, fm = gid * WGM, gsz = (nM - fm) < WGM ? (nM - fm) : WGM;
        u.pm = fm + ((wgid % nig) % gsz); u.pn = (wgid % nig) / gsz; return true;
    }
    static constexpr bool GATHER = false;
    __device__ __forceinline__ int arow(const Unit& u, int r) const { return u.pm * BM + r; }
};
template <bool GATHER_> struct MoeOrder {
    static constexpr bool GATHER = GATHER_;
    const PG8_LAS int* tile_e; const int* tok; int ntiles, ncol, G, c;
    __device__ __forceinline__ bool next(int i, Unit& u) const {
        int rt, ct;
        if ((G & 7) == 0 && ((G >> 3) % ncol) == 0) {
            const int R = G / ncol, x = c & 7, j = c >> 3;
            rt = i * R + x * (R >> 3) + j / ncol; ct = j % ncol; if (rt >= ntiles) return false;
        } else { const long L = (long)i * G + c; if (L >= (long)ntiles * ncol) return false; rt = (int)(L / ncol); ct = (int)(L % ncol); }
        u.pm = rt; u.pn = __builtin_amdgcn_readfirstlane(tile_e[rt]) * ncol + ct; return true;
    }
    __device__ __forceinline__ int arow(const Unit& u, int r) const { return (GATHER_ && tok) ? tok[u.pm * BM + r] : u.pm * BM + r; }
};

typedef float f32x2_t __attribute__((ext_vector_type(2))); typedef __bf16 bf16x2_t __attribute__((ext_vector_type(2)));
__device__ __forceinline__ unsigned cvt_pk_bf16(float lo, float hi) { const f32x2_t v = {lo, hi}; const bf16x2_t b = __builtin_convertvector(v, bf16x2_t); return __builtin_bit_cast(unsigned, b); }
__device__ __forceinline__ float bf_lo(unsigned w) { return __builtin_bit_cast(float, w << 16); }
__device__ __forceinline__ float bf_hi(unsigned w) { return __builtin_bit_cast(float, w & 0xffff0000u); }

__device__ __forceinline__ unsigned pk4_fp8(float a, float b, float c, float d) { unsigned w = 0u; w = __builtin_amdgcn_cvt_pk_fp8_f32(a, b, w, false); w = __builtin_amdgcn_cvt_pk_fp8_f32(c, d, w, true); return w; }
template <class T> __device__ __forceinline__ T* sbase(T* p) { asm volatile("" : "+s"(p)); return p; }
__device__ __forceinline__ unsigned vopaque(unsigned v) { asm volatile("" : "+v"(v)); return v; }
struct EpiBf16 {
    static constexpr bool PERM = true;
    bf16_t* O; int ldc;
    __device__ __forceinline__ void pre(const Unit&, int, int, int, int) const {}
    __device__ __forceinline__ void operator()(const f32x4 (&acc)[2][2][4][2], const Unit& u, int wr, int wc, int fr, int fq) const {
        const unsigned lo = vopaque(((unsigned)(wr * 64 + fr) * (unsigned)ldc + (unsigned)(wc * 32 + 8 * fq)) * 2u);
#pragma unroll
        for (int ai = 0; ai < 2; ++ai)
#pragma unroll
            for (int m = 0; m < 4; ++m) { char* rb = (char*)sbase(O + (size_t)(u.pm * BM + ai * HALF + m * 16) * ldc + u.pn * BM);
#pragma unroll
                for (int bj = 0; bj < 2; ++bj) { const f32x4 v0 = acc[ai][bj][m][0], v1 = acc[ai][bj][m][1];
                    u32x4 w; w.x = cvt_pk_bf16(v0[0], v0[1]); w.y = cvt_pk_bf16(v0[2], v0[3]); w.z = cvt_pk_bf16(v1[0], v1[1]); w.w = cvt_pk_bf16(v1[2], v1[3]);
                    *(u32x4*)(rb + bj * HALF * 2 + lo) = w; } }
    }
};
struct EpiResBf16 {
    static constexpr bool PERM = true;
    bf16_t* C; const bf16_t* R; int ldc; float alpha;
    __device__ __forceinline__ void pre(const Unit&, int, int, int, int) const {}
    __device__ __forceinline__ void operator()(const f32x4 (&acc)[2][2][4][2], const Unit& u, int wr, int wc, int fr, int fq) const {
        const unsigned lo = vopaque(((unsigned)(wr * 64 + fr) * (unsigned)ldc + (unsigned)(wc * 32 + 8 * fq)) * 2u);
#pragma unroll
        for (int ai = 0; ai < 2; ++ai)
#pragma unroll
            for (int m = 0; m < 4; ++m) { const size_t ro = (size_t)(u.pm * BM + ai * HALF + m * 16) * ldc + u.pn * BM; char* cb = (char*)sbase(C + ro); const char* rb = (const char*)sbase(R + ro);
#pragma unroll
                for (int bj = 0; bj < 2; ++bj) { const u32x4 rr = *(const u32x4*)(rb + bj * HALF * 2 + lo); const f32x4 v0 = acc[ai][bj][m][0], v1 = acc[ai][bj][m][1];
                    u32x4 w; w.x = cvt_pk_bf16(v0[0] + alpha * bf_lo(rr.x), v0[1] + alpha * bf_hi(rr.x)); w.y = cvt_pk_bf16(v0[2] + alpha * bf_lo(rr.y), v0[3] + alpha * bf_hi(rr.y));
                    w.z = cvt_pk_bf16(v1[0] + alpha * bf_lo(rr.z), v1[1] + alpha * bf_hi(rr.z)); w.w = cvt_pk_bf16(v1[2] + alpha * bf_lo(rr.w), v1[3] + alpha * bf_hi(rr.w));
                    *(u32x4*)(cb + bj * HALF * 2 + lo) = w; }
                if (m & 1) asm volatile("" ::: "memory"); }
    }
};
struct EpiSwiglu {
    static constexpr bool PERM = true;
    unsigned char* O; const float* b1;
    mutable f32x4 vg[2], vl[2];
    __device__ __forceinline__ void pre(const Unit& u, int wr, int wc, int fr, int fq) const {
        const int e = u.pn >> 4, ct = u.pn & 15; const unsigned lc = vopaque((unsigned)(wc * 32 + 8 * fq));
        const char* bg = (const char*)sbase(b1 + (size_t)e * 4096 + ct * 128); const char* bl = (const char*)sbase(b1 + (size_t)e * 4096 + 2048 + ct * 128);
#pragma unroll
        for (int n = 0; n < 2; ++n) { vg[n] = *(const f32x4*)(bg + n * 16 + lc * 4u); vl[n] = *(const f32x4*)(bl + n * 16 + lc * 4u); }
    }
    __device__ __forceinline__ void operator()(const f32x4 (&acc)[2][2][4][2], const Unit& u, int wr, int wc, int fr, int fq) const {
        const int ct = u.pn & 15;
        const unsigned lc = vopaque((unsigned)(wc * 32 + 8 * fq)), lo = vopaque((unsigned)(wr * 64 + fr) * 2048u) + lc;
#pragma unroll
        for (int ai = 0; ai < 2; ++ai)
#pragma unroll
            for (int m = 0; m < 4; ++m) { unsigned char* rb = sbase(O + (size_t)(u.pm * BM + ai * HALF + m * 16) * 2048 + ct * 128);
                float a[8];
#pragma unroll
                for (int n = 0; n < 2; ++n)
#pragma unroll
                    for (int i = 0; i < 4; ++i) { float g = acc[ai][0][m][n][i] + vg[n][i], l = acc[ai][1][m][n][i] + vl[n][i];
                        g = fminf(g, 7.0f); l = fminf(fmaxf(l, -7.0f), 7.0f);
                        const float sg = __builtin_amdgcn_rcpf(1.0f + __builtin_amdgcn_exp2f(-1.702f * 1.4426950408889634f * g));
                        a[n * 4 + i] = (l + 1.0f) * g * sg; }
                u32x2 w; w.x = pk4_fp8(a[0], a[1], a[2], a[3]); w.y = pk4_fp8(a[4], a[5], a[6], a[7]);
                *(u32x2*)(rb + lo) = w; }
    }
};
struct EpiGate {
    static constexpr bool PERM = true;
    unsigned char* O; const float* b2; const float* gate;
    mutable float gtv[8]; mutable f32x4 cb[2][2];
    __device__ __forceinline__ void pre(const Unit& u, int wr, int wc, int fr, int fq) const {
        const int e = u.pn >> 3, ct = u.pn & 7; const unsigned lr = vopaque((unsigned)(wr * 64 + fr)), lc = vopaque((unsigned)(wc * 32 + 8 * fq));
        const char* bb = (const char*)sbase(b2 + (size_t)e * 2048 + ct * 256);
#pragma unroll
        for (int bj = 0; bj < 2; ++bj) { cb[bj][0] = *(const f32x4*)(bb + bj * HALF * 4 + lc * 4u); cb[bj][1] = *(const f32x4*)(bb + bj * HALF * 4 + 16 + lc * 4u); }
#pragma unroll
        for (int q = 0; q < 8; ++q) gtv[q] = *(const float*)((const char*)sbase(gate + u.pm * BM + (q >> 2) * HALF + (q & 3) * 16) + lr * 4u);
    }
    __device__ __forceinline__ void operator()(const f32x4 (&acc)[2][2][4][2], const Unit& u, int wr, int wc, int fr, int fq) const {
        const int ct = u.pn & 7;
        const unsigned lr = vopaque((unsigned)(wr * 64 + fr)), lc = vopaque((unsigned)(wc * 32 + 8 * fq)), lo = lr * 2048u + lc;
#pragma unroll
        for (int ai = 0; ai < 2; ++ai)
#pragma unroll
            for (int m = 0; m < 4; ++m) { const int rg = u.pm * BM + ai * HALF + m * 16; const float gt = 64.0f * gtv[ai * 4 + m];
                unsigned char* rb = sbase(O + (size_t)rg * 2048 + ct * 256);
#pragma unroll
                for (int bj = 0; bj < 2; ++bj) { const f32x4 c0 = cb[bj][0], c1 = cb[bj][1];
                    const f32x4 v0 = (acc[ai][bj][m][0] + c0) * gt, v1 = (acc[ai][bj][m][1] + c1) * gt;
                    u32x2 w; w.x = pk4_fp8(v0[0], v0[1], v0[2], v0[3]); w.y = pk4_fp8(v1[0], v1[1], v1[2], v1[3]);
                    *(u32x2*)(rb + bj * HALF + lo) = w; } }
    }
};

template <class Epi, class Sched, bool ALIGN_EPI = true, bool FP8 = false>
__device__ __forceinline__ void gemm_phase(PG8_LAS unsigned char* lds, const Gemm g, const Sched& S, const Epi& E) {
    int tid = threadIdx.x; asm volatile("" : "+v"(tid));
    const int wid = __builtin_amdgcn_readfirstlane(tid >> 6), lane = tid & 63, wr = wid >> 2, wc = wid & 3, fr = lane & 15, fq = lane >> 4;
    const int K = g.K, nt = K / BK;
    int RA[2]; unsigned cA2[2], voffB[2];
#pragma unroll
    for (int i = 0; i < 2; ++i) { int R, C; stage_rc(tid * 16 + i * 8192, R, C); const int Rb = Epi::PERM ? ((R & ~31) + perm32(R & 31)) : R;
        RA[i] = R; cA2[i] = (unsigned)C * 2u; voffB[i] = (unsigned)(Rb * K + C) * 2u; }
    const size_t kstep = (size_t)(BK * 2);
    const size_t hstep = (size_t)HALF * K * 2;
    const size_t tstep = 2 * hstep;
    const unsigned ldsw = (unsigned)wid * 1024u;
    const int aoff = lds_byte(wr * 64 + fr, fq * 8), boff = lds_byte(wc * 32 + fr, fq * 8);
#define PG8_SA(b, h) (((b) * 2 + (h)) * HTB)
#define PG8_SB(b, h) ((4 + (b) * 2 + (h)) * HTB)
#define PG8_STAGE(bufoff, gbase, voff) do { const char* _gb = (const char*)(gbase); asm volatile("" : "+s"(_gb)); _Pragma("unroll") for (int _i = 0; _i < 2; ++_i) { \
        unsigned _vo = (voff)[_i]; asm volatile("" : "+v"(_vo));     \
        __builtin_amdgcn_global_load_lds((const unsigned*)(_gb + _vo), (PG8_LAS unsigned*)(lds + (bufoff) + ldsw + _i * 8192), 16, 0, 0); } } while (0)
#define PG8_LD32(p) __builtin_shufflevector(*(const PG8_LAS v4i32*)(p), *(const PG8_LAS v4i32*)((p) + 1024), 0, 1, 2, 3, 4, 5, 6, 7)
#define PG8_LDA(dst, b, h) do { _Pragma("unroll") for (int m = 0; m < 4; ++m) dst[m] = PG8_LD32(lds + PG8_SA(b, h) + aoff + m * 2048); } while (0)
#define PG8_LDB(dst, b, h) do { _Pragma("unroll") for (int n = 0; n < 2; ++n) dst[n] = PG8_LD32(lds + PG8_SB(b, h) + boff + n * 2048); } while (0)
#define PG8_H0(x) __builtin_bit_cast(bf16x8, __builtin_shufflevector(x, x, 0, 1, 2, 3))
#define PG8_H1(x) __builtin_bit_cast(bf16x8, __builtin_shufflevector(x, x, 4, 5, 6, 7))
#define PG8_MMA(ai, bj, At, Bt) do { __builtin_amdgcn_s_setprio(1); _Pragma("unroll") for (int m = 0; m < 4; ++m) _Pragma("unroll") for (int n = 0; n < 2; ++n) { \
        if constexpr (FP8) acc[ai][bj][m][n] = __builtin_amdgcn_mfma_scale_f32_16x16x128_f8f6f4(Bt[n], At[m], acc[ai][bj][m][n], 0, 0, 0, SCALE_W, 0, SCALE_A); \
        else { acc[ai][bj][m][n] = __builtin_amdgcn_mfma_f32_16x16x32_bf16(PG8_H0(Bt[n]), PG8_H0(At[m]), acc[ai][bj][m][n], 0, 0, 0); \
               acc[ai][bj][m][n] = __builtin_amdgcn_mfma_f32_16x16x32_bf16(PG8_H1(Bt[n]), PG8_H1(At[m]), acc[ai][bj][m][n], 0, 0, 0); } } \
        __builtin_amdgcn_s_setprio(0); } while (0)
#define PG8_WAIT_V(n) asm volatile("s_waitcnt vmcnt(" #n ")" ::: "memory")
#define PG8_WAIT_L(n) asm volatile("s_waitcnt lgkmcnt(" #n ")" ::: "memory")
#define PG8_BAR __builtin_amdgcn_s_barrier()
#define PG8_SCHED __builtin_amdgcn_sched_barrier(0)
#define PG8_AOFF(dst, u) do { _Pragma("unroll") for (int _h = 0; _h < 2; ++_h) _Pragma("unroll") for (int _i = 0; _i < 2; ++_i) \
        dst[_h][_i] = (unsigned)S.arow(u, _h * HALF + RA[_i]) * (unsigned)(K * 2) + cA2[_i]; } while (0)
    Unit cur, nxt; int ui = 0;
    if (!S.next(0, cur)) return;
    constexpr bool GA = Sched::GATHER;
    unsigned offC[2][2], offN[2][2];
    const char* gA = (const char*)g.A; const char* nA = gA;
    int rawN[2][2]; Unit nn; bool has_nn = false;
#define PG8_ARAW(dst, u) do { _Pragma("unroll") for (int _h = 0; _h < 2; ++_h) _Pragma("unroll") for (int _i = 0; _i < 2; ++_i) dst[_h][_i] = S.arow(u, _h * HALF + RA[_i]); } while (0)
    if constexpr (GA) { PG8_AOFF(offC, cur); has_nn = S.next(1, nn); if (has_nn) PG8_ARAW(rawN, nn); asm volatile("s_waitcnt vmcnt(0)" ::: "memory"); }
    else {
#pragma unroll
        for (int i = 0; i < 2; ++i) { offC[0][i] = (unsigned)RA[i] * (unsigned)(K * 2) + cA2[i]; offC[1][i] = offC[0][i] + (unsigned)hstep; }
        gA += (size_t)cur.pm * tstep; }
    E.pre(cur, wr, wc, fr, fq);
    f32x4 acc[2][2][4][2];
#pragma unroll
    for (int a = 0; a < 2; ++a)
#pragma unroll
        for (int b = 0; b < 2; ++b)
#pragma unroll
            for (int m = 0; m < 4; ++m)
#pragma unroll
                for (int n = 0; n < 2; ++n) acc[a][b][m][n] = (f32x4){0.f, 0.f, 0.f, 0.f};
    v8i32 At[4], B0[2], B1[2];
    const char* cB = (const char*)g.Bt + (size_t)cur.pn * tstep;
    PG8_STAGE(PG8_SB(0, 0), cB, voffB); PG8_STAGE(PG8_SB(0, 1), cB + hstep, voffB); PG8_STAGE(PG8_SA(0, 0), gA, offC[0]); PG8_STAGE(PG8_SA(0, 1), gA, offC[1]);
    if (wr == 1) PG8_BAR;
    PG8_WAIT_V(2); PG8_BAR;
    PG8_STAGE(PG8_SB(1, 0), cB + kstep, voffB); PG8_STAGE(PG8_SA(1, 0), gA + kstep, offC[0]); PG8_STAGE(PG8_SB(1, 1), cB + hstep + kstep, voffB);
    PG8_WAIT_V(6); PG8_BAR;
    for (;;) {
        bool has_next;
        if constexpr (GA) {
            has_next = has_nn; nxt = nn;
#pragma unroll
            for (int h = 0; h < 2; ++h)
#pragma unroll
                for (int i = 0; i < 2; ++i) offN[h][i] = has_next ? (unsigned)rawN[h][i] * (unsigned)(K * 2) + cA2[i] : offC[h][i];
            has_nn = S.next(ui + 2, nn); if (has_nn) PG8_ARAW(rawN, nn);
        } else { has_next = S.next(ui + 1, nxt); nA = has_next ? (const char*)g.A + (size_t)nxt.pm * tstep : gA; }
        const char* nB = has_next ? (const char*)g.Bt + (size_t)nxt.pn * tstep : cB;
        for (int t = 0; t < nt; t += 2) {
            const bool last = (t == nt - 2);
            const char* a1 = gA + (size_t)(t + 1) * kstep;
            const char* a2 = last ? nA : gA + (size_t)(t + 2) * kstep; const char* b2 = last ? nB : cB + (size_t)(t + 2) * kstep;
            const char* a3 = a2 + kstep; const char* b3 = b2 + kstep;
            PG8_LDB(B0, 0, 0); PG8_LDB(B1, 0, 1); PG8_SCHED; PG8_LDA(At, 0, 0); PG8_STAGE(PG8_SA(1, 1), a1, offC[1]);
            if constexpr (GA) { if (last) {
#pragma unroll
                for (int h = 0; h < 2; ++h)
#pragma unroll
                    for (int i = 0; i < 2; ++i) offC[h][i] = offN[h][i]; } }
            PG8_WAIT_V(8); PG8_WAIT_L(0); PG8_BAR; PG8_MMA(0, 0, At, B0); PG8_MMA(0, 1, At, B1); PG8_BAR; PG8_SCHED;
            PG8_LDA(At, 0, 1); PG8_STAGE(PG8_SB(0, 0), b2, voffB); PG8_STAGE(PG8_SB(0, 1), b2 + hstep, voffB); PG8_STAGE(PG8_SA(0, 0), a2, offC[0]);
            PG8_WAIT_V(8); PG8_WAIT_L(0); PG8_BAR; PG8_MMA(1, 0, At, B0); PG8_MMA(1, 1, At, B1); PG8_BAR; PG8_SCHED;
            PG8_LDB(B0, 1, 0); PG8_LDB(B1, 1, 1); PG8_SCHED; PG8_LDA(At, 1, 0); PG8_STAGE(PG8_SA(0, 1), a2, offC[1]);
            PG8_WAIT_V(8); PG8_WAIT_L(0); PG8_BAR; PG8_MMA(0, 0, At, B0); PG8_MMA(0, 1, At, B1); PG8_BAR; PG8_SCHED;
            PG8_LDA(At, 1, 1); PG8_STAGE(PG8_SB(1, 0), b3, voffB); PG8_STAGE(PG8_SB(1, 1), b3 + hstep, voffB); PG8_STAGE(PG8_SA(1, 0), a3, offC[0]);
            PG8_WAIT_V(8); PG8_WAIT_L(0); PG8_BAR; PG8_MMA(1, 0, At, B0); PG8_MMA(1, 1, At, B1); PG8_BAR; PG8_SCHED;
        }
        if constexpr (ALIGN_EPI) { if (wr == 0) PG8_BAR; }
        E(acc, cur, wr, wc, fr, fq);
        if (!has_next) break;
#pragma unroll
        for (int a = 0; a < 2; ++a)
#pragma unroll
            for (int b = 0; b < 2; ++b)
#pragma unroll
                for (int m = 0; m < 4; ++m)
#pragma unroll
                    for (int n = 0; n < 2; ++n) acc[a][b][m][n] = (f32x4){0.f, 0.f, 0.f, 0.f};
        cur = nxt; cB = nB; ++ui; if constexpr (!GA) gA = nA;
        E.pre(cur, wr, wc, fr, fq);
        if constexpr (ALIGN_EPI) { if (wr == 1) PG8_BAR; }
    }
    PG8_WAIT_V(0);
    if constexpr (!ALIGN_EPI) { if (wr == 0) PG8_BAR; }
    PG8_BAR;
#undef PG8_SA
#undef PG8_SB
#undef PG8_STAGE
#undef PG8_LDA
#undef PG8_LDB
#undef PG8_LD32
#undef PG8_H0
#undef PG8_H1
#undef PG8_MMA
#undef PG8_WAIT_V
#undef PG8_WAIT_L
#undef PG8_BAR
#undef PG8_SCHED
#undef PG8_AOFF
#undef PG8_ARAW
}
}
#define GAS __attribute__((address_space(1)))
#define LAS __attribute__((address_space(3)))
typedef unsigned short bf16;
typedef unsigned v4u __attribute__((ext_vector_type(4)));
typedef float f32x4 __attribute__((ext_vector_type(4)));
typedef short bf16x8 __attribute__((ext_vector_type(8)));
typedef GAS unsigned gu32;
typedef GAS unsigned long long gu64;
#define RLX_AGENT __ATOMIC_RELAXED, __HIP_MEMORY_SCOPE_AGENT
#define LDS_WAIT() asm volatile("s_waitcnt lgkmcnt(0)" ::: "memory")
#define VM_WAIT() asm volatile("s_waitcnt vmcnt(0)" ::: "memory")
__device__ __forceinline__ unsigned long long rt() { return __builtin_amdgcn_s_memrealtime(); }
__device__ __forceinline__ unsigned pk2(float lo, float hi) { return pg8::cvt_pk_bf16(lo, hi); }
__device__ __forceinline__ unsigned f2bf(float f) { return pg8::cvt_pk_bf16(f, 0.f) & 0xffffu; }

#define XB_TMO      128
#define XB_XCNT(j)  (256  + 64 * (j))
#define XB_XSUB(j)  (1280 + 64 * (j))
#define XB_XGEN(j)  (2304 + 64 * (j))
#define XB_TOP      3328
#define XB_TOPGEN   3392
#define XCD_BAR_WORDS 3456
#define XB_SPIN_CAP (1u << 18)

__device__ __forceinline__ unsigned xb_ld(unsigned* p)              { return __hip_atomic_load(p, __ATOMIC_RELAXED, __HIP_MEMORY_SCOPE_AGENT); }
__device__ __forceinline__ unsigned xb_add(unsigned* p, unsigned v) { return __hip_atomic_fetch_add(p, v, __ATOMIC_RELAXED, __HIP_MEMORY_SCOPE_AGENT); }
__device__ __forceinline__ unsigned xb_xcc_id() { return (unsigned)__builtin_amdgcn_s_getreg((3 << 11) | 20) & 0xFu; }
#define XB_SPIN(cond, bar) do { unsigned _sp = 0; while (cond) { __builtin_amdgcn_s_sleep(1); \
    if ((++_sp & 255u) == 0u) { if (xb_ld(&(bar)[XB_TMO])) break; if (_sp > XB_SPIN_CAP) { atomicAdd(&(bar)[XB_TMO], 1u); break; } } } } while (0)

struct XcdBarrier {
    unsigned* bar; unsigned x;
    volatile LAS unsigned* st;
};

__device__ __forceinline__ XcdBarrier xcd_barrier_post(unsigned* bar, volatile LAS unsigned* st) {
    XcdBarrier b; b.bar = bar; b.x = xb_xcc_id(); b.st = st;
    if (threadIdx.x == 0) (void)xb_add(&bar[XB_XCNT(b.x)], 1u);
    return b;
}
__device__ __forceinline__ void xcd_barrier_complete(unsigned* bar, unsigned x, unsigned& nloc, unsigned& nx) {
    const unsigned G = gridDim.x * gridDim.y * gridDim.z;
    unsigned sum, cnt, mine, sp = 0u;
    for (;;) {
        sum = 0u; cnt = 0u; mine = 0u;
#pragma unroll
        for (unsigned j = 0; j < 16; ++j) { const unsigned c = xb_ld(&bar[XB_XCNT(j)]); sum += c; cnt += (c > 0u) ? 1u : 0u; mine = (j == x) ? c : mine; }
        if (sum == G) break;
        __builtin_amdgcn_s_sleep(1);
        if ((++sp & 255u) == 0u) { if (xb_ld(&bar[XB_TMO])) break; if (sp > XB_SPIN_CAP) { atomicAdd(&bar[XB_TMO], 1u); break; } }
    }
    nloc = mine > 0u ? mine : 1u; nx = cnt > 0u ? cnt : 1u;
}

__device__ __forceinline__ void xcd_barrier(const XcdBarrier& b) {
    asm volatile("s_waitcnt vmcnt(0)" ::: "memory");
    __syncthreads();
    if (threadIdx.x == 0) {
        unsigned* bar = b.bar;
        __builtin_amdgcn_s_waitcnt(0);
        unsigned nloc = b.st[0], nx = b.st[1];
        if (nloc == 0u) { xcd_barrier_complete(bar, b.x, nloc, nx); b.st[0] = nloc; b.st[1] = nx; }
        const unsigned old = xb_add(&bar[XB_XSUB(b.x)], 1u);
        const unsigned gen = old / nloc;
        if (old + 1u == (gen + 1u) * nloc) {
            __builtin_amdgcn_fence(__ATOMIC_RELEASE, "agent");
            asm volatile("s_waitcnt vmcnt(0)" ::: "memory");
            const unsigned og = xb_add(&bar[XB_TOP], 1u);
            const unsigned tg = og / nx;
            if (og + 1u == (tg + 1u) * nx) xb_add(&bar[XB_TOPGEN], 1u);
            else XB_SPIN(xb_ld(&bar[XB_TOPGEN]) == tg, bar);
            __builtin_amdgcn_fence(__ATOMIC_ACQUIRE, "agent");
            xb_add(&bar[XB_XGEN(b.x)], 1u);
            asm volatile("s_waitcnt vmcnt(0)" ::: "memory");
        } else {
            XB_SPIN(xb_ld(&bar[XB_XGEN(b.x)]) == gen, bar);
            __builtin_amdgcn_fence(__ATOMIC_ACQUIRE, "agent");
            asm volatile("s_waitcnt vmcnt(0)" ::: "memory");
        }
    }
    __syncthreads();
}


constexpr int NB = 2, T = 16384, NTOK = NB * T, D = 2048;
constexpr int PW = 5632;
constexpr int C_R = 0, C_K = 1024, C_V = 2048, C_DW = 3072, C_DA = 3168, C_DG = 3264, C_FQ = 3520, C_FK = 4032, C_FV = 4544, C_FF = 5056, C_MQ = 5064, IN_W = 5576;
constexpr int NE = 32, CAP = 131072 + 8192, MAXT = CAP / 256;
constexpr int MEM_LEN = 256;
constexpr float LN_EPS = 1e-5f, GN_EPS = 64e-5f, ALPHA = 1.189207115002721f, LOG2E = 1.4426950408889634f;
constexpr int NWAVES = 8, NTHR = 512;

constexpr size_t MiB = 1u << 20;
constexpr size_t WS_CTL = 0, CTL_ZERO_BYTES = 1 * MiB;
constexpr size_t WS_WI = 2 * MiB, WS_WO = 24 * MiB, WS_WKV = 32 * MiB, WS_RWT = 36 * MiB, WS_MEMN = 37 * MiB, WS_KVM = 39 * MiB, WS_C = 40 * MiB  ;
constexpr size_t WS_ROUTE = 42 * MiB;
constexpr size_t RT_TOPI = WS_ROUTE, RT_TOPG = RT_TOPI + 512 * 1024, RT_POS = RT_TOPG + 512 * 1024, RT_CNT = RT_POS + 512 * 1024, RT_TOK = RT_CNT + 64 * 1024, RT_GATE = RT_TOK + 1024 * 1024, RT_TILE = RT_GATE + 1024 * 1024;
constexpr size_t WS_W1 = 48 * MiB, WS_W2 = 560 * MiB, WS_H0 = 816 * MiB, WS_H1 = 944 * MiB, WS_MIX = 1072 * MiB, WS_Z1 = 1200 * MiB, WS_P = 1456 * MiB;
constexpr size_t WS_RW = 1808 * MiB, RW_ARR = 128 * MiB;
constexpr size_t WS_ACT = 2960 * MiB, WS_Y = 3504 * MiB, WS_END = 4048 * MiB;
constexpr size_t WS_WLT = 46 * MiB;
constexpr size_t WS_H1Q = 304 * MiB;
constexpr size_t WS_FOXB = 47 * MiB;
constexpr float FOX_SKIP = 30.0f;
constexpr int CW_BAR = 4096;
constexpr int CW_KMAX = 2048;
constexpr int CW_QUEUE = 2112;
constexpr int CW_XQ = 2176;
constexpr int CW_A0Q = 2240;
constexpr int NG_INPROJ = 192;

constexpr int LDS_BYTES = 147456, MISC_OFF = LDS_BYTES - 256;

struct Args { const float* in[31]; float* out; unsigned char* ws; int ph_lo, ph_hi; };

__device__ __forceinline__ float wave_sum(float v) {
#pragma unroll
    for (int o = 1; o < 64; o <<= 1) v += __shfl_xor(v, o);
    return v;
}
__device__ __forceinline__ float bfl(unsigned w) { return __builtin_bit_cast(float, w << 16); }
__device__ __forceinline__ float bfh(unsigned w) { return __builtin_bit_cast(float, w & 0xffff0000u); }
__device__ __forceinline__ float bf1(bf16 h) { return __builtin_bit_cast(float, (unsigned)h << 16); }
__device__ __forceinline__ float sigmoidf_(float x) { return 1.0f / (1.0f + __expf(-x)); }

__device__ __forceinline__ void ln_row(f32x4 (&v)[8], const float* g, const float* b, float eps, int lane) {
    float s = 0.f;
#pragma unroll
    for (int j = 0; j < 8; ++j) s += (v[j].x + v[j].y) + (v[j].z + v[j].w);
    const float mean = wave_sum(s) * (1.f / D); float s2 = 0.f;
#pragma unroll
    for (int j = 0; j < 8; ++j) { v[j] = v[j] - mean; s2 += (v[j].x * v[j].x + v[j].y * v[j].y) + (v[j].z * v[j].z + v[j].w * v[j].w); }
    const float rstd = 1.f / sqrtf(wave_sum(s2) * (1.f / D) + eps);
#pragma unroll
    for (int j = 0; j < 8; ++j) { const f32x4 gg = *(const f32x4*)(g + 4 * lane + 256 * j), bb = *(const f32x4*)(b + 4 * lane + 256 * j); v[j] = v[j] * rstd * gg + bb; }
}
__device__ __forceinline__ void store_row_bf16(bf16* orow, const f32x4 (&v)[8], int lane) {
#pragma unroll
    for (int j = 0; j < 8; ++j) { pg8::u32x2 w; w.x = pk2(v[j].x, v[j].y); w.y = pk2(v[j].z, v[j].w); *(pg8::u32x2*)(orow + 4 * lane + 256 * j) = w; }
}

template <class RowMap>
__device__ __forceinline__ void transpose_item(const float* W, int ldw, int nvalid, int K, bf16* WT, const RowMap& rm, LAS float* scr, int k0, int n0, int lane) {
#pragma unroll 4
    for (int it = 0; it < 16; ++it) { const int k = 4 * it + (lane >> 4), nl = 4 * (lane & 15), n = n0 + nl;
        f32x4 v = (f32x4){0.f, 0.f, 0.f, 0.f}; if (n < nvalid) v = *(const f32x4*)(W + (size_t)(k0 + k) * ldw + n);
        LAS float* s = scr + k * 65 + nl; s[0] = v.x; s[1] = v.y; s[2] = v.z; s[3] = v.w; }
    LDS_WAIT(); asm volatile("" ::: "memory");
    const int c = lane & 7;
#pragma unroll
    for (int j = 0; j < 8; ++j) { const int nl = 8 * j + (lane >> 3); const LAS float* s = scr + (8 * c) * 65 + nl;
        v4u o; o.x = pk2(s[0 * 65], s[1 * 65]); o.y = pk2(s[2 * 65], s[3 * 65]); o.z = pk2(s[4 * 65], s[5 * 65]); o.w = pk2(s[6 * 65], s[7 * 65]);
        *(v4u*)(WT + (size_t)rm(n0 + nl) * K + k0 + 8 * c) = o; }
    LDS_WAIT(); asm volatile("" ::: "memory");
}
template <class RowMap>
__device__ __forceinline__ void transpose_item_fp8(const float* W, int ldw, int K, unsigned char* WT, const RowMap& rm, LAS float* scr, int k0, int n0, int lane) {
#pragma unroll 4
    for (int it = 0; it < 16; ++it) { const int k = 4 * it + (lane >> 4), nl = 4 * (lane & 15);
        const f32x4 v = *(const f32x4*)(W + (size_t)(k0 + k) * ldw + n0 + nl);
        LAS float* s = scr + k * 65 + nl; s[0] = v.x; s[1] = v.y; s[2] = v.z; s[3] = v.w; }
    LDS_WAIT(); asm volatile("" ::: "memory");
    const int c = lane & 3;
#pragma unroll
    for (int j = 0; j < 4; ++j) { const int nl = 16 * j + (lane >> 2); const LAS float* s = scr + (16 * c) * 65 + nl;
        v4u o; o.x = pg8::pk4_fp8(64.f * s[0 * 65], 64.f * s[1 * 65], 64.f * s[2 * 65], 64.f * s[3 * 65]); o.y = pg8::pk4_fp8(64.f * s[4 * 65], 64.f * s[5 * 65], 64.f * s[6 * 65], 64.f * s[7 * 65]);
        o.z = pg8::pk4_fp8(64.f * s[8 * 65], 64.f * s[9 * 65], 64.f * s[10 * 65], 64.f * s[11 * 65]); o.w = pg8::pk4_fp8(64.f * s[12 * 65], 64.f * s[13 * 65], 64.f * s[14 * 65], 64.f * s[15 * 65]);
        *(v4u*)(WT + (size_t)rm(n0 + nl) * K + k0 + 16 * c) = o; }
    LDS_WAIT(); asm volatile("" ::: "memory");
}
struct XItem { const float* W; unsigned char* WT; int ldw, k0, n0, rowoff, isw1; };
__device__ __forceinline__ XItem xitem(const Args& A, unsigned char* ws, int r) {
    XItem x; constexpr int I1 = 32 * 32 * 64;
    if (r < I1) { const int e = r >> 11, q = r & 2047; x.W = A.in[25] + (size_t)e * D * 4096; x.WT = ws + WS_W1; x.ldw = 4096; x.k0 = 64 * (q >> 6); x.n0 = 64 * (q & 63); x.rowoff = e * 4096; x.isw1 = 1; }
    else { const int r2 = r - I1, e = r2 >> 10, q = r2 & 1023; x.W = A.in[27] + (size_t)e * D * D; x.WT = ws + WS_W2; x.ldw = D; x.k0 = 64 * (q >> 5); x.n0 = 64 * (q & 31); x.rowoff = e * D; x.isw1 = 0; }
    return x;
}
__device__ __forceinline__ void xload(f32x4 (&v)[16], const XItem& x, int lane) {
#pragma unroll
    for (int it = 0; it < 16; ++it) v[it] = *(const f32x4*)(x.W + (size_t)(x.k0 + 4 * it + (lane >> 4)) * x.ldw + x.n0 + 4 * (lane & 15));
}
__device__ __forceinline__ void xstore(const f32x4 (&v)[16], const XItem& x, LAS float* scr, int lane) {
#pragma unroll
    for (int it = 0; it < 16; ++it) { LAS float* s = scr + (4 * it + (lane >> 4)) * 65 + 4 * (lane & 15); s[0] = v[it].x; s[1] = v[it].y; s[2] = v[it].z; s[3] = v[it].w; }
    LDS_WAIT(); asm volatile("" ::: "memory");
    const int c = lane & 3;
#pragma unroll
    for (int j = 0; j < 4; ++j) { const int nl = 16 * j + (lane >> 2), n = x.n0 + nl; const LAS float* s = scr + (16 * c) * 65 + nl;
        int row; if (x.isw1) { const int l = n >= 2048, cc = n - 2048 * l; row = (cc >> 7) * 256 + 128 * l + (cc & 127); } else row = n;
        v4u o; o.x = pg8::pk4_fp8(64.f * s[0 * 65], 64.f * s[1 * 65], 64.f * s[2 * 65], 64.f * s[3 * 65]); o.y = pg8::pk4_fp8(64.f * s[4 * 65], 64.f * s[5 * 65], 64.f * s[6 * 65], 64.f * s[7 * 65]);
        o.z = pg8::pk4_fp8(64.f * s[8 * 65], 64.f * s[9 * 65], 64.f * s[10 * 65], 64.f * s[11 * 65]); o.w = pg8::pk4_fp8(64.f * s[12 * 65], 64.f * s[13 * 65], 64.f * s[14 * 65], 64.f * s[15 * 65]);
        *(v4u*)(x.WT + (size_t)(x.rowoff + row) * D + x.k0 + 16 * c) = o; }
    LDS_WAIT(); asm volatile("" ::: "memory");
}
struct RmId { int off; __device__ __forceinline__ int operator()(int n) const { return off + n; } };
struct RmW1 { int off; __device__ __forceinline__ int operator()(int n) const { const int l = n >= 2048, c = n - 2048 * l; return off + (c >> 7) * 256 + 128 * l + (c & 127); } };

constexpr int I_XALL = 32 * 32 * 64 + 32 * 32 * 32;
__device__ __forceinline__ void conv_pull_loop(const Args& A, LAS unsigned char* lds, int tid, int wave, int lane) {
    unsigned char* ws = A.ws; unsigned* ctl = (unsigned*)(ws + WS_CTL); LAS float* scr = (LAS float*)(lds + wave * 16640); LAS int* qs = (LAS int*)(lds + 8 * 16640);
    for (;;) {
        __syncthreads();
        if (tid == 0) qs[0] = (int)__hip_atomic_fetch_add(ctl + CW_XQ, 16u, __ATOMIC_RELAXED, __HIP_MEMORY_SCOPE_AGENT);
        __syncthreads();
        const int base = qs[0]; if (base >= I_XALL) break;
        f32x4 va[16], vb[16]; const int i0 = base + wave, i1 = base + 8 + wave;
        const XItem xa = xitem(A, ws, min(i0, I_XALL - 1)), xb = xitem(A, ws, min(i1, I_XALL - 1));
        xload(va, xa, lane); xload(vb, xb, lane);
        if (i0 < I_XALL) xstore(va, xa, scr, lane);
        if (i1 < I_XALL) xstore(vb, xb, scr, lane);
    }
}
__device__ __forceinline__ void p0_prologue(const Args& A, LAS unsigned char* lds, int vcu, int G, int wave, int lane) {
    unsigned char* ws = A.ws;
    LAS float* scr = (LAS float*)(lds + wave * 16640);
    const int gw = vcu * NWAVES + wave, NGW = G * NWAVES;
    constexpr int I_WI = 32 * 88, I_WO = 32 * 32, I_WKV = 32 * 16;
    constexpr int NITEMS = I_WI + I_WO + I_WKV;
    for (int it = gw; it < NITEMS; it += NGW) {
        int r = it;
        if (r < I_WI) { transpose_item(A.in[4], IN_W, IN_W, D, (bf16*)(ws + WS_WI), RmId{0}, scr, 64 * (r / 88), 64 * (r % 88), lane); continue; } r -= I_WI;
        if (r < I_WO) { transpose_item_fp8(A.in[20], D, D, ws + WS_WO, RmId{0}, scr, 64 * (r / 32), 64 * (r % 32), lane); continue; } r -= I_WO;
        transpose_item(A.in[19], 1024, 1024, D, (bf16*)(ws + WS_WKV), RmId{0}, scr, 64 * (r / 16), 64 * (r % 16), lane);
    }
    { bf16* wlt = (bf16*)(ws + WS_WLT);
      for (int i = gw * 64 + lane; i < 1024 * 448; i += NGW * 64) { const int ch = i / 448, k = i % 448;
          const float v = k < 96 ? A.in[7][k * 1024 + ch] : (k < 192 ? A.in[9][(k - 96) * 1024 + ch] : A.in[10][(k - 192) * 1024 + ch]); wlt[i] = (bf16)f2bf(v); } }
    { bf16* rwf = (bf16*)(ws + WS_RWT); const float* rw = A.in[23];
      for (int i = gw * 64 + lane; i < 64 * 2 * 2 * 64 * 8; i += NGW * 64) { const int e = i & 7, ln = (i >> 3) & 63, hl = (i >> 9) & 1, nt = (i >> 10) & 1, sidx = i >> 11;
          const float w = rw[(32 * sidx + 8 * (ln >> 4) + e) * NE + 16 * nt + (ln & 15)]; const unsigned hb = f2bf(w); const float hf = __builtin_bit_cast(float, hb << 16);
          rwf[i] = (bf16)(hl ? f2bf(w - hf) : hb); } }
    for (int m = gw; m < NTOK + NB * MEM_LEN; m += NGW) {
        const bool ismem = m >= NTOK; const int r = ismem ? m - NTOK : m;
        const float* xr = (ismem ? A.in[1] : A.in[0]) + (size_t)r * D;
        f32x4 v[8];
#pragma unroll
        for (int j = 0; j < 8; ++j) v[j] = *(const f32x4*)(xr + 4 * lane + 256 * j);
        ln_row(v, ismem ? A.in[17] : A.in[2], ismem ? A.in[18] : A.in[3], LN_EPS, lane);
        store_row_bf16((bf16*)(ws + (ismem ? WS_MEMN : WS_H0)) + (size_t)r * D, v, lane);
    }
}

__device__ __forceinline__ void p2_fox_cumsum(const Args& A, LAS unsigned char* lds, int vcu, int G, int tid) {
    const bf16* P = (const bf16*)(A.ws + WS_P); double* C = (double*)(A.ws + WS_C);
    LAS double* part = (LAS double*)(lds + 32768);
    for (int bh = vcu; bh < 16; bh += G) {
        const int b = bh >> 3, h = bh & 7; const float bf = A.in[16][h];
        float lf[32]; double s = 0.0;
#pragma unroll
        for (int i = 0; i < 32; ++i) { const float x = bf1(P[(size_t)(b * T + tid * 32 + i) * PW + C_FF + h]) + bf;
            lf[i] = -(fmaxf(-x, 0.f) + log1pf(__expf(-fabsf(x)))); s += (double)lf[i]; }
        __syncthreads();
        part[tid] = s;
        __syncthreads();
        double pre = 0.0;
        for (int j = 0; j < tid; ++j) pre += part[j];
        double* c = C + (size_t)bh * T + tid * 32;
#pragma unroll
        for (int i = 0; i < 32; ++i) { pre += (double)lf[i]; c[i] = pre; }
    }
}
__device__ __forceinline__ void p2_fox_norms(const Args& A, LAS unsigned char* lds, int vcu, int G, int tid, int wave, int lane) {
    const bf16* P = (const bf16*)(A.ws + WS_P); float* FOXB = (float*)(A.ws + WS_FOXB); unsigned* ctl = (unsigned*)(A.ws + WS_CTL);
    LAS float* red = (LAS float*)(lds + 40960);
    for (int u = vcu; u < 1024; u += G) {
        const int bh = u >> 6, qb = u & 63, b = bh >> 3, h = bh & 7; const int tk = tid & 255, isk = tid >> 8;
        const bf16* pr = P + (size_t)(b * T + qb * 256 + tk) * PW + (isk ? C_FK : C_FQ) + h * 64;
        float n2 = 0.f;
#pragma unroll
        for (int v = 0; v < 8; ++v) { const v4u x = *(const v4u*)(pr + v * 8); const unsigned w[4] = {x.x, x.y, x.z, x.w};
#pragma unroll
            for (int e = 0; e < 4; ++e) { const float a0 = bfl(w[e]), a1 = bfh(w[e]); n2 += a0 * a0 + a1 * a1; } }
#pragma unroll
        for (int o = 1; o < 64; o <<= 1) n2 = fmaxf(n2, __shfl_xor(n2, o));
        __syncthreads();
        if (lane == 0) red[wave] = n2;
        __syncthreads();
        if (tid == 0) { FOXB[bh * 80 + qb] = fmaxf(fmaxf(red[0], red[1]), fmaxf(red[2], red[3]));
            __hip_atomic_fetch_max(ctl + CW_KMAX + bh, __float_as_uint(fmaxf(fmaxf(red[4], red[5]), fmaxf(red[6], red[7]))), __ATOMIC_RELAXED, __HIP_MEMORY_SCOPE_AGENT); }
    }
}

__device__ __forceinline__ int crow(int r, int hi) { return (r & 3) + 8 * (r >> 2) + 4 * hi; }
typedef float f32x16 __attribute__((ext_vector_type(16)));
typedef short s16x4 __attribute__((ext_vector_type(4)));
typedef short v4i16_t __attribute__((ext_vector_type(4)));
template <int DH, bool FOX>
__device__ __forceinline__ void attn_unit(const bf16* Qp, int qpitch, const bf16* Kp, const bf16* Vp, int kvpitch, unsigned char* Op, int opitch, int q0, int jlo, int jhi,
                                          const double* cseq, float scale2, LAS unsigned char* lds, int tid, int wave, int lane) {
    constexpr int KROW = (DH + 8) * 2, VROW = DH * 2 + 64, NP = DH / 64;
    LAS unsigned char* KS = lds; LAS unsigned char* VT = lds + 64 * KROW; LAS float* CB = (LAS float*)(VT + 64 * VROW); LAS float* WSF = (LAS float*)(lds + 2 * (64 * KROW + 64 * VROW + 256)) + wave * 32;
    const int r32 = lane & 31, hi = lane >> 5;
    bf16x8 qr[DH / 16];
#pragma unroll
    for (int d0 = 0; d0 < DH / 16; ++d0) qr[d0] = *(const bf16x8*)(Qp + (size_t)(32 * wave + r32) * qpitch + d0 * 16 + hi * 8);
    f32x16 o[DH / 32];
#pragma unroll
    for (int d = 0; d < DH / 32; ++d)
#pragma unroll
        for (int r = 0; r < 16; ++r) o[d][r] = 0.f;
    float m = -1e30f, l = 0.f;
    const int qpos = q0 + 32 * wave + r32;
    double cref = 0.0; if (FOX) cref = cseq[q0];
    v4u kreg[NP], vreg[NP]; float cbv = 0.f;
#define ATT_LOAD(j) do { _Pragma("unroll") for (int p = 0; p < NP; ++p) { const int idx = tid + p * NTHR, row = idx / (DH / 8), ch = idx % (DH / 8); \
        kreg[p] = *(const v4u*)(Kp + (size_t)((j) * 64 + row) * kvpitch + ch * 8); vreg[p] = *(const v4u*)(Vp + (size_t)((j) * 64 + row) * kvpitch + ch * 8); } \
        if (FOX && tid < 64) cbv = (float)(cref - cseq[(j) * 64 + tid]) * LOG2E; } while (0)
    constexpr bool PREF = (DH == 64);
    constexpr int TILEB = 64 * KROW + 64 * VROW + 256;
#define ATT_STORE(bufo) do { _Pragma("unroll") for (int p = 0; p < NP; ++p) { const int idx = tid + p * NTHR, row = idx / (DH / 8), ch = idx % (DH / 8); \
        *(LAS v4u*)(KS + (bufo) + row * KROW + ch * 16) = kreg[p]; *(LAS v4u*)(VT + (bufo) + row * VROW + ch * 16) = vreg[p]; } \
        if (FOX && tid < 64) *(LAS float*)((LAS unsigned char*)CB + (bufo) + tid * 4) = cbv; } while (0)
    if (PREF) { ATT_LOAD(jlo); __syncthreads(); ATT_STORE(0); __syncthreads(); }
    for (int j = jlo; j < jhi; ++j) {
        const int bo = PREF ? ((j - jlo) & 1) * TILEB : 0;
        if (PREF) { if (j + 1 < jhi) ATT_LOAD(j + 1); }
        else { __syncthreads();
#pragma unroll
            for (int p = 0; p < NP; ++p) { const int idx = tid + p * NTHR, row = idx / (DH / 8), ch = idx % (DH / 8);
                kreg[0] = *(const v4u*)(Kp + (size_t)(j * 64 + row) * kvpitch + ch * 8); vreg[0] = *(const v4u*)(Vp + (size_t)(j * 64 + row) * kvpitch + ch * 8);
                *(LAS v4u*)(KS + row * KROW + ch * 16) = kreg[0]; *(LAS v4u*)(VT + row * VROW + ch * 16) = vreg[0]; }
            __syncthreads(); }
        f32x16 p[2];
#pragma unroll
        for (int kh = 0; kh < 2; ++kh) {
#pragma unroll
            for (int r = 0; r < 16; ++r) p[kh][r] = 0.f;
#pragma unroll
            for (int d0 = 0; d0 < DH / 16; ++d0) { const bf16x8 a = *(const LAS bf16x8*)(KS + bo + (32 * kh + r32) * KROW + (16 * d0 + 8 * hi) * 2);
                p[kh] = __builtin_amdgcn_mfma_f32_32x32x16_bf16(a, qr[d0], p[kh], 0, 0, 0); }
        }
        const bool diag = FOX && (j * 64 + 63 > q0);
        float mx = -1e30f;
        if (diag) {
#pragma unroll
            for (int kh = 0; kh < 2; ++kh)
#pragma unroll
                for (int g = 0; g < 4; ++g) { const f32x4 cb = *(const LAS f32x4*)((const LAS unsigned char*)CB + bo + (32 * kh + 8 * g + 4 * hi) * 4);
#pragma unroll
                    for (int i = 0; i < 4; ++i) { const int r = 4 * g + i; float v = p[kh][r] * scale2 + cb[i];
                        if (j * 64 + 32 * kh + 8 * g + 4 * hi + i > qpos) v = -1e30f;
                        p[kh][r] = v; mx = fmaxf(mx, v); } }
        } else {
#pragma unroll
            for (int kh = 0; kh < 2; ++kh)
#pragma unroll
                for (int g = 0; g < 4; ++g) { f32x4 cb = (f32x4){0.f, 0.f, 0.f, 0.f}; if (FOX) cb = *(const LAS f32x4*)((const LAS unsigned char*)CB + bo + (32 * kh + 8 * g + 4 * hi) * 4);
#pragma unroll
                    for (int i = 0; i < 4; ++i) { const int r = 4 * g + i; const float v = p[kh][r] * scale2 + cb[i]; p[kh][r] = v; mx = fmaxf(mx, v); } }
        }
        mx = fmaxf(mx, __shfl_xor(mx, 32));
        const float mn = fmaxf(m, mx), corr = __builtin_amdgcn_exp2f(m - mn); m = mn;
        float ls = 0.f;
#pragma unroll
        for (int kh = 0; kh < 2; ++kh)
#pragma unroll
            for (int r = 0; r < 16; ++r) { const float e = __builtin_amdgcn_exp2f(p[kh][r] - mn); p[kh][r] = e; ls += e; }
        l = l * corr + ls;
        if (__any(corr != 1.0f)) {
            if (hi == 0) WSF[r32] = corr;
#pragma unroll
            for (int g = 0; g < 4; ++g) { const f32x4 c4 = *(const LAS f32x4*)(WSF + 8 * g + 4 * hi);
#pragma unroll
                for (int d = 0; d < DH / 32; ++d) { o[d][4 * g] *= c4.x; o[d][4 * g + 1] *= c4.y; o[d][4 * g + 2] *= c4.z; o[d][4 * g + 3] *= c4.w; } }
        }
        bf16x8 pa[4];
#pragma unroll
        for (int s = 0; s < 4; ++s) { const int kh = s >> 1, b8 = 8 * (s & 1); v4u w;
            w.x = pg8::cvt_pk_bf16(p[kh][b8 + 0], p[kh][b8 + 1]); w.y = pg8::cvt_pk_bf16(p[kh][b8 + 2], p[kh][b8 + 3]);
            w.z = pg8::cvt_pk_bf16(p[kh][b8 + 4], p[kh][b8 + 5]); w.w = pg8::cvt_pk_bf16(p[kh][b8 + 6], p[kh][b8 + 7]);
            pa[s] = __builtin_bit_cast(bf16x8, w); }
#pragma unroll
        for (int d = 0; d < DH / 32; ++d)
#pragma unroll
            for (int s = 0; s < 4; ++s) { const LAS unsigned char* vp = VT + bo + (16 * s + 4 * hi + ((lane & 15) >> 2)) * VROW + (32 * d + 16 * ((lane >> 4) & 1) + 4 * (lane & 3)) * 2;
                const s16x4 lo = __builtin_bit_cast(s16x4, __builtin_amdgcn_ds_read_tr16_b64_v4i16((LAS v4i16_t*)vp)), hh = __builtin_bit_cast(s16x4, __builtin_amdgcn_ds_read_tr16_b64_v4i16((LAS v4i16_t*)(vp + 8 * VROW)));
                const bf16x8 vf = (bf16x8){lo[0], lo[1], lo[2], lo[3], hh[0], hh[1], hh[2], hh[3]};
                o[d] = __builtin_amdgcn_mfma_f32_32x32x16_bf16(pa[s], vf, o[d], 0, 0, 0); }
        if (PREF) { if (j + 1 < jhi) ATT_STORE(TILEB - bo); __syncthreads(); }
    }
#undef ATT_LOAD
#undef ATT_STORE
    l += __shfl_xor(l, 32);
    if (hi == 0) WSF[r32] = 1.0f / l;
    float rli[16];
#pragma unroll
    for (int g = 0; g < 4; ++g) { const f32x4 c4 = *(const LAS f32x4*)(WSF + 8 * g + 4 * hi); rli[4 * g] = c4.x; rli[4 * g + 1] = c4.y; rli[4 * g + 2] = c4.z; rli[4 * g + 3] = c4.w; }
#pragma unroll
    for (int r = 0; r < 16; ++r) { unsigned char* orow = Op + (size_t)(32 * wave + crow(r, hi)) * opitch + r32;
#pragma unroll
        for (int d = 0; d < DH / 32; ++d) { const float x = o[d][r] * rli[r]; orow[32 * d] = (unsigned char)__builtin_amdgcn_cvt_pk_fp8_f32(x, x, 0, false); } }
    __syncthreads();
}

__device__ __forceinline__ void p3_attention(const Args& A, LAS unsigned char* lds, int tid, int wave, int lane) {
    unsigned char* ws = A.ws; const bf16* P = (const bf16*)(ws + WS_P); unsigned char* MIX = ws + WS_MIX; const bf16* KVM = (const bf16*)(ws + WS_KVM); const double* C = (const double*)(ws + WS_C);
    unsigned* ctl = (unsigned*)(ws + WS_CTL); LAS int* sj = (LAS int*)(lds + 65536);
    for (;;) {
        __syncthreads();
        if (tid == 0) sj[1] = (int)__hip_atomic_fetch_add(ctl + CW_QUEUE, 1u, __ATOMIC_RELAXED, __HIP_MEMORY_SCOPE_AGENT);
        __syncthreads();
        const int u = sj[1];
        if (u >= 1536) break;
        if (u < 1024) {
#ifndef NO_FOX
            const int bh = u & 15, qb = 63 - (u >> 4), b = bh >> 3, h = bh & 7, q0 = qb * 256; const double* cs = C + (size_t)bh * T; const float* fb = (const float*)(ws + WS_FOXB) + bh * 80; const size_t rowb = (size_t)b * T;
            if (tid == 0) sj[0] = q0 / 64;
            __syncthreads();
            if (tid < q0 / 64) { const float bound = 0.25f * sqrtf(fb[qb] * __uint_as_float(ctl[CW_KMAX + bh])) + FOX_SKIP; if ((float)(cs[q0] - cs[tid * 64 + 63]) + bound >= 0.f) __hip_atomic_fetch_min(sj, tid, __ATOMIC_RELAXED, __HIP_MEMORY_SCOPE_WORKGROUP); }
            __syncthreads();
            const int jlo = sj[0];
            attn_unit<64, true>(P + (rowb + q0) * PW + C_FQ + h * 64, PW, P + rowb * PW + C_FK + h * 64, P + rowb * PW + C_FV + h * 64, PW,
                                MIX + (rowb + q0) * D + 1024 + h * 64, D, q0, jlo, q0 / 64 + 4, cs, 0.125f * LOG2E, lds, tid, wave, lane);
#endif
        } else {
#ifndef NO_MEMATT
            const int v = u - 1024, b = v >> 8, h = (v >> 6) & 3, qb = v & 63, q0 = qb * 256; const size_t rowb = (size_t)b * T;
            attn_unit<128, false>(P + (rowb + q0) * PW + C_MQ + h * 128, PW, KVM + (size_t)b * MEM_LEN * 1024 + h * 128, KVM + (size_t)b * MEM_LEN * 1024 + 512 + h * 128, 1024,
                                  MIX + (rowb + q0) * D + 1536 + h * 128, D, q0, 0, 4, nullptr, 0.08838834764831845f * LOG2E, lds, tid, wave, lane);
#endif
        }
    }
}

constexpr size_t AIN_BYTES = 73728, REC_BYTES = 62464;
constexpr size_t WS_AIN = WS_RW, WS_REC = WS_AIN + 576 * MiB, WS_YRAW = WS_REC + 488 * MiB, WS_G1 = 368 * MiB, WS_G2 = 432 * MiB;
static_assert(WS_YRAW + 64 * MiB <= WS_ACT && 8192 * REC_BYTES <= 488 * MiB && 8192 * AIN_BYTES <= 576 * MiB && WS_G2 + 64 * MiB <= WS_W2, "rwkv workspace");
constexpr int AIN_LD = 0, AIN_R = 16384, AIN_K2 = 24576, AIN_V = 32768, AIN_AV = 40960, AIN_BV = 49152, AIN_G1 = 57344, AIN_G2 = 65536;
constexpr int A0_IN = 29184, A0_INW = 13200, A0_ROWB = 400;
constexpr int REC_W = 0, REC_RT = 9216, REC_ARB = 18432, REC_BGT = 27648, REC_U0 = 36864, REC_Y0 = 45056, REC_M0 = 53248, REC_GC = 61440;
typedef float f32x4_t __attribute__((ext_vector_type(4)));

__device__ __forceinline__ float softplusf_(float x) { return fmaxf(x, 0.f) + log1pf(__expf(-fabsf(x))); }
__device__ __forceinline__ float xsum16_32(float v) { v += __shfl_xor(v, 16); v += __shfl_xor(v, 32); return v; }

__device__ __forceinline__ float fsigmoid(float x) { return __builtin_amdgcn_rcpf(1.0f + __builtin_amdgcn_exp2f(-LOG2E * x)); }
__device__ __forceinline__ float fsoftplus(float x) { return fmaxf(x, 0.f) + 0.6931471805599453f * __builtin_amdgcn_logf(1.0f + __builtin_amdgcn_exp2f(-LOG2E * fabsf(x))); }
struct A0Par { f32x4 mur, muk, muv, a0, kkw, kaw, rkw, w0, gng, gnb; };
template <bool FULL> __device__ __forceinline__ void a0_loadpar(A0Par& p, const Args& A, const float* mu, int col) {
    p.mur = *(const f32x4*)(mu + C_R + col); p.muk = *(const f32x4*)(mu + C_K + col); p.muv = *(const f32x4*)(mu + C_V + col);
    p.a0 = *(const f32x4*)(A.in[8] + col); p.kkw = *(const f32x4*)(A.in[11] + col); p.kaw = *(const f32x4*)(A.in[12] + col); p.rkw = *(const f32x4*)(A.in[13] + col);
    if constexpr (FULL) { p.w0 = *(const f32x4*)(A.in[6] + col); p.gng = *(const f32x4*)(A.in[14] + col); p.gnb = *(const f32x4*)(A.in[15] + col); }
}
template <bool FULL>
__device__ __forceinline__ void a0_mfma(f32x4 (&acc)[2][3], const bf16x8* wf, LAS unsigned char* lds, int c16, int g) {
    constexpr int KS0 = FULL ? 0 : 3, KS1 = FULL ? 14 : 6;
#pragma unroll
    for (int tt = 0; tt < 2; ++tt)
#pragma unroll
        for (int o = 0; o < 3; ++o) acc[tt][o] = (f32x4){0.f, 0.f, 0.f, 0.f};
#pragma unroll
    for (int ks = KS0; ks < KS1; ++ks) { const int o = ks < 3 ? 0 : (ks < 6 ? 1 : 2);
#pragma unroll
        for (int tt = 0; tt < 2; ++tt) { const bf16x8 b = *(const LAS bf16x8*)(lds + (16 * tt + c16) * 912 + (32 * ks + 8 * g) * 2);
            acc[tt][o] = __builtin_amdgcn_mfma_f32_16x16x32_bf16(wf[ks - KS0], b, acc[tt][o], 0, 0, 0); } }
}
template <bool FULL>
__device__ __forceinline__ void a0_ct(const f32x4 (&acc)[2][3], const A0Par& p, const LAS unsigned char* inw, unsigned char* blk,
                                      int tl0, int ct, int c16, int g, float (&ssk)[2], float (&ssb)[2]) {
#pragma unroll
    for (int tt = 0; tt < 2; ++tt) {
        const LAS unsigned char* pc = inw + (1 + 16 * tt + c16) * A0_ROWB + (16 * ct + 4 * g) * 2;
        const pg8::u32x2 r0 = *(const LAS pg8::u32x2*)pc, k0 = *(const LAS pg8::u32x2*)(pc + 128), v0 = *(const LAS pg8::u32x2*)(pc + 256);
        const pg8::u32x2 r1 = *(const LAS pg8::u32x2*)(pc - A0_ROWB), k1 = *(const LAS pg8::u32x2*)(pc - A0_ROWB + 128), v1 = *(const LAS pg8::u32x2*)(pc - A0_ROWB + 256);
        float rr[4], kk[4], vv[4];
        { const float ra[4] = {bfl(r0.x), bfh(r0.x), bfl(r0.y), bfh(r0.y)}, rb[4] = {bfl(r1.x), bfh(r1.x), bfl(r1.y), bfh(r1.y)};
          const float ka[4] = {bfl(k0.x), bfh(k0.x), bfl(k0.y), bfh(k0.y)}, kb[4] = {bfl(k1.x), bfh(k1.x), bfl(k1.y), bfh(k1.y)};
          const float va[4] = {bfl(v0.x), bfh(v0.x), bfl(v0.y), bfh(v0.y)}, vb[4] = {bfl(v1.x), bfh(v1.x), bfl(v1.y), bfh(v1.y)};
#pragma unroll
          for (int r = 0; r < 4; ++r) { rr[r] = ra[r] + p.mur[r] * (rb[r] - ra[r]); kk[r] = ka[r] + p.muk[r] * (kb[r] - ka[r]); vv[r] = va[r] + p.muv[r] * (vb[r] - va[r]); } }
        float aa[4], k2[4], kc[4];
#pragma unroll
        for (int r = 0; r < 4; ++r) { aa[r] = fsigmoid(p.a0[r] + acc[tt][1][r]); kc[r] = kk[r] * p.kkw[r]; k2[r] = kk[r] * (1.0f + (aa[r] - 1.0f) * p.kaw[r]); }
        if constexpr (!FULL) {
#pragma unroll
            for (int r = 0; r < 4; ++r) { ssk[tt] += kc[r] * kc[r]; ssb[tt] += rr[r] * k2[r] * p.rkw[r]; }
        } else {
            const int e0 = (ct * 64 + tl0 + 16 * tt + c16) * 16 + 4 * g;
            f32x4 ld; float av[4], bv[4], g1[4], g2[4];
#pragma unroll
            for (int r = 0; r < 4; ++r) { const float sp = fsoftplus(-(p.w0[r] + acc[tt][0][r])); ld[r] = -__builtin_amdgcn_exp2f(-LOG2E * (sp + 0.5f));
                const float kn = kc[r] * ssk[tt]; av[r] = -kn; bv[r] = kn * aa[r]; const float gg = acc[tt][2][r]; g1[r] = p.gng[r] * gg; g2[r] = (p.gnb[r] + ssb[tt] * vv[r]) * gg; }
            *(f32x4*)(blk + AIN_LD + e0 * 4) = ld;
            *(pg8::u32x2*)(blk + AIN_R + e0 * 2) = (pg8::u32x2){pk2(rr[0], rr[1]), pk2(rr[2], rr[3])};
            *(pg8::u32x2*)(blk + AIN_K2 + e0 * 2) = (pg8::u32x2){pk2(k2[0], k2[1]), pk2(k2[2], k2[3])};
            *(pg8::u32x2*)(blk + AIN_V + e0 * 2) = (pg8::u32x2){pk2(vv[0], vv[1]), pk2(vv[2], vv[3])};
            *(pg8::u32x2*)(blk + AIN_AV + e0 * 2) = (pg8::u32x2){pk2(av[0], av[1]), pk2(av[2], av[3])};
            *(pg8::u32x2*)(blk + AIN_BV + e0 * 2) = (pg8::u32x2){pk2(bv[0], bv[1]), pk2(bv[2], bv[3])};
            *(pg8::u32x2*)(blk + AIN_G1 + e0 * 2) = (pg8::u32x2){pk2(g1[0], g1[1]), pk2(g1[2], g1[3])};
            *(pg8::u32x2*)(blk + AIN_G2 + e0 * 2) = (pg8::u32x2){pk2(g2[0], g2[1]), pk2(g2[2], g2[3])};
        }
        asm volatile("" ::: "memory");
    }
}
template <int PV = 0>
__device__ __forceinline__ void p2_rwkv_tok(const Args& A, LAS unsigned char* lds, int vcu, int G, int tid, int wave, int lane) {
    unsigned char* ws = A.ws; const bf16* P = (const bf16*)(ws + WS_P); const bf16* WLT = (const bf16*)(ws + WS_WLT); const float* mu = A.in[5];
    unsigned char* AIN = ws + WS_AIN;
    const int c16 = lane & 15, g = lane >> 4;
    for (int tile = vcu; tile < NTOK / 32; tile += G) {
        const int row0 = tile * 32;
        __syncthreads();
        int tidv = tid; asm volatile("" : "+v"(tidv));
        {
#pragma unroll
            for (int bt = 0; bt < 2; ++bt) {
            v4u pt[2], pp[2]; f32x4 m0[2], m1[2];
#pragma unroll
            for (int i = 0; i < 2; ++i) { const int idx = min(tidv + NTHR * (2 * bt + i), 32 * 56 - 1), tk = idx / 56, vec = idx % 56, row = row0 + tk, col = C_DW + vec * 8;
                pt[i] = *(const v4u*)(P + (size_t)row * PW + col); pp[i] = *(const v4u*)(P + (size_t)(row - ((row % T) ? 1 : 0)) * PW + col);
                m0[i] = *(const f32x4*)(mu + col); m1[i] = *(const f32x4*)(mu + col + 4); }
#pragma unroll
            for (int i = 0; i < 2; ++i) { const int idx = tidv + NTHR * (2 * bt + i), idc = min(idx, 32 * 56 - 1), tk = idc / 56, vec = idc % 56, row = row0 + tk; const bool hp = (row % T) != 0;
                float x[8]; const unsigned tw[4] = {pt[i].x, pt[i].y, pt[i].z, pt[i].w}, pw[4] = {pp[i].x, pp[i].y, pp[i].z, pp[i].w}; const float mm[8] = {m0[i].x, m0[i].y, m0[i].z, m0[i].w, m1[i].x, m1[i].y, m1[i].z, m1[i].w};
#pragma unroll
                for (int e = 0; e < 8; ++e) { const float a = (e & 1) ? bfh(tw[e >> 1]) : bfl(tw[e >> 1]); float b = (e & 1) ? bfh(pw[e >> 1]) : bfl(pw[e >> 1]); b = hp ? b : 0.f; const float ps = a + mm[e] * (b - a);
                    x[e] = vec < 12 ? 2.0f * fsigmoid(2.0f * ps) - 1.0f : (vec < 24 ? ps : fsigmoid(ps)); }
                v4u o; o.x = pk2(x[0], x[1]); o.y = pk2(x[2], x[3]); o.z = pk2(x[4], x[5]); o.w = pk2(x[6], x[7]);
                if (idx < 32 * 56) *(LAS v4u*)(lds + tk * 912 + vec * 16) = o; }
            asm volatile("" ::: "memory"); }
        }
        __syncthreads();
#pragma unroll 1
        for (int hh = 0; hh < 2; ++hh) {
            const int h = wave * 2 + hh;
            LAS unsigned char* inw = lds + A0_IN + wave * A0_INW;
            { const bool first = (row0 % T) == 0; int lanev = lane; asm volatile("" : "+v"(lanev));
#pragma unroll
              for (int bt = 0; bt < 2; ++bt) { v4u x[7];
#pragma unroll
                for (int i = 0; i < 7; ++i) { const int idx = lanev + 64 * (7 * bt + i), seg = min(idx >> 3, 98), pc = idx & 7, r = seg / 3, a = seg - 3 * r, grow = row0 - 1 + r + ((first && r == 0) ? 1 : 0);
                    x[i] = *(const v4u*)(P + (size_t)grow * PW + a * 1024 + h * 64 + pc * 8); }
#pragma unroll
                for (int i = 0; i < 7; ++i) { const int idx = lanev + 64 * (7 * bt + i), seg = idx >> 3, pc = idx & 7, r = seg / 3, a = seg - 3 * r;
                    const v4u z = (v4u){0u, 0u, 0u, 0u}; if (seg < 99) *(LAS v4u*)(inw + r * A0_ROWB + a * 128 + pc * 16) = (first && r == 0) ? z : x[i]; }
                asm volatile("" ::: "memory"); } }
            const int tpos0 = row0 % T, b = row0 / T; unsigned char* blk = AIN + (size_t)((b * 16 + h) * 256 + (tpos0 >> 6)) * AIN_BYTES; const int tl0 = tpos0 & 63;
            float ssk[2] = {0.f, 0.f}, ssb[2] = {0.f, 0.f};
            const bf16* wbase = WLT + (size_t)(h * 64 + c16) * 448 + 8 * g; const int colb = h * 64 + 4 * g;
            if constexpr (PV != 2) { bf16x8 w0[3]; A0Par pn;
#pragma unroll
              for (int ks = 0; ks < 3; ++ks) w0[ks] = *(const bf16x8*)(wbase + 32 * (3 + ks));
              a0_loadpar<false>(pn, A, mu, colb);
#pragma unroll 1
              for (int ct = 0; ct < 4; ++ct) { f32x4 acc[2][3]; a0_mfma<false>(acc, w0, lds, c16, g); const A0Par p = pn;
                  if (ct < 3) {
#pragma unroll
                      for (int ks = 0; ks < 3; ++ks) w0[ks] = *(const bf16x8*)(wbase + (size_t)(ct + 1) * 16 * 448 + 32 * (3 + ks));
                      a0_loadpar<false>(pn, A, mu, colb + 16 * (ct + 1)); }
                  asm volatile("" ::: "memory");
                  a0_ct<false>(acc, p, inw, blk, tl0, ct, c16, g, ssk, ssb); asm volatile("" ::: "memory"); } }
#pragma unroll
            for (int tt = 0; tt < 2; ++tt) { ssk[tt] = 1.0f / fmaxf(sqrtf(xsum16_32(ssk[tt])), 1e-12f); ssb[tt] = xsum16_32(ssb[tt]); }
            if constexpr (PV != 0) { if (ssk[0] + ssb[1] == 1234.5f) *(float*)blk = ssk[0]; }
            if constexpr (PV == 0) { bf16x8 w1[14]; A0Par pn;
#pragma unroll
              for (int ks = 0; ks < 14; ++ks) w1[ks] = *(const bf16x8*)(wbase + 32 * ks);
              a0_loadpar<true>(pn, A, mu, colb);
#pragma unroll 1
              for (int ct = 0; ct < 4; ++ct) { f32x4 acc[2][3]; a0_mfma<true>(acc, w1, lds, c16, g); const A0Par p = pn;
                  if (ct < 3) {
#pragma unroll
                      for (int ks = 0; ks < 14; ++ks) w1[ks] = *(const bf16x8*)(wbase + (size_t)(ct + 1) * 16 * 448 + 32 * ks);
                      a0_loadpar<true>(pn, A, mu, colb + 16 * (ct + 1)); }
                  asm volatile("" ::: "memory");
                  a0_ct<true>(acc, p, inw, blk, tl0, ct, c16, g, ssk, ssb);
                  asm volatile("" ::: "memory"); } }
        }
    }
}

constexpr int LA_CL = 0, LA_AS = 16640, LA_BS = 25856, LA_KS = 35072, LA_RS = 44288, LA_KGT = 53504, LA_BGT = 62720, LA_VT = 71936, LA_NS = 81152, LA_XU = 98560, LA_WS = 115968, LA_TOT = 125184, LA_SCR = 126208, LA_TS = 134400;
__device__ __forceinline__ f32x16 gtile32(LAS unsigned char* lds, int offA, int si, int offB, int ti, int r32, int hi) {
    f32x16 c;
#pragma unroll
    for (int r = 0; r < 16; ++r) c[r] = 0.f;
#pragma unroll
    for (int ks = 0; ks < 4; ++ks) { const bf16x8 a = *(const LAS bf16x8*)(lds + offA + (32 * si + r32) * 144 + (16 * ks + 8 * hi) * 2), b = *(const LAS bf16x8*)(lds + offB + (32 * ti + r32) * 144 + (16 * ks + 8 * hi) * 2);
        c = __builtin_amdgcn_mfma_f32_32x32x16_bf16(a, b, c, 0, 0, 0); }
    return c;
}
template <bool INCL> __device__ __forceinline__ void mask_lower(f32x16& c, int r32, int hi) {
#pragma unroll
    for (int r = 0; r < 16; ++r) { const int s = crow(r, hi); if (INCL ? (s > r32) : (s >= r32)) c[r] = 0.f; }
}
__device__ __forceinline__ float xcomb(float v) {
    { auto r = __builtin_amdgcn_permlane16_swap(__float_as_uint(v), __float_as_uint(v), false, false); v = __uint_as_float(r[0]) + __uint_as_float(r[1]); }
    { auto r = __builtin_amdgcn_permlane32_swap(__float_as_uint(v), __float_as_uint(v), false, false); v = __uint_as_float(r[0]) + __uint_as_float(r[1]); }
    return v;
}
__device__ __forceinline__ void gv_acc(f32x16& o, const f32x16& G, LAS unsigned char* lds, int si, int ib, int r32, int hi) {
#pragma unroll
    for (int sp = 0; sp < 2; ++sp) { v4u w; const int b8 = 8 * sp;
        w.x = pg8::cvt_pk_bf16(G[b8 + 0], G[b8 + 1]); w.y = pg8::cvt_pk_bf16(G[b8 + 2], G[b8 + 3]); w.z = pg8::cvt_pk_bf16(G[b8 + 4], G[b8 + 5]); w.w = pg8::cvt_pk_bf16(G[b8 + 6], G[b8 + 7]);
        const LAS unsigned char* vp = lds + LA_VT + (32 * ib + r32) * 144 + (32 * si + 16 * sp + 4 * hi) * 2;
        const s16x4 lo = *(const LAS s16x4*)vp, hh = *(const LAS s16x4*)(vp + 16);
        o = __builtin_amdgcn_mfma_f32_32x32x16_bf16(__builtin_bit_cast(bf16x8, w), (bf16x8){lo[0], lo[1], lo[2], lo[3], hh[0], hh[1], hh[2], hh[3]}, o, 0, 0, 0); }
}
__device__ __forceinline__ void p3_rwkv_chunk(const Args& A, LAS unsigned char* lds, int vcu, int G, int tid, int wave, int lane) {
    unsigned char* ws = A.ws;
    const int r32 = lane & 31, hi = lane >> 5, c16 = lane & 15, g = lane >> 4;
    LAS float* CL = (LAS float*)(lds + LA_CL); LAS float* TOT = (LAS float*)(lds + LA_TOT);
    const int t = tid >> 3, j0 = (tid & 7) * 8;
    const int e0 = ((j0 >> 4) * 64 + t) * 16 + (j0 & 15);
    f32x4 l0, l1; v4u vr, vk, vv, va, vb;
#define PA_LOAD_LD(ucx) do { const unsigned char* blk_ = ws + WS_AIN + (size_t)(ucx) * AIN_BYTES; l0 = *(const f32x4*)(blk_ + AIN_LD + e0 * 4); l1 = *(const f32x4*)(blk_ + AIN_LD + (e0 + 4) * 4); } while (0)
#define PA_LOAD(ucx) do { const unsigned char* blk_ = ws + WS_AIN + (size_t)(ucx) * AIN_BYTES; \
        vr = *(const v4u*)(blk_ + AIN_R + e0 * 2); vk = *(const v4u*)(blk_ + AIN_K2 + e0 * 2); vv = *(const v4u*)(blk_ + AIN_V + e0 * 2); \
        va = *(const v4u*)(blk_ + AIN_AV + e0 * 2); vb = *(const v4u*)(blk_ + AIN_BV + e0 * 2); } while (0)
    PA_LOAD_LD(min(vcu, 8191));
    for (int uc = vcu; uc < 8192; uc += G) {
        unsigned char* rec = ws + WS_REC + (size_t)uc * REC_BYTES;
        __syncthreads();
        PA_LOAD(uc);
        { LAS float* c = CL + t * 65 + j0; c[0] = l0.x; c[1] = l0.y; c[2] = l0.z; c[3] = l0.w; c[4] = l1.x; c[5] = l1.y; c[6] = l1.z; c[7] = l1.w; }
        __syncthreads();
        float xs[16];
        if (tid < 256) { const int j = tid & 63, q = tid >> 6; float run = 0.f;
#pragma unroll
            for (int e = 0; e < 16; ++e) { run += CL[(16 * q + e) * 65 + j]; xs[e] = run; }
            TOT[q * 64 + j] = run; }
        __syncthreads();
        if (tid < 256) { const int j = tid & 63, q = tid >> 6; float off = 0.f; for (int qq = 0; qq < q; ++qq) off += TOT[qq * 64 + j];
#pragma unroll
            for (int e = 0; e < 16; ++e) CL[(16 * q + e) * 65 + j] = off + xs[e]; }
        __syncthreads();
        {   const unsigned wr[4] = {vr.x, vr.y, vr.z, vr.w}, wk[4] = {vk.x, vk.y, vk.z, vk.w}, wv[4] = {vv.x, vv.y, vv.z, vv.w}, wa[4] = {va.x, va.y, va.z, va.w}, wb[4] = {vb.x, vb.y, vb.z, vb.w};
            float at[8], bt[8], kt[8], rt_[8], kg[8], bg[8], gc[8];
#pragma unroll
            for (int e = 0; e < 8; ++e) { const float ct = CL[t * 65 + j0 + e], cp = t ? CL[(t - 1) * 65 + j0 + e] : 0.f, cL = CL[63 * 65 + j0 + e];
                const float r_ = (e & 1) ? bfh(wr[e >> 1]) : bfl(wr[e >> 1]), k_ = (e & 1) ? bfh(wk[e >> 1]) : bfl(wk[e >> 1]), a_ = (e & 1) ? bfh(wa[e >> 1]) : bfl(wa[e >> 1]), b_ = (e & 1) ? bfh(wb[e >> 1]) : bfl(wb[e >> 1]);
                const float eg = __expf(ct), egi = __expf(-ct), ep = __expf(cp), eL = __expf(cL - ct);
                at[e] = a_ * ep; bt[e] = b_ * egi; kt[e] = k_ * egi; rt_[e] = r_ * eg; kg[e] = k_ * eL; bg[e] = b_ * eL; gc[e] = __expf(cL); }
            v4u o;
            o.x = pk2(at[0], at[1]); o.y = pk2(at[2], at[3]); o.z = pk2(at[4], at[5]); o.w = pk2(at[6], at[7]); *(LAS v4u*)(lds + LA_AS + t * 144 + j0 * 2) = o;
            o.x = pk2(bt[0], bt[1]); o.y = pk2(bt[2], bt[3]); o.z = pk2(bt[4], bt[5]); o.w = pk2(bt[6], bt[7]); *(LAS v4u*)(lds + LA_BS + t * 144 + j0 * 2) = o;
            o.x = pk2(kt[0], kt[1]); o.y = pk2(kt[2], kt[3]); o.z = pk2(kt[4], kt[5]); o.w = pk2(kt[6], kt[7]); *(LAS v4u*)(lds + LA_KS + t * 144 + j0 * 2) = o;
            o.x = pk2(rt_[0], rt_[1]); o.y = pk2(rt_[2], rt_[3]); o.z = pk2(rt_[4], rt_[5]); o.w = pk2(rt_[6], rt_[7]); *(LAS v4u*)(lds + LA_RS + t * 144 + j0 * 2) = o;
            *(v4u*)(rec + REC_RT + t * 144 + j0 * 2) = o;
#pragma unroll
            for (int e = 0; e < 8; ++e) { *(LAS bf16*)(lds + LA_KGT + (j0 + e) * 144 + t * 2) = (bf16)f2bf(kg[e]); *(LAS bf16*)(lds + LA_BGT + (j0 + e) * 144 + t * 2) = (bf16)f2bf(bg[e]);
                *(LAS bf16*)(lds + LA_VT + (j0 + e) * 144 + t * 2) = (bf16)((e & 1) ? (wv[e >> 1] >> 16) : (wv[e >> 1] & 0xffffu)); }
            if (t == 63) { *(f32x4*)(rec + REC_GC + j0 * 4) = (f32x4){gc[0], gc[1], gc[2], gc[3]}; *(f32x4*)(rec + REC_GC + (j0 + 4) * 4) = (f32x4){gc[4], gc[5], gc[6], gc[7]}; }
        }
        __syncthreads();
        if (wave < 4) {
            const int ib = wave & 1; const bool isY = wave >= 2; const int offX = isY ? LA_RS : LA_AS;
            f32x16 o;
#pragma unroll
            for (int r = 0; r < 16; ++r) o[r] = 0.f;
            { f32x16 Gt = gtile32(lds, LA_KS, 0, offX, 1, r32, hi); gv_acc(o, Gt, lds, 0, ib, r32, hi); }
            { f32x16 Gt = gtile32(lds, LA_KS, 1, offX, 1, r32, hi); if (isY) mask_lower<true>(Gt, r32, hi); else mask_lower<false>(Gt, r32, hi); gv_acc(o, Gt, lds, 1, ib, r32, hi); }
            if (!isY) {
#pragma unroll
                for (int r = 0; r < 16; ++r) *(LAS float*)(lds + LA_XU + ((32 + crow(r, hi)) * 68 + 32 * ib + r32) * 4) = o[r];
            } else {
#pragma unroll
                for (int u = 0; u < 4; ++u) { const int m = 2 + (u >> 1), lp = (r32 & 15) + 16 * (2 * (u & 1) + hi), vs = 2 * ib + (r32 >> 4);
                    *(pg8::u32x2*)(rec + REC_Y0 + ((vs * 4 + m) * 64 + lp) * 8) = (pg8::u32x2){pk2(o[4 * u], o[4 * u + 1]), pk2(o[4 * u + 2], o[4 * u + 3])}; }
            }
        } else if (wave < 6) {
            const bool isY = wave == 5; const int offX = isY ? LA_RS : LA_AS;
            f32x16 Gt = gtile32(lds, LA_KS, 0, offX, 0, r32, hi); if (isY) mask_lower<true>(Gt, r32, hi); else mask_lower<false>(Gt, r32, hi);
#pragma unroll
            for (int ib = 0; ib < 2; ++ib) { f32x16 o;
#pragma unroll
                for (int r = 0; r < 16; ++r) o[r] = 0.f;
                gv_acc(o, Gt, lds, 0, ib, r32, hi);
                if (!isY) {
#pragma unroll
                    for (int r = 0; r < 16; ++r) *(LAS float*)(lds + LA_XU + (crow(r, hi) * 68 + 32 * ib + r32) * 4) = o[r];
                } else {
#pragma unroll
                    for (int u = 0; u < 4; ++u) { const int m = (u >> 1), lp = (r32 & 15) + 16 * (2 * (u & 1) + hi), vs = 2 * ib + (r32 >> 4);
                        *(pg8::u32x2*)(rec + REC_Y0 + ((vs * 4 + m) * 64 + lp) * 8) = (pg8::u32x2){pk2(o[4 * u], o[4 * u + 1]), pk2(o[4 * u + 2], o[4 * u + 3])}; }
                } }
            const int hf = wave - 4;
#pragma unroll
            for (int jj = 0; jj < 2; ++jj)
#pragma unroll
                for (int vs = 0; vs < 4; ++vs) { const int jt = 2 * hf + jj; f32x4 acc = (f32x4){0.f, 0.f, 0.f, 0.f};
#pragma unroll
                    for (int ks = 0; ks < 2; ++ks) { const bf16x8 a = *(const LAS bf16x8*)(lds + LA_KGT + (16 * jt + c16) * 144 + (32 * ks + 8 * g) * 2), b = *(const LAS bf16x8*)(lds + LA_VT + (16 * vs + c16) * 144 + (32 * ks + 8 * g) * 2);
                        acc = __builtin_amdgcn_mfma_f32_16x16x32_bf16(a, b, acc, 0, 0, 0); }
                    *(pg8::u32x2*)(rec + REC_M0 + ((vs * 4 + jt) * 64 + lane) * 8) = (pg8::u32x2){pk2(acc[0], acc[1]), pk2(acc[2], acc[3])}; }
        } else {
            const bool isR = wave == 7; const int offX = isR ? LA_RS : LA_AS;
#pragma unroll
            for (int k = 0; k < 3; ++k) { const int si = k == 2 ? 1 : 0, ti = k == 0 ? 0 : 1;
                f32x16 Gt = gtile32(lds, LA_BS, si, offX, ti, r32, hi);
                if (si == ti) { if (isR) mask_lower<true>(Gt, r32, hi); else mask_lower<false>(Gt, r32, hi); }
#pragma unroll
                for (int u = 0; u < 4; ++u) {
                    if (!isR) *(LAS f32x4*)(lds + LA_NS + (32 * ti + r32) * 272 + (32 * si + 8 * u + 4 * hi) * 4) = (f32x4){Gt[4 * u], Gt[4 * u + 1], Gt[4 * u + 2], Gt[4 * u + 3]};
                    else *(pg8::u32x2*)(rec + REC_ARB + (32 * ti + r32) * 144 + (32 * si + 8 * u + 4 * hi) * 2) = (pg8::u32x2){pk2(Gt[4 * u], Gt[4 * u + 1]), pk2(Gt[4 * u + 2], Gt[4 * u + 3])}; }
            }
            if (isR) { const v4u z = (v4u){0u, 0u, 0u, 0u}; *(v4u*)(rec + REC_ARB + r32 * 144 + (32 + 16 * hi) * 2) = z; *(v4u*)(rec + REC_ARB + r32 * 144 + (40 + 16 * hi) * 2) = z; }
        }
        __syncthreads();
        const v4u vg1 = *(const v4u*)(ws + WS_AIN + (size_t)uc * AIN_BYTES + AIN_G1 + e0 * 2), vg2 = *(const v4u*)(ws + WS_AIN + (size_t)uc * AIN_BYTES + AIN_G2 + e0 * 2);
        PA_LOAD_LD(min(uc + G, 8191));
        if (wave < 4 && lane < 16) { const int bb = wave; float tc[16];
#pragma unroll
            for (int t2 = 0; t2 < 16; ++t2) { float v = (t2 == lane) ? 1.f : 0.f;
#pragma unroll
                for (int s4 = 0; s4 < (t2 + 3) / 4; ++s4) { const f32x4 n4 = *(const LAS f32x4*)(lds + LA_NS + (16 * bb + t2) * 272 + (16 * bb + 4 * s4) * 4);
#pragma unroll
                    for (int e = 0; e < 4; ++e) if (4 * s4 + e < t2) v += n4[e] * tc[4 * s4 + e]; }
                tc[t2] = v; *(LAS float*)(lds + LA_TS + ((bb * 16 + t2) * 16 + lane) * 4) = v; if ((t2 & 3) == 3) asm volatile("" ::: "memory"); } }
        __syncthreads();
        {   const bool isW = wave < 4; const int colw = 16 * (wave & 3) + c16;
            LAS float* RS = (LAS float*)(lds + LA_SCR + wave * 1024);
#pragma unroll 1
            for (int bb = 0; bb < 4; ++bb) {
                f32x4 acc;
#pragma unroll
                for (int r = 0; r < 4; ++r) acc[r] = isW ? bf1(*(const LAS bf16*)(lds + LA_AS + (16 * bb + 4 * g + r) * 144 + colw * 2)) : *(const LAS float*)(lds + LA_XU + ((16 * bb + 4 * g + r) * 68 + colw) * 4);
#pragma unroll 4
                for (int kk = 0; kk < 4 * bb; ++kk) { const float av = *(const LAS float*)(lds + LA_NS + (16 * bb + c16) * 272 + (4 * kk + g) * 4);
                    const float bv = isW ? CL[(4 * kk + g) * 65 + colw] : *(const LAS float*)(lds + LA_XU + ((4 * kk + g) * 68 + colw) * 4);
                    acc = __builtin_amdgcn_mfma_f32_16x16x4f32(av, bv, acc, 0, 0, 0); }
#pragma unroll
                for (int r = 0; r < 4; ++r) RS[(4 * g + r) * 16 + c16] = acc[r];
                f32x4 xa = (f32x4){0.f, 0.f, 0.f, 0.f};
#pragma unroll
                for (int kk = 0; kk < 4; ++kk) { const float av = *(const LAS float*)(lds + LA_TS + ((bb * 16 + c16) * 16 + 4 * kk + g) * 4); const float bv = RS[(4 * kk + g) * 16 + c16];
                    xa = __builtin_amdgcn_mfma_f32_16x16x4f32(av, bv, xa, 0, 0, 0); }
#pragma unroll
                for (int r = 0; r < 4; ++r) { if (isW) CL[(16 * bb + 4 * g + r) * 65 + colw] = xa[r]; else *(LAS float*)(lds + LA_XU + ((16 * bb + 4 * g + r) * 68 + colw) * 4) = xa[r]; }
                if (isW) {
#pragma unroll
                    for (int r = 0; r < 4; ++r) *(LAS bf16*)(lds + LA_WS + (16 * bb + 4 * g + r) * 144 + colw * 2) = (bf16)f2bf(xa[r]);
                } else *(pg8::u32x2*)(rec + REC_U0 + (((wave & 3) * 4 + bb) * 64 + lane) * 8) = (pg8::u32x2){pk2(xa[0], xa[1]), pk2(xa[2], xa[3])};
            }
        }
        __syncthreads();
        { const int bh = uc >> 8, row = (bh >> 4) * T + (uc & 255) * 64 + t; const size_t go = (size_t)row * 1024 + (bh & 15) * 64 + j0;
          *(v4u*)((bf16*)(ws + WS_G1) + go) = vg1; *(v4u*)((bf16*)(ws + WS_G2) + go) = vg2; }
        for (int i = tid; i < 576; i += NTHR) { *(v4u*)(rec + REC_W + i * 16) = *(const LAS v4u*)(lds + LA_WS + i * 16); *(v4u*)(rec + REC_BGT + i * 16) = *(const LAS v4u*)(lds + LA_BGT + i * 16); }
    }
}

#undef PA_LOAD
#undef PA_LOAD_LD
__device__ __forceinline__ bf16x8 afrag16(const LAS unsigned char* base, int row, int s, int g) {
    const LAS unsigned char* p = base + row * 144 + (32 * s + 4 * g) * 2; const s16x4 lo = *(const LAS s16x4*)p, hh = *(const LAS s16x4*)(p + 32);
    return (bf16x8){lo[0], lo[1], lo[2], lo[3], hh[0], hh[1], hh[2], hh[3]};
}
__device__ __forceinline__ bf16x8 pack_cc(const f32x4& a, const f32x4& b) { v4u w; w.x = pg8::cvt_pk_bf16(a[0], a[1]); w.y = pg8::cvt_pk_bf16(a[2], a[3]); w.z = pg8::cvt_pk_bf16(b[0], b[1]); w.w = pg8::cvt_pk_bf16(b[2], b[3]); return __builtin_bit_cast(bf16x8, w); }
__device__ __forceinline__ f32x4 cfrag(const LAS unsigned char* base, int vs, int m, int lane) { const pg8::u32x2 u = *(const LAS pg8::u32x2*)(base + ((vs * 4 + m) * 64 + lane) * 8); return (f32x4){bfl(u.x), bfh(u.x), bfl(u.y), bfh(u.y)}; }
constexpr int B_SLOT = 44032, B_NP = 43;
__device__ __forceinline__ void b_issue(const unsigned char* rec, LAS unsigned char* slot, int vs, int lw, int lane) {
    for (int p = lw; p < B_NP; p += 4) {
        const int src = p < 36 ? p * 1024 : (p < 42 ? REC_U0 + ((p - 36) >> 1) * 8192 + vs * 2048 + ((p - 36) & 1) * 1024 : REC_GC);
        __builtin_amdgcn_global_load_lds((const unsigned*)(rec + src + lane * 16), (LAS unsigned*)(slot + p * 1024), 16, 0, 0); }
}
__device__ __forceinline__ void p4_rwkv_seq(const Args& A, LAS unsigned char* lds, int q, int wave, int lane) {
    unsigned char* ws = A.ws; const int bh = q >> 2, vs = q & 3;
    const unsigned char* REC = ws + WS_REC + (size_t)bh * 256 * REC_BYTES; bf16* YR = (bf16*)(ws + WS_YRAW);
    const int b = bh >> 4, h = bh & 15, c16 = lane & 15, g = lane >> 4, lw = wave - 4;
    const bool many = ((B_NP - 1 - lw) / 4 + 1) == 11;
    if (wave >= 4) { b_issue(REC, lds, vs, lw, lane); b_issue(REC + REC_BYTES, lds + B_SLOT, vs, lw, lane);
        if (many) asm volatile("s_waitcnt vmcnt(11)" ::: "memory"); else asm volatile("s_waitcnt vmcnt(10)" ::: "memory"); }
    __syncthreads();
    f32x4 H[4];
#pragma unroll
    for (int jt = 0; jt < 4; ++jt) H[jt] = (f32x4){0.f, 0.f, 0.f, 0.f};
#pragma unroll 1
    for (int c = 0; c < 256; ++c) {
        const LAS unsigned char* buf = lds + (c % 3) * B_SLOT;
        if (wave >= 4) {
            if (c + 2 < 256) { b_issue(REC + (size_t)(c + 2) * REC_BYTES, lds + ((c + 2) % 3) * B_SLOT, vs, lw, lane);
                if (many) asm volatile("s_waitcnt vmcnt(11)" ::: "memory"); else asm volatile("s_waitcnt vmcnt(10)" ::: "memory"); }
            else asm volatile("s_waitcnt vmcnt(0)" ::: "memory");
        } else if (wave == 0) {
            const LAS unsigned char* qb = buf + 36864;
            bf16x8 hb[2]; hb[0] = pack_cc(H[0], H[1]); hb[1] = pack_cc(H[2], H[3]);
            f32x4 U[4];
#pragma unroll
            for (int m = 0; m < 4; ++m) { U[m] = cfrag(qb, 0, m, lane);
#pragma unroll
                for (int s = 0; s < 2; ++s) U[m] = __builtin_amdgcn_mfma_f32_16x16x32_bf16(afrag16(buf + REC_W, 16 * m + c16, s, g), hb[s], U[m], 0, 0, 0); }
            bf16x8 ub[2]; ub[0] = pack_cc(U[0], U[1]); ub[1] = pack_cc(U[2], U[3]);
#pragma unroll
            for (int jt = 0; jt < 4; ++jt) { const f32x4 gc = *(const LAS f32x4*)(qb + 6144 + (16 * jt + 4 * g) * 4); f32x4 hn = H[jt] * gc + cfrag(qb + 4096, 0, jt, lane);
#pragma unroll
                for (int s = 0; s < 2; ++s) hn = __builtin_amdgcn_mfma_f32_16x16x32_bf16(afrag16(buf + REC_BGT, 16 * jt + c16, s, g), ub[s], hn, 0, 0, 0);
                H[jt] = hn; }
#pragma unroll
            for (int m = 0; m < 4; ++m) { f32x4 y = cfrag(qb + 2048, 0, m, lane);
#pragma unroll
                for (int s = 0; s < 2; ++s) y = __builtin_amdgcn_mfma_f32_16x16x32_bf16(afrag16(buf + REC_RT, 16 * m + c16, s, g), hb[s], y, 0, 0, 0);
#pragma unroll
                for (int s = 0; s < 2; ++s) y = __builtin_amdgcn_mfma_f32_16x16x32_bf16(afrag16(buf + REC_ARB, 16 * m + c16, s, g), ub[s], y, 0, 0, 0);
                bf16* yp = YR + (size_t)(b * T + 64 * c + 16 * m + 4 * g) * 1024 + h * 64 + 16 * vs + c16;
                yp[0] = (bf16)f2bf(y[0]); yp[1024] = (bf16)f2bf(y[1]); yp[2048] = (bf16)f2bf(y[2]); yp[3072] = (bf16)f2bf(y[3]); }
        }
        __syncthreads();
    }
}
__device__ __forceinline__ void p5_rwkv_final(const Args& A, int vcu, int G, int wave, int lane) {
    const bf16* YR = (const bf16*)(A.ws + WS_YRAW); const bf16* G1 = (const bf16*)(A.ws + WS_G1); const bf16* G2 = (const bf16*)(A.ws + WS_G2); unsigned char* MIX = A.ws + WS_MIX;
    const int gw = vcu * NWAVES + wave, NGW = G * NWAVES, pr = lane >> 3, oct = lane & 7;
    for (int it0 = gw * 8 + pr; it0 < NTOK * 16; it0 += NGW * 8 * 4) {
        v4u y[4], a[4], c[4];
#pragma unroll
        for (int k = 0; k < 4; ++k) { const int it = min(it0 + k * NGW * 8, NTOK * 16 - 1); const size_t o = (size_t)(it >> 4) * 1024 + (it & 15) * 64 + oct * 8;
            y[k] = *(const v4u*)(YR + o); a[k] = *(const v4u*)(G1 + o); c[k] = *(const v4u*)(G2 + o); }
#pragma unroll
        for (int k = 0; k < 4; ++k) { const int it = it0 + k * NGW * 8;
            const unsigned yw[4] = {y[k].x, y[k].y, y[k].z, y[k].w}, aw[4] = {a[k].x, a[k].y, a[k].z, a[k].w}, cw[4] = {c[k].x, c[k].y, c[k].z, c[k].w};
            float v[8]; float sm = 0.f;
#pragma unroll
            for (int e = 0; e < 4; ++e) { v[2 * e] = bfl(yw[e]); v[2 * e + 1] = bfh(yw[e]); sm += v[2 * e] + v[2 * e + 1]; }
            sm += __shfl_xor(sm, 1); sm += __shfl_xor(sm, 2); sm += __shfl_xor(sm, 4);
            const float mean = sm * (1.f / 64.f); float sq = 0.f;
#pragma unroll
            for (int e = 0; e < 8; ++e) { v[e] -= mean; sq += v[e] * v[e]; }
            sq += __shfl_xor(sq, 1); sq += __shfl_xor(sq, 2); sq += __shfl_xor(sq, 4);
            const float rstd = 1.0f / sqrtf(sq * (1.f / 64.f) + GN_EPS);
            float ov[8];
#pragma unroll
            for (int e = 0; e < 4; ++e) { ov[2 * e] = v[2 * e] * rstd * bfl(aw[e]) + bfl(cw[e]); ov[2 * e + 1] = v[2 * e + 1] * rstd * bfh(aw[e]) + bfh(cw[e]); }
            pg8::u32x2 o2; o2.x = pg8::pk4_fp8(ov[0], ov[1], ov[2], ov[3]); o2.y = pg8::pk4_fp8(ov[4], ov[5], ov[6], ov[7]);
            if (it < NTOK * 16) *(pg8::u32x2*)(MIX + (size_t)(it >> 4) * D + (it & 15) * 64 + oct * 8) = o2; }
    }
}

__device__ __forceinline__ void p5_ln_router(const Args& A, LAS unsigned char* lds, int vcu, int G, int tid, int wave, int lane) {
    unsigned char* ws = A.ws; const bf16* Z1 = (const bf16*)(ws + WS_Z1); bf16* H1 = (bf16*)(ws + WS_H1); const bf16* RWF = (const bf16*)(ws + WS_RWT);
    int* TOPI = (int*)(ws + RT_TOPI); float* TOPG = (float*)(ws + RT_TOPG); int* CNT = (int*)(ws + RT_CNT);
    LAS int* hist = (LAS int*)lds; const int c16 = lane & 15, g = lane >> 4;
    const float* gam = A.in[21]; const float* bet = A.in[22];
    for (int batch = vcu; batch < NTOK / 128; batch += G) {
        __syncthreads();
        if (tid < NE) hist[tid] = 0;
        __syncthreads();
        const int row0 = batch * 128 + wave * 16; const bf16* zr = Z1 + (size_t)(row0 + c16) * D + 8 * g;
        float sm = 0.f, sq = 0.f;
#pragma unroll 8
        for (int sx = 0; sx < 64; ++sx) { const v4u z = *(const v4u*)(zr + 32 * sx); const unsigned zw[4] = {z.x, z.y, z.z, z.w};
#pragma unroll
            for (int e = 0; e < 4; ++e) { const float a = bfl(zw[e]), b = bfh(zw[e]); sm += a + b; sq += a * a + b * b; } }
        sm += __shfl_xor(sm, 16); sm += __shfl_xor(sm, 32); sq += __shfl_xor(sq, 16); sq += __shfl_xor(sq, 32);
        const float mean = sm * (1.f / D); const float rstd = 1.0f / sqrtf(fmaxf(sq * (1.f / D) - mean * mean, 0.f) + LN_EPS);
        f32x4 acc[2]; acc[0] = (f32x4){0.f, 0.f, 0.f, 0.f}; acc[1] = acc[0];
        bf16* hr = H1 + (size_t)(row0 + c16) * D + 8 * g; unsigned char* hq = ws + WS_H1Q + (size_t)(row0 + c16) * D + 8 * g;
#pragma unroll 2
        for (int sx = 0; sx < 64; ++sx) { const v4u z = *(const v4u*)(zr + 32 * sx); const f32x4 a = (f32x4){bfl(z.x), bfh(z.x), bfl(z.y), bfh(z.y)}, b = (f32x4){bfl(z.z), bfh(z.z), bfl(z.w), bfh(z.w)};
            const f32x4 g0 = *(const f32x4*)(gam + 32 * sx + 8 * g), g1 = *(const f32x4*)(gam + 32 * sx + 8 * g + 4), b0 = *(const f32x4*)(bet + 32 * sx + 8 * g), b1 = *(const f32x4*)(bet + 32 * sx + 8 * g + 4);
            const f32x4 h0 = (a - mean) * rstd * g0 + b0, h1 = (b - mean) * rstd * g1 + b1;
            v4u hi; hi.x = pg8::cvt_pk_bf16(h0.x, h0.y); hi.y = pg8::cvt_pk_bf16(h0.z, h0.w); hi.z = pg8::cvt_pk_bf16(h1.x, h1.y); hi.w = pg8::cvt_pk_bf16(h1.z, h1.w);
            *(v4u*)(hr + 32 * sx) = hi;
            *(pg8::u32x2*)(hq + 32 * sx) = (pg8::u32x2){pg8::pk4_fp8(h0.x, h0.y, h0.z, h0.w), pg8::pk4_fp8(h1.x, h1.y, h1.z, h1.w)};
            v4u lo; lo.x = pg8::cvt_pk_bf16(h0.x - bfl(hi.x), h0.y - bfh(hi.x)); lo.y = pg8::cvt_pk_bf16(h0.z - bfl(hi.y), h0.w - bfh(hi.y));
            lo.z = pg8::cvt_pk_bf16(h1.x - bfl(hi.z), h1.y - bfh(hi.z)); lo.w = pg8::cvt_pk_bf16(h1.z - bfl(hi.w), h1.w - bfh(hi.w));
            const bf16x8 ah = __builtin_bit_cast(bf16x8, hi), al = __builtin_bit_cast(bf16x8, lo);
#pragma unroll
            for (int nt = 0; nt < 2; ++nt) { const bf16* fp = RWF + ((size_t)((sx * 2 + nt) * 2) * 64 + lane) * 8; const bf16x8 wh = *(const bf16x8*)fp, wl = *(const bf16x8*)(fp + 512);
                acc[nt] = __builtin_amdgcn_mfma_f32_16x16x32_bf16(ah, wh, acc[nt], 0, 0, 0); acc[nt] = __builtin_amdgcn_mfma_f32_16x16x32_bf16(ah, wl, acc[nt], 0, 0, 0);
                acc[nt] = __builtin_amdgcn_mfma_f32_16x16x32_bf16(al, wh, acc[nt], 0, 0, 0); } }
        const float bia0 = A.in[24][c16], bia1 = A.in[24][16 + c16];
#pragma unroll
        for (int r = 0; r < 4; ++r) {
            float v0 = acc[0][r] + bia0, v1 = acc[1][r] + bia1; float tv[4]; int ti[4];
#pragma unroll
            for (int k = 0; k < 4; ++k) { float bv = v0; int bi = c16; if (v1 > bv) { bv = v1; bi = 16 + c16; }
#pragma unroll
                for (int o = 1; o < 16; o <<= 1) { const float ov = __shfl_xor(bv, o); const int oi = __shfl_xor(bi, o); if (ov > bv || (ov == bv && oi < bi)) { bv = ov; bi = oi; } }
                tv[k] = bv; ti[k] = bi; if (bi == c16) v0 = -INFINITY; if (bi == 16 + c16) v1 = -INFINITY; }
            const float e1 = __expf(tv[1] - tv[0]), e2 = __expf(tv[2] - tv[0]), e3 = __expf(tv[3] - tv[0]); const float inv = 1.f / (1.f + e1 + e2 + e3);
            if (c16 < 4) { const int row = row0 + 4 * g + r; const int ei = c16 == 0 ? ti[0] : c16 == 1 ? ti[1] : c16 == 2 ? ti[2] : ti[3]; const float gv = (c16 == 0 ? 1.f : c16 == 1 ? e1 : c16 == 2 ? e2 : e3) * inv;
                TOPI[row * 4 + c16] = ei; TOPG[row * 4 + c16] = gv; __hip_atomic_fetch_add(hist + ei, 1, __ATOMIC_RELAXED, __HIP_MEMORY_SCOPE_WORKGROUP); }
        }
        __syncthreads();
        if (tid < NE) CNT[batch * NE + tid] = hist[tid];
    }
}
__device__ __forceinline__ void p6_positions(const Args& A, LAS unsigned char* lds, int vcu, int G, int tid) {
    unsigned char* ws = A.ws; const int* TOPI = (const int*)(ws + RT_TOPI); const float* TOPG = (const float*)(ws + RT_TOPG); const int* CNT = (const int*)(ws + RT_CNT);
    int* POS = (int*)(ws + RT_POS); int* BTOK = (int*)(ws + RT_TOK); float* BGATE = (float*)(ws + RT_GATE); int* TILE = (int*)(ws + RT_TILE);
    LAS int* sh = (LAS int*)lds;
    for (int batch = vcu; batch < NTOK / 128; batch += G) {
        __syncthreads();
        { const int e = tid & 31, seg = tid >> 5; int sb = 0, st = 0;
          for (int q = 0; q < 16; ++q) { const int bb = seg * 16 + q; const int c = CNT[bb * NE + e]; st += c; if (bb < batch) sb += c; }
          sh[tid] = sb; sh[1152 + tid] = st; }
        sh[640 + tid] = TOPI[batch * 512 + tid];
        __syncthreads();
        if (tid < NE) { int sb = 0, st = 0; for (int s = 0; s < 16; ++s) { sb += sh[s * 32 + tid]; st += sh[1152 + s * 32 + tid]; } sh[512 + tid] = sb; sh[544 + tid] = st; }
        __syncthreads();
        if (tid == 0) { int acc = 0; for (int e = 0; e < NE; ++e) { sh[576 + e] = acc; acc += (sh[544 + e] + 255) >> 8; } sh[576 + NE] = acc; }
        __syncthreads();
        { const int e = sh[640 + tid]; int rank = 0; for (int j = 0; j < tid; ++j) rank += (sh[640 + j] == e) ? 1 : 0;
          const int dest = sh[576 + e] * 256 + sh[512 + e] + rank;
          BTOK[dest] = batch * 128 + (tid >> 2); BGATE[dest] = TOPG[batch * 512 + tid]; POS[batch * 512 + tid] = dest; }
        if (batch < NE) { const int e = batch; const int lo = sh[576 + e] * 256 + sh[544 + e], hi = sh[576 + e + 1] * 256;
            for (int i = lo + tid; i < hi; i += NTHR) { BTOK[i] = 0; BGATE[i] = 0.f; }
            for (int rt = sh[576 + e] + tid; rt < sh[576 + e + 1]; rt += NTHR) TILE[rt] = e; }
        if (batch == 0 && tid == 0) TILE[MAXT] = sh[576 + NE];
    }
}
template <int I> __device__ __forceinline__ float fp8f_(unsigned w) { return __builtin_amdgcn_cvt_f32_fp8((int)w, I); }
#define fp8f(w, i) fp8f_<i>(w)
__device__ __forceinline__ void p9_final(const Args& A, int vcu, int G, int wave, int lane) {
    unsigned char* ws = A.ws; const bf16* H1 = (const bf16*)(ws + WS_H1); const unsigned char* Y = ws + WS_Y; const int* POS = (const int*)(ws + RT_POS);
    const int gw = vcu * NWAVES + wave, NGW = G * NWAVES;
    for (int row = gw; row < NTOK; row += NGW) {
        f32x4 v[8]; const int p0 = POS[row * 4], p1 = POS[row * 4 + 1], p2 = POS[row * 4 + 2], p3 = POS[row * 4 + 3];
#pragma unroll
        for (int j = 0; j < 8; ++j) { const int c = 4 * lane + 256 * j;
            const pg8::u32x2 h = *(const pg8::u32x2*)(H1 + (size_t)row * D + c);
            const unsigned y0 = *(const unsigned*)(Y + (size_t)p0 * D + c), y1 = *(const unsigned*)(Y + (size_t)p1 * D + c), y2 = *(const unsigned*)(Y + (size_t)p2 * D + c), y3 = *(const unsigned*)(Y + (size_t)p3 * D + c);
            const float s = 1.0f / 64.0f;
            v[j].x = ALPHA * bfl(h.x) + s * ((fp8f(y0, 0) + fp8f(y1, 0)) + (fp8f(y2, 0) + fp8f(y3, 0))); v[j].y = ALPHA * bfh(h.x) + s * ((fp8f(y0, 1) + fp8f(y1, 1)) + (fp8f(y2, 1) + fp8f(y3, 1)));
            v[j].z = ALPHA * bfl(h.y) + s * ((fp8f(y0, 2) + fp8f(y1, 2)) + (fp8f(y2, 2) + fp8f(y3, 2))); v[j].w = ALPHA * bfh(h.y) + s * ((fp8f(y0, 3) + fp8f(y1, 3)) + (fp8f(y2, 3) + fp8f(y3, 3))); }
        ln_row(v, A.in[29], A.in[30], LN_EPS, lane);
#pragma unroll
        for (int j = 0; j < 8; ++j) *(f32x4*)(A.out + (size_t)row * D + 4 * lane + 256 * j) = v[j];
    }
}

constexpr int NPH = 12;
__device__ __forceinline__ int opaque_tid() { int t = (int)threadIdx.x; asm volatile("" : "+v"(t)); return t; }
template <int PLO, int PHI>
__global__ void __launch_bounds__(NTHR, 2) fwd_kernel(Args args) {
    extern __shared__ __attribute__((aligned(16))) unsigned char lds_raw[];
    LAS unsigned char* lds = (LAS unsigned char*)lds_raw;
    const int tid = threadIdx.x, lane = tid & 63, wave = __builtin_amdgcn_readfirstlane(tid >> 6);
    const int G = gridDim.x; const int bx = blockIdx.x; const int vcu = (G % 8 == 0) ? (bx % 8) * (G / 8) + bx / 8 : bx;
    volatile LAS unsigned* MISC = (volatile LAS unsigned*)(lds + MISC_OFF);
    if (tid < 64) MISC[tid] = 0u;
    __syncthreads();
    unsigned char* ws = args.ws;
    unsigned* ctl = (unsigned*)(ws + WS_CTL);
    constexpr int lo = PLO, hi = PHI;
    XcdBarrier bar; bar.bar = ctl + CW_BAR; bar.x = 0; bar.st = nullptr;
    if (hi - lo > 1) bar = xcd_barrier_post(ctl + CW_BAR, MISC + 8);
#define IN(k) (lo <= (k) && (k) < hi)
#define PH_IDS const int tid = opaque_tid(), lane = tid & 63, wave = __builtin_amdgcn_readfirstlane(tid >> 6); (void)tid; (void)lane; (void)wave
#define SEAM(k) do { if constexpr (IN(k) && IN((k) + 1)) xcd_barrier(bar); } while (0)

    if constexpr (IN(0)) { PH_IDS; p0_prologue(args, lds, vcu, G, wave, lane); }
#if defined(REP_PHASE)
    if constexpr (REP_PHASE == 0) { __syncthreads();
    if constexpr (IN(0)) { PH_IDS; p0_prologue(args, lds, vcu, G, wave, lane); }
    }
#endif
    SEAM(0);
    if constexpr (IN(1)) { PH_IDS;
        const int ng = (G == 256) ? NG_INPROJ : G;
        if (bx < ng) { pg8::Gemm g{(const bf16*)(ws + WS_H0), (const bf16*)(ws + WS_WI), NTOK, PW, D}; pg8::StaticOrder S; S.init(NTOK, PW, ng, bx);
            pg8::EpiBf16 E{(bf16*)(ws + WS_P), PW};
            pg8::gemm_phase<pg8::EpiBf16, pg8::StaticOrder>(lds, g, S, E); }
        else { pg8::Gemm g{(const bf16*)(ws + WS_MEMN), (const bf16*)(ws + WS_WKV), NB * MEM_LEN, 1024, D}; pg8::StaticOrder S; S.init(NB * MEM_LEN, 1024, G - ng, bx - ng);
            pg8::EpiBf16 E{(bf16*)(ws + WS_KVM), 1024};
            pg8::gemm_phase<pg8::EpiBf16, pg8::StaticOrder>(lds, g, S, E); }
        conv_pull_loop(args, lds, tid, wave, lane);
    }
#if defined(REP_PHASE)
    if constexpr (REP_PHASE == 1) { __syncthreads();
    if constexpr (IN(1)) { PH_IDS;
        pg8::Gemm g{(const bf16*)(ws + WS_H0), (const bf16*)(ws + WS_WI), NTOK, PW, D}; pg8::StaticOrder S; S.init(NTOK, PW, G, bx);
        pg8::EpiBf16 E{(bf16*)(ws + WS_P), PW};
        pg8::gemm_phase<pg8::EpiBf16, pg8::StaticOrder>(lds, g, S, E);
    }
    }
#endif
    SEAM(1);
    if constexpr (IN(2)) { PH_IDS;
        if (G != 256) { pg8::Gemm g{(const bf16*)(ws + WS_MEMN), (const bf16*)(ws + WS_WKV), NB * MEM_LEN, 1024, D}; pg8::StaticOrder S; S.init(NB * MEM_LEN, 1024, G, bx);
          pg8::EpiBf16 E{(bf16*)(ws + WS_KVM), 1024};
          pg8::gemm_phase<pg8::EpiBf16, pg8::StaticOrder>(lds, g, S, E); }
        __syncthreads();
        p2_fox_cumsum(args, lds, (vcu + G - 16) % G, G, tid);
        __syncthreads();
        p2_fox_norms(args, lds, vcu, G, tid, wave, lane);
        __syncthreads();
        p2_rwkv_tok(args, lds, vcu, G, tid, wave, lane);
#if defined(REP_SUB)
        __syncthreads();
        if constexpr (REP_SUB == 0) p2_rwkv_tok(args, lds, vcu, G, tid, wave, lane);
        if constexpr (REP_SUB == 11) p2_rwkv_tok<1>(args, lds, vcu, G, tid, wave, lane);
        if constexpr (REP_SUB == 12) p2_rwkv_tok<2>(args, lds, vcu, G, tid, wave, lane);
        if constexpr (REP_SUB == 1) p2_fox_norms(args, lds, vcu, G, tid, wave, lane);
        if constexpr (REP_SUB == 2) p2_fox_cumsum(args, lds, (vcu + G - 16) % G, G, tid);
        if constexpr (REP_SUB == 3) { pg8::Gemm g{(const bf16*)(ws + WS_MEMN), (const bf16*)(ws + WS_WKV), NB * MEM_LEN, 1024, D}; pg8::StaticOrder S; S.init(NB * MEM_LEN, 1024, G, bx);
          pg8::EpiBf16 E{(bf16*)(ws + WS_KVM), 1024};
          pg8::gemm_phase<pg8::EpiBf16, pg8::StaticOrder>(lds, g, S, E); }
#endif
    }
#if defined(REP_PHASE)
    if constexpr (REP_PHASE == 2) { __syncthreads();
    if constexpr (IN(2)) { PH_IDS;
        { pg8::Gemm g{(const bf16*)(ws + WS_MEMN), (const bf16*)(ws + WS_WKV), NB * MEM_LEN, 1024, D}; pg8::StaticOrder S; S.init(NB * MEM_LEN, 1024, G, bx);
          pg8::EpiBf16 E{(bf16*)(ws + WS_KVM), 1024};
          pg8::gemm_phase<pg8::EpiBf16, pg8::StaticOrder>(lds, g, S, E); }
        __syncthreads();
        p2_fox_cumsum(args, lds, (vcu + G - 16) % G, G, tid);
        __syncthreads();
        p2_fox_norms(args, lds, vcu, G, tid, wave, lane);
        __syncthreads();
        p2_rwkv_tok(args, lds, vcu, G, tid, wave, lane);
    }
    }
#endif
    SEAM(2);
    if constexpr (IN(3)) { PH_IDS; p3_rwkv_chunk(args, lds, vcu, G, tid, wave, lane); }
#if defined(REP_PHASE)
    if constexpr (REP_PHASE == 3) { __syncthreads();
    if constexpr (IN(3)) { PH_IDS; p3_rwkv_chunk(args, lds, vcu, G, tid, wave, lane); }
    }
#endif
    SEAM(3);
    if constexpr (IN(4)) { PH_IDS;
        for (int q = vcu; q < 128; q += G) { __syncthreads(); p4_rwkv_seq(args, lds, q, wave, lane); }
        p3_attention(args, lds, tid, wave, lane);
    }
#if defined(REP_PHASE)
    if constexpr (REP_PHASE == 4) { __syncthreads();
    if constexpr (IN(4)) { PH_IDS;
        for (int q = vcu; q < 128; q += G) { __syncthreads(); p4_rwkv_seq(args, lds, q, wave, lane); }
        p3_attention(args, lds, tid, wave, lane);
    }
    }
#endif
    SEAM(4);
    if constexpr (IN(5)) { PH_IDS; p5_rwkv_final(args, vcu, G, wave, lane); }
#if defined(REP_PHASE)
    if constexpr (REP_PHASE == 5) { __syncthreads();
    if constexpr (IN(5)) { PH_IDS; p5_rwkv_final(args, vcu, G, wave, lane); }
    }
#endif
    SEAM(5);
    if constexpr (IN(6)) { PH_IDS;
        LAS int* tl = (LAS int*)(lds + 131072 + 2048); __syncthreads(); if (tid < NTOK / 256) tl[tid] = 0; __syncthreads();
        pg8::Gemm g{(const bf16*)(ws + WS_MIX), (const bf16*)(ws + WS_WO), NTOK, D, D / 2};
        pg8::MoeOrder<true> S{tl, nullptr, NTOK / 256, D / 256, G, bx};
        pg8::EpiResBf16 E{(bf16*)(ws + WS_Z1), (const bf16*)(ws + WS_H0), D, ALPHA};
        pg8::gemm_phase<pg8::EpiResBf16, pg8::MoeOrder<true>, true, true>(lds, g, S, E);
    }
#if defined(REP_PHASE)
    if constexpr (REP_PHASE == 6) { __syncthreads();
    if constexpr (IN(6)) { PH_IDS;
        LAS int* tl = (LAS int*)(lds + 131072 + 2048); __syncthreads(); if (tid < NTOK / 256) tl[tid] = 0; __syncthreads();
        pg8::Gemm g{(const bf16*)(ws + WS_MIX), (const bf16*)(ws + WS_WO), NTOK, D, D / 2};
        pg8::MoeOrder<true> S{tl, nullptr, NTOK / 256, D / 256, G, bx};
        pg8::EpiResBf16 E{(bf16*)(ws + WS_Z1), (const bf16*)(ws + WS_H0), D, ALPHA};
        pg8::gemm_phase<pg8::EpiResBf16, pg8::MoeOrder<true>, true, true>(lds, g, S, E);
    }
    }
#endif
    SEAM(6);
    if constexpr (IN(7)) { PH_IDS; p5_ln_router(args, lds, vcu, G, tid, wave, lane); }
#if defined(REP_PHASE)
    if constexpr (REP_PHASE == 7) { __syncthreads();
    if constexpr (IN(7)) { PH_IDS; p5_ln_router(args, lds, vcu, G, tid, wave, lane); }
    }
#endif
    SEAM(7);
    if constexpr (IN(8)) { PH_IDS; p6_positions(args, lds, vcu, G, tid); }
#if defined(REP_PHASE)
    if constexpr (REP_PHASE == 8) { __syncthreads();
    if constexpr (IN(8)) { PH_IDS; p6_positions(args, lds, vcu, G, tid); }
    }
#endif
    SEAM(8);
    if constexpr (IN(9)) { PH_IDS;
        const int* TILE = (const int*)(ws + RT_TILE); const int ntiles = __builtin_amdgcn_readfirstlane(TILE[MAXT]);
        LAS int* tl = (LAS int*)(lds + 131072 + 2048); __syncthreads(); for (int i = tid; i < MAXT; i += NTHR) tl[i] = TILE[i]; __syncthreads();
        pg8::Gemm g{(const bf16*)(ws + WS_H1Q), (const bf16*)(ws + WS_W1), CAP, NE * 4096, D / 2};
        pg8::MoeOrder<true> S{tl, (const int*)(ws + RT_TOK), ntiles, 16, G, bx};
        pg8::EpiSwiglu E{ws + WS_ACT, args.in[26], {}, {}};
        pg8::gemm_phase<pg8::EpiSwiglu, pg8::MoeOrder<true>, true, true>(lds, g, S, E);
    }
#if defined(REP_PHASE)
    if constexpr (REP_PHASE == 9) { __syncthreads();
    if constexpr (IN(9)) { PH_IDS;
        const int* TILE = (const int*)(ws + RT_TILE); const int ntiles = __builtin_amdgcn_readfirstlane(TILE[MAXT]);
        LAS int* tl = (LAS int*)(lds + 131072 + 2048); __syncthreads(); for (int i = tid; i < MAXT; i += NTHR) tl[i] = TILE[i]; __syncthreads();
        pg8::Gemm g{(const bf16*)(ws + WS_H1Q), (const bf16*)(ws + WS_W1), CAP, NE * 4096, D / 2};
        pg8::MoeOrder<true> S{tl, (const int*)(ws + RT_TOK), ntiles, 16, G, bx};
        pg8::EpiSwiglu E{ws + WS_ACT, args.in[26], {}, {}};
        pg8::gemm_phase<pg8::EpiSwiglu, pg8::MoeOrder<true>, true, true>(lds, g, S, E);
    }
    }
#endif
    SEAM(9);
    if constexpr (IN(10)) { PH_IDS;
        const int* TILE = (const int*)(ws + RT_TILE); const int ntiles = __builtin_amdgcn_readfirstlane(TILE[MAXT]);
        LAS int* tl = (LAS int*)(lds + 131072 + 2048); __syncthreads(); for (int i = tid; i < MAXT; i += NTHR) tl[i] = TILE[i]; __syncthreads();
        pg8::Gemm g{(const bf16*)(ws + WS_ACT), (const bf16*)(ws + WS_W2), CAP, NE * D, D / 2};
        pg8::MoeOrder<true> S{tl, nullptr, ntiles, 8, G, bx};
        pg8::EpiGate E{ws + WS_Y, args.in[28], (const float*)(ws + RT_GATE), {}, {}};
        pg8::gemm_phase<pg8::EpiGate, pg8::MoeOrder<true>, true, true>(lds, g, S, E);
    }
#if defined(REP_PHASE)
    if constexpr (REP_PHASE == 10) { __syncthreads();
    if constexpr (IN(10)) { PH_IDS;
        const int* TILE = (const int*)(ws + RT_TILE); const int ntiles = __builtin_amdgcn_readfirstlane(TILE[MAXT]);
        LAS int* tl = (LAS int*)(lds + 131072 + 2048); __syncthreads(); for (int i = tid; i < MAXT; i += NTHR) tl[i] = TILE[i]; __syncthreads();
        pg8::Gemm g{(const bf16*)(ws + WS_ACT), (const bf16*)(ws + WS_W2), CAP, NE * D, D / 2};
        pg8::MoeOrder<true> S{tl, nullptr, ntiles, 8, G, bx};
        pg8::EpiGate E{ws + WS_Y, args.in[28], (const float*)(ws + RT_GATE), {}, {}};
        pg8::gemm_phase<pg8::EpiGate, pg8::MoeOrder<true>, true, true>(lds, g, S, E);
    }
    }
#endif
    SEAM(10);
    if constexpr (IN(11)) { PH_IDS; p9_final(args, vcu, G, wave, lane); }
#if defined(REP_PHASE)
    if constexpr (REP_PHASE == 11) { __syncthreads();
    if constexpr (IN(11)) { PH_IDS; p9_final(args, vcu, G, wave, lane); }
    }
#endif
#undef IN
#undef SEAM
}

template <int P> static void launch_phase(int grid, hipStream_t stream, const Args& a) {
    static bool init = false;
    if (!init) { (void)hipFuncSetAttribute((const void*)fwd_kernel<P, P + 1>, hipFuncAttributeMaxDynamicSharedMemorySize, LDS_BYTES); init = true; }
    hipLaunchKernelGGL((fwd_kernel<P, P + 1>), dim3(grid), dim3(NTHR), LDS_BYTES, stream, a);
}
extern "C" void kernel_launch(void* const* d_in, const int* in_sizes, int n_in, void* d_out, int out_size, void* d_ws, size_t ws_size, hipStream_t stream) {
    static int grid = 0;
    if (grid == 0) {
        if (n_in != 31 || out_size != NTOK * D || ws_size < WS_END) { fprintf(stderr, "kernel_launch: unexpected shapes (n_in %d out %d ws %zu, need %zu)\n", n_in, out_size, ws_size, (size_t)WS_END); grid = -1; return; }
        int dev = 0, cus = 0;
        if (hipGetDevice(&dev) != hipSuccess || hipDeviceGetAttribute(&cus, hipDeviceAttributeMultiprocessorCount, dev) != hipSuccess) { grid = -1; return; }
        grid = cus;
    }
    if (grid < 0) return;
    (void)hipMemsetAsync((char*)d_ws + WS_CTL, 0, CTL_ZERO_BYTES, stream);
    Args a{};
    for (int i = 0; i < 31; ++i) a.in[i] = (const float*)d_in[i];
    a.out = (float*)d_out; a.ws = (unsigned char*)d_ws;
#ifdef ONE_LAUNCH
    { static bool init = false; if (!init) { (void)hipFuncSetAttribute((const void*)fwd_kernel<0, NPH>, hipFuncAttributeMaxDynamicSharedMemorySize, LDS_BYTES); init = true; }
      hipLaunchKernelGGL((fwd_kernel<0, NPH>), dim3(grid), dim3(NTHR), LDS_BYTES, stream, a); }
#else
    launch_phase<0>(grid, stream, a); launch_phase<1>(grid, stream, a); launch_phase<2>(grid, stream, a); launch_phase<3>(grid, stream, a);
    launch_phase<4>(grid, stream, a); launch_phase<5>(grid, stream, a); launch_phase<6>(grid, stream, a); launch_phase<7>(grid, stream, a);
    launch_phase<8>(grid, stream, a); launch_phase<9>(grid, stream, a); launch_phase<10>(grid, stream, a); launch_phase<11>(grid, stream, a);
#endif
}
```

```cpp
#define ONE_LAUNCH 1
#include <hip/hip_runtime.h>
#include <cstdio>
#include <cstdint>

namespace pg8 {
#define PG8_LAS __attribute__((address_space(3)))
typedef unsigned short bf16_t;
typedef short bf16x8 __attribute__((ext_vector_type(8)));
typedef float f32x4 __attribute__((ext_vector_type(4)));
typedef unsigned u32x4 __attribute__((ext_vector_type(4)));
typedef unsigned u32x2 __attribute__((ext_vector_type(2)));
typedef int v4i32 __attribute__((ext_vector_type(4)));
typedef int v8i32 __attribute__((ext_vector_type(8)));
constexpr int SCALE_W = 0x79797979, SCALE_A = 0x7f7f7f7f;
constexpr int BM = 256, BK = 64, HALF = 128, HTB = HALF * BK * 2  , STAGE_BYTES = 8 * HTB, NXCD = 8, WGM = 8;

__host__ __device__ __forceinline__ int lds_byte(int r, int c) { const int st = (r >> 4) * 2 + (c >> 5), rr = r & 15, cc = c & 31, ob = rr * 64 + cc * 2; return st * 1024 + (ob ^ (((ob >> 9) & 1) << 5)); }
__host__ __device__ __forceinline__ void stage_rc(int b, int& R, int& C) { const int st = b / 1024, sb = b % 1024, swz = sb ^ (((sb >> 9) & 1) << 5); R = (st >> 1) * 16 + swz / 64; C = (st & 1) * 32 + (swz % 64) / 2; }
__host__ __device__ __forceinline__ int perm32(int rho) { const int n = rho >> 4, i = rho & 15; return 8 * (i >> 2) + 4 * n + (i & 3); }

struct Unit { int pm, pn; };
struct Gemm { const bf16_t* A; const bf16_t* Bt; int M, N, K; };

struct StaticOrder {
    int nM, nN, nwg, G, c;
    __host__ __device__ void init(int M, int N, int G_, int c_) { nM = M / BM; nN = N / BM; nwg = nM * nN; G = G_; c = c_; }
    __host__ __device__ bool next(int i, Unit& u) const {
        const long L = (long)i * G + c; if (L >= nwg) return false;
        int wgid = (int)L; { const int q = nwg / NXCD, r = nwg % NXCD, xcd = wgid % NXCD, off = wgid / NXCD; wgid = (xcd < r ? xcd * (q + 1) : r * (q + 1) + (xcd - r) * q) + off; }
        const int nig = WGM * nN, gid = wgid / nig, fm = gid * WGM, gsz = (nM - fm) < WGM ? (nM - fm) : WGM;
        u.pm = fm + ((wgid % nig) % gsz); u.pn = (wgid % nig) / gsz; return true;
    }
    static constexpr bool GATHER = false;
    __device__ __forceinline__ int arow(const Unit& u, int r) const { return u.pm * BM + r; }
};
struct QueueOrder {
    int nM, nN, nwg, x; unsigned* qhead; volatile PG8_LAS int* slot; mutable int pend;
    __device__ void init(int M, int N, int x_, unsigned* q_, volatile PG8_LAS int* s_, int pend_) { nM = M / BM; nN = N / BM; nwg = nM * nN; x = x_; qhead = q_; slot = s_; pend = pend_; }
    __device__ __forceinline__ int pop() const { return 8 * (int)__hip_atomic_fetch_add(qhead + 64 * x, 1u, __ATOMIC_RELAXED, __HIP_MEMORY_SCOPE_AGENT) + x; }
    __device__ __forceinline__ bool next(int i, Unit& u) const {
        const int L = __builtin_amdgcn_readfirstlane(slot[i % 3]);
        if (threadIdx.x == 0) { slot[(i + 2) % 3] = pend; pend = pop(); }
        if (L >= nwg) return false;
        int wgid = L; { const int q = nwg / NXCD, r = nwg % NXCD, xcd = wgid % NXCD, off = wgid / NXCD; wgid = (xcd < r ? xcd * (q + 1) : r * (q + 1) + (xcd - r) * q) + off; }
        const int nig = WGM * nN, gid = wgid / nig, fm = gid * WGM, gsz = (nM - fm) < WGM ? (nM - fm) : WGM;
        u.pm = fm + ((wgid % nig) % gsz); u.pn = (wgid % nig) / gsz; return true;
    }
    static constexpr bool GATHER = false;
    __device__ __forceinline__ int arow(const Unit& u, int r) const { return u.pm * BM + r; }
};
template <bool GATHER_> struct MoeOrder {
    static constexpr bool GATHER = GATHER_;
    const PG8_LAS int* tile_e; const int* tok; int ntiles, ncol, G, c;
    __device__ __forceinline__ bool next(int i, Unit& u) const {
        int rt, ct;
        if ((G & 7) == 0 && ((G >> 3) % ncol) == 0) {
            const int R = G / ncol, x = c & 7, j = c >> 3;
            rt = i * R + x * (R >> 3) + j / ncol; ct = j % ncol; if (rt >= ntiles) return false;
        } else { const long L = (long)i * G + c; if (L >= (long)ntiles * ncol) return false; rt = (int)(L / ncol); ct = (int)(L % ncol); }
        u.pm = rt; u.pn = __builtin_amdgcn_readfirstlane(tile_e[rt]) * ncol + ct; return true;
    }
    __device__ __forceinline__ int arow(const Unit& u, int r) const { return (GATHER_ && tok) ? tok[u.pm * BM + r] : u.pm * BM + r; }
};

typedef float f32x2_t __attribute__((ext_vector_type(2))); typedef __bf16 bf16x2_t __attribute__((ext_vector_type(2)));
__device__ __forceinline__ unsigned cvt_pk_bf16(float lo, float hi) { const f32x2_t v = {lo, hi}; const bf16x2_t b = __builtin_convertvector(v, bf16x2_t); return __builtin_bit_cast(unsigned, b); }
__device__ __forceinline__ float bf_lo(unsigned w) { return __builtin_bit_cast(float, w << 16); }
__device__ __forceinline__ float bf_hi(unsigned w) { return __builtin_bit_cast(float, w & 0xffff0000u); }

__device__ __forceinline__ unsigned pk4_fp8(float a, float b, float c, float d) { unsigned w = 0u; w = __builtin_amdgcn_cvt_pk_fp8_f32(a, b, w, false); w = __builtin_amdgcn_cvt_pk_fp8_f32(c, d, w, true); return w; }
template <class T> __device__ __forceinline__ T* sbase(T* p) { asm volatile("" : "+s"(p)); return p; }
__device__ __forceinline__ unsigned vopaque(unsigned v) { asm volatile("" : "+v"(v)); return v; }
struct EpiBf16 {
    static constexpr bool PERM = true;
    bf16_t* O; int ldc;
    __device__ __forceinline__ void pre(const Unit&, int, int, int, int) const {}
    __device__ __forceinline__ void operator()(const f32x4 (&acc)[2][2][4][2], const Unit& u, int wr, int wc, int fr, int fq) const {
        const unsigned lo = vopaque(((unsigned)(wr * 64 + fr) * (unsigned)ldc + (unsigned)(wc * 32 + 8 * fq)) * 2u);
#pragma unroll
        for (int ai = 0; ai < 2; ++ai)
#pragma unroll
            for (int m = 0; m < 4; ++m) { char* rb = (char*)sbase(O + (size_t)(u.pm * BM + ai * HALF + m * 16) * ldc + u.pn * BM);
#pragma unroll
                for (int bj = 0; bj < 2; ++bj) { const f32x4 v0 = acc[ai][bj][m][0], v1 = acc[ai][bj][m][1];
                    u32x4 w; w.x = cvt_pk_bf16(v0[0], v0[1]); w.y = cvt_pk_bf16(v0[2], v0[3]); w.z = cvt_pk_bf16(v1[0], v1[1]); w.w = cvt_pk_bf16(v1[2], v1[3]);
                    *(u32x4*)(rb + bj * HALF * 2 + lo) = w; } }
    }
};
struct EpiResBf16 {
    static constexpr bool PERM = true;
    bf16_t* C; const bf16_t* R; int ldc; float alpha;
    __device__ __forceinline__ void pre(const Unit&, int, int, int, int) const {}
    __device__ __forceinline__ void operator()(const f32x4 (&acc)[2][2][4][2], const Unit& u, int wr, int wc, int fr, int fq) const {
        const unsigned lo = vopaque(((unsigned)(wr * 64 + fr) * (unsigned)ldc + (unsigned)(wc * 32 + 8 * fq)) * 2u);
#pragma unroll
        for (int ai = 0; ai < 2; ++ai)
#pragma unroll
            for (int m = 0; m < 4; ++m) { const size_t ro = (size_t)(u.pm * BM + ai * HALF + m * 16) * ldc + u.pn * BM; char* cb = (char*)sbase(C + ro); const char* rb = (const char*)sbase(R + ro);
#pragma unroll
                for (int bj = 0; bj < 2; ++bj) { const u32x4 rr = *(const u32x4*)(rb + bj * HALF * 2 + lo); const f32x4 v0 = acc[ai][bj][m][0], v1 = acc[ai][bj][m][1];
                    u32x4 w; w.x = cvt_pk_bf16(v0[0] + alpha * bf_lo(rr.x), v0[1] + alpha * bf_hi(rr.x)); w.y = cvt_pk_bf16(v0[2] + alpha * bf_lo(rr.y), v0[3] + alpha * bf_hi(rr.y));
                    w.z = cvt_pk_bf16(v1[0] + alpha * bf_lo(rr.z), v1[1] + alpha * bf_hi(rr.z)); w.w = cvt_pk_bf16(v1[2] + alpha * bf_lo(rr.w), v1[3] + alpha * bf_hi(rr.w));
                    *(u32x4*)(cb + bj * HALF * 2 + lo) = w; }
                if (m & 1) asm volatile("" ::: "memory"); }
    }
};
struct EpiSwiglu {
    static constexpr bool PERM = true;
    unsigned char* O; const float* b1;
    mutable f32x4 vg[2], vl[2];
    __device__ __forceinline__ void pre(const Unit& u, int wr, int wc, int fr, int fq) const {
        const int e = u.pn >> 4, ct = u.pn & 15; const unsigned lc = vopaque((unsigned)(wc * 32 + 8 * fq));
        const char* bg = (const char*)sbase(b1 + (size_t)e * 4096 + ct * 128); const char* bl = (const char*)sbase(b1 + (size_t)e * 4096 + 2048 + ct * 128);
#pragma unroll
        for (int n = 0; n < 2; ++n) { vg[n] = *(const f32x4*)(bg + n * 16 + lc * 4u); vl[n] = *(const f32x4*)(bl + n * 16 + lc * 4u); }
    }
    __device__ __forceinline__ void operator()(const f32x4 (&acc)[2][2][4][2], const Unit& u, int wr, int wc, int fr, int fq) const {
        const int ct = u.pn & 15;
        const unsigned lo2 = vopaque(((unsigned)(wr * 64 + fr) + 16u * (unsigned)(fq & 1)) * 2048u + (unsigned)(wc * 32 + 16 * (fq >> 1)));
#pragma unroll
        for (int ai = 0; ai < 2; ++ai)
#pragma unroll
            for (int mp = 0; mp < 2; ++mp) { unsigned char* rb = sbase(O + (size_t)(u.pm * BM + ai * HALF + mp * 32) * 2048 + ct * 128);
                unsigned px[2], py[2];
#pragma unroll
                for (int q = 0; q < 2; ++q) { const int m = 2 * mp + q; float a[8];
#pragma unroll
                    for (int n = 0; n < 2; ++n)
#pragma unroll
                        for (int i = 0; i < 4; ++i) { float g = acc[ai][0][m][n][i] + vg[n][i], l = acc[ai][1][m][n][i] + vl[n][i];
                            g = fminf(g, 7.0f); l = fminf(fmaxf(l, -7.0f), 7.0f);
                            const float sg = __builtin_amdgcn_rcpf(1.0f + __builtin_amdgcn_exp2f(-1.702f * 1.4426950408889634f * g));
                            a[n * 4 + i] = (l + 1.0f) * g * sg; }
                    px[q] = pk4_fp8(a[0], a[1], a[2], a[3]); py[q] = pk4_fp8(a[4], a[5], a[6], a[7]); }
                const auto sx = __builtin_amdgcn_permlane16_swap(px[0], px[1], false, false); const auto sy = __builtin_amdgcn_permlane16_swap(py[0], py[1], false, false);
                u32x4 w; w.x = sx[0]; w.y = sy[0]; w.z = sx[1]; w.w = sy[1];
                *(u32x4*)(rb + lo2) = w; }
    }
};
struct EpiGate {
    static constexpr bool PERM = true;
    unsigned char* O; const float* b2; const float* gate;
    mutable float gtv[8]; mutable f32x4 cb[2][2];
    __device__ __forceinline__ void pre(const Unit& u, int wr, int wc, int fr, int fq) const {
        const int e = u.pn >> 3, ct = u.pn & 7; const unsigned lr = vopaque((unsigned)(wr * 64 + fr)), lc = vopaque((unsigned)(wc * 32 + 8 * fq));
        const char* bb = (const char*)sbase(b2 + (size_t)e * 2048 + ct * 256);
#pragma unroll
        for (int bj = 0; bj < 2; ++bj) { cb[bj][0] = *(const f32x4*)(bb + bj * HALF * 4 + lc * 4u); cb[bj][1] = *(const f32x4*)(bb + bj * HALF * 4 + 16 + lc * 4u); }
#pragma unroll
        for (int q = 0; q < 8; ++q) gtv[q] = *(const float*)((const char*)sbase(gate + u.pm * BM + (q >> 2) * HALF + (q & 3) * 16) + lr * 4u);
    }
    __device__ __forceinline__ void operator()(const f32x4 (&acc)[2][2][4][2], const Unit& u, int wr, int wc, int fr, int fq) const {
        const int ct = u.pn & 7;
        const unsigned lr = vopaque((unsigned)(wr * 64 + fr)), lc = vopaque((unsigned)(wc * 32 + 8 * fq)), lo = lr * 2048u + lc;
        const unsigned lo2 = vopaque((lr + 16u * (unsigned)(fq & 1)) * 2048u + (unsigned)(wc * 32 + 16 * (fq >> 1)));
#pragma unroll
        for (int ai = 0; ai < 2; ++ai)
#pragma unroll
            for (int mp = 0; mp < 2; ++mp) { const int rg = u.pm * BM + ai * HALF + mp * 32; const float gt0 = 64.0f * gtv[ai * 4 + 2 * mp], gt1 = 64.0f * gtv[ai * 4 + 2 * mp + 1];
                unsigned char* rb = sbase(O + (size_t)rg * 2048 + ct * 256);
#pragma unroll
                for (int bj = 0; bj < 2; ++bj) { const f32x4 c0 = cb[bj][0], c1 = cb[bj][1];
                    const f32x4 a0 = (acc[ai][bj][2 * mp][0] + c0) * gt0, a1 = (acc[ai][bj][2 * mp][1] + c1) * gt0, b0 = (acc[ai][bj][2 * mp + 1][0] + c0) * gt1, b1 = (acc[ai][bj][2 * mp + 1][1] + c1) * gt1;
                    const unsigned ax = pk4_fp8(a0[0], a0[1], a0[2], a0[3]), ay = pk4_fp8(a1[0], a1[1], a1[2], a1[3]), bx = pk4_fp8(b0[0], b0[1], b0[2], b0[3]), by = pk4_fp8(b1[0], b1[1], b1[2], b1[3]);
                    const auto sx = __builtin_amdgcn_permlane16_swap(ax, bx, false, false); const auto sy = __builtin_amdgcn_permlane16_swap(ay, by, false, false);
                    u32x4 w; w.x = sx[0]; w.y = sy[0]; w.z = sx[1]; w.w = sy[1];
                    *(u32x4*)(rb + bj * HALF + lo2) = w; } }
    }
};

template <class Epi, class Sched, bool ALIGN_EPI = true, bool FP8 = false>
__device__ __forceinline__ void gemm_phase(PG8_LAS unsigned char* lds, const Gemm g, const Sched& S, const Epi& E) {
    int tid = threadIdx.x; asm volatile("" : "+v"(tid));
    const int wid = __builtin_amdgcn_readfirstlane(tid >> 6), lane = tid & 63, wr = wid >> 2, wc = wid & 3, fr = lane & 15, fq = lane >> 4;
    const int K = g.K, nt = K / BK;
    int RA[2]; unsigned cA2[2], voffB[2];
#pragma unroll
    for (int i = 0; i < 2; ++i) { int R, C; stage_rc(tid * 16 + i * 8192, R, C); const int Rb = Epi::PERM ? ((R & ~31) + perm32(R & 31)) : R;
        RA[i] = R; cA2[i] = (unsigned)C * 2u; voffB[i] = (unsigned)(Rb * K + C) * 2u; }
    const size_t kstep = (size_t)(BK * 2);
    const size_t hstep = (size_t)HALF * K * 2;
    const size_t tstep = 2 * hstep;
    const unsigned ldsw = (unsigned)wid * 1024u;
    const int aoff = lds_byte(wr * 64 + fr, fq * 8), boff = lds_byte(wc * 32 + fr, fq * 8);
#define PG8_SA(b, h) (((b) * 2 + (h)) * HTB)
#define PG8_SB(b, h) ((4 + (b) * 2 + (h)) * HTB)
#define PG8_STAGE(bufoff, gbase, voff) do { const char* _gb = (const char*)(gbase); asm volatile("" : "+s"(_gb)); _Pragma("unroll") for (int _i = 0; _i < 2; ++_i) { \
        unsigned _vo = (voff)[_i]; asm volatile("" : "+v"(_vo));     \
        __builtin_amdgcn_global_load_lds((const unsigned*)(_gb + _vo), (PG8_LAS unsigned*)(lds + (bufoff) + ldsw + _i * 8192), 16, 0, 0); } } while (0)
#define PG8_LD32(p) __builtin_shufflevector(*(const PG8_LAS v4i32*)(p), *(const PG8_LAS v4i32*)((p) + 1024), 0, 1, 2, 3, 4, 5, 6, 7)
#define PG8_LDA(dst, b, h) do { _Pragma("unroll") for (int m = 0; m < 4; ++m) dst[m] = PG8_LD32(lds + PG8_SA(b, h) + aoff + m * 2048); } while (0)
#define PG8_LDB(dst, b, h) do { _Pragma("unroll") for (int n = 0; n < 2; ++n) dst[n] = PG8_LD32(lds + PG8_SB(b, h) + boff + n * 2048); } while (0)
#define PG8_H0(x) __builtin_bit_cast(bf16x8, __builtin_shufflevector(x, x, 0, 1, 2, 3))
#define PG8_H1(x) __builtin_bit_cast(bf16x8, __builtin_shufflevector(x, x, 4, 5, 6, 7))
#define PG8_MMA(ai, bj, At, Bt) do { __builtin_amdgcn_s_setprio(1); _Pragma("unroll") for (int m = 0; m < 4; ++m) _Pragma("unroll") for (int n = 0; n < 2; ++n) { \
        if constexpr (FP8) acc[ai][bj][m][n] = __builtin_amdgcn_mfma_scale_f32_16x16x128_f8f6f4(Bt[n], At[m], acc[ai][bj][m][n], 0, 0, 0, SCALE_W, 0, SCALE_A); \
        else { acc[ai][bj][m][n] = __builtin_amdgcn_mfma_f32_16x16x32_bf16(PG8_H0(Bt[n]), PG8_H0(At[m]), acc[ai][bj][m][n], 0, 0, 0); \
               acc[ai][bj][m][n] = __builtin_amdgcn_mfma_f32_16x16x32_bf16(PG8_H1(Bt[n]), PG8_H1(At[m]), acc[ai][bj][m][n], 0, 0, 0); } } \
        __builtin_amdgcn_s_setprio(0); } while (0)
#define PG8_WAIT_V(n) asm volatile("s_waitcnt vmcnt(" #n ")" ::: "memory")
#define PG8_WAIT_L(n) asm volatile("s_waitcnt lgkmcnt(" #n ")" ::: "memory")
#define PG8_BAR __builtin_amdgcn_s_barrier()
#define PG8_SCHED __builtin_amdgcn_sched_barrier(0)
#define PG8_AOFF(dst, u) do { _Pragma("unroll") for (int _h = 0; _h < 2; ++_h) _Pragma("unroll") for (int _i = 0; _i < 2; ++_i) \
        dst[_h][_i] = (unsigned)S.arow(u, _h * HALF + RA[_i]) * (unsigned)(K * 2) + cA2[_i]; } while (0)
    Unit cur, nxt; int ui = 0;
    if (!S.next(0, cur)) return;
    constexpr bool GA = Sched::GATHER;
    unsigned offC[2][2], offN[2][2];
    const char* gA = (const char*)g.A; const char* nA = gA;
    int rawN[2][2]; Unit nn; bool has_nn = false;
#define PG8_ARAW(dst, u) do { _Pragma("unroll") for (int _h = 0; _h < 2; ++_h) _Pragma("unroll") for (int _i = 0; _i < 2; ++_i) dst[_h][_i] = S.arow(u, _h * HALF + RA[_i]); } while (0)
    if constexpr (GA) { PG8_AOFF(offC, cur); has_nn = S.next(1, nn); if (has_nn) PG8_ARAW(rawN, nn); asm volatile("s_waitcnt vmcnt(0)" ::: "memory"); }
    else {
#pragma unroll
        for (int i = 0; i < 2; ++i) { offC[0][i] = (unsigned)RA[i] * (unsigned)(K * 2) + cA2[i]; offC[1][i] = offC[0][i] + (unsigned)hstep; }
        gA += (size_t)cur.pm * tstep; }
    E.pre(cur, wr, wc, fr, fq);
    f32x4 acc[2][2][4][2];
#pragma unroll
    for (int a = 0; a < 2; ++a)
#pragma unroll
        for (int b = 0; b < 2; ++b)
#pragma unroll
            for (int m = 0; m < 4; ++m)
#pragma unroll
                for (int n = 0; n < 2; ++n) acc[a][b][m][n] = (f32x4){0.f, 0.f, 0.f, 0.f};
    v8i32 At[4], B0[2], B1[2];
    const char* cB = (const char*)g.Bt + (size_t)cur.pn * tstep;
    PG8_STAGE(PG8_SB(0, 0), cB, voffB); PG8_STAGE(PG8_SB(0, 1), cB + hstep, voffB); PG8_STAGE(PG8_SA(0, 0), gA, offC[0]); PG8_STAGE(PG8_SA(0, 1), gA, offC[1]);
    if (wr == 1) PG8_BAR;
    PG8_WAIT_V(2); PG8_BAR;
    PG8_STAGE(PG8_SB(1, 0), cB + kstep, voffB); PG8_STAGE(PG8_SA(1, 0), gA + kstep, offC[0]); PG8_STAGE(PG8_SB(1, 1), cB + hstep + kstep, voffB);
    PG8_WAIT_V(6); PG8_BAR;
    for (;;) {
        bool has_next;
        if constexpr (GA) {
            has_next = has_nn; nxt = nn;
#pragma unroll
            for (int h = 0; h < 2; ++h)
#pragma unroll
                for (int i = 0; i < 2; ++i) offN[h][i] = has_next ? (unsigned)rawN[h][i] * (unsigned)(K * 2) + cA2[i] : offC[h][i];
            has_nn = S.next(ui + 2, nn); if (has_nn) PG8_ARAW(rawN, nn);
        } else { has_next = S.next(ui + 1, nxt); nA = has_next ? (const char*)g.A + (size_t)nxt.pm * tstep : gA; }
        const char* nB = has_next ? (const char*)g.Bt + (size_t)nxt.pn * tstep : cB;
        for (int t = 0; t < nt; t += 2) {
            const bool last = (t == nt - 2);
            const char* a1 = gA + (size_t)(t + 1) * kstep;
            const char* a2 = last ? nA : gA + (size_t)(t + 2) * kstep; const char* b2 = last ? nB : cB + (size_t)(t + 2) * kstep;
            const char* a3 = a2 + kstep; const char* b3 = b2 + kstep;
            PG8_LDB(B0, 0, 0); PG8_LDB(B1, 0, 1); PG8_SCHED; PG8_LDA(At, 0, 0); PG8_STAGE(PG8_SA(1, 1), a1, offC[1]);
            if constexpr (GA) { if (last) {
#pragma unroll
                for (int h = 0; h < 2; ++h)
#pragma unroll
                    for (int i = 0; i < 2; ++i) offC[h][i] = offN[h][i]; } }
            PG8_WAIT_V(8); PG8_WAIT_L(0); PG8_BAR; PG8_MMA(0, 0, At, B0); PG8_MMA(0, 1, At, B1); PG8_BAR; PG8_SCHED;
            PG8_LDA(At, 0, 1); PG8_STAGE(PG8_SB(0, 0), b2, voffB); PG8_STAGE(PG8_SB(0, 1), b2 + hstep, voffB); PG8_STAGE(PG8_SA(0, 0), a2, offC[0]);
            PG8_WAIT_V(8); PG8_WAIT_L(0); PG8_BAR; PG8_MMA(1, 0, At, B0); PG8_MMA(1, 1, At, B1); PG8_BAR; PG8_SCHED;
            PG8_LDB(B0, 1, 0); PG8_LDB(B1, 1, 1); PG8_SCHED; PG8_LDA(At, 1, 0); PG8_STAGE(PG8_SA(0, 1), a2, offC[1]);
            PG8_WAIT_V(8); PG8_WAIT_L(0); PG8_BAR; PG8_MMA(0, 0, At, B0); PG8_MMA(0, 1, At, B1); PG8_BAR; PG8_SCHED;
            PG8_LDA(At, 1, 1); PG8_STAGE(PG8_SB(1, 0), b3, voffB); PG8_STAGE(PG8_SB(1, 1), b3 + hstep, voffB); PG8_STAGE(PG8_SA(1, 0), a3, offC[0]);
            PG8_WAIT_V(8); PG8_WAIT_L(0); PG8_BAR; PG8_MMA(1, 0, At, B0); PG8_MMA(1, 1, At, B1); PG8_BAR; PG8_SCHED;
        }
        if constexpr (ALIGN_EPI) { if (wr == 0) PG8_BAR; }
        E(acc, cur, wr, wc, fr, fq);
        if (!has_next) break;
#pragma unroll
        for (int a = 0; a < 2; ++a)
#pragma unroll
            for (int b = 0; b < 2; ++b)
#pragma unroll
                for (int m = 0; m < 4; ++m)
#pragma unroll
                    for (int n = 0; n < 2; ++n) acc[a][b][m][n] = (f32x4){0.f, 0.f, 0.f, 0.f};
        cur = nxt; cB = nB; ++ui; if constexpr (!GA) gA = nA;
        E.pre(cur, wr, wc, fr, fq);
        if constexpr (ALIGN_EPI) { if (wr == 1) PG8_BAR; }
    }
    PG8_WAIT_V(0);
    if constexpr (!ALIGN_EPI) { if (wr == 0) PG8_BAR; }
    PG8_BAR;
#undef PG8_SA
#undef PG8_SB
#undef PG8_STAGE
#undef PG8_LDA
#undef PG8_LDB
#undef PG8_LD32
#undef PG8_H0
#undef PG8_H1
#undef PG8_MMA
#undef PG8_WAIT_V
#undef PG8_WAIT_L
#undef PG8_BAR
#undef PG8_SCHED
#undef PG8_AOFF
#undef PG8_ARAW
}
}
#define GAS __attribute__((address_space(1)))
#define LAS __attribute__((address_space(3)))
typedef unsigned short bf16;
typedef unsigned v4u __attribute__((ext_vector_type(4)));
typedef float f32x4 __attribute__((ext_vector_type(4)));
typedef short bf16x8 __attribute__((ext_vector_type(8)));
typedef GAS unsigned gu32;
typedef GAS unsigned long long gu64;
#define RLX_AGENT __ATOMIC_RELAXED, __HIP_MEMORY_SCOPE_AGENT
#define LDS_WAIT() asm volatile("s_waitcnt lgkmcnt(0)" ::: "memory")
#define VM_WAIT() asm volatile("s_waitcnt vmcnt(0)" ::: "memory")
__device__ __forceinline__ unsigned long long rt() { return __builtin_amdgcn_s_memrealtime(); }
__device__ __forceinline__ unsigned pk2(float lo, float hi) { return pg8::cvt_pk_bf16(lo, hi); }
__device__ __forceinline__ unsigned f2bf(float f) { return pg8::cvt_pk_bf16(f, 0.f) & 0xffffu; }

#define XB_TMO      128
#define XB_XCNT(j)  (256  + 64 * (j))
#define XB_XSUB(j)  (1280 + 64 * (j))
#define XB_XGEN(j)  (2304 + 64 * (j))
#define XB_TOP      3328
#define XB_TOPGEN   3392
#define XCD_BAR_WORDS 3456
#define XB_SPIN_CAP (1u << 18)

__device__ __forceinline__ unsigned xb_ld(unsigned* p)              { return __hip_atomic_load(p, __ATOMIC_RELAXED, __HIP_MEMORY_SCOPE_AGENT); }
__device__ __forceinline__ unsigned xb_add(unsigned* p, unsigned v) { return __hip_atomic_fetch_add(p, v, __ATOMIC_RELAXED, __HIP_MEMORY_SCOPE_AGENT); }
__device__ __forceinline__ unsigned xb_xcc_id() { return (unsigned)__builtin_amdgcn_s_getreg((3 << 11) | 20) & 0xFu; }
#define XB_SPIN(cond, bar) do { unsigned _sp = 0; while (cond) { __builtin_amdgcn_s_sleep(1); \
    if ((++_sp & 255u) == 0u) { if (xb_ld(&(bar)[XB_TMO])) break; if (_sp > XB_SPIN_CAP) { atomicAdd(&(bar)[XB_TMO], 1u); break; } } } } while (0)

struct XcdBarrier {
    unsigned* bar; unsigned x;
    volatile LAS unsigned* st;
};

__device__ __forceinline__ XcdBarrier xcd_barrier_post(unsigned* bar, volatile LAS unsigned* st) {
    XcdBarrier b; b.bar = bar; b.x = xb_xcc_id(); b.st = st;
    if (threadIdx.x == 0) (void)xb_add(&bar[XB_XCNT(b.x)], 1u);
    return b;
}
__device__ __forceinline__ void xcd_barrier_complete(unsigned* bar, unsigned x, unsigned& nloc, unsigned& nx) {
    const unsigned G = gridDim.x * gridDim.y * gridDim.z;
    unsigned sum, cnt, mine, sp = 0u;
    for (;;) {
        sum = 0u; cnt = 0u; mine = 0u;
#pragma unroll
        for (unsigned j = 0; j < 16; ++j) { const unsigned c = xb_ld(&bar[XB_XCNT(j)]); sum += c; cnt += (c > 0u) ? 1u : 0u; mine = (j == x) ? c : mine; }
        if (sum == G) break;
        __builtin_amdgcn_s_sleep(1);
        if ((++sp & 255u) == 0u) { if (xb_ld(&bar[XB_TMO])) break; if (sp > XB_SPIN_CAP) { atomicAdd(&bar[XB_TMO], 1u); break; } }
    }
    nloc = mine > 0u ? mine : 1u; nx = cnt > 0u ? cnt : 1u;
}

__device__ __forceinline__ void xcd_barrier(const XcdBarrier& b) {
    asm volatile("s_waitcnt vmcnt(0)" ::: "memory");
    __syncthreads();
    if (threadIdx.x == 0) {
        unsigned* bar = b.bar;
        __builtin_amdgcn_s_waitcnt(0);
        unsigned nloc = b.st[0], nx = b.st[1];
        if (nloc == 0u) { xcd_barrier_complete(bar, b.x, nloc, nx); b.st[0] = nloc; b.st[1] = nx; }
        const unsigned old = xb_add(&bar[XB_XSUB(b.x)], 1u);
        const unsigned gen = old / nloc;
        if (old + 1u == (gen + 1u) * nloc) {
            __builtin_amdgcn_fence(__ATOMIC_RELEASE, "agent");
            asm volatile("s_waitcnt vmcnt(0)" ::: "memory");
            const unsigned og = xb_add(&bar[XB_TOP], 1u);
            const unsigned tg = og / nx;
            if (og + 1u == (tg + 1u) * nx) xb_add(&bar[XB_TOPGEN], 1u);
            else XB_SPIN(xb_ld(&bar[XB_TOPGEN]) == tg, bar);
            __builtin_amdgcn_fence(__ATOMIC_ACQUIRE, "agent");
            xb_add(&bar[XB_XGEN(b.x)], 1u);
            asm volatile("s_waitcnt vmcnt(0)" ::: "memory");
        } else {
            XB_SPIN(xb_ld(&bar[XB_XGEN(b.x)]) == gen, bar);
            __builtin_amdgcn_fence(__ATOMIC_ACQUIRE, "agent");
            asm volatile("s_waitcnt vmcnt(0)" ::: "memory");
        }
    }
    __syncthreads();
}


constexpr int NB = 2, T = 16384, NTOK = NB * T, D = 2048;
constexpr int PW = 5632;
constexpr int C_R = 0, C_K = 1024, C_V = 2048, C_DW = 3072, C_DA = 3168, C_DG = 3264, C_FQ = 3520, C_FK = 4032, C_FV = 4544, C_FF = 5056, C_MQ = 5064, IN_W = 5576;
constexpr int NE = 32, CAP = 131072 + 8192, MAXT = CAP / 256;
constexpr int MEM_LEN = 256;
constexpr float LN_EPS = 1e-5f, GN_EPS = 64e-5f, ALPHA = 1.189207115002721f, LOG2E = 1.4426950408889634f;
constexpr int NWAVES = 8, NTHR = 512;

constexpr size_t MiB = 1u << 20;
constexpr size_t WS_CTL = 0, CTL_ZERO_BYTES = 1 * MiB;
constexpr size_t WS_WI = 2 * MiB, WS_WO = 24 * MiB, WS_WKV = 32 * MiB, WS_RWT = 36 * MiB, WS_MEMN = 37 * MiB, WS_KVM = 39 * MiB, WS_C = 40 * MiB  ;
constexpr size_t WS_ROUTE = 42 * MiB;
constexpr size_t RT_TOPI = WS_ROUTE, RT_TOPG = RT_TOPI + 512 * 1024, RT_POS = RT_TOPG + 512 * 1024, RT_CNT = RT_POS + 512 * 1024, RT_TOK = RT_CNT + 64 * 1024, RT_GATE = RT_TOK + 1024 * 1024, RT_TILE = RT_GATE + 1024 * 1024;
constexpr size_t WS_W1 = 48 * MiB, WS_W2 = 560 * MiB, WS_H0 = 816 * MiB, WS_H1 = 944 * MiB, WS_MIX = 1072 * MiB, WS_Z1 = 1200 * MiB, WS_P = 1456 * MiB;
constexpr size_t WS_RW = 1808 * MiB, RW_ARR = 128 * MiB;
constexpr size_t WS_ACT = 2960 * MiB, WS_Y = 3504 * MiB, WS_END = 4048 * MiB;
constexpr size_t WS_WLT = 46 * MiB;
constexpr size_t WS_H1Q = 304 * MiB;
constexpr size_t WS_FOXB = 47 * MiB;
constexpr float FOX_SKIP = 30.0f;
constexpr int CW_BAR = 4096;
constexpr int CW_KMAX = 2048;
constexpr int CW_QUEUE = 2112;
constexpr int CW_XQ = 2176;
constexpr int CW_A0Q = 2240;
constexpr int NG_INPROJ = 192;

constexpr int LDS_BYTES = 147456, MISC_OFF = LDS_BYTES - 256;

struct Args { const float* in[31]; float* out; unsigned char* ws; int ph_lo, ph_hi; };

__device__ __forceinline__ float wave_sum(float v) {
#pragma unroll
    for (int o = 1; o < 64; o <<= 1) v += __shfl_xor(v, o);
    return v;
}
__device__ __forceinline__ float bfl(unsigned w) { return __builtin_bit_cast(float, w << 16); }
__device__ __forceinline__ float bfh(unsigned w) { return __builtin_bit_cast(float, w & 0xffff0000u); }
__device__ __forceinline__ float bf1(bf16 h) { return __builtin_bit_cast(float, (unsigned)h << 16); }
__device__ __forceinline__ float sigmoidf_(float x) { return 1.0f / (1.0f + __expf(-x)); }

__device__ __forceinline__ void ln_row(f32x4 (&v)[8], const float* g, const float* b, float eps, int lane) {
    float s = 0.f;
#pragma unroll
    for (int j = 0; j < 8; ++j) s += (v[j].x + v[j].y) + (v[j].z + v[j].w);
    const float mean = wave_sum(s) * (1.f / D); float s2 = 0.f;
#pragma unroll
    for (int j = 0; j < 8; ++j) { v[j] = v[j] - mean; s2 += (v[j].x * v[j].x + v[j].y * v[j].y) + (v[j].z * v[j].z + v[j].w * v[j].w); }
    const float rstd = 1.f / sqrtf(wave_sum(s2) * (1.f / D) + eps);
#pragma unroll
    for (int j = 0; j < 8; ++j) { const f32x4 gg = *(const f32x4*)(g + 4 * lane + 256 * j), bb = *(const f32x4*)(b + 4 * lane + 256 * j); v[j] = v[j] * rstd * gg + bb; }
}
__device__ __forceinline__ void store_row_bf16(bf16* orow, const f32x4 (&v)[8], int lane) {
#pragma unroll
    for (int j = 0; j < 8; ++j) { pg8::u32x2 w; w.x = pk2(v[j].x, v[j].y); w.y = pk2(v[j].z, v[j].w); *(pg8::u32x2*)(orow + 4 * lane + 256 * j) = w; }
}

template <class RowMap>
__device__ __forceinline__ void transpose_item(const float* W, int ldw, int nvalid, int K, bf16* WT, const RowMap& rm, LAS float* scr, int k0, int n0, int lane) {
#pragma unroll 4
    for (int it = 0; it < 16; ++it) { const int k = 4 * it + (lane >> 4), nl = 4 * (lane & 15), n = n0 + nl;
        f32x4 v = (f32x4){0.f, 0.f, 0.f, 0.f}; if (n < nvalid) v = *(const f32x4*)(W + (size_t)(k0 + k) * ldw + n);
        LAS float* s = scr + k * 65 + nl; s[0] = v.x; s[1] = v.y; s[2] = v.z; s[3] = v.w; }
    LDS_WAIT(); asm volatile("" ::: "memory");
    const int c = lane & 7;
#pragma unroll
    for (int j = 0; j < 8; ++j) { const int nl = 8 * j + (lane >> 3); const LAS float* s = scr + (8 * c) * 65 + nl;
        v4u o; o.x = pk2(s[0 * 65], s[1 * 65]); o.y = pk2(s[2 * 65], s[3 * 65]); o.z = pk2(s[4 * 65], s[5 * 65]); o.w = pk2(s[6 * 65], s[7 * 65]);
        *(v4u*)(WT + (size_t)rm(n0 + nl) * K + k0 + 8 * c) = o; }
    LDS_WAIT(); asm volatile("" ::: "memory");
}
template <class RowMap>
__device__ __forceinline__ void transpose_item_fp8(const float* W, int ldw, int K, unsigned char* WT, const RowMap& rm, LAS float* scr, int k0, int n0, int lane) {
#pragma unroll 4
    for (int it = 0; it < 16; ++it) { const int k = 4 * it + (lane >> 4), nl = 4 * (lane & 15);
        const f32x4 v = *(const f32x4*)(W + (size_t)(k0 + k) * ldw + n0 + nl);
        LAS float* s = scr + k * 65 + nl; s[0] = v.x; s[1] = v.y; s[2] = v.z; s[3] = v.w; }
    LDS_WAIT(); asm volatile("" ::: "memory");
    const int c = lane & 3;
#pragma unroll
    for (int j = 0; j < 4; ++j) { const int nl = 16 * j + (lane >> 2); const LAS float* s = scr + (16 * c) * 65 + nl;
        v4u o; o.x = pg8::pk4_fp8(64.f * s[0 * 65], 64.f * s[1 * 65], 64.f * s[2 * 65], 64.f * s[3 * 65]); o.y = pg8::pk4_fp8(64.f * s[4 * 65], 64.f * s[5 * 65], 64.f * s[6 * 65], 64.f * s[7 * 65]);
        o.z = pg8::pk4_fp8(64.f * s[8 * 65], 64.f * s[9 * 65], 64.f * s[10 * 65], 64.f * s[11 * 65]); o.w = pg8::pk4_fp8(64.f * s[12 * 65], 64.f * s[13 * 65], 64.f * s[14 * 65], 64.f * s[15 * 65]);
        *(v4u*)(WT + (size_t)rm(n0 + nl) * K + k0 + 16 * c) = o; }
    LDS_WAIT(); asm volatile("" ::: "memory");
}
struct XItem { const float* W; unsigned char* WT; int ldw, k0, n0, rowoff, isw1; };
__device__ __forceinline__ XItem xitem(const Args& A, unsigned char* ws, int r) {
    XItem x; constexpr int I1 = 32 * 32 * 64;
    if (r < I1) { const int e = r >> 11, q = r & 2047; x.W = A.in[25] + (size_t)e * D * 4096; x.WT = ws + WS_W1; x.ldw = 4096; x.k0 = 64 * (q >> 6); x.n0 = 64 * (q & 63); x.rowoff = e * 4096; x.isw1 = 1; }
    else { const int r2 = r - I1, e = r2 >> 10, q = r2 & 1023; x.W = A.in[27] + (size_t)e * D * D; x.WT = ws + WS_W2; x.ldw = D; x.k0 = 64 * (q >> 5); x.n0 = 64 * (q & 31); x.rowoff = e * D; x.isw1 = 0; }
    return x;
}
__device__ __forceinline__ void xload(f32x4 (&v)[16], const XItem& x, int lane) {
#pragma unroll
    for (int it = 0; it < 16; ++it) v[it] = *(const f32x4*)(x.W + (size_t)(x.k0 + 4 * it + (lane >> 4)) * x.ldw + x.n0 + 4 * (lane & 15));
}
__device__ __forceinline__ void xstore(const f32x4 (&v)[16], const XItem& x, LAS float* scr, int lane) {
#pragma unroll
    for (int it = 0; it < 16; ++it) { LAS float* s = scr + (4 * it + (lane >> 4)) * 65 + 4 * (lane & 15); s[0] = v[it].x; s[1] = v[it].y; s[2] = v[it].z; s[3] = v[it].w; }
    LDS_WAIT(); asm volatile("" ::: "memory");
    const int c = lane & 3;
#pragma unroll
    for (int j = 0; j < 4; ++j) { const int nl = 16 * j + (lane >> 2), n = x.n0 + nl; const LAS float* s = scr + (16 * c) * 65 + nl;
        int row; if (x.isw1) { const int l = n >= 2048, cc = n - 2048 * l; row = (cc >> 7) * 256 + 128 * l + (cc & 127); } else row = n;
        v4u o; o.x = pg8::pk4_fp8(64.f * s[0 * 65], 64.f * s[1 * 65], 64.f * s[2 * 65], 64.f * s[3 * 65]); o.y = pg8::pk4_fp8(64.f * s[4 * 65], 64.f * s[5 * 65], 64.f * s[6 * 65], 64.f * s[7 * 65]);
        o.z = pg8::pk4_fp8(64.f * s[8 * 65], 64.f * s[9 * 65], 64.f * s[10 * 65], 64.f * s[11 * 65]); o.w = pg8::pk4_fp8(64.f * s[12 * 65], 64.f * s[13 * 65], 64.f * s[14 * 65], 64.f * s[15 * 65]);
        *(v4u*)(x.WT + (size_t)(x.rowoff + row) * D + x.k0 + 16 * c) = o; }
    LDS_WAIT(); asm volatile("" ::: "memory");
}
struct RmId { int off; __device__ __forceinline__ int operator()(int n) const { return off + n; } };
struct RmW1 { int off; __device__ __forceinline__ int operator()(int n) const { const int l = n >= 2048, c = n - 2048 * l; return off + (c >> 7) * 256 + 128 * l + (c & 127); } };

constexpr int I_XALL = 32 * 32 * 64 + 32 * 32 * 32;
__device__ __forceinline__ void conv_pull_loop(const Args& A, LAS unsigned char* lds, int tid, int wave, int lane) {
    unsigned char* ws = A.ws; unsigned* ctl = (unsigned*)(ws + WS_CTL); LAS float* scr = (LAS float*)(lds + wave * 16640); LAS int* qs = (LAS int*)(lds + 8 * 16640);
    for (;;) {
        __syncthreads();
        if (tid == 0) qs[0] = (int)__hip_atomic_fetch_add(ctl + CW_XQ, 16u, __ATOMIC_RELAXED, __HIP_MEMORY_SCOPE_AGENT);
        __syncthreads();
        const int base = qs[0]; if (base >= I_XALL) break;
        f32x4 va[16], vb[16]; const int i0 = base + wave, i1 = base + 8 + wave;
        const XItem xa = xitem(A, ws, min(i0, I_XALL - 1)), xb = xitem(A, ws, min(i1, I_XALL - 1));
        xload(va, xa, lane); xload(vb, xb, lane);
        if (i0 < I_XALL) xstore(va, xa, scr, lane);
        if (i1 < I_XALL) xstore(vb, xb, scr, lane);
    }
}
__device__ __forceinline__ void p0_prologue(const Args& A, LAS unsigned char* lds, int vcu, int G, int wave, int lane) {
    unsigned char* ws = A.ws;
    LAS float* scr = (LAS float*)(lds + wave * 16640);
    const int gw = vcu * NWAVES + wave, NGW = G * NWAVES;
    constexpr int I_WI = 32 * 88, I_WO = 32 * 32, I_WKV = 32 * 16;
    constexpr int NITEMS = I_WI + I_WO + I_WKV;
    for (int it = gw; it < NITEMS; it += NGW) {
        int r = it;
        if (r < I_WI) { transpose_item(A.in[4], IN_W, IN_W, D, (bf16*)(ws + WS_WI), RmId{0}, scr, 64 * (r / 88), 64 * (r % 88), lane); continue; } r -= I_WI;
        if (r < I_WO) { transpose_item_fp8(A.in[20], D, D, ws + WS_WO, RmId{0}, scr, 64 * (r / 32), 64 * (r % 32), lane); continue; } r -= I_WO;
        transpose_item(A.in[19], 1024, 1024, D, (bf16*)(ws + WS_WKV), RmId{0}, scr, 64 * (r / 16), 64 * (r % 16), lane);
    }
    { bf16* wlt = (bf16*)(ws + WS_WLT);
      for (int i = gw * 64 + lane; i < 1024 * 448; i += NGW * 64) { const int ch = i / 448, k = i % 448;
          const float v = k < 96 ? A.in[7][k * 1024 + ch] : (k < 192 ? A.in[9][(k - 96) * 1024 + ch] : A.in[10][(k - 192) * 1024 + ch]); wlt[i] = (bf16)f2bf(v); } }
    { bf16* rwf = (bf16*)(ws + WS_RWT); const float* rw = A.in[23];
      for (int i = gw * 64 + lane; i < 64 * 2 * 2 * 64 * 8; i += NGW * 64) { const int e = i & 7, ln = (i >> 3) & 63, hl = (i >> 9) & 1, nt = (i >> 10) & 1, sidx = i >> 11;
          const float w = rw[(32 * sidx + 8 * (ln >> 4) + e) * NE + 16 * nt + (ln & 15)]; const unsigned hb = f2bf(w); const float hf = __builtin_bit_cast(float, hb << 16);
          rwf[i] = (bf16)(hl ? f2bf(w - hf) : hb); } }
    for (int m = gw; m < NTOK + NB * MEM_LEN; m += NGW) {
        const bool ismem = m >= NTOK; const int r = ismem ? m - NTOK : m;
        const float* xr = (ismem ? A.in[1] : A.in[0]) + (size_t)r * D;
        f32x4 v[8];
#pragma unroll
        for (int j = 0; j < 8; ++j) v[j] = *(const f32x4*)(xr + 4 * lane + 256 * j);
        ln_row(v, ismem ? A.in[17] : A.in[2], ismem ? A.in[18] : A.in[3], LN_EPS, lane);
        store_row_bf16((bf16*)(ws + (ismem ? WS_MEMN : WS_H0)) + (size_t)r * D, v, lane);
    }
}

__device__ __forceinline__ void p2_fox_cumsum(const Args& A, LAS unsigned char* lds, int vcu, int G, int tid) {
    const bf16* P = (const bf16*)(A.ws + WS_P); double* C = (double*)(A.ws + WS_C);
    LAS double* part = (LAS double*)(lds + 32768);
    for (int bh = vcu; bh < 16; bh += G) {
        const int b = bh >> 3, h = bh & 7; const float bf = A.in[16][h];
        float lf[32]; double s = 0.0;
#pragma unroll
        for (int i = 0; i < 32; ++i) { const float x = bf1(P[(size_t)(b * T + tid * 32 + i) * PW + C_FF + h]) + bf;
            lf[i] = -(fmaxf(-x, 0.f) + log1pf(__expf(-fabsf(x)))); s += (double)lf[i]; }
        __syncthreads();
        part[tid] = s;
        __syncthreads();
        double pre = 0.0;
        for (int j = 0; j < tid; ++j) pre += part[j];
        double* c = C + (size_t)bh * T + tid * 32;
#pragma unroll
        for (int i = 0; i < 32; ++i) { pre += (double)lf[i]; c[i] = pre; }
    }
}
__device__ __forceinline__ void p2_fox_norms(const Args& A, LAS unsigned char* lds, int vcu, int G, int tid, int wave, int lane) {
    const bf16* P = (const bf16*)(A.ws + WS_P); float* FOXB = (float*)(A.ws + WS_FOXB); unsigned* ctl = (unsigned*)(A.ws + WS_CTL);
    LAS float* red = (LAS float*)(lds + 40960);
    for (int u = vcu; u < 1024; u += G) {
        const int bh = u >> 6, qb = u & 63, b = bh >> 3, h = bh & 7; const int tk = tid & 255, isk = tid >> 8;
        const bf16* pr = P + (size_t)(b * T + qb * 256 + tk) * PW + (isk ? C_FK : C_FQ) + h * 64;
        float n2 = 0.f;
#pragma unroll
        for (int v = 0; v < 8; ++v) { const v4u x = *(const v4u*)(pr + v * 8); const unsigned w[4] = {x.x, x.y, x.z, x.w};
#pragma unroll
            for (int e = 0; e < 4; ++e) { const float a0 = bfl(w[e]), a1 = bfh(w[e]); n2 += a0 * a0 + a1 * a1; } }
#pragma unroll
        for (int o = 1; o < 64; o <<= 1) n2 = fmaxf(n2, __shfl_xor(n2, o));
        __syncthreads();
        if (lane == 0) red[wave] = n2;
        __syncthreads();
        if (tid == 0) { FOXB[bh * 80 + qb] = fmaxf(fmaxf(red[0], red[1]), fmaxf(red[2], red[3]));
            __hip_atomic_fetch_max(ctl + CW_KMAX + bh, __float_as_uint(fmaxf(fmaxf(red[4], red[5]), fmaxf(red[6], red[7]))), __ATOMIC_RELAXED, __HIP_MEMORY_SCOPE_AGENT); }
    }
}

__device__ __forceinline__ int crow(int r, int hi) { return (r & 3) + 8 * (r >> 2) + 4 * hi; }
typedef float f32x16 __attribute__((ext_vector_type(16)));
typedef short s16x4 __attribute__((ext_vector_type(4)));
typedef short v4i16_t __attribute__((ext_vector_type(4)));
template <int DH, bool FOX>
__device__ __forceinline__ void attn_unit(const bf16* Qp, int qpitch, const bf16* Kp, const bf16* Vp, int kvpitch, unsigned char* Op, int opitch, int q0, int jlo, int jhi,
                                          const double* cseq, float scale2, LAS unsigned char* lds, int tid, int wave, int lane) {
    constexpr int KROW = (DH + 8) * 2, VROW = DH * 2 + 64, NP = DH / 64;
    LAS unsigned char* KS = lds; LAS unsigned char* VT = lds + 64 * KROW; LAS float* CB = (LAS float*)(VT + 64 * VROW); LAS float* WSF = (LAS float*)(lds + 2 * (64 * KROW + 64 * VROW + 256)) + wave * 32;
    const int r32 = lane & 31, hi = lane >> 5;
    bf16x8 qr[DH / 16];
#pragma unroll
    for (int d0 = 0; d0 < DH / 16; ++d0) qr[d0] = *(const bf16x8*)(Qp + (size_t)(32 * wave + r32) * qpitch + d0 * 16 + hi * 8);
    f32x16 o[DH / 32];
#pragma unroll
    for (int d = 0; d < DH / 32; ++d)
#pragma unroll
        for (int r = 0; r < 16; ++r) o[d][r] = 0.f;
    float m = -1e30f, l = 0.f;
    const int qpos = q0 + 32 * wave + r32;
    double cref = 0.0; if (FOX) cref = cseq[q0];
    v4u kreg[NP], vreg[NP]; float cbv = 0.f;
#define ATT_LOAD(j) do { _Pragma("unroll") for (int p = 0; p < NP; ++p) { const int idx = tid + p * NTHR, row = idx / (DH / 8), ch = idx % (DH / 8); \
        kreg[p] = *(const v4u*)(Kp + (size_t)((j) * 64 + row) * kvpitch + ch * 8); vreg[p] = *(const v4u*)(Vp + (size_t)((j) * 64 + row) * kvpitch + ch * 8); } \
        if (FOX && tid < 64) cbv = (float)(cref - cseq[(j) * 64 + tid]) * LOG2E; } while (0)
    constexpr bool PREF = (DH == 64);
    constexpr int TILEB = 64 * KROW + 64 * VROW + 256;
#define ATT_STORE(bufo) do { _Pragma("unroll") for (int p = 0; p < NP; ++p) { const int idx = tid + p * NTHR, row = idx / (DH / 8), ch = idx % (DH / 8); \
        *(LAS v4u*)(KS + (bufo) + row * KROW + ch * 16) = kreg[p]; *(LAS v4u*)(VT + (bufo) + row * VROW + ch * 16) = vreg[p]; } \
        if (FOX && tid < 64) *(LAS float*)((LAS unsigned char*)CB + (bufo) + tid * 4) = cbv; } while (0)
    if (PREF) { ATT_LOAD(jlo); __syncthreads(); ATT_STORE(0); __syncthreads(); }
    for (int j = jlo; j < jhi; ++j) {
        const int bo = PREF ? ((j - jlo) & 1) * TILEB : 0;
        if (PREF) { if (j + 1 < jhi) ATT_LOAD(j + 1); }
        else { __syncthreads();
#pragma unroll
            for (int p = 0; p < NP; ++p) { const int idx = tid + p * NTHR, row = idx / (DH / 8), ch = idx % (DH / 8);
                kreg[0] = *(const v4u*)(Kp + (size_t)(j * 64 + row) * kvpitch + ch * 8); vreg[0] = *(const v4u*)(Vp + (size_t)(j * 64 + row) * kvpitch + ch * 8);
                *(LAS v4u*)(KS + row * KROW + ch * 16) = kreg[0]; *(LAS v4u*)(VT + row * VROW + ch * 16) = vreg[0]; }
            __syncthreads(); }
        f32x16 p[2];
#pragma unroll
        for (int kh = 0; kh < 2; ++kh) {
#pragma unroll
            for (int r = 0; r < 16; ++r) p[kh][r] = 0.f;
#pragma unroll
            for (int d0 = 0; d0 < DH / 16; ++d0) { const bf16x8 a = *(const LAS bf16x8*)(KS + bo + (32 * kh + r32) * KROW + (16 * d0 + 8 * hi) * 2);
                p[kh] = __builtin_amdgcn_mfma_f32_32x32x16_bf16(a, qr[d0], p[kh], 0, 0, 0); }
        }
        const bool diag = FOX && (j * 64 + 63 > q0);
        float mx = -1e30f;
        if (diag) {
#pragma unroll
            for (int kh = 0; kh < 2; ++kh)
#pragma unroll
                for (int g = 0; g < 4; ++g) { const f32x4 cb = *(const LAS f32x4*)((const LAS unsigned char*)CB + bo + (32 * kh + 8 * g + 4 * hi) * 4);
#pragma unroll
                    for (int i = 0; i < 4; ++i) { const int r = 4 * g + i; float v = p[kh][r] * scale2 + cb[i];
                        if (j * 64 + 32 * kh + 8 * g + 4 * hi + i > qpos) v = -1e30f;
                        p[kh][r] = v; mx = fmaxf(mx, v); } }
        } else {
#pragma unroll
            for (int kh = 0; kh < 2; ++kh)
#pragma unroll
                for (int g = 0; g < 4; ++g) { f32x4 cb = (f32x4){0.f, 0.f, 0.f, 0.f}; if (FOX) cb = *(const LAS f32x4*)((const LAS unsigned char*)CB + bo + (32 * kh + 8 * g + 4 * hi) * 4);
#pragma unroll
                    for (int i = 0; i < 4; ++i) { const int r = 4 * g + i; const float v = p[kh][r] * scale2 + cb[i]; p[kh][r] = v; mx = fmaxf(mx, v); } }
        }
        mx = fmaxf(mx, __shfl_xor(mx, 32));
        const float mn = fmaxf(m, mx), corr = __builtin_amdgcn_exp2f(m - mn); m = mn;
        float ls = 0.f;
#pragma unroll
        for (int kh = 0; kh < 2; ++kh)
#pragma unroll
            for (int r = 0; r < 16; ++r) { const float e = __builtin_amdgcn_exp2f(p[kh][r] - mn); p[kh][r] = e; ls += e; }
        l = l * corr + ls;
        if (__any(corr != 1.0f)) {
            if (hi == 0) WSF[r32] = corr;
#pragma unroll
            for (int g = 0; g < 4; ++g) { const f32x4 c4 = *(const LAS f32x4*)(WSF + 8 * g + 4 * hi);
#pragma unroll
                for (int d = 0; d < DH / 32; ++d) { o[d][4 * g] *= c4.x; o[d][4 * g + 1] *= c4.y; o[d][4 * g + 2] *= c4.z; o[d][4 * g + 3] *= c4.w; } }
        }
        bf16x8 pa[4];
#pragma unroll
        for (int s = 0; s < 4; ++s) { const int kh = s >> 1, b8 = 8 * (s & 1); v4u w;
            w.x = pg8::cvt_pk_bf16(p[kh][b8 + 0], p[kh][b8 + 1]); w.y = pg8::cvt_pk_bf16(p[kh][b8 + 2], p[kh][b8 + 3]);
            w.z = pg8::cvt_pk_bf16(p[kh][b8 + 4], p[kh][b8 + 5]); w.w = pg8::cvt_pk_bf16(p[kh][b8 + 6], p[kh][b8 + 7]);
            pa[s] = __builtin_bit_cast(bf16x8, w); }
#pragma unroll
        for (int d = 0; d < DH / 32; ++d)
#pragma unroll
            for (int s = 0; s < 4; ++s) { const LAS unsigned char* vp = VT + bo + (16 * s + 4 * hi + ((lane & 15) >> 2)) * VROW + (32 * d + 16 * ((lane >> 4) & 1) + 4 * (lane & 3)) * 2;
                const s16x4 lo = __builtin_bit_cast(s16x4, __builtin_amdgcn_ds_read_tr16_b64_v4i16((LAS v4i16_t*)vp)), hh = __builtin_bit_cast(s16x4, __builtin_amdgcn_ds_read_tr16_b64_v4i16((LAS v4i16_t*)(vp + 8 * VROW)));
                const bf16x8 vf = (bf16x8){lo[0], lo[1], lo[2], lo[3], hh[0], hh[1], hh[2], hh[3]};
                o[d] = __builtin_amdgcn_mfma_f32_32x32x16_bf16(pa[s], vf, o[d], 0, 0, 0); }
        if (PREF) { if (j + 1 < jhi) ATT_STORE(TILEB - bo); __syncthreads(); }
    }
#undef ATT_LOAD
#undef ATT_STORE
    l += __shfl_xor(l, 32);
    if (hi == 0) WSF[r32] = 1.0f / l;
    float rli[16];
#pragma unroll
    for (int g = 0; g < 4; ++g) { const f32x4 c4 = *(const LAS f32x4*)(WSF + 8 * g + 4 * hi); rli[4 * g] = c4.x; rli[4 * g + 1] = c4.y; rli[4 * g + 2] = c4.z; rli[4 * g + 3] = c4.w; }
#pragma unroll
    for (int r = 0; r < 16; ++r) { unsigned char* orow = Op + (size_t)(32 * wave + crow(r, hi)) * opitch + r32;
#pragma unroll
        for (int d = 0; d < DH / 32; ++d) { const float x = o[d][r] * rli[r]; orow[32 * d] = (unsigned char)__builtin_amdgcn_cvt_pk_fp8_f32(x, x, 0, false); } }
    __syncthreads();
}

__device__ __forceinline__ void p3_attention(const Args& A, LAS unsigned char* lds, int tid, int wave, int lane) {
    unsigned char* ws = A.ws; const bf16* P = (const bf16*)(ws + WS_P); unsigned char* MIX = ws + WS_MIX; const bf16* KVM = (const bf16*)(ws + WS_KVM); const double* C = (const double*)(ws + WS_C);
    unsigned* ctl = (unsigned*)(ws + WS_CTL); LAS int* sj = (LAS int*)(lds + 65536);
    for (;;) {
        __syncthreads();
        if (tid == 0) sj[1] = (int)__hip_atomic_fetch_add(ctl + CW_QUEUE, 1u, __ATOMIC_RELAXED, __HIP_MEMORY_SCOPE_AGENT);
        __syncthreads();
        const int u = sj[1];
        if (u >= 1536) break;
        if (u < 1024) {
#ifndef NO_FOX
            const int bh = u & 15, qb = 63 - (u >> 4), b = bh >> 3, h = bh & 7, q0 = qb * 256; const double* cs = C + (size_t)bh * T; const float* fb = (const float*)(ws + WS_FOXB) + bh * 80; const size_t rowb = (size_t)b * T;
            if (tid == 0) sj[0] = q0 / 64;
            __syncthreads();
            if (tid < q0 / 64) { const float bound = 0.25f * sqrtf(fb[qb] * __uint_as_float(ctl[CW_KMAX + bh])) + FOX_SKIP; if ((float)(cs[q0] - cs[tid * 64 + 63]) + bound >= 0.f) __hip_atomic_fetch_min(sj, tid, __ATOMIC_RELAXED, __HIP_MEMORY_SCOPE_WORKGROUP); }
            __syncthreads();
            const int jlo = sj[0];
            attn_unit<64, true>(P + (rowb + q0) * PW + C_FQ + h * 64, PW, P + rowb * PW + C_FK + h * 64, P + rowb * PW + C_FV + h * 64, PW,
                                MIX + (rowb + q0) * D + 1024 + h * 64, D, q0, jlo, q0 / 64 + 4, cs, 0.125f * LOG2E, lds, tid, wave, lane);
#endif
        } else {
#ifndef NO_MEMATT
            const int v = u - 1024, b = v >> 8, h = (v >> 6) & 3, qb = v & 63, q0 = qb * 256; const size_t rowb = (size_t)b * T;
            attn_unit<128, false>(P + (rowb + q0) * PW + C_MQ + h * 128, PW, KVM + (size_t)b * MEM_LEN * 1024 + h * 128, KVM + (size_t)b * MEM_LEN * 1024 + 512 + h * 128, 1024,
                                  MIX + (rowb + q0) * D + 1536 + h * 128, D, q0, 0, 4, nullptr, 0.08838834764831845f * LOG2E, lds, tid, wave, lane);
#endif
        }
    }
}

constexpr size_t AIN_BYTES = 73728, REC_BYTES = 62464;
constexpr size_t WS_AIN = WS_RW, WS_REC = WS_AIN + 576 * MiB, WS_YRAW = WS_REC + 488 * MiB, WS_G1 = 368 * MiB, WS_G2 = 432 * MiB;
static_assert(WS_YRAW + 64 * MiB <= WS_ACT && 8192 * REC_BYTES <= 488 * MiB && 8192 * AIN_BYTES <= 576 * MiB && WS_G2 + 64 * MiB <= WS_W2, "rwkv workspace");
constexpr int AIN_LD = 0, AIN_R = 16384, AIN_K2 = 24576, AIN_V = 32768, AIN_AV = 40960, AIN_BV = 49152, AIN_G1 = 57344, AIN_G2 = 65536;
constexpr int A0_IN = 29184, A0_INW = 13200, A0_ROWB = 400;
constexpr int REC_W = 0, REC_RT = 9216, REC_ARB = 18432, REC_BGT = 27648, REC_U0 = 36864, REC_Y0 = 45056, REC_M0 = 53248, REC_GC = 61440;
typedef float f32x4_t __attribute__((ext_vector_type(4)));

__device__ __forceinline__ float softplusf_(float x) { return fmaxf(x, 0.f) + log1pf(__expf(-fabsf(x))); }
__device__ __forceinline__ float xsum16_32(float v) { v += __shfl_xor(v, 16); v += __shfl_xor(v, 32); return v; }

__device__ __forceinline__ float fsigmoid(float x) { return __builtin_amdgcn_rcpf(1.0f + __builtin_amdgcn_exp2f(-LOG2E * x)); }
__device__ __forceinline__ float fsoftplus(float x) { return fmaxf(x, 0.f) + 0.6931471805599453f * __builtin_amdgcn_logf(1.0f + __builtin_amdgcn_exp2f(-LOG2E * fabsf(x))); }
struct A0Par { f32x4 mur, muk, muv, a0, kkw, kaw, rkw, w0, gng, gnb; };
template <bool FULL> __device__ __forceinline__ void a0_loadpar(A0Par& p, const Args& A, const float* mu, int col) {
    p.mur = *(const f32x4*)(mu + C_R + col); p.muk = *(const f32x4*)(mu + C_K + col); p.muv = *(const f32x4*)(mu + C_V + col);
    p.a0 = *(const f32x4*)(A.in[8] + col); p.kkw = *(const f32x4*)(A.in[11] + col); p.kaw = *(const f32x4*)(A.in[12] + col); p.rkw = *(const f32x4*)(A.in[13] + col);
    if constexpr (FULL) { p.w0 = *(const f32x4*)(A.in[6] + col); p.gng = *(const f32x4*)(A.in[14] + col); p.gnb = *(const f32x4*)(A.in[15] + col); }
}
template <bool FULL>
__device__ __forceinline__ void a0_mfma(f32x4 (&acc)[2][3], const bf16x8* wf, LAS unsigned char* lds, int c16, int g) {
    constexpr int KS0 = FULL ? 0 : 3, KS1 = FULL ? 14 : 6;
#pragma unroll
    for (int tt = 0; tt < 2; ++tt)
#pragma unroll
        for (int o = 0; o < 3; ++o) acc[tt][o] = (f32x4){0.f, 0.f, 0.f, 0.f};
#pragma unroll
    for (int ks = KS0; ks < KS1; ++ks) { const int o = ks < 3 ? 0 : (ks < 6 ? 1 : 2);
#pragma unroll
        for (int tt = 0; tt < 2; ++tt) { const bf16x8 b = *(const LAS bf16x8*)(lds + (16 * tt + c16) * 912 + (32 * ks + 8 * g) * 2);
            acc[tt][o] = __builtin_amdgcn_mfma_f32_16x16x32_bf16(wf[ks - KS0], b, acc[tt][o], 0, 0, 0); } }
}
template <bool FULL>
__device__ __forceinline__ void a0_ct(const f32x4 (&acc)[2][3], const A0Par& p, const LAS unsigned char* inw, unsigned char* blk,
                                      int tl0, int ct, int c16, int g, float (&ssk)[2], float (&ssb)[2]) {
#pragma unroll
    for (int tt = 0; tt < 2; ++tt) {
        const LAS unsigned char* pc = inw + (1 + 16 * tt + c16) * A0_ROWB + (16 * ct + 4 * g) * 2;
        const pg8::u32x2 r0 = *(const LAS pg8::u32x2*)pc, k0 = *(const LAS pg8::u32x2*)(pc + 128), v0 = *(const LAS pg8::u32x2*)(pc + 256);
        const pg8::u32x2 r1 = *(const LAS pg8::u32x2*)(pc - A0_ROWB), k1 = *(const LAS pg8::u32x2*)(pc - A0_ROWB + 128), v1 = *(const LAS pg8::u32x2*)(pc - A0_ROWB + 256);
        float rr[4], kk[4], vv[4];
        { const float ra[4] = {bfl(r0.x), bfh(r0.x), bfl(r0.y), bfh(r0.y)}, rb[4] = {bfl(r1.x), bfh(r1.x), bfl(r1.y), bfh(r1.y)};
          const float ka[4] = {bfl(k0.x), bfh(k0.x), bfl(k0.y), bfh(k0.y)}, kb[4] = {bfl(k1.x), bfh(k1.x), bfl(k1.y), bfh(k1.y)};
          const float va[4] = {bfl(v0.x), bfh(v0.x), bfl(v0.y), bfh(v0.y)}, vb[4] = {bfl(v1.x), bfh(v1.x), bfl(v1.y), bfh(v1.y)};
#pragma unroll
          for (int r = 0; r < 4; ++r) { rr[r] = ra[r] + p.mur[r] * (rb[r] - ra[r]); kk[r] = ka[r] + p.muk[r] * (kb[r] - ka[r]); vv[r] = va[r] + p.muv[r] * (vb[r] - va[r]); } }
        float aa[4], k2[4], kc[4];
#pragma unroll
        for (int r = 0; r < 4; ++r) { aa[r] = fsigmoid(p.a0[r] + acc[tt][1][r]); kc[r] = kk[r] * p.kkw[r]; k2[r] = kk[r] * (1.0f + (aa[r] - 1.0f) * p.kaw[r]); }
        if constexpr (!FULL) {
#pragma unroll
            for (int r = 0; r < 4; ++r) { ssk[tt] += kc[r] * kc[r]; ssb[tt] += rr[r] * k2[r] * p.rkw[r]; }
        } else {
            const int e0 = (ct * 64 + tl0 + 16 * tt + c16) * 16 + 4 * g;
            f32x4 ld; float av[4], bv[4], g1[4], g2[4];
#pragma unroll
            for (int r = 0; r < 4; ++r) { const float sp = fsoftplus(-(p.w0[r] + acc[tt][0][r])); ld[r] = -__builtin_amdgcn_exp2f(-LOG2E * (sp + 0.5f));
                const float kn = kc[r] * ssk[tt]; av[r] = -kn; bv[r] = kn * aa[r]; const float gg = acc[tt][2][r]; g1[r] = p.gng[r] * gg; g2[r] = (p.gnb[r] + ssb[tt] * vv[r]) * gg; }
            *(f32x4*)(blk + AIN_LD + e0 * 4) = ld;
            *(pg8::u32x2*)(blk + AIN_R + e0 * 2) = (pg8::u32x2){pk2(rr[0], rr[1]), pk2(rr[2], rr[3])};
            *(pg8::u32x2*)(blk + AIN_K2 + e0 * 2) = (pg8::u32x2){pk2(k2[0], k2[1]), pk2(k2[2], k2[3])};
            *(pg8::u32x2*)(blk + AIN_V + e0 * 2) = (pg8::u32x2){pk2(vv[0], vv[1]), pk2(vv[2], vv[3])};
            *(pg8::u32x2*)(blk + AIN_AV + e0 * 2) = (pg8::u32x2){pk2(av[0], av[1]), pk2(av[2], av[3])};
            *(pg8::u32x2*)(blk + AIN_BV + e0 * 2) = (pg8::u32x2){pk2(bv[0], bv[1]), pk2(bv[2], bv[3])};
            *(pg8::u32x2*)(blk + AIN_G1 + e0 * 2) = (pg8::u32x2){pk2(g1[0], g1[1]), pk2(g1[2], g1[3])};
            *(pg8::u32x2*)(blk + AIN_G2 + e0 * 2) = (pg8::u32x2){pk2(g2[0], g2[1]), pk2(g2[2], g2[3])};
        }
        asm volatile("" ::: "memory");
    }
}
template <int PV = 0>
__device__ __forceinline__ void p2_rwkv_tok(const Args& A, LAS unsigned char* lds, int vcu, int G, int tid, int wave, int lane) {
    unsigned char* ws = A.ws; const bf16* P = (const bf16*)(ws + WS_P); const bf16* WLT = (const bf16*)(ws + WS_WLT); const float* mu = A.in[5];
    unsigned char* AIN = ws + WS_AIN;
    const int c16 = lane & 15, g = lane >> 4;
    for (int tile = vcu; tile < NTOK / 32; tile += G) {
        const int row0 = tile * 32;
        __syncthreads();
        int tidv = tid; asm volatile("" : "+v"(tidv));
        {
#pragma unroll
            for (int bt = 0; bt < 2; ++bt) {
            v4u pt[2], pp[2]; f32x4 m0[2], m1[2];
#pragma unroll
            for (int i = 0; i < 2; ++i) { const int idx = min(tidv + NTHR * (2 * bt + i), 32 * 56 - 1), tk = idx / 56, vec = idx % 56, row = row0 + tk, col = C_DW + vec * 8;
                pt[i] = *(const v4u*)(P + (size_t)row * PW + col); pp[i] = *(const v4u*)(P + (size_t)(row - ((row % T) ? 1 : 0)) * PW + col);
                m0[i] = *(const f32x4*)(mu + col); m1[i] = *(const f32x4*)(mu + col + 4); }
#pragma unroll
            for (int i = 0; i < 2; ++i) { const int idx = tidv + NTHR * (2 * bt + i), idc = min(idx, 32 * 56 - 1), tk = idc / 56, vec = idc % 56, row = row0 + tk; const bool hp = (row % T) != 0;
                float x[8]; const unsigned tw[4] = {pt[i].x, pt[i].y, pt[i].z, pt[i].w}, pw[4] = {pp[i].x, pp[i].y, pp[i].z, pp[i].w}; const float mm[8] = {m0[i].x, m0[i].y, m0[i].z, m0[i].w, m1[i].x, m1[i].y, m1[i].z, m1[i].w};
#pragma unroll
                for (int e = 0; e < 8; ++e) { const float a = (e & 1) ? bfh(tw[e >> 1]) : bfl(tw[e >> 1]); float b = (e & 1) ? bfh(pw[e >> 1]) : bfl(pw[e >> 1]); b = hp ? b : 0.f; const float ps = a + mm[e] * (b - a);
                    x[e] = vec < 12 ? 2.0f * fsigmoid(2.0f * ps) - 1.0f : (vec < 24 ? ps : fsigmoid(ps)); }
                v4u o; o.x = pk2(x[0], x[1]); o.y = pk2(x[2], x[3]); o.z = pk2(x[4], x[5]); o.w = pk2(x[6], x[7]);
                if (idx < 32 * 56) *(LAS v4u*)(lds + tk * 912 + vec * 16) = o; }
            asm volatile("" ::: "memory"); }
        }
        __syncthreads();
#pragma unroll 1
        for (int hh = 0; hh < 2; ++hh) {
            const int h = wave * 2 + hh;
            LAS unsigned char* inw = lds + A0_IN + wave * A0_INW;
            { const bool first = (row0 % T) == 0; int lanev = lane; asm volatile("" : "+v"(lanev));
#pragma unroll
              for (int bt = 0; bt < 2; ++bt) { v4u x[7];
#pragma unroll
                for (int i = 0; i < 7; ++i) { const int idx = lanev + 64 * (7 * bt + i), seg = min(idx >> 3, 98), pc = idx & 7, r = seg / 3, a = seg - 3 * r, grow = row0 - 1 + r + ((first && r == 0) ? 1 : 0);
                    x[i] = *(const v4u*)(P + (size_t)grow * PW + a * 1024 + h * 64 + pc * 8); }
#pragma unroll
                for (int i = 0; i < 7; ++i) { const int idx = lanev + 64 * (7 * bt + i), seg = idx >> 3, pc = idx & 7, r = seg / 3, a = seg - 3 * r;
                    const v4u z = (v4u){0u, 0u, 0u, 0u}; if (seg < 99) *(LAS v4u*)(inw + r * A0_ROWB + a * 128 + pc * 16) = (first && r == 0) ? z : x[i]; }
                asm volatile("" ::: "memory"); } }
            const int tpos0 = row0 % T, b = row0 / T; unsigned char* blk = AIN + (size_t)((b * 16 + h) * 256 + (tpos0 >> 6)) * AIN_BYTES; const int tl0 = tpos0 & 63;
            float ssk[2] = {0.f, 0.f}, ssb[2] = {0.f, 0.f};
            const bf16* wbase = WLT + (size_t)(h * 64 + c16) * 448 + 8 * g; const int colb = h * 64 + 4 * g;
            if constexpr (PV != 2) { bf16x8 w0[3]; A0Par pn;
#pragma unroll
              for (int ks = 0; ks < 3; ++ks) w0[ks] = *(const bf16x8*)(wbase + 32 * (3 + ks));
              a0_loadpar<false>(pn, A, mu, colb);
#pragma unroll 1
              for (int ct = 0; ct < 4; ++ct) { f32x4 acc[2][3]; a0_mfma<false>(acc, w0, lds, c16, g); const A0Par p = pn;
                  if (ct < 3) {
#pragma unroll
                      for (int ks = 0; ks < 3; ++ks) w0[ks] = *(const bf16x8*)(wbase + (size_t)(ct + 1) * 16 * 448 + 32 * (3 + ks));
                      a0_loadpar<false>(pn, A, mu, colb + 16 * (ct + 1)); }
                  asm volatile("" ::: "memory");
                  a0_ct<false>(acc, p, inw, blk, tl0, ct, c16, g, ssk, ssb); asm volatile("" ::: "memory"); } }
#pragma unroll
            for (int tt = 0; tt < 2; ++tt) { ssk[tt] = 1.0f / fmaxf(sqrtf(xsum16_32(ssk[tt])), 1e-12f); ssb[tt] = xsum16_32(ssb[tt]); }
            if constexpr (PV != 0) { if (ssk[0] + ssb[1] == 1234.5f) *(float*)blk = ssk[0]; }
            if constexpr (PV == 0) { bf16x8 w1[14]; A0Par pn;
#pragma unroll
              for (int ks = 0; ks < 14; ++ks) w1[ks] = *(const bf16x8*)(wbase + 32 * ks);
              a0_loadpar<true>(pn, A, mu, colb);
#pragma unroll 1
              for (int ct = 0; ct < 4; ++ct) { f32x4 acc[2][3]; a0_mfma<true>(acc, w1, lds, c16, g); const A0Par p = pn;
                  if (ct < 3) {
#pragma unroll
                      for (int ks = 0; ks < 14; ++ks) w1[ks] = *(const bf16x8*)(wbase + (size_t)(ct + 1) * 16 * 448 + 32 * ks);
                      a0_loadpar<true>(pn, A, mu, colb + 16 * (ct + 1)); }
                  asm volatile("" ::: "memory");
                  a0_ct<true>(acc, p, inw, blk, tl0, ct, c16, g, ssk, ssb);
                  asm volatile("" ::: "memory"); } }
        }
    }
}

constexpr int LA_CL = 0, LA_AS = 16640, LA_BS = 25856, LA_KS = 35072, LA_RS = 44288, LA_KGT = 53504, LA_BGT = 62720, LA_VT = 71936, LA_NS = 81152, LA_XU = 98560, LA_WS = 115968, LA_TOT = 125184, LA_SCR = 126208, LA_TS = 134400;
__device__ __forceinline__ f32x16 gtile32(LAS unsigned char* lds, int offA, int si, int offB, int ti, int r32, int hi) {
    f32x16 c;
#pragma unroll
    for (int r = 0; r < 16; ++r) c[r] = 0.f;
#pragma unroll
    for (int ks = 0; ks < 4; ++ks) { const bf16x8 a = *(const LAS bf16x8*)(lds + offA + (32 * si + r32) * 144 + (16 * ks + 8 * hi) * 2), b = *(const LAS bf16x8*)(lds + offB + (32 * ti + r32) * 144 + (16 * ks + 8 * hi) * 2);
        c = __builtin_amdgcn_mfma_f32_32x32x16_bf16(a, b, c, 0, 0, 0); }
    return c;
}
template <bool INCL> __device__ __forceinline__ void mask_lower(f32x16& c, int r32, int hi) {
#pragma unroll
    for (int r = 0; r < 16; ++r) { const int s = crow(r, hi); if (INCL ? (s > r32) : (s >= r32)) c[r] = 0.f; }
}
__device__ __forceinline__ float xcomb(float v) {
    { auto r = __builtin_amdgcn_permlane16_swap(__float_as_uint(v), __float_as_uint(v), false, false); v = __uint_as_float(r[0]) + __uint_as_float(r[1]); }
    { auto r = __builtin_amdgcn_permlane32_swap(__float_as_uint(v), __float_as_uint(v), false, false); v = __uint_as_float(r[0]) + __uint_as_float(r[1]); }
    return v;
}
__device__ __forceinline__ void gv_acc(f32x16& o, const f32x16& G, LAS unsigned char* lds, int si, int ib, int r32, int hi) {
#pragma unroll
    for (int sp = 0; sp < 2; ++sp) { v4u w; const int b8 = 8 * sp;
        w.x = pg8::cvt_pk_bf16(G[b8 + 0], G[b8 + 1]); w.y = pg8::cvt_pk_bf16(G[b8 + 2], G[b8 + 3]); w.z = pg8::cvt_pk_bf16(G[b8 + 4], G[b8 + 5]); w.w = pg8::cvt_pk_bf16(G[b8 + 6], G[b8 + 7]);
        const LAS unsigned char* vp = lds + LA_VT + (32 * ib + r32) * 144 + (32 * si + 16 * sp + 4 * hi) * 2;
        const s16x4 lo = *(const LAS s16x4*)vp, hh = *(const LAS s16x4*)(vp + 16);
        o = __builtin_amdgcn_mfma_f32_32x32x16_bf16(__builtin_bit_cast(bf16x8, w), (bf16x8){lo[0], lo[1], lo[2], lo[3], hh[0], hh[1], hh[2], hh[3]}, o, 0, 0, 0); }
}
__device__ __forceinline__ void p3_rwkv_chunk(const Args& A, LAS unsigned char* lds, int vcu, int G, int tid, int wave, int lane) {
    unsigned char* ws = A.ws;
    const int r32 = lane & 31, hi = lane >> 5, c16 = lane & 15, g = lane >> 4;
    LAS float* CL = (LAS float*)(lds + LA_CL); LAS float* TOT = (LAS float*)(lds + LA_TOT);
    const int t = tid >> 3, j0 = (tid & 7) * 8;
    const int e0 = ((j0 >> 4) * 64 + t) * 16 + (j0 & 15);
    f32x4 l0, l1; v4u vr, vk, vv, va, vb;
#define PA_LOAD_LD(ucx) do { const unsigned char* blk_ = ws + WS_AIN + (size_t)(ucx) * AIN_BYTES; l0 = *(const f32x4*)(blk_ + AIN_LD + e0 * 4); l1 = *(const f32x4*)(blk_ + AIN_LD + (e0 + 4) * 4); } while (0)
#define PA_LOAD(ucx) do { const unsigned char* blk_ = ws + WS_AIN + (size_t)(ucx) * AIN_BYTES; \
        vr = *(const v4u*)(blk_ + AIN_R + e0 * 2); vk = *(const v4u*)(blk_ + AIN_K2 + e0 * 2); vv = *(const v4u*)(blk_ + AIN_V + e0 * 2); \
        va = *(const v4u*)(blk_ + AIN_AV + e0 * 2); vb = *(const v4u*)(blk_ + AIN_BV + e0 * 2); } while (0)
    PA_LOAD_LD(min(vcu, 8191));
    for (int uc = vcu; uc < 8192; uc += G) {
        unsigned char* rec = ws + WS_REC + (size_t)uc * REC_BYTES;
        __syncthreads();
        PA_LOAD(uc);
        { LAS float* c = CL + t * 65 + j0; c[0] = l0.x; c[1] = l0.y; c[2] = l0.z; c[3] = l0.w; c[4] = l1.x; c[5] = l1.y; c[6] = l1.z; c[7] = l1.w; }
        __syncthreads();
        float xs[16];
        if (tid < 256) { const int j = tid & 63, q = tid >> 6; float run = 0.f;
#pragma unroll
            for (int e = 0; e < 16; ++e) { run += CL[(16 * q + e) * 65 + j]; xs[e] = run; }
            TOT[q * 64 + j] = run; }
        __syncthreads();
        if (tid < 256) { const int j = tid & 63, q = tid >> 6; float off = 0.f; for (int qq = 0; qq < q; ++qq) off += TOT[qq * 64 + j];
#pragma unroll
            for (int e = 0; e < 16; ++e) CL[(16 * q + e) * 65 + j] = off + xs[e]; }
        __syncthreads();
        {   const unsigned wr[4] = {vr.x, vr.y, vr.z, vr.w}, wk[4] = {vk.x, vk.y, vk.z, vk.w}, wv[4] = {vv.x, vv.y, vv.z, vv.w}, wa[4] = {va.x, va.y, va.z, va.w}, wb[4] = {vb.x, vb.y, vb.z, vb.w};
            float at[8], bt[8], kt[8], rt_[8], kg[8], bg[8], gc[8];
#pragma unroll
            for (int e = 0; e < 8; ++e) { const float ct = CL[t * 65 + j0 + e], cp = t ? CL[(t - 1) * 65 + j0 + e] : 0.f, cL = CL[63 * 65 + j0 + e];
                const float r_ = (e & 1) ? bfh(wr[e >> 1]) : bfl(wr[e >> 1]), k_ = (e & 1) ? bfh(wk[e >> 1]) : bfl(wk[e >> 1]), a_ = (e & 1) ? bfh(wa[e >> 1]) : bfl(wa[e >> 1]), b_ = (e & 1) ? bfh(wb[e >> 1]) : bfl(wb[e >> 1]);
                const float eg = __expf(ct), egi = __expf(-ct), ep = __expf(cp), eL = __expf(cL - ct);
                at[e] = a_ * ep; bt[e] = b_ * egi; kt[e] = k_ * egi; rt_[e] = r_ * eg; kg[e] = k_ * eL; bg[e] = b_ * eL; gc[e] = __expf(cL); }
            v4u o;
            o.x = pk2(at[0], at[1]); o.y = pk2(at[2], at[3]); o.z = pk2(at[4], at[5]); o.w = pk2(at[6], at[7]); *(LAS v4u*)(lds + LA_AS + t * 144 + j0 * 2) = o;
            o.x = pk2(bt[0], bt[1]); o.y = pk2(bt[2], bt[3]); o.z = pk2(bt[4], bt[5]); o.w = pk2(bt[6], bt[7]); *(LAS v4u*)(lds + LA_BS + t * 144 + j0 * 2) = o;
            o.x = pk2(kt[0], kt[1]); o.y = pk2(kt[2], kt[3]); o.z = pk2(kt[4], kt[5]); o.w = pk2(kt[6], kt[7]); *(LAS v4u*)(lds + LA_KS + t * 144 + j0 * 2) = o;
            o.x = pk2(rt_[0], rt_[1]); o.y = pk2(rt_[2], rt_[3]); o.z = pk2(rt_[4], rt_[5]); o.w = pk2(rt_[6], rt_[7]); *(LAS v4u*)(lds + LA_RS + t * 144 + j0 * 2) = o;
            *(v4u*)(rec + REC_RT + t * 144 + j0 * 2) = o;
#pragma unroll
            for (int e = 0; e < 8; ++e) { *(LAS bf16*)(lds + LA_KGT + (j0 + e) * 144 + t * 2) = (bf16)f2bf(kg[e]); *(LAS bf16*)(lds + LA_BGT + (j0 + e) * 144 + t * 2) = (bf16)f2bf(bg[e]);
                *(LAS bf16*)(lds + LA_VT + (j0 + e) * 144 + t * 2) = (bf16)((e & 1) ? (wv[e >> 1] >> 16) : (wv[e >> 1] & 0xffffu)); }
            if (t == 63) { *(f32x4*)(rec + REC_GC + j0 * 4) = (f32x4){gc[0], gc[1], gc[2], gc[3]}; *(f32x4*)(rec + REC_GC + (j0 + 4) * 4) = (f32x4){gc[4], gc[5], gc[6], gc[7]}; }
        }
        __syncthreads();
        if (wave < 4) {
            const int ib = wave & 1; const bool isY = wave >= 2; const int offX = isY ? LA_RS : LA_AS;
            f32x16 o;
#pragma unroll
            for (int r = 0; r < 16; ++r) o[r] = 0.f;
            { f32x16 Gt = gtile32(lds, LA_KS, 0, offX, 1, r32, hi); gv_acc(o, Gt, lds, 0, ib, r32, hi); }
            { f32x16 Gt = gtile32(lds, LA_KS, 1, offX, 1, r32, hi); if (isY) mask_lower<true>(Gt, r32, hi); else mask_lower<false>(Gt, r32, hi); gv_acc(o, Gt, lds, 1, ib, r32, hi); }
            if (!isY) {
#pragma unroll
                for (int r = 0; r < 16; ++r) *(LAS float*)(lds + LA_XU + ((32 + crow(r, hi)) * 68 + 32 * ib + r32) * 4) = o[r];
            } else {
#pragma unroll
                for (int u = 0; u < 4; ++u) { const int m = 2 + (u >> 1), lp = (r32 & 15) + 16 * (2 * (u & 1) + hi), vs = 2 * ib + (r32 >> 4);
                    *(pg8::u32x2*)(rec + REC_Y0 + ((vs * 4 + m) * 64 + lp) * 8) = (pg8::u32x2){pk2(o[4 * u], o[4 * u + 1]), pk2(o[4 * u + 2], o[4 * u + 3])}; }
            }
        } else if (wave < 6) {
            const bool isY = wave == 5; const int offX = isY ? LA_RS : LA_AS;
            f32x16 Gt = gtile32(lds, LA_KS, 0, offX, 0, r32, hi); if (isY) mask_lower<true>(Gt, r32, hi); else mask_lower<false>(Gt, r32, hi);
#pragma unroll
            for (int ib = 0; ib < 2; ++ib) { f32x16 o;
#pragma unroll
                for (int r = 0; r < 16; ++r) o[r] = 0.f;
                gv_acc(o, Gt, lds, 0, ib, r32, hi);
                if (!isY) {
#pragma unroll
                    for (int r = 0; r < 16; ++r) *(LAS float*)(lds + LA_XU + (crow(r, hi) * 68 + 32 * ib + r32) * 4) = o[r];
                } else {
#pragma unroll
                    for (int u = 0; u < 4; ++u) { const int m = (u >> 1), lp = (r32 & 15) + 16 * (2 * (u & 1) + hi), vs = 2 * ib + (r32 >> 4);
                        *(pg8::u32x2*)(rec + REC_Y0 + ((vs * 4 + m) * 64 + lp) * 8) = (pg8::u32x2){pk2(o[4 * u], o[4 * u + 1]), pk2(o[4 * u + 2], o[4 * u + 3])}; }
                } }
            const int hf = wave - 4;
#pragma unroll
            for (int jj = 0; jj < 2; ++jj)
#pragma unroll
                for (int vs = 0; vs < 4; ++vs) { const int jt = 2 * hf + jj; f32x4 acc = (f32x4){0.f, 0.f, 0.f, 0.f};
#pragma unroll
                    for (int ks = 0; ks < 2; ++ks) { const bf16x8 a = *(const LAS bf16x8*)(lds + LA_KGT + (16 * jt + c16) * 144 + (32 * ks + 8 * g) * 2), b = *(const LAS bf16x8*)(lds + LA_VT + (16 * vs + c16) * 144 + (32 * ks + 8 * g) * 2);
                        acc = __builtin_amdgcn_mfma_f32_16x16x32_bf16(a, b, acc, 0, 0, 0); }
                    *(pg8::u32x2*)(rec + REC_M0 + ((vs * 4 + jt) * 64 + lane) * 8) = (pg8::u32x2){pk2(acc[0], acc[1]), pk2(acc[2], acc[3])}; }
        } else {
            const bool isR = wave == 7; const int offX = isR ? LA_RS : LA_AS;
#pragma unroll
            for (int k = 0; k < 3; ++k) { const int si = k == 2 ? 1 : 0, ti = k == 0 ? 0 : 1;
                f32x16 Gt = gtile32(lds, LA_BS, si, offX, ti, r32, hi);
                if (si == ti) { if (isR) mask_lower<true>(Gt, r32, hi); else mask_lower<false>(Gt, r32, hi); }
#pragma unroll
                for (int u = 0; u < 4; ++u) {
                    if (!isR) *(LAS f32x4*)(lds + LA_NS + (32 * ti + r32) * 272 + (32 * si + 8 * u + 4 * hi) * 4) = (f32x4){Gt[4 * u], Gt[4 * u + 1], Gt[4 * u + 2], Gt[4 * u + 3]};
                    else *(pg8::u32x2*)(rec + REC_ARB + (32 * ti + r32) * 144 + (32 * si + 8 * u + 4 * hi) * 2) = (pg8::u32x2){pk2(Gt[4 * u], Gt[4 * u + 1]), pk2(Gt[4 * u + 2], Gt[4 * u + 3])}; }
            }
            if (isR) { const v4u z = (v4u){0u, 0u, 0u, 0u}; *(v4u*)(rec + REC_ARB + r32 * 144 + (32 + 16 * hi) * 2) = z; *(v4u*)(rec + REC_ARB + r32 * 144 + (40 + 16 * hi) * 2) = z; }
        }
        __syncthreads();
        const v4u vg1 = *(const v4u*)(ws + WS_AIN + (size_t)uc * AIN_BYTES + AIN_G1 + e0 * 2), vg2 = *(const v4u*)(ws + WS_AIN + (size_t)uc * AIN_BYTES + AIN_G2 + e0 * 2);
        PA_LOAD_LD(min(uc + G, 8191));
        if (wave < 4 && lane < 16) { const int bb = wave; float tc[16];
#pragma unroll
            for (int t2 = 0; t2 < 16; ++t2) { float v = (t2 == lane) ? 1.f : 0.f;
#pragma unroll
                for (int s4 = 0; s4 < (t2 + 3) / 4; ++s4) { const f32x4 n4 = *(const LAS f32x4*)(lds + LA_NS + (16 * bb + t2) * 272 + (16 * bb + 4 * s4) * 4);
#pragma unroll
                    for (int e = 0; e < 4; ++e) if (4 * s4 + e < t2) v += n4[e] * tc[4 * s4 + e]; }
                tc[t2] = v; *(LAS float*)(lds + LA_TS + ((bb * 16 + t2) * 16 + lane) * 4) = v; if ((t2 & 3) == 3) asm volatile("" ::: "memory"); } }
        __syncthreads();
        {   const bool isW = wave < 4; const int colw = 16 * (wave & 3) + c16;
            LAS float* RS = (LAS float*)(lds + LA_SCR + wave * 1024);
#pragma unroll 1
            for (int bb = 0; bb < 4; ++bb) {
                f32x4 acc;
#pragma unroll
                for (int r = 0; r < 4; ++r) acc[r] = isW ? bf1(*(const LAS bf16*)(lds + LA_AS + (16 * bb + 4 * g + r) * 144 + colw * 2)) : *(const LAS float*)(lds + LA_XU + ((16 * bb + 4 * g + r) * 68 + colw) * 4);
#pragma unroll 4
                for (int kk = 0; kk < 4 * bb; ++kk) { const float av = *(const LAS float*)(lds + LA_NS + (16 * bb + c16) * 272 + (4 * kk + g) * 4);
                    const float bv = isW ? CL[(4 * kk + g) * 65 + colw] : *(const LAS float*)(lds + LA_XU + ((4 * kk + g) * 68 + colw) * 4);
                    acc = __builtin_amdgcn_mfma_f32_16x16x4f32(av, bv, acc, 0, 0, 0); }
#pragma unroll
                for (int r = 0; r < 4; ++r) RS[(4 * g + r) * 16 + c16] = acc[r];
                f32x4 xa = (f32x4){0.f, 0.f, 0.f, 0.f};
#pragma unroll
                for (int kk = 0; kk < 4; ++kk) { const float av = *(const LAS float*)(lds + LA_TS + ((bb * 16 + c16) * 16 + 4 * kk + g) * 4); const float bv = RS[(4 * kk + g) * 16 + c16];
                    xa = __builtin_amdgcn_mfma_f32_16x16x4f32(av, bv, xa, 0, 0, 0); }
#pragma unroll
                for (int r = 0; r < 4; ++r) { if (isW) CL[(16 * bb + 4 * g + r) * 65 + colw] = xa[r]; else *(LAS float*)(lds + LA_XU + ((16 * bb + 4 * g + r) * 68 + colw) * 4) = xa[r]; }
                if (isW) {
#pragma unroll
                    for (int r = 0; r < 4; ++r) *(LAS bf16*)(lds + LA_WS + (16 * bb + 4 * g + r) * 144 + colw * 2) = (bf16)f2bf(xa[r]);
                } else *(pg8::u32x2*)(rec + REC_U0 + (((wave & 3) * 4 + bb) * 64 + lane) * 8) = (pg8::u32x2){pk2(xa[0], xa[1]), pk2(xa[2], xa[3])};
            }
        }
        __syncthreads();
        { const int bh = uc >> 8, row = (bh >> 4) * T + (uc & 255) * 64 + t; const size_t go = (size_t)row * 1024 + (bh & 15) * 64 + j0;
          *(v4u*)((bf16*)(ws + WS_G1) + go) = vg1; *(v4u*)((bf16*)(ws + WS_G2) + go) = vg2; }
        for (int i = tid; i < 576; i += NTHR) { *(v4u*)(rec + REC_W + i * 16) = *(const LAS v4u*)(lds + LA_WS + i * 16); *(v4u*)(rec + REC_BGT + i * 16) = *(const LAS v4u*)(lds + LA_BGT + i * 16); }
    }
}

#undef PA_LOAD
#undef PA_LOAD_LD
__device__ __forceinline__ bf16x8 afrag16(const LAS unsigned char* base, int row, int s, int g) {
    const LAS unsigned char* p = base + row * 144 + (32 * s + 4 * g) * 2; const s16x4 lo = *(const LAS s16x4*)p, hh = *(const LAS s16x4*)(p + 32);
    return (bf16x8){lo[0], lo[1], lo[2], lo[3], hh[0], hh[1], hh[2], hh[3]};
}
__device__ __forceinline__ bf16x8 pack_cc(const f32x4& a, const f32x4& b) { v4u w; w.x = pg8::cvt_pk_bf16(a[0], a[1]); w.y = pg8::cvt_pk_bf16(a[2], a[3]); w.z = pg8::cvt_pk_bf16(b[0], b[1]); w.w = pg8::cvt_pk_bf16(b[2], b[3]); return __builtin_bit_cast(bf16x8, w); }
__device__ __forceinline__ f32x4 cfrag(const LAS unsigned char* base, int vs, int m, int lane) { const pg8::u32x2 u = *(const LAS pg8::u32x2*)(base + ((vs * 4 + m) * 64 + lane) * 8); return (f32x4){bfl(u.x), bfh(u.x), bfl(u.y), bfh(u.y)}; }
constexpr int B_SLOT = 44032, B_NP = 43;
__device__ __forceinline__ void b_issue(const unsigned char* rec, LAS unsigned char* slot, int vs, int lw, int lane) {
    for (int p = lw; p < B_NP; p += 4) {
        const int src = p < 36 ? p * 1024 : (p < 42 ? REC_U0 + ((p - 36) >> 1) * 8192 + vs * 2048 + ((p - 36) & 1) * 1024 : REC_GC);
        __builtin_amdgcn_global_load_lds((const unsigned*)(rec + src + lane * 16), (LAS unsigned*)(slot + p * 1024), 16, 0, 0); }
}
__device__ __forceinline__ void p4_rwkv_seq(const Args& A, LAS unsigned char* lds, int q, int wave, int lane) {
    unsigned char* ws = A.ws; const int bh = q >> 2, vs = q & 3;
    const unsigned char* REC = ws + WS_REC + (size_t)bh * 256 * REC_BYTES; bf16* YR = (bf16*)(ws + WS_YRAW);
    const int b = bh >> 4, h = bh & 15, c16 = lane & 15, g = lane >> 4, lw = wave - 4;
    const bool many = ((B_NP - 1 - lw) / 4 + 1) == 11;
    if (wave >= 4) { b_issue(REC, lds, vs, lw, lane); b_issue(REC + REC_BYTES, lds + B_SLOT, vs, lw, lane);
        if (many) asm volatile("s_waitcnt vmcnt(11)" ::: "memory"); else asm volatile("s_waitcnt vmcnt(10)" ::: "memory"); }
    __syncthreads();
    f32x4 H[4];
#pragma unroll
    for (int jt = 0; jt < 4; ++jt) H[jt] = (f32x4){0.f, 0.f, 0.f, 0.f};
#pragma unroll 1
    for (int c = 0; c < 256; ++c) {
        const LAS unsigned char* buf = lds + (c % 3) * B_SLOT;
        if (wave >= 4) {
            if (c + 2 < 256) { b_issue(REC + (size_t)(c + 2) * REC_BYTES, lds + ((c + 2) % 3) * B_SLOT, vs, lw, lane);
                if (many) asm volatile("s_waitcnt vmcnt(11)" ::: "memory"); else asm volatile("s_waitcnt vmcnt(10)" ::: "memory"); }
            else asm volatile("s_waitcnt vmcnt(0)" ::: "memory");
        } else if (wave == 0) {
            const LAS unsigned char* qb = buf + 36864;
            bf16x8 hb[2]; hb[0] = pack_cc(H[0], H[1]); hb[1] = pack_cc(H[2], H[3]);
            f32x4 U[4];
#pragma unroll
            for (int m = 0; m < 4; ++m) { U[m] = cfrag(qb, 0, m, lane);
#pragma unroll
                for (int s = 0; s < 2; ++s) U[m] = __builtin_amdgcn_mfma_f32_16x16x32_bf16(afrag16(buf + REC_W, 16 * m + c16, s, g), hb[s], U[m], 0, 0, 0); }
            bf16x8 ub[2]; ub[0] = pack_cc(U[0], U[1]); ub[1] = pack_cc(U[2], U[3]);
#pragma unroll
            for (int jt = 0; jt < 4; ++jt) { const f32x4 gc = *(const LAS f32x4*)(qb + 6144 + (16 * jt + 4 * g) * 4); f32x4 hn = H[jt] * gc + cfrag(qb + 4096, 0, jt, lane);
#pragma unroll
                for (int s = 0; s < 2; ++s) hn = __builtin_amdgcn_mfma_f32_16x16x32_bf16(afrag16(buf + REC_BGT, 16 * jt + c16, s, g), ub[s], hn, 0, 0, 0);
                H[jt] = hn; }
#pragma unroll
            for (int m = 0; m < 4; ++m) { f32x4 y = cfrag(qb + 2048, 0, m, lane);
#pragma unroll
                for (int s = 0; s < 2; ++s) y = __builtin_amdgcn_mfma_f32_16x16x32_bf16(afrag16(buf + REC_RT, 16 * m + c16, s, g), hb[s], y, 0, 0, 0);
#pragma unroll
                for (int s = 0; s < 2; ++s) y = __builtin_amdgcn_mfma_f32_16x16x32_bf16(afrag16(buf + REC_ARB, 16 * m + c16, s, g), ub[s], y, 0, 0, 0);
                bf16* yp = YR + (size_t)(b * T + 64 * c + 16 * m + 4 * g) * 1024 + h * 64 + 16 * vs + c16;
                yp[0] = (bf16)f2bf(y[0]); yp[1024] = (bf16)f2bf(y[1]); yp[2048] = (bf16)f2bf(y[2]); yp[3072] = (bf16)f2bf(y[3]); }
        }
        __syncthreads();
    }
}
__device__ __forceinline__ void p5_rwkv_final(const Args& A, int vcu, int G, int wave, int lane) {
    const bf16* YR = (const bf16*)(A.ws + WS_YRAW); const bf16* G1 = (const bf16*)(A.ws + WS_G1); const bf16* G2 = (const bf16*)(A.ws + WS_G2); unsigned char* MIX = A.ws + WS_MIX;
    const int gw = vcu * NWAVES + wave, NGW = G * NWAVES, pr = lane >> 3, oct = lane & 7;
    for (int it0 = gw * 8 + pr; it0 < NTOK * 16; it0 += NGW * 8 * 4) {
        v4u y[4], a[4], c[4];
#pragma unroll
        for (int k = 0; k < 4; ++k) { const int it = min(it0 + k * NGW * 8, NTOK * 16 - 1); const size_t o = (size_t)(it >> 4) * 1024 + (it & 15) * 64 + oct * 8;
            y[k] = *(const v4u*)(YR + o); a[k] = *(const v4u*)(G1 + o); c[k] = *(const v4u*)(G2 + o); }
#pragma unroll
        for (int k = 0; k < 4; ++k) { const int it = it0 + k * NGW * 8;
            const unsigned yw[4] = {y[k].x, y[k].y, y[k].z, y[k].w}, aw[4] = {a[k].x, a[k].y, a[k].z, a[k].w}, cw[4] = {c[k].x, c[k].y, c[k].z, c[k].w};
            float v[8]; float sm = 0.f;
#pragma unroll
            for (int e = 0; e < 4; ++e) { v[2 * e] = bfl(yw[e]); v[2 * e + 1] = bfh(yw[e]); sm += v[2 * e] + v[2 * e + 1]; }
            sm += __shfl_xor(sm, 1); sm += __shfl_xor(sm, 2); sm += __shfl_xor(sm, 4);
            const float mean = sm * (1.f / 64.f); float sq = 0.f;
#pragma unroll
            for (int e = 0; e < 8; ++e) { v[e] -= mean; sq += v[e] * v[e]; }
            sq += __shfl_xor(sq, 1); sq += __shfl_xor(sq, 2); sq += __shfl_xor(sq, 4);
            const float rstd = 1.0f / sqrtf(sq * (1.f / 64.f) + GN_EPS);
            float ov[8];
#pragma unroll
            for (int e = 0; e < 4; ++e) { ov[2 * e] = v[2 * e] * rstd * bfl(aw[e]) + bfl(cw[e]); ov[2 * e + 1] = v[2 * e + 1] * rstd * bfh(aw[e]) + bfh(cw[e]); }
            pg8::u32x2 o2; o2.x = pg8::pk4_fp8(ov[0], ov[1], ov[2], ov[3]); o2.y = pg8::pk4_fp8(ov[4], ov[5], ov[6], ov[7]);
            if (it < NTOK * 16) *(pg8::u32x2*)(MIX + (size_t)(it >> 4) * D + (it & 15) * 64 + oct * 8) = o2; }
    }
}

__device__ __forceinline__ void p5_ln_router(const Args& A, LAS unsigned char* lds, int vcu, int G, int tid, int wave, int lane) {
    unsigned char* ws = A.ws; const bf16* Z1 = (const bf16*)(ws + WS_Z1); bf16* H1 = (bf16*)(ws + WS_H1); const bf16* RWF = (const bf16*)(ws + WS_RWT);
    int* TOPI = (int*)(ws + RT_TOPI); float* TOPG = (float*)(ws + RT_TOPG); int* CNT = (int*)(ws + RT_CNT);
    LAS int* hist = (LAS int*)lds; const int c16 = lane & 15, g = lane >> 4;
    const float* gam = A.in[21]; const float* bet = A.in[22];
    for (int batch = vcu; batch < NTOK / 128; batch += G) {
        __syncthreads();
        if (tid < NE) hist[tid] = 0;
        __syncthreads();
        const int row0 = batch * 128 + wave * 16; const bf16* zr = Z1 + (size_t)(row0 + c16) * D + 8 * g;
        float sm = 0.f, sq = 0.f;
#pragma unroll 8
        for (int sx = 0; sx < 64; ++sx) { const v4u z = *(const v4u*)(zr + 32 * sx); const unsigned zw[4] = {z.x, z.y, z.z, z.w};
#pragma unroll
            for (int e = 0; e < 4; ++e) { const float a = bfl(zw[e]), b = bfh(zw[e]); sm += a + b; sq += a * a + b * b; } }
        sm += __shfl_xor(sm, 16); sm += __shfl_xor(sm, 32); sq += __shfl_xor(sq, 16); sq += __shfl_xor(sq, 32);
        const float mean = sm * (1.f / D); const float rstd = 1.0f / sqrtf(fmaxf(sq * (1.f / D) - mean * mean, 0.f) + LN_EPS);
        f32x4 acc[2]; acc[0] = (f32x4){0.f, 0.f, 0.f, 0.f}; acc[1] = acc[0];
        bf16* hr = H1 + (size_t)(row0 + c16) * D + 8 * g; unsigned char* hq = ws + WS_H1Q + (size_t)(row0 + c16) * D + 8 * g;
#pragma unroll 2
        for (int sx = 0; sx < 64; ++sx) { const v4u z = *(const v4u*)(zr + 32 * sx); const f32x4 a = (f32x4){bfl(z.x), bfh(z.x), bfl(z.y), bfh(z.y)}, b = (f32x4){bfl(z.z), bfh(z.z), bfl(z.w), bfh(z.w)};
            const f32x4 g0 = *(const f32x4*)(gam + 32 * sx + 8 * g), g1 = *(const f32x4*)(gam + 32 * sx + 8 * g + 4), b0 = *(const f32x4*)(bet + 32 * sx + 8 * g), b1 = *(const f32x4*)(bet + 32 * sx + 8 * g + 4);
            const f32x4 h0 = (a - mean) * rstd * g0 + b0, h1 = (b - mean) * rstd * g1 + b1;
            v4u hi; hi.x = pg8::cvt_pk_bf16(h0.x, h0.y); hi.y = pg8::cvt_pk_bf16(h0.z, h0.w); hi.z = pg8::cvt_pk_bf16(h1.x, h1.y); hi.w = pg8::cvt_pk_bf16(h1.z, h1.w);
            *(v4u*)(hr + 32 * sx) = hi;
            *(pg8::u32x2*)(hq + 32 * sx) = (pg8::u32x2){pg8::pk4_fp8(h0.x, h0.y, h0.z, h0.w), pg8::pk4_fp8(h1.x, h1.y, h1.z, h1.w)};
            v4u lo; lo.x = pg8::cvt_pk_bf16(h0.x - bfl(hi.x), h0.y - bfh(hi.x)); lo.y = pg8::cvt_pk_bf16(h0.z - bfl(hi.y), h0.w - bfh(hi.y));
            lo.z = pg8::cvt_pk_bf16(h1.x - bfl(hi.z), h1.y - bfh(hi.z)); lo.w = pg8::cvt_pk_bf16(h1.z - bfl(hi.w), h1.w - bfh(hi.w));
            const bf16x8 ah = __builtin_bit_cast(bf16x8, hi), al = __builtin_bit_cast(bf16x8, lo);
#pragma unroll
            for (int nt = 0; nt < 2; ++nt) { const bf16* fp = RWF + ((size_t)((sx * 2 + nt) * 2) * 64 + lane) * 8; const bf16x8 wh = *(const bf16x8*)fp, wl = *(const bf16x8*)(fp + 512);
                acc[nt] = __builtin_amdgcn_mfma_f32_16x16x32_bf16(ah, wh, acc[nt], 0, 0, 0); acc[nt] = __builtin_amdgcn_mfma_f32_16x16x32_bf16(ah, wl, acc[nt], 0, 0, 0);
                acc[nt] = __builtin_amdgcn_mfma_f32_16x16x32_bf16(al, wh, acc[nt], 0, 0, 0); } }
        const float bia0 = A.in[24][c16], bia1 = A.in[24][16 + c16];
#pragma unroll
        for (int r = 0; r < 4; ++r) {
            float v0 = acc[0][r] + bia0, v1 = acc[1][r] + bia1; float tv[4]; int ti[4];
#pragma unroll
            for (int k = 0; k < 4; ++k) { float bv = v0; int bi = c16; if (v1 > bv) { bv = v1; bi = 16 + c16; }
#pragma unroll
                for (int o = 1; o < 16; o <<= 1) { const float ov = __shfl_xor(bv, o); const int oi = __shfl_xor(bi, o); if (ov > bv || (ov == bv && oi < bi)) { bv = ov; bi = oi; } }
                tv[k] = bv; ti[k] = bi; if (bi == c16) v0 = -INFINITY; if (bi == 16 + c16) v1 = -INFINITY; }
            const float e1 = __expf(tv[1] - tv[0]), e2 = __expf(tv[2] - tv[0]), e3 = __expf(tv[3] - tv[0]); const float inv = 1.f / (1.f + e1 + e2 + e3);
            if (c16 < 4) { const int row = row0 + 4 * g + r; const int ei = c16 == 0 ? ti[0] : c16 == 1 ? ti[1] : c16 == 2 ? ti[2] : ti[3]; const float gv = (c16 == 0 ? 1.f : c16 == 1 ? e1 : c16 == 2 ? e2 : e3) * inv;
                TOPI[row * 4 + c16] = ei; TOPG[row * 4 + c16] = gv; __hip_atomic_fetch_add(hist + ei, 1, __ATOMIC_RELAXED, __HIP_MEMORY_SCOPE_WORKGROUP); }
        }
        __syncthreads();
        if (tid < NE) CNT[batch * NE + tid] = hist[tid];
    }
}
__device__ __forceinline__ void p6_positions(const Args& A, LAS unsigned char* lds, int vcu, int G, int tid) {
    unsigned char* ws = A.ws; const int* TOPI = (const int*)(ws + RT_TOPI); const float* TOPG = (const float*)(ws + RT_TOPG); const int* CNT = (const int*)(ws + RT_CNT);
    int* POS = (int*)(ws + RT_POS); int* BTOK = (int*)(ws + RT_TOK); float* BGATE = (float*)(ws + RT_GATE); int* TILE = (int*)(ws + RT_TILE);
    LAS int* sh = (LAS int*)lds;
    for (int batch = vcu; batch < NTOK / 128; batch += G) {
        __syncthreads();
        { const int e = tid & 31, seg = tid >> 5; int sb = 0, st = 0;
          for (int q = 0; q < 16; ++q) { const int bb = seg * 16 + q; const int c = CNT[bb * NE + e]; st += c; if (bb < batch) sb += c; }
          sh[tid] = sb; sh[1152 + tid] = st; }
        sh[640 + tid] = TOPI[batch * 512 + tid];
        __syncthreads();
        if (tid < NE) { int sb = 0, st = 0; for (int s = 0; s < 16; ++s) { sb += sh[s * 32 + tid]; st += sh[1152 + s * 32 + tid]; } sh[512 + tid] = sb; sh[544 + tid] = st; }
        __syncthreads();
        if (tid == 0) { int acc = 0; for (int e = 0; e < NE; ++e) { sh[576 + e] = acc; acc += (sh[544 + e] + 255) >> 8; } sh[576 + NE] = acc; }
        __syncthreads();
        { const int e = sh[640 + tid]; int rank = 0; for (int j = 0; j < tid; ++j) rank += (sh[640 + j] == e) ? 1 : 0;
          const int dest = sh[576 + e] * 256 + sh[512 + e] + rank;
          BTOK[dest] = batch * 128 + (tid >> 2); BGATE[dest] = TOPG[batch * 512 + tid]; POS[batch * 512 + tid] = dest; }
        if (batch < NE) { const int e = batch; const int lo = sh[576 + e] * 256 + sh[544 + e], hi = sh[576 + e + 1] * 256;
            for (int i = lo + tid; i < hi; i += NTHR) { BTOK[i] = 0; BGATE[i] = 0.f; }
            for (int rt = sh[576 + e] + tid; rt < sh[576 + e + 1]; rt += NTHR) TILE[rt] = e; }
        if (batch == 0 && tid == 0) TILE[MAXT] = sh[576 + NE];
    }
}
template <int I> __device__ __forceinline__ float fp8f_(unsigned w) { return __builtin_amdgcn_cvt_f32_fp8((int)w, I); }
#define fp8f(w, i) fp8f_<i>(w)
__device__ __forceinline__ void p9_final(const Args& A, int vcu, int G, int wave, int lane) {
    unsigned char* ws = A.ws; const bf16* H1 = (const bf16*)(ws + WS_H1); const unsigned char* Y = ws + WS_Y; const int* POS = (const int*)(ws + RT_POS);
    const int gw = vcu * NWAVES + wave, NGW = G * NWAVES;
    for (int row = gw; row < NTOK; row += NGW) {
        f32x4 v[8]; const int p0 = POS[row * 4], p1 = POS[row * 4 + 1], p2 = POS[row * 4 + 2], p3 = POS[row * 4 + 3];
#pragma unroll
        for (int j = 0; j < 8; ++j) { const int c = 4 * lane + 256 * j;
            const pg8::u32x2 h = *(const pg8::u32x2*)(H1 + (size_t)row * D + c);
            const unsigned y0 = *(const unsigned*)(Y + (size_t)p0 * D + c), y1 = *(const unsigned*)(Y + (size_t)p1 * D + c), y2 = *(const unsigned*)(Y + (size_t)p2 * D + c), y3 = *(const unsigned*)(Y + (size_t)p3 * D + c);
            const float s = 1.0f / 64.0f;
            v[j].x = ALPHA * bfl(h.x) + s * ((fp8f(y0, 0) + fp8f(y1, 0)) + (fp8f(y2, 0) + fp8f(y3, 0))); v[j].y = ALPHA * bfh(h.x) + s * ((fp8f(y0, 1) + fp8f(y1, 1)) + (fp8f(y2, 1) + fp8f(y3, 1)));
            v[j].z = ALPHA * bfl(h.y) + s * ((fp8f(y0, 2) + fp8f(y1, 2)) + (fp8f(y2, 2) + fp8f(y3, 2))); v[j].w = ALPHA * bfh(h.y) + s * ((fp8f(y0, 3) + fp8f(y1, 3)) + (fp8f(y2, 3) + fp8f(y3, 3))); }
        ln_row(v, A.in[29], A.in[30], LN_EPS, lane);
#pragma unroll
        for (int j = 0; j < 8; ++j) *(f32x4*)(A.out + (size_t)row * D + 4 * lane + 256 * j) = v[j];
    }
}

constexpr int NPH = 12;
__device__ __forceinline__ int opaque_tid() { int t = (int)threadIdx.x; asm volatile("" : "+v"(t)); return t; }
template <int PLO, int PHI>
__global__ void __launch_bounds__(NTHR, 2) fwd_kernel(Args args) {
    extern __shared__ __attribute__((aligned(16))) unsigned char lds_raw[];
    LAS unsigned char* lds = (LAS unsigned char*)lds_raw;
    const int tid = threadIdx.x, lane = tid & 63, wave = __builtin_amdgcn_readfirstlane(tid >> 6);
    const int G = gridDim.x; const int bx = blockIdx.x; const int vcu = (G % 8 == 0) ? (bx % 8) * (G / 8) + bx / 8 : bx;
    volatile LAS unsigned* MISC = (volatile LAS unsigned*)(lds + MISC_OFF);
    if (tid < 64) MISC[tid] = 0u;
    __syncthreads();
    unsigned char* ws = args.ws;
    unsigned* ctl = (unsigned*)(ws + WS_CTL);
    constexpr int lo = PLO, hi = PHI;
    XcdBarrier bar; bar.bar = ctl + CW_BAR; bar.x = 0; bar.st = nullptr;
    if (hi - lo > 1) bar = xcd_barrier_post(ctl + CW_BAR, MISC + 8);
#define IN(k) (lo <= (k) && (k) < hi)
#define PH_IDS const int tid = opaque_tid(), lane = tid & 63, wave = __builtin_amdgcn_readfirstlane(tid >> 6); (void)tid; (void)lane; (void)wave
#define SEAM(k) do { if constexpr (IN(k) && IN((k) + 1)) xcd_barrier(bar); } while (0)

    if constexpr (IN(0)) { PH_IDS; p0_prologue(args, lds, vcu, G, wave, lane); }
#if defined(REP_PHASE)
    if constexpr (REP_PHASE == 0) { __syncthreads();
    if constexpr (IN(0)) { PH_IDS; p0_prologue(args, lds, vcu, G, wave, lane); }
    }
#endif
    SEAM(0);
    if constexpr (IN(1)) { PH_IDS;
        const int ng = (G == 256) ? NG_INPROJ : G;
        if (bx < ng) { pg8::Gemm g{(const bf16*)(ws + WS_H0), (const bf16*)(ws + WS_WI), NTOK, PW, D}; pg8::StaticOrder S; S.init(NTOK, PW, ng, bx);
            pg8::EpiBf16 E{(bf16*)(ws + WS_P), PW};
            pg8::gemm_phase<pg8::EpiBf16, pg8::StaticOrder>(lds, g, S, E); }
        else { pg8::Gemm g{(const bf16*)(ws + WS_MEMN), (const bf16*)(ws + WS_WKV), NB * MEM_LEN, 1024, D}; pg8::StaticOrder S; S.init(NB * MEM_LEN, 1024, G - ng, bx - ng);
            pg8::EpiBf16 E{(bf16*)(ws + WS_KVM), 1024};
            pg8::gemm_phase<pg8::EpiBf16, pg8::StaticOrder>(lds, g, S, E); }
        conv_pull_loop(args, lds, tid, wave, lane);
    }
#if defined(REP_PHASE)
    if constexpr (REP_PHASE == 1) { __syncthreads();
    if constexpr (IN(1)) { PH_IDS;
        pg8::Gemm g{(const bf16*)(ws + WS_H0), (const bf16*)(ws + WS_WI), NTOK, PW, D}; pg8::StaticOrder S; S.init(NTOK, PW, G, bx);
        pg8::EpiBf16 E{(bf16*)(ws + WS_P), PW};
        pg8::gemm_phase<pg8::EpiBf16, pg8::StaticOrder>(lds, g, S, E);
    }
    }
#endif
    SEAM(1);
    if constexpr (IN(2)) { PH_IDS;
        if (G != 256) { pg8::Gemm g{(const bf16*)(ws + WS_MEMN), (const bf16*)(ws + WS_WKV), NB * MEM_LEN, 1024, D}; pg8::StaticOrder S; S.init(NB * MEM_LEN, 1024, G, bx);
          pg8::EpiBf16 E{(bf16*)(ws + WS_KVM), 1024};
          pg8::gemm_phase<pg8::EpiBf16, pg8::StaticOrder>(lds, g, S, E); }
        __syncthreads();
        p2_fox_cumsum(args, lds, (vcu + G - 16) % G, G, tid);
        __syncthreads();
        p2_fox_norms(args, lds, vcu, G, tid, wave, lane);
        __syncthreads();
        p2_rwkv_tok(args, lds, vcu, G, tid, wave, lane);
#if defined(REP_SUB)
        __syncthreads();
        if constexpr (REP_SUB == 0) p2_rwkv_tok(args, lds, vcu, G, tid, wave, lane);
        if constexpr (REP_SUB == 11) p2_rwkv_tok<1>(args, lds, vcu, G, tid, wave, lane);
        if constexpr (REP_SUB == 12) p2_rwkv_tok<2>(args, lds, vcu, G, tid, wave, lane);
        if constexpr (REP_SUB == 1) p2_fox_norms(args, lds, vcu, G, tid, wave, lane);
        if constexpr (REP_SUB == 2) p2_fox_cumsum(args, lds, (vcu + G - 16) % G, G, tid);
        if constexpr (REP_SUB == 3) { pg8::Gemm g{(const bf16*)(ws + WS_MEMN), (const bf16*)(ws + WS_WKV), NB * MEM_LEN, 1024, D}; pg8::StaticOrder S; S.init(NB * MEM_LEN, 1024, G, bx);
          pg8::EpiBf16 E{(bf16*)(ws + WS_KVM), 1024};
          pg8::gemm_phase<pg8::EpiBf16, pg8::StaticOrder>(lds, g, S, E); }
#endif
    }
#if defined(REP_PHASE)
    if constexpr (REP_PHASE == 2) { __syncthreads();
    if constexpr (IN(2)) { PH_IDS;
        { pg8::Gemm g{(const bf16*)(ws + WS_MEMN), (const bf16*)(ws + WS_WKV), NB * MEM_LEN, 1024, D}; pg8::StaticOrder S; S.init(NB * MEM_LEN, 1024, G, bx);
          pg8::EpiBf16 E{(bf16*)(ws + WS_KVM), 1024};
          pg8::gemm_phase<pg8::EpiBf16, pg8::StaticOrder>(lds, g, S, E); }
        __syncthreads();
        p2_fox_cumsum(args, lds, (vcu + G - 16) % G, G, tid);
        __syncthreads();
        p2_fox_norms(args, lds, vcu, G, tid, wave, lane);
        __syncthreads();
        p2_rwkv_tok(args, lds, vcu, G, tid, wave, lane);
    }
    }
#endif
    SEAM(2);
    if constexpr (IN(3)) { PH_IDS; p3_rwkv_chunk(args, lds, vcu, G, tid, wave, lane); }
#if defined(REP_PHASE)
    if constexpr (REP_PHASE == 3) { __syncthreads();
    if constexpr (IN(3)) { PH_IDS; p3_rwkv_chunk(args, lds, vcu, G, tid, wave, lane); }
    }
#endif
    SEAM(3);
    if constexpr (IN(4)) { PH_IDS;
        for (int q = vcu; q < 128; q += G) { __syncthreads(); p4_rwkv_seq(args, lds, q, wave, lane); }
        p3_attention(args, lds, tid, wave, lane);
    }
#if defined(REP_PHASE)
    if constexpr (REP_PHASE == 4) { __syncthreads();
    if constexpr (IN(4)) { PH_IDS;
        for (int q = vcu; q < 128; q += G) { __syncthreads(); p4_rwkv_seq(args, lds, q, wave, lane); }
        p3_attention(args, lds, tid, wave, lane);
    }
    }
#endif
    SEAM(4);
    if constexpr (IN(5)) { PH_IDS; p5_rwkv_final(args, vcu, G, wave, lane); }
#if defined(REP_PHASE)
    if constexpr (REP_PHASE == 5) { __syncthreads();
    if constexpr (IN(5)) { PH_IDS; p5_rwkv_final(args, vcu, G, wave, lane); }
    }
#endif
    SEAM(5);
    if constexpr (IN(6)) { PH_IDS;
        LAS int* tl = (LAS int*)(lds + 131072 + 2048); __syncthreads(); if (tid < NTOK / 256) tl[tid] = 0; __syncthreads();
        pg8::Gemm g{(const bf16*)(ws + WS_MIX), (const bf16*)(ws + WS_WO), NTOK, D, D / 2};
        pg8::MoeOrder<true> S{tl, nullptr, NTOK / 256, D / 256, G, bx};
        pg8::EpiResBf16 E{(bf16*)(ws + WS_Z1), (const bf16*)(ws + WS_H0), D, ALPHA};
        pg8::gemm_phase<pg8::EpiResBf16, pg8::MoeOrder<true>, true, true>(lds, g, S, E);
    }
#if defined(REP_PHASE)
    if constexpr (REP_PHASE == 6) { __syncthreads();
    if constexpr (IN(6)) { PH_IDS;
        LAS int* tl = (LAS int*)(lds + 131072 + 2048); __syncthreads(); if (tid < NTOK / 256) tl[tid] = 0; __syncthreads();
        pg8::Gemm g{(const bf16*)(ws + WS_MIX), (const bf16*)(ws + WS_WO), NTOK, D, D / 2};
        pg8::MoeOrder<true> S{tl, nullptr, NTOK / 256, D / 256, G, bx};
        pg8::EpiResBf16 E{(bf16*)(ws + WS_Z1), (const bf16*)(ws + WS_H0), D, ALPHA};
        pg8::gemm_phase<pg8::EpiResBf16, pg8::MoeOrder<true>, true, true>(lds, g, S, E);
    }
    }
#endif
    SEAM(6);
    if constexpr (IN(7)) { PH_IDS; p5_ln_router(args, lds, vcu, G, tid, wave, lane); }
#if defined(REP_PHASE)
    if constexpr (REP_PHASE == 7) { __syncthreads();
    if constexpr (IN(7)) { PH_IDS; p5_ln_router(args, lds, vcu, G, tid, wave, lane); }
    }
#endif
    SEAM(7);
    if constexpr (IN(8)) { PH_IDS; p6_positions(args, lds, vcu, G, tid); }
#if defined(REP_PHASE)
    if constexpr (REP_PHASE == 8) { __syncthreads();
    if constexpr (IN(8)) { PH_IDS; p6_positions(args, lds, vcu, G, tid); }
    }
#endif
    SEAM(8);
    if constexpr (IN(9)) { PH_IDS;
        const int* TILE = (const int*)(ws + RT_TILE); const int ntiles = __builtin_amdgcn_readfirstlane(TILE[MAXT]);
        LAS int* tl = (LAS int*)(lds + 131072 + 2048); __syncthreads(); for (int i = tid; i < MAXT; i += NTHR) tl[i] = TILE[i]; __syncthreads();
        pg8::Gemm g{(const bf16*)(ws + WS_H1Q), (const bf16*)(ws + WS_W1), CAP, NE * 4096, D / 2};
        pg8::MoeOrder<true> S{tl, (const int*)(ws + RT_TOK), ntiles, 16, G, bx};
        pg8::EpiSwiglu E{ws + WS_ACT, args.in[26], {}, {}};
        pg8::gemm_phase<pg8::EpiSwiglu, pg8::MoeOrder<true>, true, true>(lds, g, S, E);
    }
#if defined(REP_PHASE)
    if constexpr (REP_PHASE == 9) { __syncthreads();
    if constexpr (IN(9)) { PH_IDS;
        const int* TILE = (const int*)(ws + RT_TILE); const int ntiles = __builtin_amdgcn_readfirstlane(TILE[MAXT]);
        LAS int* tl = (LAS int*)(lds + 131072 + 2048); __syncthreads(); for (int i = tid; i < MAXT; i += NTHR) tl[i] = TILE[i]; __syncthreads();
        pg8::Gemm g{(const bf16*)(ws + WS_H1Q), (const bf16*)(ws + WS_W1), CAP, NE * 4096, D / 2};
        pg8::MoeOrder<true> S{tl, (const int*)(ws + RT_TOK), ntiles, 16, G, bx};
        pg8::EpiSwiglu E{ws + WS_ACT, args.in[26], {}, {}};
        pg8::gemm_phase<pg8::EpiSwiglu, pg8::MoeOrder<true>, true, true>(lds, g, S, E);
    }
    }
#endif
    SEAM(9);
    if constexpr (IN(10)) { PH_IDS;
        const int* TILE = (const int*)(ws + RT_TILE); const int ntiles = __builtin_amdgcn_readfirstlane(TILE[MAXT]);
        LAS int* tl = (LAS int*)(lds + 131072 + 2048); __syncthreads(); for (int i = tid; i < MAXT; i += NTHR) tl[i] = TILE[i]; __syncthreads();
        pg8::Gemm g{(const bf16*)(ws + WS_ACT), (const bf16*)(ws + WS_W2), CAP, NE * D, D / 2};
        pg8::MoeOrder<true> S{tl, nullptr, ntiles, 8, G, bx};
        pg8::EpiGate E{ws + WS_Y, args.in[28], (const float*)(ws + RT_GATE), {}, {}};
        pg8::gemm_phase<pg8::EpiGate, pg8::MoeOrder<true>, true, true>(lds, g, S, E);
    }
#if defined(REP_PHASE)
    if constexpr (REP_PHASE == 10) { __syncthreads();
    if constexpr (IN(10)) { PH_IDS;
        const int* TILE = (const int*)(ws + RT_TILE); const int ntiles = __builtin_amdgcn_readfirstlane(TILE[MAXT]);
        LAS int* tl = (LAS int*)(lds + 131072 + 2048); __syncthreads(); for (int i = tid; i < MAXT; i += NTHR) tl[i] = TILE[i]; __syncthreads();
        pg8::Gemm g{(const bf16*)(ws + WS_ACT), (const bf16*)(ws + WS_W2), CAP, NE * D, D / 2};
        pg8::MoeOrder<true> S{tl, nullptr, ntiles, 8, G, bx};
        pg8::EpiGate E{ws + WS_Y, args.in[28], (const float*)(ws + RT_GATE), {}, {}};
        pg8::gemm_phase<pg8::EpiGate, pg8::MoeOrder<true>, true, true>(lds, g, S, E);
    }
    }
#endif
    SEAM(10);
    if constexpr (IN(11)) { PH_IDS; p9_final(args, vcu, G, wave, lane); }
#if defined(REP_PHASE)
    if constexpr (REP_PHASE == 11) { __syncthreads();
    if constexpr (IN(11)) { PH_IDS; p9_final(args, vcu, G, wave, lane); }
    }
#endif
#undef IN
#undef SEAM
}

template <int P> static void launch_phase(int grid, hipStream_t stream, const Args& a) {
    static bool init = false;
    if (!init) { (void)hipFuncSetAttribute((const void*)fwd_kernel<P, P + 1>, hipFuncAttributeMaxDynamicSharedMemorySize, LDS_BYTES); init = true; }
    hipLaunchKernelGGL((fwd_kernel<P, P + 1>), dim3(grid), dim3(NTHR), LDS_BYTES, stream, a);
}
extern "C" void kernel_launch(void* const* d_in, const int* in_sizes, int n_in, void* d_out, int out_size, void* d_ws, size_t ws_size, hipStream_t stream) {
    static int grid = 0;
    if (grid == 0) {
        if (n_in != 31 || out_size != NTOK * D || ws_size < WS_END) { fprintf(stderr, "kernel_launch: unexpected shapes (n_in %d out %d ws %zu, need %zu)\n", n_in, out_size, ws_size, (size_t)WS_END); grid = -1; return; }
        int dev = 0, cus = 0;
        if (hipGetDevice(&dev) != hipSuccess || hipDeviceGetAttribute(&cus, hipDeviceAttributeMultiprocessorCount, dev) != hipSuccess) { grid = -1; return; }
        grid = cus;
    }
    if (grid < 0) return;
    (void)hipMemsetAsync((char*)d_ws + WS_CTL, 0, CTL_ZERO_BYTES, stream);
    Args a{};
    for (int i = 0; i < 31; ++i) a.in[i] = (const float*)d_in[i];
    a.out = (float*)d_out; a.ws = (unsigned char*)d_ws;
#ifdef ONE_LAUNCH
    { static bool init = false; if (!init) { (void)hipFuncSetAttribute((const void*)fwd_kernel<0, NPH>, hipFuncAttributeMaxDynamicSharedMemorySize, LDS_BYTES); init = true; }
      hipLaunchKernelGGL((fwd_kernel<0, NPH>), dim3(grid), dim3(NTHR), LDS_BYTES, stream, a); }
#else
    launch_phase<0>(grid, stream, a); launch_phase<1>(grid, stream, a); launch_phase<2>(grid, stream, a); launch_phase<3>(grid, stream, a);
    launch_phase<4>(grid, stream, a); launch_phase<5>(grid, stream, a); launch_phase<6>(grid, stream, a); launch_phase<7>(grid, stream, a);
    launch_phase<8>(grid, stream, a); launch_phase<9>(grid, stream, a); launch_phase<10>(grid, stream, a); launch_phase<11>(grid, stream, a);
#endif
}
```

```cpp
#define ONE_LAUNCH 1
#include <hip/hip_runtime.h>
#include <cstdio>
#include <cstdint>

namespace pg8 {
#define PG8_LAS __attribute__((address_space(3)))
typedef unsigned short bf16_t;
typedef short bf16x8 __attribute__((ext_vector_type(8)));
typedef float f32x4 __attribute__((ext_vector_type(4)));
typedef unsigned u32x4 __attribute__((ext_vector_type(4)));
typedef unsigned u32x2 __attribute__((ext_vector_type(2)));
typedef int v4i32 __attribute__((ext_vector_type(4)));
typedef int v8i32 __attribute__((ext_vector_type(8)));
constexpr int SCALE_W = 0x79797979, SCALE_A = 0x7f7f7f7f;
constexpr int BM = 256, BK = 64, HALF = 128, HTB = HALF * BK * 2  , STAGE_BYTES = 8 * HTB, NXCD = 8, WGM = 8;

__host__ __device__ __forceinline__ int lds_byte(int r, int c) { const int st = (r >> 4) * 2 + (c >> 5), rr = r & 15, cc = c & 31, ob = rr * 64 + cc * 2; return st * 1024 + (ob ^ (((ob >> 9) & 1) << 5)); }
__host__ __device__ __forceinline__ void stage_rc(int b, int& R, int& C) { const int st = b / 1024, sb = b % 1024, swz = sb ^ (((sb >> 9) & 1) << 5); R = (st >> 1) * 16 + swz / 64; C = (st & 1) * 32 + (swz % 64) / 2; }
__host__ __device__ __forceinline__ int perm32(int rho) { const int n = rho >> 4, i = rho & 15; return 8 * (i >> 2) + 4 * n + (i & 3); }

struct Unit { int pm, pn; };
struct Gemm { const bf16_t* A; const bf16_t* Bt; int M, N, K; };

struct StaticOrder {
    int nM, nN, nwg, G, c;
    __host__ __device__ void init(int M, int N, int G_, int c_) { nM = M / BM; nN = N / BM; nwg = nM * nN; G = G_; c = c_; }
    __host__ __device__ bool next(int i, Unit& u) const {
        const long L = (long)i * G + c; if (L >= nwg) return false;
        int wgid = (int)L; { const int q = nwg / NXCD, r = nwg % NXCD, xcd = wgid % NXCD, off = wgid / NXCD; wgid = (xcd < r ? xcd * (q + 1) : r * (q + 1) + (xcd - r) * q) + off; }
        const int nig = WGM * nN, gid = wgid / nig, fm = gid * WGM, gsz = (nM - fm) < WGM ? (nM - fm) : WGM;
        u.pm = fm + ((wgid % nig) % gsz); u.pn = (wgid % nig) / gsz; return true;
    }
    static constexpr bool GATHER = false;
    __device__ __forceinline__ int arow(const Unit& u, int r) const { return u.pm * BM + r; }
};
struct QueueOrder {
    int nM, nN, nwg, x; unsigned* qhead; volatile PG8_LAS int* slot; mutable int pend;
    __device__ void init(int M, int N, int x_, unsigned* q_, volatile PG8_LAS int* s_, int pend_) { nM = M / BM; nN = N / BM; nwg = nM * nN; x = x_; qhead = q_; slot = s_; pend = pend_; }
    __device__ __forceinline__ int pop() const { return 8 * (int)__hip_atomic_fetch_add(qhead + 64 * x, 1u, __ATOMIC_RELAXED, __HIP_MEMORY_SCOPE_AGENT) + x; }
    __device__ __forceinline__ bool next(int i, Unit& u) const {
        const int L = __builtin_amdgcn_readfirstlane(slot[i % 3]);
        if (threadIdx.x == 0) { slot[(i + 2) % 3] = pend; pend = pop(); }
        if (L >= nwg) return false;
        int wgid = L; { const int q = nwg / NXCD, r = nwg % NXCD, xcd = wgid % NXCD, off = wgid / NXCD; wgid = (xcd < r ? xcd * (q + 1) : r * (q + 1) + (xcd - r) * q) + off; }
        const int nig = WGM * nN, gid = wgid / nig, fm = gid * WGM, gsz = (nM - fm) < WGM ? (nM - fm) : WGM;
        u.pm = fm + ((wgid % nig) % gsz); u.pn = (wgid % nig) / gsz; return true;
    }
    static constexpr bool GATHER = false;
    __device__ __forceinline__ int arow(const Unit& u, int r) const { return u.pm * BM + r; }
};
template <bool GATHER_> struct MoeOrder {
    static constexpr bool GATHER = GATHER_;
    const PG8_LAS int* tile_e; const int* tok; int ntiles, ncol, G, c;
    __device__ __forceinline__ bool next(int i, Unit& u) const {
        int rt, ct;
        if ((G & 7) == 0 && ((G >> 3) % ncol) == 0) {
            const int R = G / ncol, x = c & 7, j = c >> 3;
            rt = i * R + x * (R >> 3) + j / ncol; ct = j % ncol; if (rt >= ntiles) return false;
        } else { const long L = (long)i * G + c; if (L >= (long)ntiles * ncol) return false; rt = (int)(L / ncol); ct = (int)(L % ncol); }
        u.pm = rt; u.pn = __builtin_amdgcn_readfirstlane(tile_e[rt]) * ncol + ct; return true;
    }
    __device__ __forceinline__ int arow(const Unit& u, int r) const { return (GATHER_ && tok) ? tok[u.pm * BM + r] : u.pm * BM + r; }
};

typedef float f32x2_t __attribute__((ext_vector_type(2))); typedef __bf16 bf16x2_t __attribute__((ext_vector_type(2)));
__device__ __forceinline__ unsigned cvt_pk_bf16(float lo, float hi) { const f32x2_t v = {lo, hi}; const bf16x2_t b = __builtin_convertvector(v, bf16x2_t); return __builtin_bit_cast(unsigned, b); }
__device__ __forceinline__ float bf_lo(unsigned w) { return __builtin_bit_cast(float, w << 16); }
__device__ __forceinline__ float bf_hi(unsigned w) { return __builtin_bit_cast(float, w & 0xffff0000u); }

__device__ __forceinline__ unsigned pk4_fp8(float a, float b, float c, float d) { unsigned w = 0u; w = __builtin_amdgcn_cvt_pk_fp8_f32(a, b, w, false); w = __builtin_amdgcn_cvt_pk_fp8_f32(c, d, w, true); return w; }
template <class T> __device__ __forceinline__ T* sbase(T* p) { asm volatile("" : "+s"(p)); return p; }
__device__ __forceinline__ unsigned vopaque(unsigned v) { asm volatile("" : "+v"(v)); return v; }
struct EpiBf16 {
    static constexpr bool PERM = true;
    bf16_t* O; int ldc;
    __device__ __forceinline__ void pre(const Unit&, int, int, int, int) const {}
    __device__ __forceinline__ void operator()(const f32x4 (&acc)[2][2][4][2], const Unit& u, int wr, int wc, int fr, int fq) const {
        const unsigned lo = vopaque(((unsigned)(wr * 64 + fr) * (unsigned)ldc + (unsigned)(wc * 32 + 8 * fq)) * 2u);
#pragma unroll
        for (int ai = 0; ai < 2; ++ai)
#pragma unroll
            for (int m = 0; m < 4; ++m) { char* rb = (char*)sbase(O + (size_t)(u.pm * BM + ai * HALF + m * 16) * ldc + u.pn * BM);
#pragma unroll
                for (int bj = 0; bj < 2; ++bj) { const f32x4 v0 = acc[ai][bj][m][0], v1 = acc[ai][bj][m][1];
                    u32x4 w; w.x = cvt_pk_bf16(v0[0], v0[1]); w.y = cvt_pk_bf16(v0[2], v0[3]); w.z = cvt_pk_bf16(v1[0], v1[1]); w.w = cvt_pk_bf16(v1[2], v1[3]);
                    *(u32x4*)(rb + bj * HALF * 2 + lo) = w; } }
    }
};
struct EpiResBf16 {
    static constexpr bool PERM = true;
    bf16_t* C; const bf16_t* R; int ldc; float alpha;
    __device__ __forceinline__ void pre(const Unit&, int, int, int, int) const {}
    __device__ __forceinline__ void operator()(const f32x4 (&acc)[2][2][4][2], const Unit& u, int wr, int wc, int fr, int fq) const {
        const unsigned lo = vopaque(((unsigned)(wr * 64 + fr) * (unsigned)ldc + (unsigned)(wc * 32 + 8 * fq)) * 2u);
#pragma unroll
        for (int ai = 0; ai < 2; ++ai)
#pragma unroll
            for (int m = 0; m < 4; ++m) { const size_t ro = (size_t)(u.pm * BM + ai * HALF + m * 16) * ldc + u.pn * BM; char* cb = (char*)sbase(C + ro); const char* rb = (const char*)sbase(R + ro);
#pragma unroll
                for (int bj = 0; bj < 2; ++bj) { const u32x4 rr = *(const u32x4*)(rb + bj * HALF * 2 + lo); const f32x4 v0 = acc[ai][bj][m][0], v1 = acc[ai][bj][m][1];
                    u32x4 w; w.x = cvt_pk_bf16(v0[0] + alpha * bf_lo(rr.x), v0[1] + alpha * bf_hi(rr.x)); w.y = cvt_pk_bf16(v0[2] + alpha * bf_lo(rr.y), v0[3] + alpha * bf_hi(rr.y));
                    w.z = cvt_pk_bf16(v1[0] + alpha * bf_lo(rr.z), v1[1] + alpha * bf_hi(rr.z)); w.w = cvt_pk_bf16(v1[2] + alpha * bf_lo(rr.w), v1[3] + alpha * bf_hi(rr.w));
                    *(u32x4*)(cb + bj * HALF * 2 + lo) = w; }
                if (m & 1) asm volatile("" ::: "memory"); }
    }
};
struct EpiSwiglu {
    static constexpr bool PERM = true;
    unsigned char* O; const float* b1;
    mutable f32x4 vg[2], vl[2];
    __device__ __forceinline__ void pre(const Unit& u, int wr, int wc, int fr, int fq) const {
        const int e = u.pn >> 4, ct = u.pn & 15; const unsigned lc = vopaque((unsigned)(wc * 32 + 8 * fq));
        const char* bg = (const char*)sbase(b1 + (size_t)e * 4096 + ct * 128); const char* bl = (const char*)sbase(b1 + (size_t)e * 4096 + 2048 + ct * 128);
#pragma unroll
        for (int n = 0; n < 2; ++n) { vg[n] = *(const f32x4*)(bg + n * 16 + lc * 4u); vl[n] = *(const f32x4*)(bl + n * 16 + lc * 4u); }
    }
    __device__ __forceinline__ void operator()(const f32x4 (&acc)[2][2][4][2], const Unit& u, int wr, int wc, int fr, int fq) const {
        const int ct = u.pn & 15;
        const unsigned lo2 = vopaque(((unsigned)(wr * 64 + fr) + 16u * (unsigned)(fq & 1)) * 2048u + (unsigned)(wc * 32 + 16 * (fq >> 1)));
#pragma unroll
        for (int ai = 0; ai < 2; ++ai)
#pragma unroll
            for (int mp = 0; mp < 2; ++mp) { unsigned char* rb = sbase(O + (size_t)(u.pm * BM + ai * HALF + mp * 32) * 2048 + ct * 128);
                unsigned px[2], py[2];
#pragma unroll
                for (int q = 0; q < 2; ++q) { const int m = 2 * mp + q; float a[8];
#pragma unroll
                    for (int n = 0; n < 2; ++n)
#pragma unroll
                        for (int i = 0; i < 4; ++i) { float g = acc[ai][0][m][n][i] + vg[n][i], l = acc[ai][1][m][n][i] + vl[n][i];
                            g = fminf(g, 7.0f); l = fminf(fmaxf(l, -7.0f), 7.0f);
                            const float sg = __builtin_amdgcn_rcpf(1.0f + __builtin_amdgcn_exp2f(-1.702f * 1.4426950408889634f * g));
                            a[n * 4 + i] = (l + 1.0f) * g * sg; }
                    px[q] = pk4_fp8(a[0], a[1], a[2], a[3]); py[q] = pk4_fp8(a[4], a[5], a[6], a[7]); }
                const auto sx = __builtin_amdgcn_permlane16_swap(px[0], px[1], false, false); const auto sy = __builtin_amdgcn_permlane16_swap(py[0], py[1], false, false);
                u32x4 w; w.x = sx[0]; w.y = sy[0]; w.z = sx[1]; w.w = sy[1];
                *(u32x4*)(rb + lo2) = w; }
    }
};
struct EpiGate {
    static constexpr bool PERM = true;
    unsigned char* O; const float* b2; const float* gate;
    mutable float gtv[8]; mutable f32x4 cb[2][2];
    __device__ __forceinline__ void pre(const Unit& u, int wr, int wc, int fr, int fq) const {
        const int e = u.pn >> 3, ct = u.pn & 7; const unsigned lr = vopaque((unsigned)(wr * 64 + fr)), lc = vopaque((unsigned)(wc * 32 + 8 * fq));
        const char* bb = (const char*)sbase(b2 + (size_t)e * 2048 + ct * 256);
#pragma unroll
        for (int bj = 0; bj < 2; ++bj) { cb[bj][0] = *(const f32x4*)(bb + bj * HALF * 4 + lc * 4u); cb[bj][1] = *(const f32x4*)(bb + bj * HALF * 4 + 16 + lc * 4u); }
#pragma unroll
        for (int q = 0; q < 8; ++q) gtv[q] = *(const float*)((const char*)sbase(gate + u.pm * BM + (q >> 2) * HALF + (q & 3) * 16) + lr * 4u);
    }
    __device__ __forceinline__ void operator()(const f32x4 (&acc)[2][2][4][2], const Unit& u, int wr, int wc, int fr, int fq) const {
        const int ct = u.pn & 7;
        const unsigned lr = vopaque((unsigned)(wr * 64 + fr)), lc = vopaque((unsigned)(wc * 32 + 8 * fq)), lo = lr * 2048u + lc;
        const unsigned lo2 = vopaque((lr + 16u * (unsigned)(fq & 1)) * 2048u + (unsigned)(wc * 32 + 16 * (fq >> 1)));
#pragma unroll
        for (int ai = 0; ai < 2; ++ai)
#pragma unroll
            for (int mp = 0; mp < 2; ++mp) { const int rg = u.pm * BM + ai * HALF + mp * 32; const float gt0 = 64.0f * gtv[ai * 4 + 2 * mp], gt1 = 64.0f * gtv[ai * 4 + 2 * mp + 1];
                unsigned char* rb = sbase(O + (size_t)rg * 2048 + ct * 256);
#pragma unroll
                for (int bj = 0; bj < 2; ++bj) { const f32x4 c0 = cb[bj][0], c1 = cb[bj][1];
                    const f32x4 a0 = (acc[ai][bj][2 * mp][0] + c0) * gt0, a1 = (acc[ai][bj][2 * mp][1] + c1) * gt0, b0 = (acc[ai][bj][2 * mp + 1][0] + c0) * gt1, b1 = (acc[ai][bj][2 * mp + 1][1] + c1) * gt1;
                    const unsigned ax = pk4_fp8(a0[0], a0[1], a0[2], a0[3]), ay = pk4_fp8(a1[0], a1[1], a1[2], a1[3]), bx = pk4_fp8(b0[0], b0[1], b0[2], b0[3]), by = pk4_fp8(b1[0], b1[1], b1[2], b1[3]);
                    const auto sx = __builtin_amdgcn_permlane16_swap(ax, bx, false, false); const auto sy = __builtin_amdgcn_permlane16_swap(ay, by, false, false);
                    u32x4 w; w.x = sx[0]; w.y = sy[0]; w.z = sx[1]; w.w = sy[1];
                    *(u32x4*)(rb + bj * HALF + lo2) = w; } }
    }
};

template <class Epi, class Sched, bool ALIGN_EPI = true, bool FP8 = false>
__device__ __forceinline__ void gemm_phase(PG8_LAS unsigned char* lds, const Gemm g, const Sched& S, const Epi& E) {
    int tid = threadIdx.x; asm volatile("" : "+v"(tid));
    const int wid = __builtin_amdgcn_readfirstlane(tid >> 6), lane = tid & 63, wr = wid >> 2, wc = wid & 3, fr = lane & 15, fq = lane >> 4;
    const int K = g.K, nt = K / BK;
    int RA[2]; unsigned cA2[2], voffB[2];
#pragma unroll
    for (int i = 0; i < 2; ++i) { int R, C; stage_rc(tid * 16 + i * 8192, R, C); const int Rb = Epi::PERM ? ((R & ~31) + perm32(R & 31)) : R;
        RA[i] = R; cA2[i] = (unsigned)C * 2u; voffB[i] = (unsigned)(Rb * K + C) * 2u; }
    const size_t kstep = (size_t)(BK * 2);
    const size_t hstep = (size_t)HALF * K * 2;
    const size_t tstep = 2 * hstep;
    const unsigned ldsw = (unsigned)wid * 1024u;
    const int aoff = lds_byte(wr * 64 + fr, fq * 8), boff = lds_byte(wc * 32 + fr, fq * 8);
#define PG8_SA(b, h) (((b) * 2 + (h)) * HTB)
#define PG8_SB(b, h) ((4 + (b) * 2 + (h)) * HTB)
#define PG8_STAGE(bufoff, gbase, voff) do { const char* _gb = (const char*)(gbase); asm volatile("" : "+s"(_gb)); _Pragma("unroll") for (int _i = 0; _i < 2; ++_i) { \
        unsigned _vo = (voff)[_i]; asm volatile("" : "+v"(_vo));     \
        __builtin_amdgcn_global_load_lds((const unsigned*)(_gb + _vo), (PG8_LAS unsigned*)(lds + (bufoff) + ldsw + _i * 8192), 16, 0, 0); } } while (0)
#define PG8_LD32(p) __builtin_shufflevector(*(const PG8_LAS v4i32*)(p), *(const PG8_LAS v4i32*)((p) + 1024), 0, 1, 2, 3, 4, 5, 6, 7)
#define PG8_LDA(dst, b, h) do { _Pragma("unroll") for (int m = 0; m < 4; ++m) dst[m] = PG8_LD32(lds + PG8_SA(b, h) + aoff + m * 2048); } while (0)
#define PG8_LDB(dst, b, h) do { _Pragma("unroll") for (int n = 0; n < 2; ++n) dst[n] = PG8_LD32(lds + PG8_SB(b, h) + boff + n * 2048); } while (0)
#define PG8_H0(x) __builtin_bit_cast(bf16x8, __builtin_shufflevector(x, x, 0, 1, 2, 3))
#define PG8_H1(x) __builtin_bit_cast(bf16x8, __builtin_shufflevector(x, x, 4, 5, 6, 7))
#define PG8_MMA(ai, bj, At, Bt) do { __builtin_amdgcn_s_setprio(1); _Pragma("unroll") for (int m = 0; m < 4; ++m) _Pragma("unroll") for (int n = 0; n < 2; ++n) { \
        if constexpr (FP8) acc[ai][bj][m][n] = __builtin_amdgcn_mfma_scale_f32_16x16x128_f8f6f4(Bt[n], At[m], acc[ai][bj][m][n], 0, 0, 0, SCALE_W, 0, SCALE_A); \
        else { acc[ai][bj][m][n] = __builtin_amdgcn_mfma_f32_16x16x32_bf16(PG8_H0(Bt[n]), PG8_H0(At[m]), acc[ai][bj][m][n], 0, 0, 0); \
               acc[ai][bj][m][n] = __builtin_amdgcn_mfma_f32_16x16x32_bf16(PG8_H1(Bt[n]), PG8_H1(At[m]), acc[ai][bj][m][n], 0, 0, 0); } } \
        __builtin_amdgcn_s_setprio(0); } while (0)
#define PG8_WAIT_V(n) asm volatile("s_waitcnt vmcnt(" #n ")" ::: "memory")
#define PG8_WAIT_L(n) asm volatile("s_waitcnt lgkmcnt(" #n ")" ::: "memory")
#define PG8_BAR __builtin_amdgcn_s_barrier()
#define PG8_SCHED __builtin_amdgcn_sched_barrier(0)
#define PG8_AOFF(dst, u) do { _Pragma("unroll") for (int _h = 0; _h < 2; ++_h) _Pragma("unroll") for (int _i = 0; _i < 2; ++_i) \
        dst[_h][_i] = (unsigned)S.arow(u, _h * HALF + RA[_i]) * (unsigned)(K * 2) + cA2[_i]; } while (0)
    Unit cur, nxt; int ui = 0;
    if (!S.next(0, cur)) return;
    constexpr bool GA = Sched::GATHER;
    unsigned offC[2][2], offN[2][2];
    const char* gA = (const char*)g.A; const char* nA = gA;
    int rawN[2][2]; Unit nn; bool has_nn = false;
#define PG8_ARAW(dst, u) do { _Pragma("unroll") for (int _h = 0; _h < 2; ++_h) _Pragma("unroll") for (int _i = 0; _i < 2; ++_i) dst[_h][_i] = S.arow(u, _h * HALF + RA[_i]); } while (0)
    if constexpr (GA) { PG8_AOFF(offC, cur); has_nn = S.next(1, nn); if (has_nn) PG8_ARAW(rawN, nn); asm volatile("s_waitcnt vmcnt(0)" ::: "memory"); }
    else {
#pragma unroll
        for (int i = 0; i < 2; ++i) { offC[0][i] = (unsigned)RA[i] * (unsigned)(K * 2) + cA2[i]; offC[1][i] = offC[0][i] + (unsigned)hstep; }
        gA += (size_t)cur.pm * tstep; }
    E.pre(cur, wr, wc, fr, fq);
    f32x4 acc[2][2][4][2];
#pragma unroll
    for (int a = 0; a < 2; ++a)
#pragma unroll
        for (int b = 0; b < 2; ++b)
#pragma unroll
            for (int m = 0; m < 4; ++m)
#pragma unroll
                for (int n = 0; n < 2; ++n) acc[a][b][m][n] = (f32x4){0.f, 0.f, 0.f, 0.f};
    v8i32 At[4], B0[2], B1[2];
    const char* cB = (const char*)g.Bt + (size_t)cur.pn * tstep;
    PG8_STAGE(PG8_SB(0, 0), cB, voffB); PG8_STAGE(PG8_SB(0, 1), cB + hstep, voffB); PG8_STAGE(PG8_SA(0, 0), gA, offC[0]); PG8_STAGE(PG8_SA(0, 1), gA, offC[1]);
    if (wr == 1) PG8_BAR;
    PG8_WAIT_V(2); PG8_BAR;
    PG8_STAGE(PG8_SB(1, 0), cB + kstep, voffB); PG8_STAGE(PG8_SA(1, 0), gA + kstep, offC[0]); PG8_STAGE(PG8_SB(1, 1), cB + hstep + kstep, voffB);
    PG8_WAIT_V(6); PG8_BAR;
    for (;;) {
        bool has_next;
        if constexpr (GA) {
            has_next = has_nn; nxt = nn;
#pragma unroll
            for (int h = 0; h < 2; ++h)
#pragma unroll
                for (int i = 0; i < 2; ++i) offN[h][i] = has_next ? (unsigned)rawN[h][i] * (unsigned)(K * 2) + cA2[i] : offC[h][i];
            has_nn = S.next(ui + 2, nn); if (has_nn) PG8_ARAW(rawN, nn);
        } else { has_next = S.next(ui + 1, nxt); nA = has_next ? (const char*)g.A + (size_t)nxt.pm * tstep : gA; }
        const char* nB = has_next ? (const char*)g.Bt + (size_t)nxt.pn * tstep : cB;
        for (int t = 0; t < nt; t += 2) {
            const bool last = (t == nt - 2);
            const char* a1 = gA + (size_t)(t + 1) * kstep;
            const char* a2 = last ? nA : gA + (size_t)(t + 2) * kstep; const char* b2 = last ? nB : cB + (size_t)(t + 2) * kstep;
            const char* a3 = a2 + kstep; const char* b3 = b2 + kstep;
            PG8_LDB(B0, 0, 0); PG8_LDB(B1, 0, 1); PG8_SCHED; PG8_LDA(At, 0, 0); PG8_STAGE(PG8_SA(1, 1), a1, offC[1]);
            if constexpr (GA) { if (last) {
#pragma unroll
                for (int h = 0; h < 2; ++h)
#pragma unroll
                    for (int i = 0; i < 2; ++i) offC[h][i] = offN[h][i]; } }
            PG8_WAIT_V(8); PG8_WAIT_L(0); PG8_BAR; PG8_MMA(0, 0, At, B0); PG8_MMA(0, 1, At, B1); PG8_BAR; PG8_SCHED;
            PG8_LDA(At, 0, 1); PG8_STAGE(PG8_SB(0, 0), b2, voffB); PG8_STAGE(PG8_SB(0, 1), b2 + hstep, voffB); PG8_STAGE(PG8_SA(0, 0), a2, offC[0]);
            PG8_WAIT_V(8); PG8_WAIT_L(0); PG8_BAR; PG8_MMA(1, 0, At, B0); PG8_MMA(1, 1, At, B1); PG8_BAR; PG8_SCHED;
            PG8_LDB(B0, 1, 0); PG8_LDB(B1, 1, 1); PG8_SCHED; PG8_LDA(At, 1, 0); PG8_STAGE(PG8_SA(0, 1), a2, offC[1]);
            PG8_WAIT_V(8); PG8_WAIT_L(0); PG8_BAR; PG8_MMA(0, 0, At, B0); PG8_MMA(0, 1, At, B1); PG8_BAR; PG8_SCHED;
            PG8_LDA(At, 1, 1); PG8_STAGE(PG8_SB(1, 0), b3, voffB); PG8_STAGE(PG8_SB(1, 1), b3 + hstep, voffB); PG8_STAGE(PG8_SA(1, 0), a3, offC[0]);
            PG8_WAIT_V(8); PG8_WAIT_L(0); PG8_BAR; PG8_MMA(1, 0, At, B0); PG8_MMA(1, 1, At, B1); PG8_BAR; PG8_SCHED;
        }
        if constexpr (ALIGN_EPI) { if (wr == 0) PG8_BAR; }
        E(acc, cur, wr, wc, fr, fq);
        if (!has_next) break;
#pragma unroll
        for (int a = 0; a < 2; ++a)
#pragma unroll
            for (int b = 0; b < 2; ++b)
#pragma unroll
                for (int m = 0; m < 4; ++m)
#pragma unroll
                    for (int n = 0; n < 2; ++n) acc[a][b][m][n] = (f32x4){0.f, 0.f, 0.f, 0.f};
        cur = nxt; cB = nB; ++ui; if constexpr (!GA) gA = nA;
        E.pre(cur, wr, wc, fr, fq);
        if constexpr (ALIGN_EPI) { if (wr == 1) PG8_BAR; }
    }
    PG8_WAIT_V(0);
    if constexpr (!ALIGN_EPI) { if (wr == 0) PG8_BAR; }
    PG8_BAR;
#undef PG8_SA
#undef PG8_SB
#undef PG8_STAGE
#undef PG8_LDA
#undef PG8_LDB
#undef PG8_LD32
#undef PG8_H0
#undef PG8_H1
#undef PG8_MMA
#undef PG8_WAIT_V
#undef PG8_WAIT_L
#undef PG8_BAR
#undef PG8_SCHED
#undef PG8_AOFF
#undef PG8_ARAW
}
}
#define GAS __attribute__((address_space(1)))
#define LAS __attribute__((address_space(3)))
typedef unsigned short bf16;
typedef unsigned v4u __attribute__((ext_vector_type(4)));
typedef float f32x4 __attribute__((ext_vector_type(4)));
typedef short bf16x8 __attribute__((ext_vector_type(8)));
typedef GAS unsigned gu32;
typedef GAS unsigned long long gu64;
#define RLX_AGENT __ATOMIC_RELAXED, __HIP_MEMORY_SCOPE_AGENT
#define LDS_WAIT() asm volatile("s_waitcnt lgkmcnt(0)" ::: "memory")
#define VM_WAIT() asm volatile("s_waitcnt vmcnt(0)" ::: "memory")
__device__ __forceinline__ unsigned long long rt() { return __builtin_amdgcn_s_memrealtime(); }
__device__ __forceinline__ unsigned pk2(float lo, float hi) { return pg8::cvt_pk_bf16(lo, hi); }
__device__ __forceinline__ unsigned f2bf(float f) { return pg8::cvt_pk_bf16(f, 0.f) & 0xffffu; }

#define XB_TMO      128
#define XB_XCNT(j)  (256  + 64 * (j))
#define XB_XSUB(j)  (1280 + 64 * (j))
#define XB_XGEN(j)  (2304 + 64 * (j))
#define XB_TOP      3328
#define XB_TOPGEN   3392
#define XCD_BAR_WORDS 3456
#define XB_SPIN_CAP (1u << 18)

__device__ __forceinline__ unsigned xb_ld(unsigned* p)              { return __hip_atomic_load(p, __ATOMIC_RELAXED, __HIP_MEMORY_SCOPE_AGENT); }
__device__ __forceinline__ unsigned xb_add(unsigned* p, unsigned v) { return __hip_atomic_fetch_add(p, v, __ATOMIC_RELAXED, __HIP_MEMORY_SCOPE_AGENT); }
__device__ __forceinline__ unsigned xb_xcc_id() { return (unsigned)__builtin_amdgcn_s_getreg((3 << 11) | 20) & 0xFu; }
#define XB_SPIN(cond, bar) do { unsigned _sp = 0; while (cond) { __builtin_amdgcn_s_sleep(1); \
    if ((++_sp & 255u) == 0u) { if (xb_ld(&(bar)[XB_TMO])) break; if (_sp > XB_SPIN_CAP) { atomicAdd(&(bar)[XB_TMO], 1u); break; } } } } while (0)

struct XcdBarrier {
    unsigned* bar; unsigned x;
    volatile LAS unsigned* st;
};

__device__ __forceinline__ XcdBarrier xcd_barrier_post(unsigned* bar, volatile LAS unsigned* st) {
    XcdBarrier b; b.bar = bar; b.x = xb_xcc_id(); b.st = st;
    if (threadIdx.x == 0) (void)xb_add(&bar[XB_XCNT(b.x)], 1u);
    return b;
}
__device__ __forceinline__ void xcd_barrier_complete(unsigned* bar, unsigned x, unsigned& nloc, unsigned& nx) {
    const unsigned G = gridDim.x * gridDim.y * gridDim.z;
    unsigned sum, cnt, mine, sp = 0u;
    for (;;) {
        sum = 0u; cnt = 0u; mine = 0u;
#pragma unroll
        for (unsigned j = 0; j < 16; ++j) { const unsigned c = xb_ld(&bar[XB_XCNT(j)]); sum += c; cnt += (c > 0u) ? 1u : 0u; mine = (j == x) ? c : mine; }
        if (sum == G) break;
        __builtin_amdgcn_s_sleep(1);
        if ((++sp & 255u) == 0u) { if (xb_ld(&bar[XB_TMO])) break; if (sp > XB_SPIN_CAP) { atomicAdd(&bar[XB_TMO], 1u); break; } }
    }
    nloc = mine > 0u ? mine : 1u; nx = cnt > 0u ? cnt : 1u;
}

__device__ __forceinline__ void xcd_barrier(const XcdBarrier& b) {
    asm volatile("s_waitcnt vmcnt(0)" ::: "memory");
    __syncthreads();
    if (threadIdx.x == 0) {
        unsigned* bar = b.bar;
        __builtin_amdgcn_s_waitcnt(0);
        unsigned nloc = b.st[0], nx = b.st[1];
        if (nloc == 0u) { xcd_barrier_complete(bar, b.x, nloc, nx); b.st[0] = nloc; b.st[1] = nx; }
        const unsigned old = xb_add(&bar[XB_XSUB(b.x)], 1u);
        const unsigned gen = old / nloc;
        if (old + 1u == (gen + 1u) * nloc) {
            __builtin_amdgcn_fence(__ATOMIC_RELEASE, "agent");
            asm volatile("s_waitcnt vmcnt(0)" ::: "memory");
            const unsigned og = xb_add(&bar[XB_TOP], 1u);
            const unsigned tg = og / nx;
            if (og + 1u == (tg + 1u) * nx) xb_add(&bar[XB_TOPGEN], 1u);
            else XB_SPIN(xb_ld(&bar[XB_TOPGEN]) == tg, bar);
            __builtin_amdgcn_fence(__ATOMIC_ACQUIRE, "agent");
            xb_add(&bar[XB_XGEN(b.x)], 1u);
            asm volatile("s_waitcnt vmcnt(0)" ::: "memory");
        } else {
            XB_SPIN(xb_ld(&bar[XB_XGEN(b.x)]) == gen, bar);
            __builtin_amdgcn_fence(__ATOMIC_ACQUIRE, "agent");
            asm volatile("s_waitcnt vmcnt(0)" ::: "memory");
        }
    }
    __syncthreads();
}


constexpr int NB = 2, T = 16384, NTOK = NB * T, D = 2048;
constexpr int PW = 5632;
constexpr int C_R = 0, C_K = 1024, C_V = 2048, C_DW = 3072, C_DA = 3168, C_DG = 3264, C_FQ = 3520, C_FK = 4032, C_FV = 4544, C_FF = 5056, C_MQ = 5064, IN_W = 5576;
constexpr int NE = 32, CAP = 131072 + 8192, MAXT = CAP / 256;
constexpr int MEM_LEN = 256;
constexpr float LN_EPS = 1e-5f, GN_EPS = 64e-5f, ALPHA = 1.189207115002721f, LOG2E = 1.4426950408889634f;
constexpr int NWAVES = 8, NTHR = 512;

constexpr size_t MiB = 1u << 20;
constexpr size_t WS_CTL = 0, CTL_ZERO_BYTES = 1 * MiB;
constexpr size_t WS_WI = 2 * MiB, WS_WO = 24 * MiB, WS_WKV = 32 * MiB, WS_RWT = 36 * MiB, WS_MEMN = 37 * MiB, WS_KVM = 39 * MiB, WS_C = 40 * MiB  ;
constexpr size_t WS_ROUTE = 42 * MiB;
constexpr size_t RT_TOPI = WS_ROUTE, RT_TOPG = RT_TOPI + 512 * 1024, RT_POS = RT_TOPG + 512 * 1024, RT_CNT = RT_POS + 512 * 1024, RT_TOK = RT_CNT + 64 * 1024, RT_GATE = RT_TOK + 1024 * 1024, RT_TILE = RT_GATE + 1024 * 1024;
constexpr size_t WS_W1 = 48 * MiB, WS_W2 = 560 * MiB, WS_H0 = 816 * MiB, WS_H1 = 944 * MiB, WS_MIX = 1072 * MiB, WS_Z1 = 1200 * MiB, WS_P = 1456 * MiB;
constexpr size_t WS_RW = 1808 * MiB, RW_ARR = 128 * MiB;
constexpr size_t WS_ACT = 2960 * MiB, WS_Y = 3504 * MiB, WS_END = 4048 * MiB;
constexpr size_t WS_WLT = 46 * MiB;
constexpr size_t WS_H1Q = 304 * MiB;
constexpr size_t WS_FOXB = 47 * MiB;
constexpr float FOX_SKIP = 30.0f;
constexpr int CW_BAR = 4096;
constexpr int CW_KMAX = 2048;
constexpr int CW_QUEUE = 2112;
constexpr int CW_XQ = 2176;
constexpr int CW_A0Q = 2240;
constexpr int NG_INPROJ = 192;

constexpr int LDS_BYTES = 147456, MISC_OFF = LDS_BYTES - 256;

struct Args { const float* in[31]; float* out; unsigned char* ws; int ph_lo, ph_hi; };

__device__ __forceinline__ float wave_sum(float v) {
#pragma unroll
    for (int o = 1; o < 64; o <<= 1) v += __shfl_xor(v, o);
    return v;
}
__device__ __forceinline__ float bfl(unsigned w) { return __builtin_bit_cast(float, w << 16); }
__device__ __forceinline__ float bfh(unsigned w) { return __builtin_bit_cast(float, w & 0xffff0000u); }
__device__ __forceinline__ float bf1(bf16 h) { return __builtin_bit_cast(float, (unsigned)h << 16); }
__device__ __forceinline__ float sigmoidf_(float x) { return 1.0f / (1.0f + __expf(-x)); }

__device__ __forceinline__ void ln_row(f32x4 (&v)[8], const float* g, const float* b, float eps, int lane) {
    float s = 0.f;
#pragma unroll
    for (int j = 0; j < 8; ++j) s += (v[j].x + v[j].y) + (v[j].z + v[j].w);
    const float mean = wave_sum(s) * (1.f / D); float s2 = 0.f;
#pragma unroll
    for (int j = 0; j < 8; ++j) { v[j] = v[j] - mean; s2 += (v[j].x * v[j].x + v[j].y * v[j].y) + (v[j].z * v[j].z + v[j].w * v[j].w); }
    const float rstd = 1.f / sqrtf(wave_sum(s2) * (1.f / D) + eps);
#pragma unroll
    for (int j = 0; j < 8; ++j) { const f32x4 gg = *(const f32x4*)(g + 4 * lane + 256 * j), bb = *(const f32x4*)(b + 4 * lane + 256 * j); v[j] = v[j] * rstd * gg + bb; }
}
__device__ __forceinline__ void store_row_bf16(bf16* orow, const f32x4 (&v)[8], int lane) {
#pragma unroll
    for (int j = 0; j < 8; ++j) { pg8::u32x2 w; w.x = pk2(v[j].x, v[j].y); w.y = pk2(v[j].z, v[j].w); *(pg8::u32x2*)(orow + 4 * lane + 256 * j) = w; }
}

template <class RowMap>
__device__ __forceinline__ void transpose_item(const float* W, int ldw, int nvalid, int K, bf16* WT, const RowMap& rm, LAS float* scr, int k0, int n0, int lane) {
#pragma unroll 4
    for (int it = 0; it < 16; ++it) { const int k = 4 * it + (lane >> 4), nl = 4 * (lane & 15), n = n0 + nl;
        f32x4 v = (f32x4){0.f, 0.f, 0.f, 0.f}; if (n < nvalid) v = *(const f32x4*)(W + (size_t)(k0 + k) * ldw + n);
        LAS float* s = scr + k * 65 + nl; s[0] = v.x; s[1] = v.y; s[2] = v.z; s[3] = v.w; }
    LDS_WAIT(); asm volatile("" ::: "memory");
    const int c = lane & 7;
#pragma unroll
    for (int j = 0; j < 8; ++j) { const int nl = 8 * j + (lane >> 3); const LAS float* s = scr + (8 * c) * 65 + nl;
        v4u o; o.x = pk2(s[0 * 65], s[1 * 65]); o.y = pk2(s[2 * 65], s[3 * 65]); o.z = pk2(s[4 * 65], s[5 * 65]); o.w = pk2(s[6 * 65], s[7 * 65]);
        *(v4u*)(WT + (size_t)rm(n0 + nl) * K + k0 + 8 * c) = o; }
    LDS_WAIT(); asm volatile("" ::: "memory");
}
template <class RowMap>
__device__ __forceinline__ void transpose_item_fp8(const float* W, int ldw, int K, unsigned char* WT, const RowMap& rm, LAS float* scr, int k0, int n0, int lane) {
#pragma unroll 4
    for (int it = 0; it < 16; ++it) { const int k = 4 * it + (lane >> 4), nl = 4 * (lane & 15);
        const f32x4 v = *(const f32x4*)(W + (size_t)(k0 + k) * ldw + n0 + nl);
        LAS float* s = scr + k * 65 + nl; s[0] = v.x; s[1] = v.y; s[2] = v.z; s[3] = v.w; }
    LDS_WAIT(); asm volatile("" ::: "memory");
    const int c = lane & 3;
#pragma unroll
    for (int j = 0; j < 4; ++j) { const int nl = 16 * j + (lane >> 2); const LAS float* s = scr + (16 * c) * 65 + nl;
        v4u o; o.x = pg8::pk4_fp8(64.f * s[0 * 65], 64.f * s[1 * 65], 64.f * s[2 * 65], 64.f * s[3 * 65]); o.y = pg8::pk4_fp8(64.f * s[4 * 65], 64.f * s[5 * 65], 64.f * s[6 * 65], 64.f * s[7 * 65]);
        o.z = pg8::pk4_fp8(64.f * s[8 * 65], 64.f * s[9 * 65], 64.f * s[10 * 65], 64.f * s[11 * 65]); o.w = pg8::pk4_fp8(64.f * s[12 * 65], 64.f * s[13 * 65], 64.f * s[14 * 65], 64.f * s[15 * 65]);
        *(v4u*)(WT + (size_t)rm(n0 + nl) * K + k0 + 16 * c) = o; }
    LDS_WAIT(); asm volatile("" ::: "memory");
}
struct XItem { const float* W; unsigned char* WT; int ldw, k0, n0, rowoff, isw1; };
__device__ __forceinline__ XItem xitem(const Args& A, unsigned char* ws, int r) {
    XItem x; constexpr int I1 = 32 * 32 * 64;
    if (r < I1) { const int e = r >> 11, q = r & 2047; x.W = A.in[25] + (size_t)e * D * 4096; x.WT = ws + WS_W1; x.ldw = 4096; x.k0 = 64 * (q >> 6); x.n0 = 64 * (q & 63); x.rowoff = e * 4096; x.isw1 = 1; }
    else { const int r2 = r - I1, e = r2 >> 10, q = r2 & 1023; x.W = A.in[27] + (size_t)e * D * D; x.WT = ws + WS_W2; x.ldw = D; x.k0 = 64 * (q >> 5); x.n0 = 64 * (q & 31); x.rowoff = e * D; x.isw1 = 0; }
    return x;
}
__device__ __forceinline__ void xload(f32x4 (&v)[16], const XItem& x, int lane) {
#pragma unroll
    for (int it = 0; it < 16; ++it) v[it] = *(const f32x4*)(x.W + (size_t)(x.k0 + 4 * it + (lane >> 4)) * x.ldw + x.n0 + 4 * (lane & 15));
}
__device__ __forceinline__ void xstore(const f32x4 (&v)[16], const XItem& x, LAS float* scr, int lane) {
#pragma unroll
    for (int it = 0; it < 16; ++it) { LAS float* s = scr + (4 * it + (lane >> 4)) * 65 + 4 * (lane & 15); s[0] = v[it].x; s[1] = v[it].y; s[2] = v[it].z; s[3] = v[it].w; }
    LDS_WAIT(); asm volatile("" ::: "memory");
    const int c = lane & 3;
#pragma unroll
    for (int j = 0; j < 4; ++j) { const int nl = 16 * j + (lane >> 2), n = x.n0 + nl; const LAS float* s = scr + (16 * c) * 65 + nl;
        int row; if (x.isw1) { const int l = n >= 2048, cc = n - 2048 * l; row = (cc >> 7) * 256 + 128 * l + (cc & 127); } else row = n;
        v4u o; o.x = pg8::pk4_fp8(64.f * s[0 * 65], 64.f * s[1 * 65], 64.f * s[2 * 65], 64.f * s[3 * 65]); o.y = pg8::pk4_fp8(64.f * s[4 * 65], 64.f * s[5 * 65], 64.f * s[6 * 65], 64.f * s[7 * 65]);
        o.z = pg8::pk4_fp8(64.f * s[8 * 65], 64.f * s[9 * 65], 64.f * s[10 * 65], 64.f * s[11 * 65]); o.w = pg8::pk4_fp8(64.f * s[12 * 65], 64.f * s[13 * 65], 64.f * s[14 * 65], 64.f * s[15 * 65]);
        *(v4u*)(x.WT + (size_t)(x.rowoff + row) * D + x.k0 + 16 * c) = o; }
    LDS_WAIT(); asm volatile("" ::: "memory");
}
struct RmId { int off; __device__ __forceinline__ int operator()(int n) const { return off + n; } };
struct RmW1 { int off; __device__ __forceinline__ int operator()(int n) const { const int l = n >= 2048, c = n - 2048 * l; return off + (c >> 7) * 256 + 128 * l + (c & 127); } };

constexpr int I_XALL = 32 * 32 * 64 + 32 * 32 * 32;
__device__ __forceinline__ void conv_pull_loop(const Args& A, LAS unsigned char* lds, int tid, int wave, int lane) {
    unsigned char* ws = A.ws; unsigned* ctl = (unsigned*)(ws + WS_CTL); LAS float* scr = (LAS float*)(lds + wave * 16640); LAS int* qs = (LAS int*)(lds + 8 * 16640);
    for (;;) {
        __syncthreads();
        if (tid == 0) qs[0] = (int)__hip_atomic_fetch_add(ctl + CW_XQ, 16u, __ATOMIC_RELAXED, __HIP_MEMORY_SCOPE_AGENT);
        __syncthreads();
        const int base = qs[0]; if (base >= I_XALL) break;
        f32x4 va[16], vb[16]; const int i0 = base + wave, i1 = base + 8 + wave;
        const XItem xa = xitem(A, ws, min(i0, I_XALL - 1)), xb = xitem(A, ws, min(i1, I_XALL - 1));
        xload(va, xa, lane); xload(vb, xb, lane);
        if (i0 < I_XALL) xstore(va, xa, scr, lane);
        if (i1 < I_XALL) xstore(vb, xb, scr, lane);
    }
}
__device__ __forceinline__ void p0_prologue(const Args& A, LAS unsigned char* lds, int vcu, int G, int wave, int lane) {
    unsigned char* ws = A.ws;
    LAS float* scr = (LAS float*)(lds + wave * 16640);
    const int gw = vcu * NWAVES + wave, NGW = G * NWAVES;
    constexpr int I_WI = 32 * 88, I_WO = 32 * 32, I_WKV = 32 * 16;
    constexpr int NITEMS = I_WI + I_WO + I_WKV;
    for (int it = gw; it < NITEMS; it += NGW) {
        int r = it;
        if (r < I_WI) { transpose_item(A.in[4], IN_W, IN_W, D, (bf16*)(ws + WS_WI), RmId{0}, scr, 64 * (r / 88), 64 * (r % 88), lane); continue; } r -= I_WI;
        if (r < I_WO) { transpose_item_fp8(A.in[20], D, D, ws + WS_WO, RmId{0}, scr, 64 * (r / 32), 64 * (r % 32), lane); continue; } r -= I_WO;
        transpose_item(A.in[19], 1024, 1024, D, (bf16*)(ws + WS_WKV), RmId{0}, scr, 64 * (r / 16), 64 * (r % 16), lane);
    }
    { bf16* wlt = (bf16*)(ws + WS_WLT);
      for (int i = gw * 64 + lane; i < 1024 * 448; i += NGW * 64) { const int ch = i / 448, k = i % 448;
          const float v = k < 96 ? A.in[7][k * 1024 + ch] : (k < 192 ? A.in[9][(k - 96) * 1024 + ch] : A.in[10][(k - 192) * 1024 + ch]); wlt[i] = (bf16)f2bf(v); } }
    { bf16* rwf = (bf16*)(ws + WS_RWT); const float* rw = A.in[23];
      for (int i = gw * 64 + lane; i < 64 * 2 * 2 * 64 * 8; i += NGW * 64) { const int e = i & 7, ln = (i >> 3) & 63, hl = (i >> 9) & 1, nt = (i >> 10) & 1, sidx = i >> 11;
          const float w = rw[(32 * sidx + 8 * (ln >> 4) + e) * NE + 16 * nt + (ln & 15)]; const unsigned hb = f2bf(w); const float hf = __builtin_bit_cast(float, hb << 16);
          rwf[i] = (bf16)(hl ? f2bf(w - hf) : hb); } }
    for (int m = gw; m < NTOK + NB * MEM_LEN; m += NGW) {
        const bool ismem = m >= NTOK; const int r = ismem ? m - NTOK : m;
        const float* xr = (ismem ? A.in[1] : A.in[0]) + (size_t)r * D;
        f32x4 v[8];
#pragma unroll
        for (int j = 0; j < 8; ++j) v[j] = *(const f32x4*)(xr + 4 * lane + 256 * j);
        ln_row(v, ismem ? A.in[17] : A.in[2], ismem ? A.in[18] : A.in[3], LN_EPS, lane);
        store_row_bf16((bf16*)(ws + (ismem ? WS_MEMN : WS_H0)) + (size_t)r * D, v, lane);
    }
}

__device__ __forceinline__ void p2_fox_cumsum(const Args& A, LAS unsigned char* lds, int vcu, int G, int tid) {
    const bf16* P = (const bf16*)(A.ws + WS_P); double* C = (double*)(A.ws + WS_C);
    LAS double* part = (LAS double*)(lds + 32768);
    for (int bh = vcu; bh < 16; bh += G) {
        const int b = bh >> 3, h = bh & 7; const float bf = A.in[16][h];
        float lf[32]; double s = 0.0;
#pragma unroll
        for (int i = 0; i < 32; ++i) { const float x = bf1(P[(size_t)(b * T + tid * 32 + i) * PW + C_FF + h]) + bf;
            lf[i] = -(fmaxf(-x, 0.f) + log1pf(__expf(-fabsf(x)))); s += (double)lf[i]; }
        __syncthreads();
        part[tid] = s;
        __syncthreads();
        double pre = 0.0;
        for (int j = 0; j < tid; ++j) pre += part[j];
        double* c = C + (size_t)bh * T + tid * 32;
#pragma unroll
        for (int i = 0; i < 32; ++i) { pre += (double)lf[i]; c[i] = pre; }
    }
}
__device__ __forceinline__ void p2_fox_norms(const Args& A, LAS unsigned char* lds, int vcu, int G, int tid, int wave, int lane) {
    const bf16* P = (const bf16*)(A.ws + WS_P); float* FOXB = (float*)(A.ws + WS_FOXB); unsigned* ctl = (unsigned*)(A.ws + WS_CTL);
    LAS float* red = (LAS float*)(lds + 40960);
    for (int u = vcu; u < 1024; u += G) {
        const int bh = u >> 6, qb = u & 63, b = bh >> 3, h = bh & 7; const int tk = tid & 255, isk = tid >> 8;
        const bf16* pr = P + (size_t)(b * T + qb * 256 + tk) * PW + (isk ? C_FK : C_FQ) + h * 64;
        float n2 = 0.f;
#pragma unroll
        for (int v = 0; v < 8; ++v) { const v4u x = *(const v4u*)(pr + v * 8); const unsigned w[4] = {x.x, x.y, x.z, x.w};
#pragma unroll
            for (int e = 0; e < 4; ++e) { const float a0 = bfl(w[e]), a1 = bfh(w[e]); n2 += a0 * a0 + a1 * a1; } }
#pragma unroll
        for (int o = 1; o < 64; o <<= 1) n2 = fmaxf(n2, __shfl_xor(n2, o));
        __syncthreads();
        if (lane == 0) red[wave] = n2;
        __syncthreads();
        if (tid == 0) { FOXB[bh * 80 + qb] = fmaxf(fmaxf(red[0], red[1]), fmaxf(red[2], red[3]));
            __hip_atomic_fetch_max(ctl + CW_KMAX + bh, __float_as_uint(fmaxf(fmaxf(red[4], red[5]), fmaxf(red[6], red[7]))), __ATOMIC_RELAXED, __HIP_MEMORY_SCOPE_AGENT); }
    }
}

__device__ __forceinline__ int crow(int r, int hi) { return (r & 3) + 8 * (r >> 2) + 4 * hi; }
typedef float f32x16 __attribute__((ext_vector_type(16)));
typedef short s16x4 __attribute__((ext_vector_type(4)));
typedef short v4i16_t __attribute__((ext_vector_type(4)));
template <int DH, bool FOX>
__device__ __forceinline__ void attn_unit(const bf16* Qp, int qpitch, const bf16* Kp, const bf16* Vp, int kvpitch, unsigned char* Op, int opitch, int q0, int jlo, int jhi,
                                          const double* cseq, float scale2, LAS unsigned char* lds, int tid, int wave, int lane) {
    constexpr int KROW = (DH + 8) * 2, VROW = DH * 2 + 64, NP = DH / 64;
    LAS unsigned char* KS = lds; LAS unsigned char* VT = lds + 64 * KROW; LAS float* CB = (LAS float*)(VT + 64 * VROW); LAS float* WSF = (LAS float*)(lds + 2 * (64 * KROW + 64 * VROW + 256)) + wave * 32;
    const int r32 = lane & 31, hi = lane >> 5;
    bf16x8 qr[DH / 16];
#pragma unroll
    for (int d0 = 0; d0 < DH / 16; ++d0) qr[d0] = *(const bf16x8*)(Qp + (size_t)(32 * wave + r32) * qpitch + d0 * 16 + hi * 8);
    f32x16 o[DH / 32];
#pragma unroll
    for (int d = 0; d < DH / 32; ++d)
#pragma unroll
        for (int r = 0; r < 16; ++r) o[d][r] = 0.f;
    float m = -1e30f, l = 0.f;
    const int qpos = q0 + 32 * wave + r32;
    double cref = 0.0; if (FOX) cref = cseq[q0];
    v4u kreg[NP], vreg[NP]; float cbv = 0.f;
#define ATT_LOAD(j) do { _Pragma("unroll") for (int p = 0; p < NP; ++p) { const int idx = tid + p * NTHR, row = idx / (DH / 8), ch = idx % (DH / 8); \
        kreg[p] = *(const v4u*)(Kp + (size_t)((j) * 64 + row) * kvpitch + ch * 8); vreg[p] = *(const v4u*)(Vp + (size_t)((j) * 64 + row) * kvpitch + ch * 8); } \
        if (FOX && tid < 64) cbv = (float)(cref - cseq[(j) * 64 + tid]) * LOG2E; } while (0)
    constexpr bool PREF = (DH == 64);
    constexpr int TILEB = 64 * KROW + 64 * VROW + 256;
#define ATT_STORE(bufo) do { _Pragma("unroll") for (int p = 0; p < NP; ++p) { const int idx = tid + p * NTHR, row = idx / (DH / 8), ch = idx % (DH / 8); \
        *(LAS v4u*)(KS + (bufo) + row * KROW + ch * 16) = kreg[p]; *(LAS v4u*)(VT + (bufo) + row * VROW + ch * 16) = vreg[p]; } \
        if (FOX && tid < 64) *(LAS float*)((LAS unsigned char*)CB + (bufo) + tid * 4) = cbv; } while (0)
    if (PREF) { ATT_LOAD(jlo); __syncthreads(); ATT_STORE(0); __syncthreads(); }
    for (int j = jlo; j < jhi; ++j) {
        const int bo = PREF ? ((j - jlo) & 1) * TILEB : 0;
        if (PREF) { if (j + 1 < jhi) ATT_LOAD(j + 1); }
        else { __syncthreads();
#pragma unroll
            for (int p = 0; p < NP; ++p) { const int idx = tid + p * NTHR, row = idx / (DH / 8), ch = idx % (DH / 8);
                kreg[0] = *(const v4u*)(Kp + (size_t)(j * 64 + row) * kvpitch + ch * 8); vreg[0] = *(const v4u*)(Vp + (size_t)(j * 64 + row) * kvpitch + ch * 8);
                *(LAS v4u*)(KS + row * KROW + ch * 16) = kreg[0]; *(LAS v4u*)(VT + row * VROW + ch * 16) = vreg[0]; }
            __syncthreads(); }
        f32x16 p[2];
#pragma unroll
        for (int kh = 0; kh < 2; ++kh) {
#pragma unroll
            for (int r = 0; r < 16; ++r) p[kh][r] = 0.f;
#pragma unroll
            for (int d0 = 0; d0 < DH / 16; ++d0) { const bf16x8 a = *(const LAS bf16x8*)(KS + bo + (32 * kh + r32) * KROW + (16 * d0 + 8 * hi) * 2);
                p[kh] = __builtin_amdgcn_mfma_f32_32x32x16_bf16(a, qr[d0], p[kh], 0, 0, 0); }
        }
        const bool diag = FOX && (j * 64 + 63 > q0);
        float mx = -1e30f;
        if (diag) {
#pragma unroll
            for (int kh = 0; kh < 2; ++kh)
#pragma unroll
                for (int g = 0; g < 4; ++g) { const f32x4 cb = *(const LAS f32x4*)((const LAS unsigned char*)CB + bo + (32 * kh + 8 * g + 4 * hi) * 4);
#pragma unroll
                    for (int i = 0; i < 4; ++i) { const int r = 4 * g + i; float v = p[kh][r] * scale2 + cb[i];
                        if (j * 64 + 32 * kh + 8 * g + 4 * hi + i > qpos) v = -1e30f;
                        p[kh][r] = v; mx = fmaxf(mx, v); } }
        } else {
#pragma unroll
            for (int kh = 0; kh < 2; ++kh)
#pragma unroll
                for (int g = 0; g < 4; ++g) { f32x4 cb = (f32x4){0.f, 0.f, 0.f, 0.f}; if (FOX) cb = *(const LAS f32x4*)((const LAS unsigned char*)CB + bo + (32 * kh + 8 * g + 4 * hi) * 4);
#pragma unroll
                    for (int i = 0; i < 4; ++i) { const int r = 4 * g + i; const float v = p[kh][r] * scale2 + cb[i]; p[kh][r] = v; mx = fmaxf(mx, v); } }
        }
        mx = fmaxf(mx, __shfl_xor(mx, 32));
        const float mn = fmaxf(m, mx), corr = __builtin_amdgcn_exp2f(m - mn); m = mn;
        float ls = 0.f;
#pragma unroll
        for (int kh = 0; kh < 2; ++kh)
#pragma unroll
            for (int r = 0; r < 16; ++r) { const float e = __builtin_amdgcn_exp2f(p[kh][r] - mn); p[kh][r] = e; ls += e; }
        l = l * corr + ls;
        if (__any(corr != 1.0f)) {
            if (hi == 0) WSF[r32] = corr;
#pragma unroll
            for (int g = 0; g < 4; ++g) { const f32x4 c4 = *(const LAS f32x4*)(WSF + 8 * g + 4 * hi);
#pragma unroll
                for (int d = 0; d < DH / 32; ++d) { o[d][4 * g] *= c4.x; o[d][4 * g + 1] *= c4.y; o[d][4 * g + 2] *= c4.z; o[d][4 * g + 3] *= c4.w; } }
        }
        bf16x8 pa[4];
#pragma unroll
        for (int s = 0; s < 4; ++s) { const int kh = s >> 1, b8 = 8 * (s & 1); v4u w;
            w.x = pg8::cvt_pk_bf16(p[kh][b8 + 0], p[kh][b8 + 1]); w.y = pg8::cvt_pk_bf16(p[kh][b8 + 2], p[kh][b8 + 3]);
            w.z = pg8::cvt_pk_bf16(p[kh][b8 + 4], p[kh][b8 + 5]); w.w = pg8::cvt_pk_bf16(p[kh][b8 + 6], p[kh][b8 + 7]);
            pa[s] = __builtin_bit_cast(bf16x8, w); }
#pragma unroll
        for (int d = 0; d < DH / 32; ++d)
#pragma unroll
            for (int s = 0; s < 4; ++s) { const LAS unsigned char* vp = VT + bo + (16 * s + 4 * hi + ((lane & 15) >> 2)) * VROW + (32 * d + 16 * ((lane >> 4) & 1) + 4 * (lane & 3)) * 2;
                const s16x4 lo = __builtin_bit_cast(s16x4, __builtin_amdgcn_ds_read_tr16_b64_v4i16((LAS v4i16_t*)vp)), hh = __builtin_bit_cast(s16x4, __builtin_amdgcn_ds_read_tr16_b64_v4i16((LAS v4i16_t*)(vp + 8 * VROW)));
                const bf16x8 vf = (bf16x8){lo[0], lo[1], lo[2], lo[3], hh[0], hh[1], hh[2], hh[3]};
                o[d] = __builtin_amdgcn_mfma_f32_32x32x16_bf16(pa[s], vf, o[d], 0, 0, 0); }
        if (PREF) { if (j + 1 < jhi) ATT_STORE(TILEB - bo); __syncthreads(); }
    }
#undef ATT_LOAD
#undef ATT_STORE
    l += __shfl_xor(l, 32);
    if (hi == 0) WSF[r32] = 1.0f / l;
    float rli[16];
#pragma unroll
    for (int g = 0; g < 4; ++g) { const f32x4 c4 = *(const LAS f32x4*)(WSF + 8 * g + 4 * hi); rli[4 * g] = c4.x; rli[4 * g + 1] = c4.y; rli[4 * g + 2] = c4.z; rli[4 * g + 3] = c4.w; }
#pragma unroll
    for (int r = 0; r < 16; ++r) { unsigned char* orow = Op + (size_t)(32 * wave + crow(r, hi)) * opitch + r32;
#pragma unroll
        for (int d = 0; d < DH / 32; ++d) { const float x = o[d][r] * rli[r]; orow[32 * d] = (unsigned char)__builtin_amdgcn_cvt_pk_fp8_f32(x, x, 0, false); } }
    __syncthreads();
}

__device__ __forceinline__ void p3_attention(const Args& A, LAS unsigned char* lds, int tid, int wave, int lane) {
    unsigned char* ws = A.ws; const bf16* P = (const bf16*)(ws + WS_P); unsigned char* MIX = ws + WS_MIX; const bf16* KVM = (const bf16*)(ws + WS_KVM); const double* C = (const double*)(ws + WS_C);
    unsigned* ctl = (unsigned*)(ws + WS_CTL); LAS int* sj = (LAS int*)(lds + 65536);
    for (;;) {
        __syncthreads();
        if (tid == 0) sj[1] = (int)__hip_atomic_fetch_add(ctl + CW_QUEUE, 1u, __ATOMIC_RELAXED, __HIP_MEMORY_SCOPE_AGENT);
        __syncthreads();
        const int u = sj[1];
        if (u >= 1536) break;
        if (u < 1024) {
#ifndef NO_FOX
            const int bh = u & 15, qb = 63 - (u >> 4), b = bh >> 3, h = bh & 7, q0 = qb * 256; const double* cs = C + (size_t)bh * T; const float* fb = (const float*)(ws + WS_FOXB) + bh * 80; const size_t rowb = (size_t)b * T;
            if (tid == 0) sj[0] = q0 / 64;
            __syncthreads();
            if (tid < q0 / 64) { const float bound = 0.25f * sqrtf(fb[qb] * __uint_as_float(ctl[CW_KMAX + bh])) + FOX_SKIP; if ((float)(cs[q0] - cs[tid * 64 + 63]) + bound >= 0.f) __hip_atomic_fetch_min(sj, tid, __ATOMIC_RELAXED, __HIP_MEMORY_SCOPE_WORKGROUP); }
            __syncthreads();
            const int jlo = sj[0];
            attn_unit<64, true>(P + (rowb + q0) * PW + C_FQ + h * 64, PW, P + rowb * PW + C_FK + h * 64, P + rowb * PW + C_FV + h * 64, PW,
                                MIX + (rowb + q0) * D + 1024 + h * 64, D, q0, jlo, q0 / 64 + 4, cs, 0.125f * LOG2E, lds, tid, wave, lane);
#endif
        } else {
#ifndef NO_MEMATT
            const int v = u - 1024, b = v >> 8, h = (v >> 6) & 3, qb = v & 63, q0 = qb * 256; const size_t rowb = (size_t)b * T;
            attn_unit<128, false>(P + (rowb + q0) * PW + C_MQ + h * 128, PW, KVM + (size_t)b * MEM_LEN * 1024 + h * 128, KVM + (size_t)b * MEM_LEN * 1024 + 512 + h * 128, 1024,
                                  MIX + (rowb + q0) * D + 1536 + h * 128, D, q0, 0, 4, nullptr, 0.08838834764831845f * LOG2E, lds, tid, wave, lane);
#endif
        }
    }
}

constexpr size_t AIN_BYTES = 73728, REC_BYTES = 62464;
constexpr size_t WS_AIN = WS_RW, WS_REC = WS_AIN + 576 * MiB, WS_YRAW = WS_REC + 488 * MiB, WS_G1 = 368 * MiB, WS_G2 = 432 * MiB;
static_assert(WS_YRAW + 64 * MiB <= WS_ACT && 8192 * REC_BYTES <= 488 * MiB && 8192 * AIN_BYTES <= 576 * MiB && WS_G2 + 64 * MiB <= WS_W2, "rwkv workspace");
constexpr int AIN_LD = 0, AIN_R = 16384, AIN_K2 = 24576, AIN_V = 32768, AIN_AV = 40960, AIN_BV = 49152, AIN_G1 = 57344, AIN_G2 = 65536;
constexpr int A0_IN = 29184, A0_INW = 13200, A0_ROWB = 400;
constexpr int REC_W = 0, REC_RT = 9216, REC_ARB = 18432, REC_BGT = 27648, REC_U0 = 36864, REC_Y0 = 45056, REC_M0 = 53248, REC_GC = 61440;
typedef float f32x4_t __attribute__((ext_vector_type(4)));

__device__ __forceinline__ float softplusf_(float x) { return fmaxf(x, 0.f) + log1pf(__expf(-fabsf(x))); }
__device__ __forceinline__ float xsum16_32(float v) { v += __shfl_xor(v, 16); v += __shfl_xor(v, 32); return v; }

__device__ __forceinline__ float fsigmoid(float x) { return __builtin_amdgcn_rcpf(1.0f + __builtin_amdgcn_exp2f(-LOG2E * x)); }
__device__ __forceinline__ float fsoftplus(float x) { return fmaxf(x, 0.f) + 0.6931471805599453f * __builtin_amdgcn_logf(1.0f + __builtin_amdgcn_exp2f(-LOG2E * fabsf(x))); }
struct A0Par { f32x4 mur, muk, muv, a0, kkw, kaw, rkw, w0, gng, gnb; };
template <bool FULL> __device__ __forceinline__ void a0_loadpar(A0Par& p, const Args& A, const float* mu, int col) {
    p.mur = *(const f32x4*)(mu + C_R + col); p.muk = *(const f32x4*)(mu + C_K + col); p.muv = *(const f32x4*)(mu + C_V + col);
    p.a0 = *(const f32x4*)(A.in[8] + col); p.kkw = *(const f32x4*)(A.in[11] + col); p.kaw = *(const f32x4*)(A.in[12] + col); p.rkw = *(const f32x4*)(A.in[13] + col);
    if constexpr (FULL) { p.w0 = *(const f32x4*)(A.in[6] + col); p.gng = *(const f32x4*)(A.in[14] + col); p.gnb = *(const f32x4*)(A.in[15] + col); }
}
template <bool FULL>
__device__ __forceinline__ void a0_mfma(f32x4 (&acc)[2][3], const bf16x8* wf, LAS unsigned char* lds, int c16, int g) {
    constexpr int KS0 = FULL ? 0 : 3, KS1 = FULL ? 14 : 6;
#pragma unroll
    for (int tt = 0; tt < 2; ++tt)
#pragma unroll
        for (int o = 0; o < 3; ++o) acc[tt][o] = (f32x4){0.f, 0.f, 0.f, 0.f};
#pragma unroll
    for (int ks = KS0; ks < KS1; ++ks) { const int o = ks < 3 ? 0 : (ks < 6 ? 1 : 2);
#pragma unroll
        for (int tt = 0; tt < 2; ++tt) { const bf16x8 b = *(const LAS bf16x8*)(lds + (16 * tt + c16) * 912 + (32 * ks + 8 * g) * 2);
            acc[tt][o] = __builtin_amdgcn_mfma_f32_16x16x32_bf16(wf[ks - KS0], b, acc[tt][o], 0, 0, 0); } }
}
template <bool FULL>
__device__ __forceinline__ void a0_ct(const f32x4 (&acc)[2][3], const A0Par& p, const LAS unsigned char* inw, unsigned char* blk,
                                      int tl0, int ct, int c16, int g, float (&ssk)[2], float (&ssb)[2]) {
#pragma unroll
    for (int tt = 0; tt < 2; ++tt) {
        const LAS unsigned char* pc = inw + (1 + 16 * tt + c16) * A0_ROWB + (16 * ct + 4 * g) * 2;
        const pg8::u32x2 r0 = *(const LAS pg8::u32x2*)pc, k0 = *(const LAS pg8::u32x2*)(pc + 128), v0 = *(const LAS pg8::u32x2*)(pc + 256);
        const pg8::u32x2 r1 = *(const LAS pg8::u32x2*)(pc - A0_ROWB), k1 = *(const LAS pg8::u32x2*)(pc - A0_ROWB + 128), v1 = *(const LAS pg8::u32x2*)(pc - A0_ROWB + 256);
        float rr[4], kk[4], vv[4];
        { const float ra[4] = {bfl(r0.x), bfh(r0.x), bfl(r0.y), bfh(r0.y)}, rb[4] = {bfl(r1.x), bfh(r1.x), bfl(r1.y), bfh(r1.y)};
          const float ka[4] = {bfl(k0.x), bfh(k0.x), bfl(k0.y), bfh(k0.y)}, kb[4] = {bfl(k1.x), bfh(k1.x), bfl(k1.y), bfh(k1.y)};
          const float va[4] = {bfl(v0.x), bfh(v0.x), bfl(v0.y), bfh(v0.y)}, vb[4] = {bfl(v1.x), bfh(v1.x), bfl(v1.y), bfh(v1.y)};
#pragma unroll
          for (int r = 0; r < 4; ++r) { rr[r] = ra[r] + p.mur[r] * (rb[r] - ra[r]); kk[r] = ka[r] + p.muk[r] * (kb[r] - ka[r]); vv[r] = va[r] + p.muv[r] * (vb[r] - va[r]); } }
        float aa[4], k2[4], kc[4];
#pragma unroll
        for (int r = 0; r < 4; ++r) { aa[r] = fsigmoid(p.a0[r] + acc[tt][1][r]); kc[r] = kk[r] * p.kkw[r]; k2[r] = kk[r] * (1.0f + (aa[r] - 1.0f) * p.kaw[r]); }
        if constexpr (!FULL) {
#pragma unroll
            for (int r = 0; r < 4; ++r) { ssk[tt] += kc[r] * kc[r]; ssb[tt] += rr[r] * k2[r] * p.rkw[r]; }
        } else {
            const int e0 = (ct * 64 + tl0 + 16 * tt + c16) * 16 + 4 * g;
            f32x4 ld; float av[4], bv[4], g1[4], g2[4];
#pragma unroll
            for (int r = 0; r < 4; ++r) { const float sp = fsoftplus(-(p.w0[r] + acc[tt][0][r])); ld[r] = -__builtin_amdgcn_exp2f(-LOG2E * (sp + 0.5f));
                const float kn = kc[r] * ssk[tt]; av[r] = -kn; bv[r] = kn * aa[r]; const float gg = acc[tt][2][r]; g1[r] = p.gng[r] * gg; g2[r] = (p.gnb[r] + ssb[tt] * vv[r]) * gg; }
            *(f32x4*)(blk + AIN_LD + e0 * 4) = ld;
            *(pg8::u32x2*)(blk + AIN_R + e0 * 2) = (pg8::u32x2){pk2(rr[0], rr[1]), pk2(rr[2], rr[3])};
            *(pg8::u32x2*)(blk + AIN_K2 + e0 * 2) = (pg8::u32x2){pk2(k2[0], k2[1]), pk2(k2[2], k2[3])};
            *(pg8::u32x2*)(blk + AIN_V + e0 * 2) = (pg8::u32x2){pk2(vv[0], vv[1]), pk2(vv[2], vv[3])};
            *(pg8::u32x2*)(blk + AIN_AV + e0 * 2) = (pg8::u32x2){pk2(av[0], av[1]), pk2(av[2], av[3])};
            *(pg8::u32x2*)(blk + AIN_BV + e0 * 2) = (pg8::u32x2){pk2(bv[0], bv[1]), pk2(bv[2], bv[3])};
            *(pg8::u32x2*)(blk + AIN_G1 + e0 * 2) = (pg8::u32x2){pk2(g1[0], g1[1]), pk2(g1[2], g1[3])};
            *(pg8::u32x2*)(blk + AIN_G2 + e0 * 2) = (pg8::u32x2){pk2(g2[0], g2[1]), pk2(g2[2], g2[3])};
        }
        asm volatile("" ::: "memory");
    }
}
template <int PV = 0>
__device__ __forceinline__ void p2_rwkv_tok(const Args& A, LAS unsigned char* lds, int vcu, int G, int tid, int wave, int lane) {
    unsigned char* ws = A.ws; const bf16* P = (const bf16*)(ws + WS_P); const bf16* WLT = (const bf16*)(ws + WS_WLT); const float* mu = A.in[5];
    unsigned char* AIN = ws + WS_AIN;
    const int c16 = lane & 15, g = lane >> 4;
    for (int tile = vcu; tile < NTOK / 32; tile += G) {
        const int row0 = tile * 32;
        __syncthreads();
        int tidv = tid; asm volatile("" : "+v"(tidv));
        {
#pragma unroll
            for (int bt = 0; bt < 2; ++bt) {
            v4u pt[2], pp[2]; f32x4 m0[2], m1[2];
#pragma unroll
            for (int i = 0; i < 2; ++i) { const int idx = min(tidv + NTHR * (2 * bt + i), 32 * 56 - 1), tk = idx / 56, vec = idx % 56, row = row0 + tk, col = C_DW + vec * 8;
                pt[i] = *(const v4u*)(P + (size_t)row * PW + col); pp[i] = *(const v4u*)(P + (size_t)(row - ((row % T) ? 1 : 0)) * PW + col);
                m0[i] = *(const f32x4*)(mu + col); m1[i] = *(const f32x4*)(mu + col + 4); }
#pragma unroll
            for (int i = 0; i < 2; ++i) { const int idx = tidv + NTHR * (2 * bt + i), idc = min(idx, 32 * 56 - 1), tk = idc / 56, vec = idc % 56, row = row0 + tk; const bool hp = (row % T) != 0;
                float x[8]; const unsigned tw[4] = {pt[i].x, pt[i].y, pt[i].z, pt[i].w}, pw[4] = {pp[i].x, pp[i].y, pp[i].z, pp[i].w}; const float mm[8] = {m0[i].x, m0[i].y, m0[i].z, m0[i].w, m1[i].x, m1[i].y, m1[i].z, m1[i].w};
#pragma unroll
                for (int e = 0; e < 8; ++e) { const float a = (e & 1) ? bfh(tw[e >> 1]) : bfl(tw[e >> 1]); float b = (e & 1) ? bfh(pw[e >> 1]) : bfl(pw[e >> 1]); b = hp ? b : 0.f; const float ps = a + mm[e] * (b - a);
                    x[e] = vec < 12 ? 2.0f * fsigmoid(2.0f * ps) - 1.0f : (vec < 24 ? ps : fsigmoid(ps)); }
                v4u o; o.x = pk2(x[0], x[1]); o.y = pk2(x[2], x[3]); o.z = pk2(x[4], x[5]); o.w = pk2(x[6], x[7]);
                if (idx < 32 * 56) *(LAS v4u*)(lds + tk * 912 + vec * 16) = o; }
            asm volatile("" ::: "memory"); }
        }
        __syncthreads();
#pragma unroll 1
        for (int hh = 0; hh < 2; ++hh) {
            const int h = wave * 2 + hh;
            LAS unsigned char* inw = lds + A0_IN + wave * A0_INW;
            { const bool first = (row0 % T) == 0; int lanev = lane; asm volatile("" : "+v"(lanev));
#pragma unroll
              for (int bt = 0; bt < 2; ++bt) { v4u x[7];
#pragma unroll
                for (int i = 0; i < 7; ++i) { const int idx = lanev + 64 * (7 * bt + i), seg = min(idx >> 3, 98), pc = idx & 7, r = seg / 3, a = seg - 3 * r, grow = row0 - 1 + r + ((first && r == 0) ? 1 : 0);
                    x[i] = *(const v4u*)(P + (size_t)grow * PW + a * 1024 + h * 64 + pc * 8); }
#pragma unroll
                for (int i = 0; i < 7; ++i) { const int idx = lanev + 64 * (7 * bt + i), seg = idx >> 3, pc = idx & 7, r = seg / 3, a = seg - 3 * r;
                    const v4u z = (v4u){0u, 0u, 0u, 0u}; if (seg < 99) *(LAS v4u*)(inw + r * A0_ROWB + a * 128 + pc * 16) = (first && r == 0) ? z : x[i]; }
                asm volatile("" ::: "memory"); } }
            const int tpos0 = row0 % T, b = row0 / T; unsigned char* blk = AIN + (size_t)((b * 16 + h) * 256 + (tpos0 >> 6)) * AIN_BYTES; const int tl0 = tpos0 & 63;
            float ssk[2] = {0.f, 0.f}, ssb[2] = {0.f, 0.f};
            const bf16* wbase = WLT + (size_t)(h * 64 + c16) * 448 + 8 * g; const int colb = h * 64 + 4 * g;
            if constexpr (PV != 2) { bf16x8 w0[3]; A0Par pn;
#pragma unroll
              for (int ks = 0; ks < 3; ++ks) w0[ks] = *(const bf16x8*)(wbase + 32 * (3 + ks));
              a0_loadpar<false>(pn, A, mu, colb);
#pragma unroll 1
              for (int ct = 0; ct < 4; ++ct) { f32x4 acc[2][3]; a0_mfma<false>(acc, w0, lds, c16, g); const A0Par p = pn;
                  if (ct < 3) {
#pragma unroll
                      for (int ks = 0; ks < 3; ++ks) w0[ks] = *(const bf16x8*)(wbase + (size_t)(ct + 1) * 16 * 448 + 32 * (3 + ks));
                      a0_loadpar<false>(pn, A, mu, colb + 16 * (ct + 1)); }
                  asm volatile("" ::: "memory");
                  a0_ct<false>(acc, p, inw, blk, tl0, ct, c16, g, ssk, ssb); asm volatile("" ::: "memory"); } }
#pragma unroll
            for (int tt = 0; tt < 2; ++tt) { ssk[tt] = 1.0f / fmaxf(sqrtf(xsum16_32(ssk[tt])), 1e-12f); ssb[tt] = xsum16_32(ssb[tt]); }
            if constexpr (PV != 0) { if (ssk[0] + ssb[1] == 1234.5f) *(float*)blk = ssk[0]; }
            if constexpr (PV == 0) { bf16x8 w1[14]; A0Par pn;
#pragma unroll
              for (int ks = 0; ks < 14; ++ks) w1[ks] = *(const bf16x8*)(wbase + 32 * ks);
              a0_loadpar<true>(pn, A, mu, colb);
#pragma unroll 1
              for (int ct = 0; ct < 4; ++ct) { f32x4 acc[2][3]; a0_mfma<true>(acc, w1, lds, c16, g); const A0Par p = pn;
                  if (ct < 3) {
#pragma unroll
                      for (int ks = 0; ks < 14; ++ks) w1[ks] = *(const bf16x8*)(wbase + (size_t)(ct + 1) * 16 * 448 + 32 * ks);
                      a0_loadpar<true>(pn, A, mu, colb + 16 * (ct + 1)); }
                  asm volatile("" ::: "memory");
                  a0_ct<true>(acc, p, inw, blk, tl0, ct, c16, g, ssk, ssb);
                  asm volatile("" ::: "memory"); } }
        }
    }
}

constexpr int LA_CL = 0, LA_AS = 16640, LA_BS = 25856, LA_KS = 35072, LA_RS = 44288, LA_KGT = 53504, LA_BGT = 62720, LA_VT = 71936, LA_NS = 81152, LA_XU = 98560, LA_WS = 115968, LA_TOT = 125184, LA_SCR = 126208, LA_TS = 134400;
__device__ __forceinline__ f32x16 gtile32(LAS unsigned char* lds, int offA, int si, int offB, int ti, int r32, int hi) {
    f32x16 c;
#pragma unroll
    for (int r = 0; r < 16; ++r) c[r] = 0.f;
#pragma unroll
    for (int ks = 0; ks < 4; ++ks) { const bf16x8 a = *(const LAS bf16x8*)(lds + offA + (32 * si + r32) * 144 + (16 * ks + 8 * hi) * 2), b = *(const LAS bf16x8*)(lds + offB + (32 * ti + r32) * 144 + (16 * ks + 8 * hi) * 2);
        c = __builtin_amdgcn_mfma_f32_32x32x16_bf16(a, b, c, 0, 0, 0); }
    return c;
}
template <bool INCL> __device__ __forceinline__ void mask_lower(f32x16& c, int r32, int hi) {
#pragma unroll
    for (int r = 0; r < 16; ++r) { const int s = crow(r, hi); if (INCL ? (s > r32) : (s >= r32)) c[r] = 0.f; }
}
__device__ __forceinline__ float xcomb(float v) {
    { auto r = __builtin_amdgcn_permlane16_swap(__float_as_uint(v), __float_as_uint(v), false, false); v = __uint_as_float(r[0]) + __uint_as_float(r[1]); }
    { auto r = __builtin_amdgcn_permlane32_swap(__float_as_uint(v), __float_as_uint(v), false, false); v = __uint_as_float(r[0]) + __uint_as_float(r[1]); }
    return v;
}
__device__ __forceinline__ void gv_acc(f32x16& o, const f32x16& G, LAS unsigned char* lds, int si, int ib, int r32, int hi) {
#pragma unroll
    for (int sp = 0; sp < 2; ++sp) { v4u w; const int b8 = 8 * sp;
        w.x = pg8::cvt_pk_bf16(G[b8 + 0], G[b8 + 1]); w.y = pg8::cvt_pk_bf16(G[b8 + 2], G[b8 + 3]); w.z = pg8::cvt_pk_bf16(G[b8 + 4], G[b8 + 5]); w.w = pg8::cvt_pk_bf16(G[b8 + 6], G[b8 + 7]);
        const LAS unsigned char* vp = lds + LA_VT + (32 * ib + r32) * 144 + (32 * si + 16 * sp + 4 * hi) * 2;
        const s16x4 lo = *(const LAS s16x4*)vp, hh = *(const LAS s16x4*)(vp + 16);
        o = __builtin_amdgcn_mfma_f32_32x32x16_bf16(__builtin_bit_cast(bf16x8, w), (bf16x8){lo[0], lo[1], lo[2], lo[3], hh[0], hh[1], hh[2], hh[3]}, o, 0, 0, 0); }
}
__device__ __forceinline__ void p3_rwkv_chunk(const Args& A, LAS unsigned char* lds, int vcu, int G, int tid, int wave, int lane) {
    unsigned char* ws = A.ws;
    const int r32 = lane & 31, hi = lane >> 5, c16 = lane & 15, g = lane >> 4;
    LAS float* CL = (LAS float*)(lds + LA_CL); LAS float* TOT = (LAS float*)(lds + LA_TOT);
    const int t = tid >> 3, j0 = (tid & 7) * 8;
    const int e0 = ((j0 >> 4) * 64 + t) * 16 + (j0 & 15);
    f32x4 l0, l1; v4u vr, vk, vv, va, vb;
#define PA_LOAD_LD(ucx) do { const unsigned char* blk_ = ws + WS_AIN + (size_t)(ucx) * AIN_BYTES; l0 = *(const f32x4*)(blk_ + AIN_LD + e0 * 4); l1 = *(const f32x4*)(blk_ + AIN_LD + (e0 + 4) * 4); } while (0)
#define PA_LOAD(ucx) do { const unsigned char* blk_ = ws + WS_AIN + (size_t)(ucx) * AIN_BYTES; \
        vr = *(const v4u*)(blk_ + AIN_R + e0 * 2); vk = *(const v4u*)(blk_ + AIN_K2 + e0 * 2); vv = *(const v4u*)(blk_ + AIN_V + e0 * 2); \
        va = *(const v4u*)(blk_ + AIN_AV + e0 * 2); vb = *(const v4u*)(blk_ + AIN_BV + e0 * 2); } while (0)
    PA_LOAD_LD(min(vcu, 8191));
    for (int uc = vcu; uc < 8192; uc += G) {
        unsigned char* rec = ws + WS_REC + (size_t)uc * REC_BYTES;
        __syncthreads();
        PA_LOAD(uc);
        { LAS float* c = CL + t * 65 + j0; c[0] = l0.x; c[1] = l0.y; c[2] = l0.z; c[3] = l0.w; c[4] = l1.x; c[5] = l1.y; c[6] = l1.z; c[7] = l1.w; }
        __syncthreads();
        float xs[16];
        if (tid < 256) { const int j = tid & 63, q = tid >> 6; float run = 0.f;
#pragma unroll
            for (int e = 0; e < 16; ++e) { run += CL[(16 * q + e) * 65 + j]; xs[e] = run; }
            TOT[q * 64 + j] = run; }
        __syncthreads();
        if (tid < 256) { const int j = tid & 63, q = tid >> 6; float off = 0.f; for (int qq = 0; qq < q; ++qq) off += TOT[qq * 64 + j];
#pragma unroll
            for (int e = 0; e < 16; ++e) CL[(16 * q + e) * 65 + j] = off + xs[e]; }
        __syncthreads();
        {   const unsigned wr[4] = {vr.x, vr.y, vr.z, vr.w}, wk[4] = {vk.x, vk.y, vk.z, vk.w}, wv[4] = {vv.x, vv.y, vv.z, vv.w}, wa[4] = {va.x, va.y, va.z, va.w}, wb[4] = {vb.x, vb.y, vb.z, vb.w};
            float at[8], bt[8], kt[8], rt_[8], kg[8], bg[8], gc[8];
#pragma unroll
            for (int e = 0; e < 8; ++e) { const float ct = CL[t * 65 + j0 + e], cp = t ? CL[(t - 1) * 65 + j0 + e] : 0.f, cL = CL[63 * 65 + j0 + e];
                const float r_ = (e & 1) ? bfh(wr[e >> 1]) : bfl(wr[e >> 1]), k_ = (e & 1) ? bfh(wk[e >> 1]) : bfl(wk[e >> 1]), a_ = (e & 1) ? bfh(wa[e >> 1]) : bfl(wa[e >> 1]), b_ = (e & 1) ? bfh(wb[e >> 1]) : bfl(wb[e >> 1]);
                const float eg = __expf(ct), egi = __expf(-ct), ep = __expf(cp), eL = __expf(cL - ct);
                at[e] = a_ * ep; bt[e] = b_ * egi; kt[e] = k_ * egi; rt_[e] = r_ * eg; kg[e] = k_ * eL; bg[e] = b_ * eL; gc[e] = __expf(cL); }
            v4u o;
            o.x = pk2(at[0], at[1]); o.y = pk2(at[2], at[3]); o.z = pk2(at[4], at[5]); o.w = pk2(at[6], at[7]); *(LAS v4u*)(lds + LA_AS + t * 144 + j0 * 2) = o;
            o.x = pk2(bt[0], bt[1]); o.y = pk2(bt[2], bt[3]); o.z = pk2(bt[4], bt[5]); o.w = pk2(bt[6], bt[7]); *(LAS v4u*)(lds + LA_BS + t * 144 + j0 * 2) = o;
            o.x = pk2(kt[0], kt[1]); o.y = pk2(kt[2], kt[3]); o.z = pk2(kt[4], kt[5]); o.w = pk2(kt[6], kt[7]); *(LAS v4u*)(lds + LA_KS + t * 144 + j0 * 2) = o;
            o.x = pk2(rt_[0], rt_[1]); o.y = pk2(rt_[2], rt_[3]); o.z = pk2(rt_[4], rt_[5]); o.w = pk2(rt_[6], rt_[7]); *(LAS v4u*)(lds + LA_RS + t * 144 + j0 * 2) = o;
            *(v4u*)(rec + REC_RT + t * 144 + j0 * 2) = o;
#pragma unroll
            for (int e = 0; e < 8; ++e) { *(LAS bf16*)(lds + LA_KGT + (j0 + e) * 144 + t * 2) = (bf16)f2bf(kg[e]); *(LAS bf16*)(lds + LA_BGT + (j0 + e) * 144 + t * 2) = (bf16)f2bf(bg[e]);
                *(LAS bf16*)(lds + LA_VT + (j0 + e) * 144 + t * 2) = (bf16)((e & 1) ? (wv[e >> 1] >> 16) : (wv[e >> 1] & 0xffffu)); }
            if (t == 63) { *(f32x4*)(rec + REC_GC + j0 * 4) = (f32x4){gc[0], gc[1], gc[2], gc[3]}; *(f32x4*)(rec + REC_GC + (j0 + 4) * 4) = (f32x4){gc[4], gc[5], gc[6], gc[7]}; }
        }
        __syncthreads();
        if (wave < 4) {
            const int ib = wave & 1; const bool isY = wave >= 2; const int offX = isY ? LA_RS : LA_AS;
            f32x16 o;
#pragma unroll
            for (int r = 0; r < 16; ++r) o[r] = 0.f;
            { f32x16 Gt = gtile32(lds, LA_KS, 0, offX, 1, r32, hi); gv_acc(o, Gt, lds, 0, ib, r32, hi); }
            { f32x16 Gt = gtile32(lds, LA_KS, 1, offX, 1, r32, hi); if (isY) mask_lower<true>(Gt, r32, hi); else mask_lower<false>(Gt, r32, hi); gv_acc(o, Gt, lds, 1, ib, r32, hi); }
            if (!isY) {
#pragma unroll
                for (int r = 0; r < 16; ++r) *(LAS float*)(lds + LA_XU + ((32 + crow(r, hi)) * 68 + 32 * ib + r32) * 4) = o[r];
            } else {
#pragma unroll
                for (int u = 0; u < 4; ++u) { const int m = 2 + (u >> 1), lp = (r32 & 15) + 16 * (2 * (u & 1) + hi), vs = 2 * ib + (r32 >> 4);
                    *(pg8::u32x2*)(rec + REC_Y0 + ((vs * 4 + m) * 64 + lp) * 8) = (pg8::u32x2){pk2(o[4 * u], o[4 * u + 1]), pk2(o[4 * u + 2], o[4 * u + 3])}; }
            }
        } else if (wave < 6) {
            const bool isY = wave == 5; const int offX = isY ? LA_RS : LA_AS;
            f32x16 Gt = gtile32(lds, LA_KS, 0, offX, 0, r32, hi); if (isY) mask_lower<true>(Gt, r32, hi); else mask_lower<false>(Gt, r32, hi);
#pragma unroll
            for (int ib = 0; ib < 2; ++ib) { f32x16 o;
#pragma unroll
                for (int r = 0; r < 16; ++r) o[r] = 0.f;
                gv_acc(o, Gt, lds, 0, ib, r32, hi);
                if (!isY) {
#pragma unroll
                    for (int r = 0; r < 16; ++r) *(LAS float*)(lds + LA_XU + (crow(r, hi) * 68 + 32 * ib + r32) * 4) = o[r];
                } else {
#pragma unroll
                    for (int u = 0; u < 4; ++u) { const int m = (u >> 1), lp = (r32 & 15) + 16 * (2 * (u & 1) + hi), vs = 2 * ib + (r32 >> 4);
                        *(pg8::u32x2*)(rec + REC_Y0 + ((vs * 4 + m) * 64 + lp) * 8) = (pg8::u32x2){pk2(o[4 * u], o[4 * u + 1]), pk2(o[4 * u + 2], o[4 * u + 3])}; }
                } }
            const int hf = wave - 4;
#pragma unroll
            for (int jj = 0; jj < 2; ++jj)
#pragma unroll
                for (int vs = 0; vs < 4; ++vs) { const int jt = 2 * hf + jj; f32x4 acc = (f32x4){0.f, 0.f, 0.f, 0.f};
#pragma unroll
                    for (int ks = 0; ks < 2; ++ks) { const bf16x8 a = *(const LAS bf16x8*)(lds + LA_KGT + (16 * jt + c16) * 144 + (32 * ks + 8 * g) * 2), b = *(const LAS bf16x8*)(lds + LA_VT + (16 * vs + c16) * 144 + (32 * ks + 8 * g) * 2);
                        acc = __builtin_amdgcn_mfma_f32_16x16x32_bf16(a, b, acc, 0, 0, 0); }
                    *(pg8::u32x2*)(rec + REC_M0 + ((vs * 4 + jt) * 64 + lane) * 8) = (pg8::u32x2){pk2(acc[0], acc[1]), pk2(acc[2], acc[3])}; }
        } else {
            const bool isR = wave == 7; const int offX = isR ? LA_RS : LA_AS;
#pragma unroll
            for (int k = 0; k < 3; ++k) { const int si = k == 2 ? 1 : 0, ti = k == 0 ? 0 : 1;
                f32x16 Gt = gtile32(lds, LA_BS, si, offX, ti, r32, hi);
                if (si == ti) { if (isR) mask_lower<true>(Gt, r32, hi); else mask_lower<false>(Gt, r32, hi); }
#pragma unroll
                for (int u = 0; u < 4; ++u) {
                    if (!isR) *(LAS f32x4*)(lds + LA_NS + (32 * ti + r32) * 272 + (32 * si + 8 * u + 4 * hi) * 4) = (f32x4){Gt[4 * u], Gt[4 * u + 1], Gt[4 * u + 2], Gt[4 * u + 3]};
                    else *(pg8::u32x2*)(rec + REC_ARB + (32 * ti + r32) * 144 + (32 * si + 8 * u + 4 * hi) * 2) = (pg8::u32x2){pk2(Gt[4 * u], Gt[4 * u + 1]), pk2(Gt[4 * u + 2], Gt[4 * u + 3])}; }
            }
            if (isR) { const v4u z = (v4u){0u, 0u, 0u, 0u}; *(v4u*)(rec + REC_ARB + r32 * 144 + (32 + 16 * hi) * 2) = z; *(v4u*)(rec + REC_ARB + r32 * 144 + (40 + 16 * hi) * 2) = z; }
        }
        __syncthreads();
        const v4u vg1 = *(const v4u*)(ws + WS_AIN + (size_t)uc * AIN_BYTES + AIN_G1 + e0 * 2), vg2 = *(const v4u*)(ws + WS_AIN + (size_t)uc * AIN_BYTES + AIN_G2 + e0 * 2);
        PA_LOAD_LD(min(uc + G, 8191));
        if (wave < 4 && lane < 16) { const int bb = wave; float tc[16];
#pragma unroll
            for (int t2 = 0; t2 < 16; ++t2) { float v = (t2 == lane) ? 1.f : 0.f;
#pragma unroll
                for (int s4 = 0; s4 < (t2 + 3) / 4; ++s4) { const f32x4 n4 = *(const LAS f32x4*)(lds + LA_NS + (16 * bb + t2) * 272 + (16 * bb + 4 * s4) * 4);
#pragma unroll
                    for (int e = 0; e < 4; ++e) if (4 * s4 + e < t2) v += n4[e] * tc[4 * s4 + e]; }
                tc[t2] = v; *(LAS float*)(lds + LA_TS + ((bb * 16 + t2) * 16 + lane) * 4) = v; if ((t2 & 3) == 3) asm volatile("" ::: "memory"); } }
        __syncthreads();
        {   const bool isW = wave < 4; const int colw = 16 * (wave & 3) + c16;
            LAS float* RS = (LAS float*)(lds + LA_SCR + wave * 1024);
#pragma unroll 1
            for (int bb = 0; bb < 4; ++bb) {
                f32x4 acc;
#pragma unroll
                for (int r = 0; r < 4; ++r) acc[r] = isW ? bf1(*(const LAS bf16*)(lds + LA_AS + (16 * bb + 4 * g + r) * 144 + colw * 2)) : *(const LAS float*)(lds + LA_XU + ((16 * bb + 4 * g + r) * 68 + colw) * 4);
#pragma unroll 4
                for (int kk = 0; kk < 4 * bb; ++kk) { const float av = *(const LAS float*)(lds + LA_NS + (16 * bb + c16) * 272 + (4 * kk + g) * 4);
                    const float bv = isW ? CL[(4 * kk + g) * 65 + colw] : *(const LAS float*)(lds + LA_XU + ((4 * kk + g) * 68 + colw) * 4);
                    acc = __builtin_amdgcn_mfma_f32_16x16x4f32(av, bv, acc, 0, 0, 0); }
#pragma unroll
                for (int r = 0; r < 4; ++r) RS[(4 * g + r) * 16 + c16] = acc[r];
                f32x4 xa = (f32x4){0.f, 0.f, 0.f, 0.f};
#pragma unroll
                for (int kk = 0; kk < 4; ++kk) { const float av = *(const LAS float*)(lds + LA_TS + ((bb * 16 + c16) * 16 + 4 * kk + g) * 4); const float bv = RS[(4 * kk + g) * 16 + c16];
                    xa = __builtin_amdgcn_mfma_f32_16x16x4f32(av, bv, xa, 0, 0, 0); }
#pragma unroll
                for (int r = 0; r < 4; ++r) { if (isW) CL[(16 * bb + 4 * g + r) * 65 + colw] = xa[r]; else *(LAS float*)(lds + LA_XU + ((16 * bb + 4 * g + r) * 68 + colw) * 4) = xa[r]; }
                if (isW) {
#pragma unroll
                    for (int r = 0; r < 4; ++r) *(LAS bf16*)(lds + LA_WS + (16 * bb + 4 * g + r) * 144 + colw * 2) = (bf16)f2bf(xa[r]);
                } else *(pg8::u32x2*)(rec + REC_U0 + (((wave & 3) * 4 + bb) * 64 + lane) * 8) = (pg8::u32x2){pk2(xa[0], xa[1]), pk2(xa[2], xa[3])};
            }
        }
        __syncthreads();
        { const int bh = uc >> 8, row = (bh >> 4) * T + (uc & 255) * 64 + t; const size_t go = (size_t)row * 1024 + (bh & 15) * 64 + j0;
          *(v4u*)((bf16*)(ws + WS_G1) + go) = vg1; *(v4u*)((bf16*)(ws + WS_G2) + go) = vg2; }
        for (int i = tid; i < 576; i += NTHR) { *(v4u*)(rec + REC_W + i * 16) = *(const LAS v4u*)(lds + LA_WS + i * 16); *(v4u*)(rec + REC_BGT + i * 16) = *(const LAS v4u*)(lds + LA_BGT + i * 16); }
    }
}

#undef PA_LOAD
#undef PA_LOAD_LD
__device__ __forceinline__ bf16x8 afrag16(const LAS unsigned char* base, int row, int s, int g) {
    const LAS unsigned char* p = base + row * 144 + (32 * s + 4 * g) * 2; const s16x4 lo = *(const LAS s16x4*)p, hh = *(const LAS s16x4*)(p + 32);
    return (bf16x8){lo[0], lo[1], lo[2], lo[3], hh[0], hh[1], hh[2], hh[3]};
}
__device__ __forceinline__ bf16x8 pack_cc(const f32x4& a, const f32x4& b) { v4u w; w.x = pg8::cvt_pk_bf16(a[0], a[1]); w.y = pg8::cvt_pk_bf16(a[2], a[3]); w.z = pg8::cvt_pk_bf16(b[0], b[1]); w.w = pg8::cvt_pk_bf16(b[2], b[3]); return __builtin_bit_cast(bf16x8, w); }
__device__ __forceinline__ f32x4 cfrag(const LAS unsigned char* base, int vs, int m, int lane) { const pg8::u32x2 u = *(const LAS pg8::u32x2*)(base + ((vs * 4 + m) * 64 + lane) * 8); return (f32x4){bfl(u.x), bfh(u.x), bfl(u.y), bfh(u.y)}; }
constexpr int B_SLOT = 44032, B_NP = 43;
__device__ __forceinline__ void b_issue(const unsigned char* rec, LAS unsigned char* slot, int vs, int lw, int lane) {
    for (int p = lw; p < B_NP; p += 4) {
        const int src = p < 36 ? p * 1024 : (p < 42 ? REC_U0 + ((p - 36) >> 1) * 8192 + vs * 2048 + ((p - 36) & 1) * 1024 : REC_GC);
        __builtin_amdgcn_global_load_lds((const unsigned*)(rec + src + lane * 16), (LAS unsigned*)(slot + p * 1024), 16, 0, 0); }
}
__device__ __forceinline__ void p4_rwkv_seq(const Args& A, LAS unsigned char* lds, int q, int wave, int lane) {
    unsigned char* ws = A.ws; const int bh = q >> 2, vs = q & 3;
    const unsigned char* REC = ws + WS_REC + (size_t)bh * 256 * REC_BYTES; bf16* YR = (bf16*)(ws + WS_YRAW);
    const int b = bh >> 4, h = bh & 15, c16 = lane & 15, g = lane >> 4, lw = wave - 4;
    const bool many = ((B_NP - 1 - lw) / 4 + 1) == 11;
    if (wave >= 4) { b_issue(REC, lds, vs, lw, lane); b_issue(REC + REC_BYTES, lds + B_SLOT, vs, lw, lane);
        if (many) asm volatile("s_waitcnt vmcnt(11)" ::: "memory"); else asm volatile("s_waitcnt vmcnt(10)" ::: "memory"); }
    __syncthreads();
    f32x4 H[4];
#pragma unroll
    for (int jt = 0; jt < 4; ++jt) H[jt] = (f32x4){0.f, 0.f, 0.f, 0.f};
#pragma unroll 1
    for (int c = 0; c < 256; ++c) {
        const LAS unsigned char* buf = lds + (c % 3) * B_SLOT;
        if (wave >= 4) {
            if (c + 2 < 256) { b_issue(REC + (size_t)(c + 2) * REC_BYTES, lds + ((c + 2) % 3) * B_SLOT, vs, lw, lane);
                if (many) asm volatile("s_waitcnt vmcnt(11)" ::: "memory"); else asm volatile("s_waitcnt vmcnt(10)" ::: "memory"); }
            else asm volatile("s_waitcnt vmcnt(0)" ::: "memory");
        } else if (wave == 0) {
            const LAS unsigned char* qb = buf + 36864;
            bf16x8 hb[2]; hb[0] = pack_cc(H[0], H[1]); hb[1] = pack_cc(H[2], H[3]);
            f32x4 U[4];
#pragma unroll
            for (int m = 0; m < 4; ++m) { U[m] = cfrag(qb, 0, m, lane);
#pragma unroll
                for (int s = 0; s < 2; ++s) U[m] = __builtin_amdgcn_mfma_f32_16x16x32_bf16(afrag16(buf + REC_W, 16 * m + c16, s, g), hb[s], U[m], 0, 0, 0); }
            bf16x8 ub[2]; ub[0] = pack_cc(U[0], U[1]); ub[1] = pack_cc(U[2], U[3]);
#pragma unroll
            for (int jt = 0; jt < 4; ++jt) { const f32x4 gc = *(const LAS f32x4*)(qb + 6144 + (16 * jt + 4 * g) * 4); f32x4 hn = H[jt] * gc + cfrag(qb + 4096, 0, jt, lane);
#pragma unroll
                for (int s = 0; s < 2; ++s) hn = __builtin_amdgcn_mfma_f32_16x16x32_bf16(afrag16(buf + REC_BGT, 16 * jt + c16, s, g), ub[s], hn, 0, 0, 0);
                H[jt] = hn; }
#pragma unroll
            for (int m = 0; m < 4; ++m) { f32x4 y = cfrag(qb + 2048, 0, m, lane);
#pragma unroll
                for (int s = 0; s < 2; ++s) y = __builtin_amdgcn_mfma_f32_16x16x32_bf16(afrag16(buf + REC_RT, 16 * m + c16, s, g), hb[s], y, 0, 0, 0);
#pragma unroll
                for (int s = 0; s < 2; ++s) y = __builtin_amdgcn_mfma_f32_16x16x32_bf16(afrag16(buf + REC_ARB, 16 * m + c16, s, g), ub[s], y, 0, 0, 0);
                bf16* yp = YR + (size_t)(b * T + 64 * c + 16 * m + 4 * g) * 1024 + h * 64 + 16 * vs + c16;
                yp[0] = (bf16)f2bf(y[0]); yp[1024] = (bf16)f2bf(y[1]); yp[2048] = (bf16)f2bf(y[2]); yp[3072] = (bf16)f2bf(y[3]); }
        }
        __syncthreads();
    }
}
__device__ __forceinline__ void p5_rwkv_final(const Args& A, int vcu, int G, int wave, int lane) {
    const bf16* YR = (const bf16*)(A.ws + WS_YRAW); const bf16* G1 = (const bf16*)(A.ws + WS_G1); const bf16* G2 = (const bf16*)(A.ws + WS_G2); unsigned char* MIX = A.ws + WS_MIX;
    const int gw = vcu * NWAVES + wave, NGW = G * NWAVES, pr = lane >> 3, oct = lane & 7;
    for (int it0 = gw * 8 + pr; it0 < NTOK * 16; it0 += NGW * 8 * 4) {
        v4u y[4], a[4], c[4];
#pragma unroll
        for (int k = 0; k < 4; ++k) { const int it = min(it0 + k * NGW * 8, NTOK * 16 - 1); const size_t o = (size_t)(it >> 4) * 1024 + (it & 15) * 64 + oct * 8;
            y[k] = *(const v4u*)(YR + o); a[k] = *(const v4u*)(G1 + o); c[k] = *(const v4u*)(G2 + o); }
#pragma unroll
        for (int k = 0; k < 4; ++k) { const int it = it0 + k * NGW * 8;
            const unsigned yw[4] = {y[k].x, y[k].y, y[k].z, y[k].w}, aw[4] = {a[k].x, a[k].y, a[k].z, a[k].w}, cw[4] = {c[k].x, c[k].y, c[k].z, c[k].w};
            float v[8]; float sm = 0.f;
#pragma unroll
            for (int e = 0; e < 4; ++e) { v[2 * e] = bfl(yw[e]); v[2 * e + 1] = bfh(yw[e]); sm += v[2 * e] + v[2 * e + 1]; }
            sm += __shfl_xor(sm, 1); sm += __shfl_xor(sm, 2); sm += __shfl_xor(sm, 4);
            const float mean = sm * (1.f / 64.f); float sq = 0.f;
#pragma unroll
            for (int e = 0; e < 8; ++e) { v[e] -= mean; sq += v[e] * v[e]; }
            sq += __shfl_xor(sq, 1); sq += __shfl_xor(sq, 2); sq += __shfl_xor(sq, 4);
            const float rstd = 1.0f / sqrtf(sq * (1.f / 64.f) + GN_EPS);
            float ov[8];
#pragma unroll
            for (int e = 0; e < 4; ++e) { ov[2 * e] = v[2 * e] * rstd * bfl(aw[e]) + bfl(cw[e]); ov[2 * e + 1] = v[2 * e + 1] * rstd * bfh(aw[e]) + bfh(cw[e]); }
            pg8::u32x2 o2; o2.x = pg8::pk4_fp8(ov[0], ov[1], ov[2], ov[3]); o2.y = pg8::pk4_fp8(ov[4], ov[5], ov[6], ov[7]);
            if (it < NTOK * 16) *(pg8::u32x2*)(MIX + (size_t)(it >> 4) * D + (it & 15) * 64 + oct * 8) = o2; }
    }
}

__device__ __forceinline__ void p5_ln_router(const Args& A, LAS unsigned char* lds, int vcu, int G, int tid, int wave, int lane) {
    unsigned char* ws = A.ws; const bf16* Z1 = (const bf16*)(ws + WS_Z1); bf16* H1 = (bf16*)(ws + WS_H1); const bf16* RWF = (const bf16*)(ws + WS_RWT);
    int* TOPI = (int*)(ws + RT_TOPI); float* TOPG = (float*)(ws + RT_TOPG); int* CNT = (int*)(ws + RT_CNT);
    LAS int* hist = (LAS int*)lds; const int c16 = lane & 15, g = lane >> 4;
    const float* gam = A.in[21]; const float* bet = A.in[22];
    for (int batch = vcu; batch < NTOK / 128; batch += G) {
        __syncthreads();
        if (tid < NE) hist[tid] = 0;
        __syncthreads();
        const int row0 = batch * 128 + wave * 16; const bf16* zr = Z1 + (size_t)(row0 + c16) * D + 8 * g;
        float sm = 0.f, sq = 0.f;
#pragma unroll 8
        for (int sx = 0; sx < 64; ++sx) { const v4u z = *(const v4u*)(zr + 32 * sx); const unsigned zw[4] = {z.x, z.y, z.z, z.w};
#pragma unroll
            for (int e = 0; e < 4; ++e) { const float a = bfl(zw[e]), b = bfh(zw[e]); sm += a + b; sq += a * a + b * b; } }
        sm += __shfl_xor(sm, 16); sm += __shfl_xor(sm, 32); sq += __shfl_xor(sq, 16); sq += __shfl_xor(sq, 32);
        const float mean = sm * (1.f / D); const float rstd = 1.0f / sqrtf(fmaxf(sq * (1.f / D) - mean * mean, 0.f) + LN_EPS);
        f32x4 acc[2]; acc[0] = (f32x4){0.f, 0.f, 0.f, 0.f}; acc[1] = acc[0];
        bf16* hr = H1 + (size_t)(row0 + c16) * D + 8 * g; unsigned char* hq = ws + WS_H1Q + (size_t)(row0 + c16) * D + 8 * g;
#pragma unroll 2
        for (int sx = 0; sx < 64; ++sx) { const v4u z = *(const v4u*)(zr + 32 * sx); const f32x4 a = (f32x4){bfl(z.x), bfh(z.x), bfl(z.y), bfh(z.y)}, b = (f32x4){bfl(z.z), bfh(z.z), bfl(z.w), bfh(z.w)};
            const f32x4 g0 = *(const f32x4*)(gam + 32 * sx + 8 * g), g1 = *(const f32x4*)(gam + 32 * sx + 8 * g + 4), b0 = *(const f32x4*)(bet + 32 * sx + 8 * g), b1 = *(const f32x4*)(bet + 32 * sx + 8 * g + 4);
            const f32x4 h0 = (a - mean) * rstd * g0 + b0, h1 = (b - mean) * rstd * g1 + b1;
            v4u hi; hi.x = pg8::cvt_pk_bf16(h0.x, h0.y); hi.y = pg8::cvt_pk_bf16(h0.z, h0.w); hi.z = pg8::cvt_pk_bf16(h1.x, h1.y); hi.w = pg8::cvt_pk_bf16(h1.z, h1.w);
            *(v4u*)(hr + 32 * sx) = hi;
            *(pg8::u32x2*)(hq + 32 * sx) = (pg8::u32x2){pg8::pk4_fp8(h0.x, h0.y, h0.z, h0.w), pg8::pk4_fp8(h1.x, h1.y, h1.z, h1.w)};
            v4u lo; lo.x = pg8::cvt_pk_bf16(h0.x - bfl(hi.x), h0.y - bfh(hi.x)); lo.y = pg8::cvt_pk_bf16(h0.z - bfl(hi.y), h0.w - bfh(hi.y));
            lo.z = pg8::cvt_pk_bf16(h1.x - bfl(hi.z), h1.y - bfh(hi.z)); lo.w = pg8::cvt_pk_bf16(h1.z - bfl(hi.w), h1.w - bfh(hi.w));
            const bf16x8 ah = __builtin_bit_cast(bf16x8, hi), al = __builtin_bit_cast(bf16x8, lo);
#pragma unroll
            for (int nt = 0; nt < 2; ++nt) { const bf16* fp = RWF + ((size_t)((sx * 2 + nt) * 2) * 64 + lane) * 8; const bf16x8 wh = *(const bf16x8*)fp, wl = *(const bf16x8*)(fp + 512);
                acc[nt] = __builtin_amdgcn_mfma_f32_16x16x32_bf16(ah, wh, acc[nt], 0, 0, 0); acc[nt] = __builtin_amdgcn_mfma_f32_16x16x32_bf16(ah, wl, acc[nt], 0, 0, 0);
                acc[nt] = __builtin_amdgcn_mfma_f32_16x16x32_bf16(al, wh, acc[nt], 0, 0, 0); } }
        const float bia0 = A.in[24][c16], bia1 = A.in[24][16 + c16];
#pragma unroll
        for (int r = 0; r < 4; ++r) {
            float v0 = acc[0][r] + bia0, v1 = acc[1][r] + bia1; float tv[4]; int ti[4];
#pragma unroll
            for (int k = 0; k < 4; ++k) { float bv = v0; int bi = c16; if (v1 > bv) { bv = v1; bi = 16 + c16; }
#pragma unroll
                for (int o = 1; o < 16; o <<= 1) { const float ov = __shfl_xor(bv, o); const int oi = __shfl_xor(bi, o); if (ov > bv || (ov == bv && oi < bi)) { bv = ov; bi = oi; } }
                tv[k] = bv; ti[k] = bi; if (bi == c16) v0 = -INFINITY; if (bi == 16 + c16) v1 = -INFINITY; }
            const float e1 = __expf(tv[1] - tv[0]), e2 = __expf(tv[2] - tv[0]), e3 = __expf(tv[3] - tv[0]); const float inv = 1.f / (1.f + e1 + e2 + e3);
            if (c16 < 4) { const int row = row0 + 4 * g + r; const int ei = c16 == 0 ? ti[0] : c16 == 1 ? ti[1] : c16 == 2 ? ti[2] : ti[3]; const float gv = (c16 == 0 ? 1.f : c16 == 1 ? e1 : c16 == 2 ? e2 : e3) * inv;
                TOPI[row * 4 + c16] = ei; TOPG[row * 4 + c16] = gv; __hip_atomic_fetch_add(hist + ei, 1, __ATOMIC_RELAXED, __HIP_MEMORY_SCOPE_WORKGROUP); }
        }
        __syncthreads();
        if (tid < NE) CNT[batch * NE + tid] = hist[tid];
    }
}
__device__ __forceinline__ void p6_positions(const Args& A, LAS unsigned char* lds, int vcu, int G, int tid) {
    unsigned char* ws = A.ws; const int* TOPI = (const int*)(ws + RT_TOPI); const float* TOPG = (const float*)(ws + RT_TOPG); const int* CNT = (const int*)(ws + RT_CNT);
    int* POS = (int*)(ws + RT_POS); int* BTOK = (int*)(ws + RT_TOK); float* BGATE = (float*)(ws + RT_GATE); int* TILE = (int*)(ws + RT_TILE);
    LAS int* sh = (LAS int*)lds;
    for (int batch = vcu; batch < NTOK / 128; batch += G) {
        __syncthreads();
        { const int e = tid & 31, seg = tid >> 5; int sb = 0, st = 0;
          for (int q = 0; q < 16; ++q) { const int bb = seg * 16 + q; const int c = CNT[bb * NE + e]; st += c; if (bb < batch) sb += c; }
          sh[tid] = sb; sh[1152 + tid] = st; }
        sh[640 + tid] = TOPI[batch * 512 + tid];
        __syncthreads();
        if (tid < NE) { int sb = 0, st = 0; for (int s = 0; s < 16; ++s) { sb += sh[s * 32 + tid]; st += sh[1152 + s * 32 + tid]; } sh[512 + tid] = sb; sh[544 + tid] = st; }
        __syncthreads();
        const int lane = tid & 63, wave = tid >> 6; const int e = sh[640 + tid];
        if (tid < 64) { const int v = tid < NE ? (sh[544 + tid] + 255) >> 8 : 0; int inc = v;
#pragma unroll
            for (int o = 1; o < 32; o <<= 1) { const int t = __shfl_up(inc, o); if (lane >= o) inc += t; }
            if (tid < NE) sh[576 + tid] = inc - v; if (tid == NE - 1) sh[576 + NE] = inc; }
        int rw = 0, mycnt = 0; { const unsigned long long lt = (1ull << lane) - 1ull;
#pragma unroll 8
            for (int x = 0; x < NE; ++x) { const unsigned long long b = __ballot(e == x); if (e == x) rw = __popcll(b & lt); if (lane == x) mycnt = __popcll(b); } }
        if (lane < NE) sh[1664 + wave * 32 + lane] = mycnt;
        __syncthreads();
        { int rank = rw; for (int w = 0; w < wave; ++w) rank += sh[1664 + w * 32 + e];
          const int dest = sh[576 + e] * 256 + sh[512 + e] + rank;
          BTOK[dest] = batch * 128 + (tid >> 2); BGATE[dest] = TOPG[batch * 512 + tid]; POS[batch * 512 + tid] = dest; }
        if (batch < NE) { const int e = batch; const int lo = sh[576 + e] * 256 + sh[544 + e], hi = sh[576 + e + 1] * 256;
            for (int i = lo + tid; i < hi; i += NTHR) { BTOK[i] = 0; BGATE[i] = 0.f; }
            for (int rt = sh[576 + e] + tid; rt < sh[576 + e + 1]; rt += NTHR) TILE[rt] = e; }
        if (batch == 0 && tid == 0) TILE[MAXT] = sh[576 + NE];
    }
}
template <int I> __device__ __forceinline__ float fp8f_(unsigned w) { return __builtin_amdgcn_cvt_f32_fp8((int)w, I); }
#define fp8f(w, i) fp8f_<i>(w)
__device__ __forceinline__ void p9_final(const Args& A, int vcu, int G, int wave, int lane) {
    unsigned char* ws = A.ws; const bf16* H1 = (const bf16*)(ws + WS_H1); const unsigned char* Y = ws + WS_Y; const int* POS = (const int*)(ws + RT_POS);
    const int gw = vcu * NWAVES + wave, NGW = G * NWAVES;
    for (int row = gw; row < NTOK; row += NGW) {
        f32x4 v[8]; const int p0 = POS[row * 4], p1 = POS[row * 4 + 1], p2 = POS[row * 4 + 2], p3 = POS[row * 4 + 3];
#pragma unroll
        for (int j = 0; j < 8; ++j) { const int c = 4 * lane + 256 * j;
            const pg8::u32x2 h = *(const pg8::u32x2*)(H1 + (size_t)row * D + c);
            const unsigned y0 = *(const unsigned*)(Y + (size_t)p0 * D + c), y1 = *(const unsigned*)(Y + (size_t)p1 * D + c), y2 = *(const unsigned*)(Y + (size_t)p2 * D + c), y3 = *(const unsigned*)(Y + (size_t)p3 * D + c);
            const float s = 1.0f / 64.0f;
            v[j].x = ALPHA * bfl(h.x) + s * ((fp8f(y0, 0) + fp8f(y1, 0)) + (fp8f(y2, 0) + fp8f(y3, 0))); v[j].y = ALPHA * bfh(h.x) + s * ((fp8f(y0, 1) + fp8f(y1, 1)) + (fp8f(y2, 1) + fp8f(y3, 1)));
            v[j].z = ALPHA * bfl(h.y) + s * ((fp8f(y0, 2) + fp8f(y1, 2)) + (fp8f(y2, 2) + fp8f(y3, 2))); v[j].w = ALPHA * bfh(h.y) + s * ((fp8f(y0, 3) + fp8f(y1, 3)) + (fp8f(y2, 3) + fp8f(y3, 3))); }
        ln_row(v, A.in[29], A.in[30], LN_EPS, lane);
#pragma unroll
        for (int j = 0; j < 8; ++j) *(f32x4*)(A.out + (size_t)row * D + 4 * lane + 256 * j) = v[j];
    }
}

constexpr int NPH = 12;
__device__ __forceinline__ int opaque_tid() { int t = (int)threadIdx.x; asm volatile("" : "+v"(t)); return t; }
template <int PLO, int PHI>
__global__ void __launch_bounds__(NTHR, 2) fwd_kernel(Args args) {
    extern __shared__ __attribute__((aligned(16))) unsigned char lds_raw[];
    LAS unsigned char* lds = (LAS unsigned char*)lds_raw;
    const int tid = threadIdx.x, lane = tid & 63, wave = __builtin_amdgcn_readfirstlane(tid >> 6);
    const int G = gridDim.x; const int bx = blockIdx.x; const int vcu = (G % 8 == 0) ? (bx % 8) * (G / 8) + bx / 8 : bx;
    volatile LAS unsigned* MISC = (volatile LAS unsigned*)(lds + MISC_OFF);
    if (tid < 64) MISC[tid] = 0u;
    __syncthreads();
    unsigned char* ws = args.ws;
    unsigned* ctl = (unsigned*)(ws + WS_CTL);
    constexpr int lo = PLO, hi = PHI;
    XcdBarrier bar; bar.bar = ctl + CW_BAR; bar.x = 0; bar.st = nullptr;
    if (hi - lo > 1) bar = xcd_barrier_post(ctl + CW_BAR, MISC + 8);
#define IN(k) (lo <= (k) && (k) < hi)
#define PH_IDS const int tid = opaque_tid(), lane = tid & 63, wave = __builtin_amdgcn_readfirstlane(tid >> 6); (void)tid; (void)lane; (void)wave
#define SEAM(k) do { if constexpr (IN(k) && IN((k) + 1)) xcd_barrier(bar); } while (0)

    if constexpr (IN(0)) { PH_IDS; p0_prologue(args, lds, vcu, G, wave, lane); }
#if defined(REP_PHASE)
    if constexpr (REP_PHASE == 0) { __syncthreads();
    if constexpr (IN(0)) { PH_IDS; p0_prologue(args, lds, vcu, G, wave, lane); }
    }
#endif
    SEAM(0);
    if constexpr (IN(1)) { PH_IDS;
        const int ng = (G == 256) ? NG_INPROJ : G;
        if (bx < ng) { pg8::Gemm g{(const bf16*)(ws + WS_H0), (const bf16*)(ws + WS_WI), NTOK, PW, D}; pg8::StaticOrder S; S.init(NTOK, PW, ng, bx);
            pg8::EpiBf16 E{(bf16*)(ws + WS_P), PW};
            pg8::gemm_phase<pg8::EpiBf16, pg8::StaticOrder>(lds, g, S, E); }
        else { pg8::Gemm g{(const bf16*)(ws + WS_MEMN), (const bf16*)(ws + WS_WKV), NB * MEM_LEN, 1024, D}; pg8::StaticOrder S; S.init(NB * MEM_LEN, 1024, G - ng, bx - ng);
            pg8::EpiBf16 E{(bf16*)(ws + WS_KVM), 1024};
            pg8::gemm_phase<pg8::EpiBf16, pg8::StaticOrder>(lds, g, S, E); }
        conv_pull_loop(args, lds, tid, wave, lane);
    }
#if defined(REP_PHASE)
    if constexpr (REP_PHASE == 1) { __syncthreads();
    if constexpr (IN(1)) { PH_IDS;
        pg8::Gemm g{(const bf16*)(ws + WS_H0), (const bf16*)(ws + WS_WI), NTOK, PW, D}; pg8::StaticOrder S; S.init(NTOK, PW, G, bx);
        pg8::EpiBf16 E{(bf16*)(ws + WS_P), PW};
        pg8::gemm_phase<pg8::EpiBf16, pg8::StaticOrder>(lds, g, S, E);
    }
    }
#endif
    SEAM(1);
    if constexpr (IN(2)) { PH_IDS;
        if (G != 256) { pg8::Gemm g{(const bf16*)(ws + WS_MEMN), (const bf16*)(ws + WS_WKV), NB * MEM_LEN, 1024, D}; pg8::StaticOrder S; S.init(NB * MEM_LEN, 1024, G, bx);
          pg8::EpiBf16 E{(bf16*)(ws + WS_KVM), 1024};
          pg8::gemm_phase<pg8::EpiBf16, pg8::StaticOrder>(lds, g, S, E); }
        __syncthreads();
        p2_fox_cumsum(args, lds, (vcu + G - 16) % G, G, tid);
        __syncthreads();
        p2_fox_norms(args, lds, vcu, G, tid, wave, lane);
        __syncthreads();
        p2_rwkv_tok(args, lds, vcu, G, tid, wave, lane);
#if defined(REP_SUB)
        __syncthreads();
        if constexpr (REP_SUB == 0) p2_rwkv_tok(args, lds, vcu, G, tid, wave, lane);
        if constexpr (REP_SUB == 11) p2_rwkv_tok<1>(args, lds, vcu, G, tid, wave, lane);
        if constexpr (REP_SUB == 12) p2_rwkv_tok<2>(args, lds, vcu, G, tid, wave, lane);
        if constexpr (REP_SUB == 1) p2_fox_norms(args, lds, vcu, G, tid, wave, lane);
        if constexpr (REP_SUB == 2) p2_fox_cumsum(args, lds, (vcu + G - 16) % G, G, tid);
        if constexpr (REP_SUB == 3) { pg8::Gemm g{(const bf16*)(ws + WS_MEMN), (const bf16*)(ws + WS_WKV), NB * MEM_LEN, 1024, D}; pg8::StaticOrder S; S.init(NB * MEM_LEN, 1024, G, bx);
          pg8::EpiBf16 E{(bf16*)(ws + WS_KVM), 1024};
          pg8::gemm_phase<pg8::EpiBf16, pg8::StaticOrder>(lds, g, S, E); }
#endif
    }
#if defined(REP_PHASE)
    if constexpr (REP_PHASE == 2) { __syncthreads();
    if constexpr (IN(2)) { PH_IDS;
        { pg8::Gemm g{(const bf16*)(ws + WS_MEMN), (const bf16*)(ws + WS_WKV), NB * MEM_LEN, 1024, D}; pg8::StaticOrder S; S.init(NB * MEM_LEN, 1024, G, bx);
          pg8::EpiBf16 E{(bf16*)(ws + WS_KVM), 1024};
          pg8::gemm_phase<pg8::EpiBf16, pg8::StaticOrder>(lds, g, S, E); }
        __syncthreads();
        p2_fox_cumsum(args, lds, (vcu + G - 16) % G, G, tid);
        __syncthreads();
        p2_fox_norms(args, lds, vcu, G, tid, wave, lane);
        __syncthreads();
        p2_rwkv_tok(args, lds, vcu, G, tid, wave, lane);
    }
    }
#endif
    SEAM(2);
    if constexpr (IN(3)) { PH_IDS; p3_rwkv_chunk(args, lds, vcu, G, tid, wave, lane); }
#if defined(REP_PHASE)
    if constexpr (REP_PHASE == 3) { __syncthreads();
    if constexpr (IN(3)) { PH_IDS; p3_rwkv_chunk(args, lds, vcu, G, tid, wave, lane); }
    }
#endif
    SEAM(3);
    if constexpr (IN(4)) { PH_IDS;
        for (int q = vcu; q < 128; q += G) { __syncthreads(); p4_rwkv_seq(args, lds, q, wave, lane); }
        p3_attention(args, lds, tid, wave, lane);
    }
#if defined(REP_PHASE)
    if constexpr (REP_PHASE == 4) { __syncthreads();
    if constexpr (IN(4)) { PH_IDS;
        for (int q = vcu; q < 128; q += G) { __syncthreads(); p4_rwkv_seq(args, lds, q, wave, lane); }
        p3_attention(args, lds, tid, wave, lane);
    }
    }
#endif
    SEAM(4);
    if constexpr (IN(5)) { PH_IDS; p5_rwkv_final(args, vcu, G, wave, lane); }
#if defined(REP_PHASE)
    if constexpr (REP_PHASE == 5) { __syncthreads();
    if constexpr (IN(5)) { PH_IDS; p5_rwkv_final(args, vcu, G, wave, lane); }
    }
#endif
    SEAM(5);
    if constexpr (IN(6)) { PH_IDS;
        LAS int* tl = (LAS int*)(lds + 131072 + 2048); __syncthreads(); if (tid < NTOK / 256) tl[tid] = 0; __syncthreads();
        pg8::Gemm g{(const bf16*)(ws + WS_MIX), (const bf16*)(ws + WS_WO), NTOK, D, D / 2};
        pg8::MoeOrder<true> S{tl, nullptr, NTOK / 256, D / 256, G, bx};
        pg8::EpiResBf16 E{(bf16*)(ws + WS_Z1), (const bf16*)(ws + WS_H0), D, ALPHA};
        pg8::gemm_phase<pg8::EpiResBf16, pg8::MoeOrder<true>, true, true>(lds, g, S, E);
    }
#if defined(REP_PHASE)
    if constexpr (REP_PHASE == 6) { __syncthreads();
    if constexpr (IN(6)) { PH_IDS;
        LAS int* tl = (LAS int*)(lds + 131072 + 2048); __syncthreads(); if (tid < NTOK / 256) tl[tid] = 0; __syncthreads();
        pg8::Gemm g{(const bf16*)(ws + WS_MIX), (const bf16*)(ws + WS_WO), NTOK, D, D / 2};
        pg8::MoeOrder<true> S{tl, nullptr, NTOK / 256, D / 256, G, bx};
        pg8::EpiResBf16 E{(bf16*)(ws + WS_Z1), (const bf16*)(ws + WS_H0), D, ALPHA};
        pg8::gemm_phase<pg8::EpiResBf16, pg8::MoeOrder<true>, true, true>(lds, g, S, E);
    }
    }
#endif
    SEAM(6);
    if constexpr (IN(7)) { PH_IDS; p5_ln_router(args, lds, vcu, G, tid, wave, lane); }
#if defined(REP_PHASE)
    if constexpr (REP_PHASE == 7) { __syncthreads();
    if constexpr (IN(7)) { PH_IDS; p5_ln_router(args, lds, vcu, G, tid, wave, lane); }
    }
#endif
    SEAM(7);
    if constexpr (IN(8)) { PH_IDS; p6_positions(args, lds, vcu, G, tid); }
#if defined(REP_PHASE)
    if constexpr (REP_PHASE == 8) { __syncthreads();
    if constexpr (IN(8)) { PH_IDS; p6_positions(args, lds, vcu, G, tid); }
    }
#endif
    SEAM(8);
    if constexpr (IN(9)) { PH_IDS;
        const int* TILE = (const int*)(ws + RT_TILE); const int ntiles = __builtin_amdgcn_readfirstlane(TILE[MAXT]);
        LAS int* tl = (LAS int*)(lds + 131072 + 2048); __syncthreads(); for (int i = tid; i < MAXT; i += NTHR) tl[i] = TILE[i]; __syncthreads();
        pg8::Gemm g{(const bf16*)(ws + WS_H1Q), (const bf16*)(ws + WS_W1), CAP, NE * 4096, D / 2};
        pg8::MoeOrder<true> S{tl, (const int*)(ws + RT_TOK), ntiles, 16, G, bx};
        pg8::EpiSwiglu E{ws + WS_ACT, args.in[26], {}, {}};
        pg8::gemm_phase<pg8::EpiSwiglu, pg8::MoeOrder<true>, true, true>(lds, g, S, E);
    }
#if defined(REP_PHASE)
    if constexpr (REP_PHASE == 9) { __syncthreads();
    if constexpr (IN(9)) { PH_IDS;
        const int* TILE = (const int*)(ws + RT_TILE); const int ntiles = __builtin_amdgcn_readfirstlane(TILE[MAXT]);
        LAS int* tl = (LAS int*)(lds + 131072 + 2048); __syncthreads(); for (int i = tid; i < MAXT; i += NTHR) tl[i] = TILE[i]; __syncthreads();
        pg8::Gemm g{(const bf16*)(ws + WS_H1Q), (const bf16*)(ws + WS_W1), CAP, NE * 4096, D / 2};
        pg8::MoeOrder<true> S{tl, (const int*)(ws + RT_TOK), ntiles, 16, G, bx};
        pg8::EpiSwiglu E{ws + WS_ACT, args.in[26], {}, {}};
        pg8::gemm_phase<pg8::EpiSwiglu, pg8::MoeOrder<true>, true, true>(lds, g, S, E);
    }
    }
#endif
    SEAM(9);
    if constexpr (IN(10)) { PH_IDS;
        const int* TILE = (const int*)(ws + RT_TILE); const int ntiles = __builtin_amdgcn_readfirstlane(TILE[MAXT]);
        LAS int* tl = (LAS int*)(lds + 131072 + 2048); __syncthreads(); for (int i = tid; i < MAXT; i += NTHR) tl[i] = TILE[i]; __syncthreads();
        pg8::Gemm g{(const bf16*)(ws + WS_ACT), (const bf16*)(ws + WS_W2), CAP, NE * D, D / 2};
        pg8::MoeOrder<true> S{tl, nullptr, ntiles, 8, G, bx};
        pg8::EpiGate E{ws + WS_Y, args.in[28], (const float*)(ws + RT_GATE), {}, {}};
        pg8::gemm_phase<pg8::EpiGate, pg8::MoeOrder<true>, true, true>(lds, g, S, E);
    }
#if defined(REP_PHASE)
    if constexpr (REP_PHASE == 10) { __syncthreads();
    if constexpr (IN(10)) { PH_IDS;
        const int* TILE = (const int*)(ws + RT_TILE); const int ntiles = __builtin_amdgcn_readfirstlane(TILE[MAXT]);
        LAS int* tl = (LAS int*)(lds + 131072 + 2048); __syncthreads(); for (int i = tid; i < MAXT; i += NTHR) tl[i] = TILE[i]; __syncthreads();
        pg8::Gemm g{(const bf16*)(ws + WS_ACT), (const bf16*)(ws + WS_W2), CAP, NE * D, D / 2};
        pg8::MoeOrder<true> S{tl, nullptr, ntiles, 8, G, bx};
        pg8::EpiGate E{ws + WS_Y, args.in[28], (const float*)(ws + RT_GATE), {}, {}};
        pg8::gemm_phase<pg8::EpiGate, pg8::MoeOrder<true>, true, true>(lds, g, S, E);
    }
    }
#endif
    SEAM(10);
    if constexpr (IN(11)) { PH_IDS; p9_final(args, vcu, G, wave, lane); }
#if defined(REP_PHASE)
    if constexpr (REP_PHASE == 11) { __syncthreads();
    if constexpr (IN(11)) { PH_IDS; p9_final(args, vcu, G, wave, lane); }
    }
#endif
#undef IN
#undef SEAM
}

template <int P> static void launch_phase(int grid, hipStream_t stream, const Args& a) {
    static bool init = false;
    if (!init) { (void)hipFuncSetAttribute((const void*)fwd_kernel<P, P + 1>, hipFuncAttributeMaxDynamicSharedMemorySize, LDS_BYTES); init = true; }
    hipLaunchKernelGGL((fwd_kernel<P, P + 1>), dim3(grid), dim3(NTHR), LDS_BYTES, stream, a);
}
extern "C" void kernel_launch(void* const* d_in, const int* in_sizes, int n_in, void* d_out, int out_size, void* d_ws, size_t ws_size, hipStream_t stream) {
    static int grid = 0;
    if (grid == 0) {
        if (n_in != 31 || out_size != NTOK * D || ws_size < WS_END) { fprintf(stderr, "kernel_launch: unexpected shapes (n_in %d out %d ws %zu, need %zu)\n", n_in, out_size, ws_size, (size_t)WS_END); grid = -1; return; }
        int dev = 0, cus = 0;
        if (hipGetDevice(&dev) != hipSuccess || hipDeviceGetAttribute(&cus, hipDeviceAttributeMultiprocessorCount, dev) != hipSuccess) { grid = -1; return; }
        grid = cus;
    }
    if (grid < 0) return;
    (void)hipMemsetAsync((char*)d_ws + WS_CTL, 0, CTL_ZERO_BYTES, stream);
    Args a{};
    for (int i = 0; i < 31; ++i) a.in[i] = (const float*)d_in[i];
    a.out = (float*)d_out; a.ws = (unsigned char*)d_ws;
#ifdef ONE_LAUNCH
    { static bool init = false; if (!init) { (void)hipFuncSetAttribute((const void*)fwd_kernel<0, NPH>, hipFuncAttributeMaxDynamicSharedMemorySize, LDS_BYTES); init = true; }
      hipLaunchKernelGGL((fwd_kernel<0, NPH>), dim3(grid), dim3(NTHR), LDS_BYTES, stream, a); }
#else
    launch_phase<0>(grid, stream, a); launch_phase<1>(grid, stream, a); launch_phase<2>(grid, stream, a); launch_phase<3>(grid, stream, a);
    launch_phase<4>(grid, stream, a); launch_phase<5>(grid, stream, a); launch_phase<6>(grid, stream, a); launch_phase<7>(grid, stream, a);
    launch_phase<8>(grid, stream, a); launch_phase<9>(grid, stream, a); launch_phase<10>(grid, stream, a); launch_phase<11>(grid, stream, a);
#endif
}
```

```cpp
#define ONE_LAUNCH 1
#include <hip/hip_runtime.h>
#include <cstdio>
#include <cstdint>

namespace pg8 {
#define PG8_LAS __attribute__((address_space(3)))
typedef unsigned short bf16_t;
typedef short bf16x8 __attribute__((ext_vector_type(8)));
typedef float f32x4 __attribute__((ext_vector_type(4)));
typedef unsigned u32x4 __attribute__((ext_vector_type(4)));
typedef unsigned u32x2 __attribute__((ext_vector_type(2)));
typedef int v4i32 __attribute__((ext_vector_type(4)));
typedef int v8i32 __attribute__((ext_vector_type(8)));
constexpr int SCALE_W = 0x79797979, SCALE_A = 0x7f7f7f7f;
constexpr int BM = 256, BK = 64, HALF = 128, HTB = HALF * BK * 2  , STAGE_BYTES = 8 * HTB, NXCD = 8, WGM = 8;

__host__ __device__ __forceinline__ int lds_byte(int r, int c) { const int st = (r >> 4) * 2 + (c >> 5), rr = r & 15, cc = c & 31, ob = rr * 64 + cc * 2; return st * 1024 + (ob ^ (((ob >> 9) & 1) << 5)); }
__host__ __device__ __forceinline__ void stage_rc(int b, int& R, int& C) { const int st = b / 1024, sb = b % 1024, swz = sb ^ (((sb >> 9) & 1) << 5); R = (st >> 1) * 16 + swz / 64; C = (st & 1) * 32 + (swz % 64) / 2; }
__host__ __device__ __forceinline__ int perm32(int rho) { const int n = rho >> 4, i = rho & 15; return 8 * (i >> 2) + 4 * n + (i & 3); }

struct Unit { int pm, pn; };
struct Gemm { const bf16_t* A; const bf16_t* Bt; int M, N, K; };

struct StaticOrder {
    int nM, nN, nwg, G, c;
    __host__ __device__ void init(int M, int N, int G_, int c_) { nM = M / BM; nN = N / BM; nwg = nM * nN; G = G_; c = c_; }
    __host__ __device__ bool next(int i, Unit& u) const {
        const long L = (long)i * G + c; if (L >= nwg) return false;
        int wgid = (int)L; { const int q = nwg / NXCD, r = nwg % NXCD, xcd = wgid % NXCD, off = wgid / NXCD; wgid = (xcd < r ? xcd * (q + 1) : r * (q + 1) + (xcd - r) * q) + off; }
        const int nig = WGM * nN, gid = wgid / nig, fm = gid * WGM, gsz = (nM - fm) < WGM ? (nM - fm) : WGM;
        u.pm = fm + ((wgid % nig) % gsz); u.pn = (wgid % nig) / gsz; return true;
    }
    static constexpr bool GATHER = false;
    __device__ __forceinline__ int arow(const Unit& u, int r) const { return u.pm * BM + r; }
};
struct QueueOrder {
    int nM, nN, nwg, x; unsigned* qhead; volatile PG8_LAS int* slot; mutable int pend;
    __device__ void init(int M, int N, int x_, unsigned* q_, volatile PG8_LAS int* s_, int pend_) { nM = M / BM; nN = N / BM; nwg = nM * nN; x = x_; qhead = q_; slot = s_; pend = pend_; }
    __device__ __forceinline__ int pop() const { return 8 * (int)__hip_atomic_fetch_add(qhead + 64 * x, 1u, __ATOMIC_RELAXED, __HIP_MEMORY_SCOPE_AGENT) + x; }
    __device__ __forceinline__ bool next(int i, Unit& u) const {
        const int L = __builtin_amdgcn_readfirstlane(slot[i % 3]);
        if (threadIdx.x == 0) { slot[(i + 2) % 3] = pend; pend = pop(); }
        if (L >= nwg) return false;
        int wgid = L; { const int q = nwg / NXCD, r = nwg % NXCD, xcd = wgid % NXCD, off = wgid / NXCD; wgid = (xcd < r ? xcd * (q + 1) : r * (q + 1) + (xcd - r) * q) + off; }
        const int nig = WGM * nN, gid = wgid / nig, fm = gid * WGM, gsz = (nM - fm) < WGM ? (nM - fm) : WGM;
        u.pm = fm + ((wgid % nig) % gsz); u.pn = (wgid % nig) / gsz; return true;
    }
    static constexpr bool GATHER = false;
    __device__ __forceinline__ int arow(const Unit& u, int r) const { return u.pm * BM + r; }
};
template <bool GATHER_> struct MoeOrder {
    static constexpr bool GATHER = GATHER_;
    const PG8_LAS int* tile_e; const int* tok; int ntiles, ncol, G, c;
    __device__ __forceinline__ bool next(int i, Unit& u) const {
        int rt, ct;
        if ((G & 7) == 0 && ((G >> 3) % ncol) == 0) {
            const int R = G / ncol, x = c & 7, j = c >> 3;
            rt = i * R + x * (R >> 3) + j / ncol; ct = j % ncol; if (rt >= ntiles) return false;
        } else { const long L = (long)i * G + c; if (L >= (long)ntiles * ncol) return false; rt = (int)(L / ncol); ct = (int)(L % ncol); }
        u.pm = rt; u.pn = __builtin_amdgcn_readfirstlane(tile_e[rt]) * ncol + ct; return true;
    }
    __device__ __forceinline__ int arow(const Unit& u, int r) const { return (GATHER_ && tok) ? tok[u.pm * BM + r] : u.pm * BM + r; }
};

typedef float f32x2_t __attribute__((ext_vector_type(2))); typedef __bf16 bf16x2_t __attribute__((ext_vector_type(2)));
__device__ __forceinline__ unsigned cvt_pk_bf16(float lo, float hi) { const f32x2_t v = {lo, hi}; const bf16x2_t b = __builtin_convertvector(v, bf16x2_t); return __builtin_bit_cast(unsigned, b); }
__device__ __forceinline__ float bf_lo(unsigned w) { return __builtin_bit_cast(float, w << 16); }
__device__ __forceinline__ float bf_hi(unsigned w) { return __builtin_bit_cast(float, w & 0xffff0000u); }

__device__ __forceinline__ unsigned pk4_fp8(float a, float b, float c, float d) { unsigned w = 0u; w = __builtin_amdgcn_cvt_pk_fp8_f32(a, b, w, false); w = __builtin_amdgcn_cvt_pk_fp8_f32(c, d, w, true); return w; }
template <class T> __device__ __forceinline__ T* sbase(T* p) { asm volatile("" : "+s"(p)); return p; }
__device__ __forceinline__ unsigned vopaque(unsigned v) { asm volatile("" : "+v"(v)); return v; }
struct EpiBf16 {
    static constexpr bool PERM = true; static constexpr int NST = 16, NPRE = 0;
    bf16_t* O; int ldc;
    __device__ __forceinline__ void pre(const Unit&, int, int, int, int) const {}
    __device__ __forceinline__ void operator()(const f32x4 (&acc)[2][2][4][2], const Unit& u, int wr, int wc, int fr, int fq) const {
        const unsigned lo = vopaque(((unsigned)(wr * 64 + fr) * (unsigned)ldc + (unsigned)(wc * 32 + 8 * fq)) * 2u);
#pragma unroll
        for (int ai = 0; ai < 2; ++ai)
#pragma unroll
            for (int m = 0; m < 4; ++m) { char* rb = (char*)sbase(O + (size_t)(u.pm * BM + ai * HALF + m * 16) * ldc + u.pn * BM);
#pragma unroll
                for (int bj = 0; bj < 2; ++bj) { const f32x4 v0 = acc[ai][bj][m][0], v1 = acc[ai][bj][m][1];
                    u32x4 w; w.x = cvt_pk_bf16(v0[0], v0[1]); w.y = cvt_pk_bf16(v0[2], v0[3]); w.z = cvt_pk_bf16(v1[0], v1[1]); w.w = cvt_pk_bf16(v1[2], v1[3]);
                    *(u32x4*)(rb + bj * HALF * 2 + lo) = w; } }
    }
};
struct EpiResBf16 {
    static constexpr bool PERM = true; static constexpr int NST = 16, NPRE = 0;
    bf16_t* C; const bf16_t* R; int ldc; float alpha; float* lns;
    __device__ __forceinline__ void pre(const Unit&, int, int, int, int) const {}
    __device__ __forceinline__ void operator()(const f32x4 (&acc)[2][2][4][2], const Unit& u, int wr, int wc, int fr, int fq) const {
        const unsigned lo = vopaque(((unsigned)(wr * 64 + fr) * (unsigned)ldc + (unsigned)(wc * 32 + 8 * fq)) * 2u);
        const unsigned ls = vopaque((unsigned)fr * 256u);
#pragma unroll
        for (int ai = 0; ai < 2; ++ai)
#pragma unroll
            for (int m = 0; m < 4; ++m) { const size_t ro = (size_t)(u.pm * BM + ai * HALF + m * 16) * ldc + u.pn * BM; char* cb = (char*)sbase(C + ro); const char* rb = (const char*)sbase(R + ro);
                float sm = 0.f, sq = 0.f;
#pragma unroll
                for (int bj = 0; bj < 2; ++bj) { const u32x4 rr = *(const u32x4*)(rb + bj * HALF * 2 + lo); const f32x4 v0 = acc[ai][bj][m][0], v1 = acc[ai][bj][m][1];
                    u32x4 w; w.x = cvt_pk_bf16(v0[0] + alpha * bf_lo(rr.x), v0[1] + alpha * bf_hi(rr.x)); w.y = cvt_pk_bf16(v0[2] + alpha * bf_lo(rr.y), v0[3] + alpha * bf_hi(rr.y));
                    w.z = cvt_pk_bf16(v1[0] + alpha * bf_lo(rr.z), v1[1] + alpha * bf_hi(rr.z)); w.w = cvt_pk_bf16(v1[2] + alpha * bf_lo(rr.w), v1[3] + alpha * bf_hi(rr.w));
                    *(u32x4*)(cb + bj * HALF * 2 + lo) = w;
                    const unsigned ww[4] = {w.x, w.y, w.z, w.w};
#pragma unroll
                    for (int e = 0; e < 4; ++e) { const float a = bf_lo(ww[e]), b = bf_hi(ww[e]); sm += a + b; sq += a * a + b * b; } }
                sm += __shfl_xor(sm, 16); sm += __shfl_xor(sm, 32); sq += __shfl_xor(sq, 16); sq += __shfl_xor(sq, 32);
                if (fq == 0) { char* sp = (char*)sbase(lns + ((size_t)(u.pm * BM + ai * HALF + m * 16 + wr * 64) * 32 + u.pn * 4 + wc) * 2); *(f32x2_t*)(sp + ls) = (f32x2_t){sm, sq}; }
                if (m & 1) asm volatile("" ::: "memory"); }
    }
};
struct EpiSwiglu {
    static constexpr bool PERM = true; static constexpr int NST = 4, NPRE = 4;
    unsigned char* O; const float* b1;
    mutable f32x4 vg[2], vl[2];
    __device__ __forceinline__ void pre(const Unit& u, int wr, int wc, int fr, int fq) const {
        const int e = u.pn >> 4, ct = u.pn & 15; const unsigned lc = vopaque((unsigned)(wc * 32 + 8 * fq));
        const char* bg = (const char*)sbase(b1 + (size_t)e * 4096 + ct * 128); const char* bl = (const char*)sbase(b1 + (size_t)e * 4096 + 2048 + ct * 128);
#pragma unroll
        for (int n = 0; n < 2; ++n) { vg[n] = *(const f32x4*)(bg + n * 16 + lc * 4u); vl[n] = *(const f32x4*)(bl + n * 16 + lc * 4u); }
    }
    __device__ __forceinline__ void operator()(const f32x4 (&acc)[2][2][4][2], const Unit& u, int wr, int wc, int fr, int fq) const {
        const int ct = u.pn & 15;
        const unsigned lo2 = vopaque(((unsigned)(wr * 64 + fr) + 16u * (unsigned)(fq & 1)) * 2048u + (unsigned)(wc * 32 + 16 * (fq >> 1)));
        f32x4 vl1[2]; vl1[0] = vl[0] + 1.0f; vl1[1] = vl[1] + 1.0f;
#pragma unroll
        for (int ai = 0; ai < 2; ++ai)
#pragma unroll
            for (int mp = 0; mp < 2; ++mp) { unsigned char* rb = sbase(O + (size_t)(u.pm * BM + ai * HALF + mp * 32) * 2048 + ct * 128);
                unsigned px[2], py[2];
#pragma unroll
                for (int q = 0; q < 2; ++q) { const int m = 2 * mp + q; float a[8];
#pragma unroll
                    for (int n = 0; n < 2; ++n)
#pragma unroll
                        for (int i = 0; i < 4; i += 2) { f32x2_t g = (f32x2_t){acc[ai][0][m][n][i], acc[ai][0][m][n][i + 1]} + (f32x2_t){vg[n][i], vg[n][i + 1]};
                            f32x2_t l = (f32x2_t){acc[ai][1][m][n][i], acc[ai][1][m][n][i + 1]} + (f32x2_t){vl1[n][i], vl1[n][i + 1]};
                            g.x = __builtin_amdgcn_fmed3f(g.x, -25.0f, 7.0f); g.y = __builtin_amdgcn_fmed3f(g.y, -25.0f, 7.0f);
                            l.x = __builtin_amdgcn_fmed3f(l.x, -6.0f, 8.0f); l.y = __builtin_amdgcn_fmed3f(l.y, -6.0f, 8.0f);
                            const f32x2_t t = g * (f32x2_t){-1.702f * 1.4426950408889634f, -1.702f * 1.4426950408889634f};
                            const f32x2_t d = (f32x2_t){__builtin_amdgcn_exp2f(t.x), __builtin_amdgcn_exp2f(t.y)} + (f32x2_t){1.0f, 1.0f};
                            const float r = __builtin_amdgcn_rcpf(d.x * d.y);
                            const f32x2_t o = l * g * ((f32x2_t){d.y, d.x} * (f32x2_t){r, r});
                            a[n * 4 + i] = o.x; a[n * 4 + i + 1] = o.y; }
                    px[q] = pk4_fp8(a[0], a[1], a[2], a[3]); py[q] = pk4_fp8(a[4], a[5], a[6], a[7]); }
                const auto sx = __builtin_amdgcn_permlane16_swap(px[0], px[1], false, false); const auto sy = __builtin_amdgcn_permlane16_swap(py[0], py[1], false, false);
                u32x4 w; w.x = sx[0]; w.y = sy[0]; w.z = sx[1]; w.w = sy[1];
                *(u32x4*)(rb + lo2) = w; }
    }
};
struct EpiGate {
    static constexpr bool PERM = true; static constexpr int NST = 8, NPRE = 12;
    unsigned char* O; const float* b2; const float* gate;
    mutable float gtv[8]; mutable f32x4 cb[2][2];
    __device__ __forceinline__ void pre(const Unit& u, int wr, int wc, int fr, int fq) const {
        const int e = u.pn >> 3, ct = u.pn & 7; const unsigned lr = vopaque((unsigned)(wr * 64 + fr)), lc = vopaque((unsigned)(wc * 32 + 8 * fq));
        const char* bb = (const char*)sbase(b2 + (size_t)e * 2048 + ct * 256);
#pragma unroll
        for (int bj = 0; bj < 2; ++bj) { cb[bj][0] = *(const f32x4*)(bb + bj * HALF * 4 + lc * 4u); cb[bj][1] = *(const f32x4*)(bb + bj * HALF * 4 + 16 + lc * 4u); }
#pragma unroll
        for (int q = 0; q < 8; ++q) gtv[q] = *(const float*)((const char*)sbase(gate + u.pm * BM + (q >> 2) * HALF + (q & 3) * 16) + lr * 4u);
    }
    __device__ __forceinline__ void operator()(const f32x4 (&acc)[2][2][4][2], const Unit& u, int wr, int wc, int fr, int fq) const {
        const int ct = u.pn & 7;
        const unsigned lr = vopaque((unsigned)(wr * 64 + fr)), lc = vopaque((unsigned)(wc * 32 + 8 * fq)), lo = lr * 2048u + lc;
        const unsigned lo2 = vopaque((lr + 16u * (unsigned)(fq & 1)) * 2048u + (unsigned)(wc * 32 + 16 * (fq >> 1)));
#pragma unroll
        for (int ai = 0; ai < 2; ++ai)
#pragma unroll
            for (int mp = 0; mp < 2; ++mp) { const int rg = u.pm * BM + ai * HALF + mp * 32; const float gt0 = 64.0f * gtv[ai * 4 + 2 * mp], gt1 = 64.0f * gtv[ai * 4 + 2 * mp + 1];
                unsigned char* rb = sbase(O + (size_t)rg * 2048 + ct * 256);
#pragma unroll
                for (int bj = 0; bj < 2; ++bj) { const f32x4 c0 = cb[bj][0], c1 = cb[bj][1];
                    const f32x4 a0 = (acc[ai][bj][2 * mp][0] + c0) * gt0, a1 = (acc[ai][bj][2 * mp][1] + c1) * gt0, b0 = (acc[ai][bj][2 * mp + 1][0] + c0) * gt1, b1 = (acc[ai][bj][2 * mp + 1][1] + c1) * gt1;
                    const unsigned ax = pk4_fp8(a0[0], a0[1], a0[2], a0[3]), ay = pk4_fp8(a1[0], a1[1], a1[2], a1[3]), bx = pk4_fp8(b0[0], b0[1], b0[2], b0[3]), by = pk4_fp8(b1[0], b1[1], b1[2], b1[3]);
                    const auto sx = __builtin_amdgcn_permlane16_swap(ax, bx, false, false); const auto sy = __builtin_amdgcn_permlane16_swap(ay, by, false, false);
                    u32x4 w; w.x = sx[0]; w.y = sy[0]; w.z = sx[1]; w.w = sy[1];
                    *(u32x4*)(rb + bj * HALF + lo2) = w; } }
    }
};

template <class Epi, class Sched, bool ALIGN_EPI = true, bool FP8 = false>
__device__ __forceinline__ void gemm_phase(PG8_LAS unsigned char* lds, const Gemm g, const Sched& S, const Epi& E) {
    int tid = threadIdx.x; asm volatile("" : "+v"(tid));
    const int wid = __builtin_amdgcn_readfirstlane(tid >> 6), lane = tid & 63, wr = wid >> 2, wc = wid & 3, fr = lane & 15, fq = lane >> 4;
    const int K = g.K, nt = K / BK;
    int RA[2]; unsigned cA2[2], voffB[2];
#pragma unroll
    for (int i = 0; i < 2; ++i) { int R, C; stage_rc(tid * 16 + i * 8192, R, C); const int Rb = Epi::PERM ? ((R & ~31) + perm32(R & 31)) : R;
        RA[i] = R; cA2[i] = (unsigned)C * 2u; voffB[i] = (unsigned)(Rb * K + C) * 2u; }
    const size_t kstep = (size_t)(BK * 2);
    const size_t hstep = (size_t)HALF * K * 2;
    const size_t tstep = 2 * hstep;
    const unsigned ldsw = (unsigned)wid * 1024u;
    const int aoff = lds_byte(wr * 64 + fr, fq * 8), boff = lds_byte(wc * 32 + fr, fq * 8);
#define PG8_SA(b, h) (((b) * 2 + (h)) * HTB)
#define PG8_SB(b, h) ((4 + (b) * 2 + (h)) * HTB)
#define PG8_STAGE(bufoff, gbase, voff) do { const char* _gb = (const char*)(gbase); asm volatile("" : "+s"(_gb)); _Pragma("unroll") for (int _i = 0; _i < 2; ++_i) { \
        unsigned _vo = (voff)[_i]; asm volatile("" : "+v"(_vo));     \
        __builtin_amdgcn_global_load_lds((const unsigned*)(_gb + _vo), (PG8_LAS unsigned*)(lds + (bufoff) + ldsw + _i * 8192), 16, 0, 0); } } while (0)
#define PG8_LD32(p) __builtin_shufflevector(*(const PG8_LAS v4i32*)(p), *(const PG8_LAS v4i32*)((p) + 1024), 0, 1, 2, 3, 4, 5, 6, 7)
#define PG8_LDA(dst, b, h) do { _Pragma("unroll") for (int m = 0; m < 4; ++m) dst[m] = PG8_LD32(lds + PG8_SA(b, h) + aoff + m * 2048); } while (0)
#define PG8_LDB(dst, b, h) do { _Pragma("unroll") for (int n = 0; n < 2; ++n) dst[n] = PG8_LD32(lds + PG8_SB(b, h) + boff + n * 2048); } while (0)
#define PG8_H0(x) __builtin_bit_cast(bf16x8, __builtin_shufflevector(x, x, 0, 1, 2, 3))
#define PG8_H1(x) __builtin_bit_cast(bf16x8, __builtin_shufflevector(x, x, 4, 5, 6, 7))
#define PG8_MMA(ai, bj, At, Bt) do { __builtin_amdgcn_s_setprio(1); _Pragma("unroll") for (int m = 0; m < 4; ++m) _Pragma("unroll") for (int n = 0; n < 2; ++n) { \
        if constexpr (FP8) acc[ai][bj][m][n] = __builtin_amdgcn_mfma_scale_f32_16x16x128_f8f6f4(Bt[n], At[m], acc[ai][bj][m][n], 0, 0, 0, SCALE_W, 0, SCALE_A); \
        else { acc[ai][bj][m][n] = __builtin_amdgcn_mfma_f32_16x16x32_bf16(PG8_H0(Bt[n]), PG8_H0(At[m]), acc[ai][bj][m][n], 0, 0, 0); \
               acc[ai][bj][m][n] = __builtin_amdgcn_mfma_f32_16x16x32_bf16(PG8_H1(Bt[n]), PG8_H1(At[m]), acc[ai][bj][m][n], 0, 0, 0); } } \
        __builtin_amdgcn_s_setprio(0); } while (0)
#define PG8_WAIT_V(n) asm volatile("s_waitcnt vmcnt(" #n ")" ::: "memory")
#define PG8_WAIT_VF(f) asm volatile("s_waitcnt vmcnt(%1)\n\ts_cmp_lg_u32 %0, 0\n\ts_cbranch_scc1 .Lwf%=\n\ts_waitcnt vmcnt(8)\n.Lwf%=:" :: "s"(f), "n"(8 + Epi::NST + Epi::NPRE) : "memory", "scc")
#define PG8_WAIT_L(n) asm volatile("s_waitcnt lgkmcnt(" #n ")" ::: "memory")
#define PG8_BAR __builtin_amdgcn_s_barrier()
#define PG8_SCHED __builtin_amdgcn_sched_barrier(0)
#define PG8_AOFF(dst, u) do { _Pragma("unroll") for (int _h = 0; _h < 2; ++_h) _Pragma("unroll") for (int _i = 0; _i < 2; ++_i) \
        dst[_h][_i] = (unsigned)S.arow(u, _h * HALF + RA[_i]) * (unsigned)(K * 2) + cA2[_i]; } while (0)
    Unit cur, nxt; int ui = 0;
    if (!S.next(0, cur)) return;
    constexpr bool GA = Sched::GATHER;
    unsigned offC[2][2], offN[2][2];
    const char* gA = (const char*)g.A; const char* nA = gA;
    int rawN[2][2]; Unit nn; bool has_nn = false;
#define PG8_ARAW(dst, u) do { _Pragma("unroll") for (int _h = 0; _h < 2; ++_h) _Pragma("unroll") for (int _i = 0; _i < 2; ++_i) dst[_h][_i] = S.arow(u, _h * HALF + RA[_i]); } while (0)
    if constexpr (GA) { PG8_AOFF(offC, cur); has_nn = S.next(1, nn); if (has_nn) PG8_ARAW(rawN, nn); asm volatile("s_waitcnt vmcnt(0)" ::: "memory"); }
    else {
#pragma unroll
        for (int i = 0; i < 2; ++i) { offC[0][i] = (unsigned)RA[i] * (unsigned)(K * 2) + cA2[i]; offC[1][i] = offC[0][i] + (unsigned)hstep; }
        gA += (size_t)cur.pm * tstep; }
    E.pre(cur, wr, wc, fr, fq);
    f32x4 acc[2][2][4][2];
#pragma unroll
    for (int a = 0; a < 2; ++a)
#pragma unroll
        for (int b = 0; b < 2; ++b)
#pragma unroll
            for (int m = 0; m < 4; ++m)
#pragma unroll
                for (int n = 0; n < 2; ++n) acc[a][b][m][n] = (f32x4){0.f, 0.f, 0.f, 0.f};
    v8i32 At[4], B0[2], B1[2];
    const char* cB = (const char*)g.Bt + (size_t)cur.pn * tstep;
    PG8_STAGE(PG8_SB(0, 0), cB, voffB); PG8_STAGE(PG8_SB(0, 1), cB + hstep, voffB); PG8_STAGE(PG8_SA(0, 0), gA, offC[0]); PG8_STAGE(PG8_SA(0, 1), gA, offC[1]);
    if (wr == 1) PG8_BAR;
    PG8_WAIT_V(2); PG8_BAR;
    PG8_STAGE(PG8_SB(1, 0), cB + kstep, voffB); PG8_STAGE(PG8_SA(1, 0), gA + kstep, offC[0]); PG8_STAGE(PG8_SB(1, 1), cB + hstep + kstep, voffB);
    PG8_WAIT_V(6); PG8_BAR;
    for (;;) {
        bool has_next;
        if constexpr (GA) {
            has_next = has_nn; nxt = nn;
#pragma unroll
            for (int h = 0; h < 2; ++h)
#pragma unroll
                for (int i = 0; i < 2; ++i) offN[h][i] = has_next ? (unsigned)rawN[h][i] * (unsigned)(K * 2) + cA2[i] : offC[h][i];
            has_nn = S.next(ui + 2, nn); if (has_nn) PG8_ARAW(rawN, nn);
        } else { has_next = S.next(ui + 1, nxt); nA = has_next ? (const char*)g.A + (size_t)nxt.pm * tstep : gA; }
        const char* nB = has_next ? (const char*)g.Bt + (size_t)nxt.pn * tstep : cB;
        for (int t = 0; t < nt; t += 2) {
            const bool last = (t == nt - 2);
            const char* a1 = gA + (size_t)(t + 1) * kstep;
            const char* a2 = last ? nA : gA + (size_t)(t + 2) * kstep; const char* b2 = last ? nB : cB + (size_t)(t + 2) * kstep;
            const char* a3 = a2 + kstep; const char* b3 = b2 + kstep;
            const int fe = __builtin_amdgcn_readfirstlane(((t == 0) && (ui > 0)) ? 1 : 0);
            PG8_LDB(B0, 0, 0); PG8_LDB(B1, 0, 1); PG8_SCHED; PG8_LDA(At, 0, 0); PG8_STAGE(PG8_SA(1, 1), a1, offC[1]);
            if constexpr (GA) { if (last) {
#pragma unroll
                for (int h = 0; h < 2; ++h)
#pragma unroll
                    for (int i = 0; i < 2; ++i) offC[h][i] = offN[h][i]; } }
            PG8_WAIT_VF(fe); PG8_WAIT_L(0); PG8_BAR; PG8_MMA(0, 0, At, B0); PG8_MMA(0, 1, At, B1); PG8_BAR; PG8_SCHED;
            PG8_LDA(At, 0, 1); PG8_STAGE(PG8_SB(0, 0), b2, voffB); PG8_STAGE(PG8_SB(0, 1), b2 + hstep, voffB); PG8_STAGE(PG8_SA(0, 0), a2, offC[0]);
            PG8_WAIT_VF(fe); PG8_WAIT_L(0); PG8_BAR; PG8_MMA(1, 0, At, B0); PG8_MMA(1, 1, At, B1); PG8_BAR; PG8_SCHED;
            PG8_LDB(B0, 1, 0); PG8_LDB(B1, 1, 1); PG8_SCHED; PG8_LDA(At, 1, 0); PG8_STAGE(PG8_SA(0, 1), a2, offC[1]);
            PG8_WAIT_V(8); PG8_WAIT_L(0); PG8_BAR; PG8_MMA(0, 0, At, B0); PG8_MMA(0, 1, At, B1); PG8_BAR; PG8_SCHED;
            PG8_LDA(At, 1, 1); PG8_STAGE(PG8_SB(1, 0), b3, voffB); PG8_STAGE(PG8_SB(1, 1), b3 + hstep, voffB); PG8_STAGE(PG8_SA(1, 0), a3, offC[0]);
            PG8_WAIT_V(8); PG8_WAIT_L(0); PG8_BAR; PG8_MMA(1, 0, At, B0); PG8_MMA(1, 1, At, B1); PG8_BAR; PG8_SCHED;
        }
        if constexpr (ALIGN_EPI) { if (wr == 0) PG8_BAR; }
        E(acc, cur, wr, wc, fr, fq);
        if (!has_next) break;
#pragma unroll
        for (int a = 0; a < 2; ++a)
#pragma unroll
            for (int b = 0; b < 2; ++b)
#pragma unroll
                for (int m = 0; m < 4; ++m)
#pragma unroll
                    for (int n = 0; n < 2; ++n) acc[a][b][m][n] = (f32x4){0.f, 0.f, 0.f, 0.f};
        cur = nxt; cB = nB; ++ui; if constexpr (!GA) gA = nA;
        E.pre(cur, wr, wc, fr, fq);
        if constexpr (ALIGN_EPI) { if (wr == 1) PG8_BAR; }
    }
    PG8_WAIT_V(0);
    if constexpr (!ALIGN_EPI) { if (wr == 0) PG8_BAR; }
    PG8_BAR;
#undef PG8_SA
#undef PG8_SB
#undef PG8_STAGE
#undef PG8_LDA
#undef PG8_LDB
#undef PG8_LD32
#undef PG8_H0
#undef PG8_H1
#undef PG8_MMA
#undef PG8_WAIT_V
#undef PG8_WAIT_L
#undef PG8_BAR
#undef PG8_SCHED
#undef PG8_AOFF
#undef PG8_ARAW
}
}
#define GAS __attribute__((address_space(1)))
#define LAS __attribute__((address_space(3)))
typedef unsigned short bf16;
typedef unsigned v4u __attribute__((ext_vector_type(4)));
typedef float f32x4 __attribute__((ext_vector_type(4)));
typedef short bf16x8 __attribute__((ext_vector_type(8)));
typedef GAS unsigned gu32;
typedef GAS unsigned long long gu64;
#define RLX_AGENT __ATOMIC_RELAXED, __HIP_MEMORY_SCOPE_AGENT
#define LDS_WAIT() asm volatile("s_waitcnt lgkmcnt(0)" ::: "memory")
#define VM_WAIT() asm volatile("s_waitcnt vmcnt(0)" ::: "memory")
__device__ __forceinline__ unsigned long long rt() { return __builtin_amdgcn_s_memrealtime(); }
__device__ __forceinline__ unsigned pk2(float lo, float hi) { return pg8::cvt_pk_bf16(lo, hi); }
__device__ __forceinline__ unsigned f2bf(float f) { return pg8::cvt_pk_bf16(f, 0.f) & 0xffffu; }

#define XB_TMO      128
#define XB_XCNT(j)  (256  + 64 * (j))
#define XB_XSUB(j)  (1280 + 64 * (j))
#define XB_XGEN(j)  (2304 + 64 * (j))
#define XB_TOP      3328
#define XB_TOPGEN   3392
#define XCD_BAR_WORDS 3456
#define XB_SPIN_CAP (1u << 18)

__device__ __forceinline__ unsigned xb_ld(unsigned* p)              { return __hip_atomic_load(p, __ATOMIC_RELAXED, __HIP_MEMORY_SCOPE_AGENT); }
__device__ __forceinline__ unsigned xb_add(unsigned* p, unsigned v) { return __hip_atomic_fetch_add(p, v, __ATOMIC_RELAXED, __HIP_MEMORY_SCOPE_AGENT); }
__device__ __forceinline__ unsigned xb_xcc_id() { return (unsigned)__builtin_amdgcn_s_getreg((3 << 11) | 20) & 0xFu; }
#define XB_SPIN(cond, bar) do { unsigned _sp = 0; while (cond) { __builtin_amdgcn_s_sleep(1); \
    if ((++_sp & 255u) == 0u) { if (xb_ld(&(bar)[XB_TMO])) break; if (_sp > XB_SPIN_CAP) { atomicAdd(&(bar)[XB_TMO], 1u); break; } } } } while (0)

struct XcdBarrier {
    unsigned* bar; unsigned x;
    volatile LAS unsigned* st;
};

__device__ __forceinline__ XcdBarrier xcd_barrier_post(unsigned* bar, volatile LAS unsigned* st) {
    XcdBarrier b; b.bar = bar; b.x = xb_xcc_id(); b.st = st;
    if (threadIdx.x == 0) (void)xb_add(&bar[XB_XCNT(b.x)], 1u);
    return b;
}
__device__ __forceinline__ void xcd_barrier_complete(unsigned* bar, unsigned x, unsigned& nloc, unsigned& nx) {
    const unsigned G = gridDim.x * gridDim.y * gridDim.z;
    unsigned sum, cnt, mine, sp = 0u;
    for (;;) {
        sum = 0u; cnt = 0u; mine = 0u;
#pragma unroll
        for (unsigned j = 0; j < 16; ++j) { const unsigned c = xb_ld(&bar[XB_XCNT(j)]); sum += c; cnt += (c > 0u) ? 1u : 0u; mine = (j == x) ? c : mine; }
        if (sum == G) break;
        __builtin_amdgcn_s_sleep(1);
        if ((++sp & 255u) == 0u) { if (xb_ld(&bar[XB_TMO])) break; if (sp > XB_SPIN_CAP) { atomicAdd(&bar[XB_TMO], 1u); break; } }
    }
    nloc = mine > 0u ? mine : 1u; nx = cnt > 0u ? cnt : 1u;
}

__device__ __forceinline__ void xcd_barrier(const XcdBarrier& b) {
    asm volatile("s_waitcnt vmcnt(0)" ::: "memory");
    __syncthreads();
    if (threadIdx.x == 0) {
        unsigned* bar = b.bar;
        __builtin_amdgcn_s_waitcnt(0);
        unsigned nloc = b.st[0], nx = b.st[1];
        if (nloc == 0u) { xcd_barrier_complete(bar, b.x, nloc, nx); b.st[0] = nloc; b.st[1] = nx; }
        const unsigned old = xb_add(&bar[XB_XSUB(b.x)], 1u);
        const unsigned gen = old / nloc;
        if (old + 1u == (gen + 1u) * nloc) {
            __builtin_amdgcn_fence(__ATOMIC_RELEASE, "agent");
            asm volatile("s_waitcnt vmcnt(0)" ::: "memory");
            const unsigned og = xb_add(&bar[XB_TOP], 1u);
            const unsigned tg = og / nx;
            if (og + 1u == (tg + 1u) * nx) xb_add(&bar[XB_TOPGEN], 1u);
            else XB_SPIN(xb_ld(&bar[XB_TOPGEN]) == tg, bar);
            __builtin_amdgcn_fence(__ATOMIC_ACQUIRE, "agent");
            xb_add(&bar[XB_XGEN(b.x)], 1u);
            asm volatile("s_waitcnt vmcnt(0)" ::: "memory");
        } else {
            XB_SPIN(xb_ld(&bar[XB_XGEN(b.x)]) == gen, bar);
            __builtin_amdgcn_fence(__ATOMIC_ACQUIRE, "agent");
            asm volatile("s_waitcnt vmcnt(0)" ::: "memory");
        }
    }
    __syncthreads();
}


constexpr int NB = 2, T = 16384, NTOK = NB * T, D = 2048;
constexpr int PW = 5632;
constexpr int C_R = 0, C_K = 1024, C_V = 2048, C_DW = 3072, C_DA = 3168, C_DG = 3264, C_FQ = 3520, C_FK = 4032, C_FV = 4544, C_FF = 5056, C_MQ = 5064, IN_W = 5576;
constexpr int NE = 32, CAP = 131072 + 8192, MAXT = CAP / 256;
constexpr int MEM_LEN = 256;
constexpr float LN_EPS = 1e-5f, GN_EPS = 64e-5f, ALPHA = 1.189207115002721f, LOG2E = 1.4426950408889634f;
constexpr int NWAVES = 8, NTHR = 512;

constexpr size_t MiB = 1u << 20;
constexpr size_t WS_CTL = 0, CTL_ZERO_BYTES = 1 * MiB;
constexpr size_t WS_WI = 2 * MiB, WS_WO = 24 * MiB, WS_WKV = 32 * MiB, WS_RWT = 36 * MiB, WS_MEMN = 37 * MiB, WS_KVM = 39 * MiB, WS_C = 40 * MiB  ;
constexpr size_t WS_ROUTE = 42 * MiB;
constexpr size_t RT_TOPI = WS_ROUTE, RT_TOPG = RT_TOPI + 512 * 1024, RT_POS = RT_TOPG + 512 * 1024, RT_CNT = RT_POS + 512 * 1024, RT_TOK = RT_CNT + 64 * 1024, RT_GATE = RT_TOK + 1024 * 1024, RT_TILE = RT_GATE + 1024 * 1024;
constexpr size_t WS_LNS = 500 * MiB;
constexpr size_t WS_W1 = 48 * MiB, WS_W2 = 560 * MiB, WS_H0 = 816 * MiB, WS_H1 = 944 * MiB, WS_MIX = 1072 * MiB, WS_Z1 = 1200 * MiB, WS_P = 1456 * MiB;
constexpr size_t WS_RW = 1808 * MiB, RW_ARR = 128 * MiB;
constexpr size_t WS_ACT = 2960 * MiB, WS_Y = 3504 * MiB, WS_END = 4048 * MiB;
constexpr size_t WS_WLT = 46 * MiB;
constexpr size_t WS_H1Q = 304 * MiB;
constexpr size_t WS_FOXB = 47 * MiB;
constexpr float FOX_SKIP = 30.0f;
constexpr int CW_BAR = 4096;
constexpr int CW_KMAX = 2048;
constexpr int CW_QUEUE = 2112;
constexpr int CW_XQ = 2176;
constexpr int CW_A0Q = 2240;
constexpr int NG_INPROJ = 192;

constexpr int LDS_BYTES = 147456, MISC_OFF = LDS_BYTES - 256;

struct Args { const float* in[31]; float* out; unsigned char* ws; int ph_lo, ph_hi; };

__device__ __forceinline__ float wave_sum(float v) {
#pragma unroll
    for (int o = 1; o < 64; o <<= 1) v += __shfl_xor(v, o);
    return v;
}
__device__ __forceinline__ float bfl(unsigned w) { return __builtin_bit_cast(float, w << 16); }
__device__ __forceinline__ float bfh(unsigned w) { return __builtin_bit_cast(float, w & 0xffff0000u); }
__device__ __forceinline__ float bf1(bf16 h) { return __builtin_bit_cast(float, (unsigned)h << 16); }
__device__ __forceinline__ float sigmoidf_(float x) { return 1.0f / (1.0f + __expf(-x)); }

__device__ __forceinline__ void ln_row(f32x4 (&v)[8], const float* g, const float* b, float eps, int lane) {
    float s = 0.f;
#pragma unroll
    for (int j = 0; j < 8; ++j) s += (v[j].x + v[j].y) + (v[j].z + v[j].w);
    const float mean = wave_sum(s) * (1.f / D); float s2 = 0.f;
#pragma unroll
    for (int j = 0; j < 8; ++j) { v[j] = v[j] - mean; s2 += (v[j].x * v[j].x + v[j].y * v[j].y) + (v[j].z * v[j].z + v[j].w * v[j].w); }
    const float rstd = 1.f / sqrtf(wave_sum(s2) * (1.f / D) + eps);
#pragma unroll
    for (int j = 0; j < 8; ++j) { const f32x4 gg = *(const f32x4*)(g + 4 * lane + 256 * j), bb = *(const f32x4*)(b + 4 * lane + 256 * j); v[j] = v[j] * rstd * gg + bb; }
}
__device__ __forceinline__ void store_row_bf16(bf16* orow, const f32x4 (&v)[8], int lane) {
#pragma unroll
    for (int j = 0; j < 8; ++j) { pg8::u32x2 w; w.x = pk2(v[j].x, v[j].y); w.y = pk2(v[j].z, v[j].w); *(pg8::u32x2*)(orow + 4 * lane + 256 * j) = w; }
}

template <class RowMap>
__device__ __forceinline__ void transpose_item(const float* W, int ldw, int nvalid, int K, bf16* WT, const RowMap& rm, LAS float* scr, int k0, int n0, int lane) {
#pragma unroll 4
    for (int it = 0; it < 16; ++it) { const int k = 4 * it + (lane >> 4), nl = 4 * (lane & 15), n = n0 + nl;
        f32x4 v = (f32x4){0.f, 0.f, 0.f, 0.f}; if (n < nvalid) v = *(const f32x4*)(W + (size_t)(k0 + k) * ldw + n);
        LAS float* s = scr + k * 65 + nl; s[0] = v.x; s[1] = v.y; s[2] = v.z; s[3] = v.w; }
    LDS_WAIT(); asm volatile("" ::: "memory");
    const int c = lane & 7;
#pragma unroll
    for (int j = 0; j < 8; ++j) { const int nl = 8 * j + (lane >> 3); const LAS float* s = scr + (8 * c) * 65 + nl;
        v4u o; o.x = pk2(s[0 * 65], s[1 * 65]); o.y = pk2(s[2 * 65], s[3 * 65]); o.z = pk2(s[4 * 65], s[5 * 65]); o.w = pk2(s[6 * 65], s[7 * 65]);
        *(v4u*)(WT + (size_t)rm(n0 + nl) * K + k0 + 8 * c) = o; }
    LDS_WAIT(); asm volatile("" ::: "memory");
}
template <class RowMap>
__device__ __forceinline__ void transpose_item_fp8(const float* W, int ldw, int K, unsigned char* WT, const RowMap& rm, LAS float* scr, int k0, int n0, int lane) {
#pragma unroll 4
    for (int it = 0; it < 16; ++it) { const int k = 4 * it + (lane >> 4), nl = 4 * (lane & 15);
        const f32x4 v = *(const f32x4*)(W + (size_t)(k0 + k) * ldw + n0 + nl);
        LAS float* s = scr + k * 65 + nl; s[0] = v.x; s[1] = v.y; s[2] = v.z; s[3] = v.w; }
    LDS_WAIT(); asm volatile("" ::: "memory");
    const int c = lane & 3;
#pragma unroll
    for (int j = 0; j < 4; ++j) { const int nl = 16 * j + (lane >> 2); const LAS float* s = scr + (16 * c) * 65 + nl;
        v4u o; o.x = pg8::pk4_fp8(64.f * s[0 * 65], 64.f * s[1 * 65], 64.f * s[2 * 65], 64.f * s[3 * 65]); o.y = pg8::pk4_fp8(64.f * s[4 * 65], 64.f * s[5 * 65], 64.f * s[6 * 65], 64.f * s[7 * 65]);
        o.z = pg8::pk4_fp8(64.f * s[8 * 65], 64.f * s[9 * 65], 64.f * s[10 * 65], 64.f * s[11 * 65]); o.w = pg8::pk4_fp8(64.f * s[12 * 65], 64.f * s[13 * 65], 64.f * s[14 * 65], 64.f * s[15 * 65]);
        *(v4u*)(WT + (size_t)rm(n0 + nl) * K + k0 + 16 * c) = o; }
    LDS_WAIT(); asm volatile("" ::: "memory");
}
struct XItem { const float* W; unsigned char* WT; int ldw, k0, n0, rowoff, isw1; };
__device__ __forceinline__ XItem xitem(const Args& A, unsigned char* ws, int r) {
    XItem x; constexpr int I1 = 32 * 32 * 64;
    if (r < I1) { const int e = r >> 11, q = r & 2047; x.W = A.in[25] + (size_t)e * D * 4096; x.WT = ws + WS_W1; x.ldw = 4096; x.k0 = 64 * (q >> 6); x.n0 = 64 * (q & 63); x.rowoff = e * 4096; x.isw1 = 1; }
    else { const int r2 = r - I1, e = r2 >> 10, q = r2 & 1023; x.W = A.in[27] + (size_t)e * D * D; x.WT = ws + WS_W2; x.ldw = D; x.k0 = 64 * (q >> 5); x.n0 = 64 * (q & 31); x.rowoff = e * D; x.isw1 = 0; }
    return x;
}
__device__ __forceinline__ void xload(f32x4 (&v)[16], const XItem& x, int lane) {
#pragma unroll
    for (int it = 0; it < 16; ++it) v[it] = *(const f32x4*)(x.W + (size_t)(x.k0 + 4 * it + (lane >> 4)) * x.ldw + x.n0 + 4 * (lane & 15));
}
__device__ __forceinline__ void xstore(const f32x4 (&v)[16], const XItem& x, LAS float* scr, int lane) {
#pragma unroll
    for (int it = 0; it < 16; ++it) { LAS float* s = scr + (4 * it + (lane >> 4)) * 65 + 4 * (lane & 15); s[0] = v[it].x; s[1] = v[it].y; s[2] = v[it].z; s[3] = v[it].w; }
    LDS_WAIT(); asm volatile("" ::: "memory");
    const int c = lane & 3;
#pragma unroll
    for (int j = 0; j < 4; ++j) { const int nl = 16 * j + (lane >> 2), n = x.n0 + nl; const LAS float* s = scr + (16 * c) * 65 + nl;
        int row; if (x.isw1) { const int l = n >= 2048, cc = n - 2048 * l; row = (cc >> 7) * 256 + 128 * l + (cc & 127); } else row = n;
        v4u o; o.x = pg8::pk4_fp8(64.f * s[0 * 65], 64.f * s[1 * 65], 64.f * s[2 * 65], 64.f * s[3 * 65]); o.y = pg8::pk4_fp8(64.f * s[4 * 65], 64.f * s[5 * 65], 64.f * s[6 * 65], 64.f * s[7 * 65]);
        o.z = pg8::pk4_fp8(64.f * s[8 * 65], 64.f * s[9 * 65], 64.f * s[10 * 65], 64.f * s[11 * 65]); o.w = pg8::pk4_fp8(64.f * s[12 * 65], 64.f * s[13 * 65], 64.f * s[14 * 65], 64.f * s[15 * 65]);
        __builtin_nontemporal_store(o, (v4u*)(x.WT + (size_t)(x.rowoff + row) * D + x.k0 + 16 * c)); }
    LDS_WAIT(); asm volatile("" ::: "memory");
}
struct RmId { int off; __device__ __forceinline__ int operator()(int n) const { return off + n; } };
struct RmW1 { int off; __device__ __forceinline__ int operator()(int n) const { const int l = n >= 2048, c = n - 2048 * l; return off + (c >> 7) * 256 + 128 * l + (c & 127); } };

constexpr int I_XALL = 32 * 32 * 64 + 32 * 32 * 32;
__device__ __forceinline__ void conv_pull_loop(const Args& A, LAS unsigned char* lds, int tid, int wave, int lane) {
    unsigned char* ws = A.ws; unsigned* ctl = (unsigned*)(ws + WS_CTL); LAS float* scr = (LAS float*)(lds + wave * 16640); LAS int* qs = (LAS int*)(lds + 8 * 16640);
    for (;;) {
        __syncthreads();
        if (tid == 0) qs[0] = (int)__hip_atomic_fetch_add(ctl + CW_XQ, 16u, __ATOMIC_RELAXED, __HIP_MEMORY_SCOPE_AGENT);
        __syncthreads();
        const int base = qs[0]; if (base >= I_XALL) break;
        f32x4 va[16], vb[16]; const int i0 = base + wave, i1 = base + 8 + wave;
        const XItem xa = xitem(A, ws, min(i0, I_XALL - 1)), xb = xitem(A, ws, min(i1, I_XALL - 1));
        xload(va, xa, lane); xload(vb, xb, lane);
        if (i0 < I_XALL) xstore(va, xa, scr, lane);
        if (i1 < I_XALL) xstore(vb, xb, scr, lane);
    }
}
__device__ __forceinline__ void p0_prologue(const Args& A, LAS unsigned char* lds, int vcu, int G, int wave, int lane) {
    unsigned char* ws = A.ws;
    LAS float* scr = (LAS float*)(lds + wave * 16640);
    const int gw = vcu * NWAVES + wave, NGW = G * NWAVES;
    constexpr int I_WI = 32 * 88, I_WO = 32 * 32, I_WKV = 32 * 16;
    constexpr int NITEMS = I_WI + I_WO + I_WKV;
    for (int it = gw; it < NITEMS; it += NGW) {
        int r = it;
        if (r < I_WI) { transpose_item(A.in[4], IN_W, IN_W, D, (bf16*)(ws + WS_WI), RmId{0}, scr, 64 * (r / 88), 64 * (r % 88), lane); continue; } r -= I_WI;
        if (r < I_WO) { transpose_item_fp8(A.in[20], D, D, ws + WS_WO, RmId{0}, scr, 64 * (r / 32), 64 * (r % 32), lane); continue; } r -= I_WO;
        transpose_item(A.in[19], 1024, 1024, D, (bf16*)(ws + WS_WKV), RmId{0}, scr, 64 * (r / 16), 64 * (r % 16), lane);
    }
    { bf16* wlt = (bf16*)(ws + WS_WLT);
      for (int i = gw * 64 + lane; i < 1024 * 448; i += NGW * 64) { const int ch = i / 448, k = i % 448;
          const float v = k < 96 ? A.in[7][k * 1024 + ch] : (k < 192 ? A.in[9][(k - 96) * 1024 + ch] : A.in[10][(k - 192) * 1024 + ch]); wlt[i] = (bf16)f2bf(v); } }
    { bf16* rwf = (bf16*)(ws + WS_RWT); const float* rw = A.in[23];
      for (int i = gw * 64 + lane; i < 64 * 2 * 2 * 64 * 8; i += NGW * 64) { const int e = i & 7, ln = (i >> 3) & 63, hl = (i >> 9) & 1, nt = (i >> 10) & 1, sidx = i >> 11;
          const float w = rw[(32 * sidx + 8 * (ln >> 4) + e) * NE + 16 * nt + (ln & 15)]; const unsigned hb = f2bf(w); const float hf = __builtin_bit_cast(float, hb << 16);
          rwf[i] = (bf16)(hl ? f2bf(w - hf) : hb); } }
    for (int m = gw; m < NTOK + NB * MEM_LEN; m += NGW) {
        const bool ismem = m >= NTOK; const int r = ismem ? m - NTOK : m;
        const float* xr = (ismem ? A.in[1] : A.in[0]) + (size_t)r * D;
        f32x4 v[8];
#pragma unroll
        for (int j = 0; j < 8; ++j) v[j] = *(const f32x4*)(xr + 4 * lane + 256 * j);
        ln_row(v, ismem ? A.in[17] : A.in[2], ismem ? A.in[18] : A.in[3], LN_EPS, lane);
        store_row_bf16((bf16*)(ws + (ismem ? WS_MEMN : WS_H0)) + (size_t)r * D, v, lane);
    }
}

__device__ __forceinline__ void p2_fox_cumsum(const Args& A, LAS unsigned char* lds, int vcu, int G, int tid) {
    const bf16* P = (const bf16*)(A.ws + WS_P); double* C = (double*)(A.ws + WS_C);
    LAS double* part = (LAS double*)(lds + 32768);
    for (int bh = vcu; bh < 16; bh += G) {
        const int b = bh >> 3, h = bh & 7; const float bf = A.in[16][h];
        float lf[32]; double s = 0.0;
#pragma unroll
        for (int i = 0; i < 32; ++i) { const float x = bf1(P[(size_t)(b * T + tid * 32 + i) * PW + C_FF + h]) + bf;
            lf[i] = -(fmaxf(-x, 0.f) + log1pf(__expf(-fabsf(x)))); s += (double)lf[i]; }
        __syncthreads();
        part[tid] = s;
        __syncthreads();
        double pre = 0.0;
        for (int j = 0; j < tid; ++j) pre += part[j];
        double* c = C + (size_t)bh * T + tid * 32;
#pragma unroll
        for (int i = 0; i < 32; ++i) { pre += (double)lf[i]; c[i] = pre; }
    }
}
__device__ __forceinline__ void p2_fox_norms(const Args& A, LAS unsigned char* lds, int vcu, int G, int tid, int wave, int lane) {
    const bf16* P = (const bf16*)(A.ws + WS_P); float* FOXB = (float*)(A.ws + WS_FOXB); unsigned* ctl = (unsigned*)(A.ws + WS_CTL);
    LAS float* red = (LAS float*)(lds + 40960);
    for (int u = vcu; u < 1024; u += G) {
        const int bh = u >> 6, qb = u & 63, b = bh >> 3, h = bh & 7; const int tk = tid & 255, isk = tid >> 8;
        const bf16* pr = P + (size_t)(b * T + qb * 256 + tk) * PW + (isk ? C_FK : C_FQ) + h * 64;
        float n2 = 0.f;
#pragma unroll
        for (int v = 0; v < 8; ++v) { const v4u x = *(const v4u*)(pr + v * 8); const unsigned w[4] = {x.x, x.y, x.z, x.w};
#pragma unroll
            for (int e = 0; e < 4; ++e) { const float a0 = bfl(w[e]), a1 = bfh(w[e]); n2 += a0 * a0 + a1 * a1; } }
#pragma unroll
        for (int o = 1; o < 64; o <<= 1) n2 = fmaxf(n2, __shfl_xor(n2, o));
        __syncthreads();
        if (lane == 0) red[wave] = n2;
        __syncthreads();
        if (tid == 0) { FOXB[bh * 80 + qb] = fmaxf(fmaxf(red[0], red[1]), fmaxf(red[2], red[3]));
            __hip_atomic_fetch_max(ctl + CW_KMAX + bh, __float_as_uint(fmaxf(fmaxf(red[4], red[5]), fmaxf(red[6], red[7]))), __ATOMIC_RELAXED, __HIP_MEMORY_SCOPE_AGENT); }
    }
}

__device__ __forceinline__ int crow(int r, int hi) { return (r & 3) + 8 * (r >> 2) + 4 * hi; }
typedef float f32x16 __attribute__((ext_vector_type(16)));
typedef short s16x4 __attribute__((ext_vector_type(4)));
typedef short v4i16_t __attribute__((ext_vector_type(4)));
typedef float f32x2_t __attribute__((ext_vector_type(2)));
constexpr float ATT_THR = 8.0f;
template <int DH, bool FOX>
__device__ __forceinline__ void attn_unit(const bf16* Qp, int qpitch, const bf16* Kp, const bf16* Vp, int kvpitch, unsigned char* Op, int opitch, int q0, int jlo, int jhi,
                                          const double* cseq, float scale2, LAS unsigned char* lds, int tid, int wave, int lane) {
    constexpr int KROW = (DH + 8) * 2, VROW = DH * 2 + 64, NP = DH / 64;
    LAS unsigned char* KS = lds; LAS unsigned char* VT = lds + 64 * KROW; LAS float* CB = (LAS float*)(VT + 64 * VROW); LAS float* WSF = (LAS float*)(lds + 2 * (64 * KROW + 64 * VROW + 256)) + wave * 32;
    const int r32 = lane & 31, hi = lane >> 5;
    bf16x8 qr[DH / 16];
#pragma unroll
    for (int d0 = 0; d0 < DH / 16; ++d0) qr[d0] = *(const bf16x8*)(Qp + (size_t)(32 * wave + r32) * qpitch + d0 * 16 + hi * 8);
    f32x16 o[DH / 32];
#pragma unroll
    for (int d = 0; d < DH / 32; ++d)
#pragma unroll
        for (int r = 0; r < 16; ++r) o[d][r] = 0.f;
    float m = -1e30f, l = 0.f;
    const int qpos = q0 + 32 * wave + r32;
    double cref = 0.0; if (FOX) cref = cseq[q0];
    v4u kreg[NP], vreg[NP]; float cbv = 0.f;
#define ATT_LOAD(j) do { _Pragma("unroll") for (int p = 0; p < NP; ++p) { const int idx = tid + p * NTHR, row = idx / (DH / 8), ch = idx % (DH / 8); \
        kreg[p] = *(const v4u*)(Kp + (size_t)((j) * 64 + row) * kvpitch + ch * 8); vreg[p] = *(const v4u*)(Vp + (size_t)((j) * 64 + row) * kvpitch + ch * 8); } \
        if (FOX && tid < 64) cbv = (float)(cref - cseq[(j) * 64 + tid]) * LOG2E; } while (0)
    constexpr bool PREF = (DH == 64);
    constexpr int TILEB = 64 * KROW + 64 * VROW + 256;
#define ATT_STORE(bufo) do { _Pragma("unroll") for (int p = 0; p < NP; ++p) { const int idx = tid + p * NTHR, row = idx / (DH / 8), ch = idx % (DH / 8); \
        *(LAS v4u*)(KS + (bufo) + row * KROW + ch * 16) = kreg[p]; *(LAS v4u*)(VT + (bufo) + row * VROW + ch * 16) = vreg[p]; } \
        if (FOX && tid < 64) *(LAS float*)((LAS unsigned char*)CB + (bufo) + tid * 4) = cbv; } while (0)
    if (PREF) { ATT_LOAD(jlo); __syncthreads(); ATT_STORE(0); __syncthreads(); }
    for (int j = jlo; j < jhi; ++j) {
        const int bo = PREF ? ((j - jlo) & 1) * TILEB : 0;
        if (PREF) { if (j + 1 < jhi) ATT_LOAD(j + 1); }
        else { __syncthreads();
#pragma unroll
            for (int p = 0; p < NP; ++p) { const int idx = tid + p * NTHR, row = idx / (DH / 8), ch = idx % (DH / 8);
                kreg[0] = *(const v4u*)(Kp + (size_t)(j * 64 + row) * kvpitch + ch * 8); vreg[0] = *(const v4u*)(Vp + (size_t)(j * 64 + row) * kvpitch + ch * 8);
                *(LAS v4u*)(KS + row * KROW + ch * 16) = kreg[0]; *(LAS v4u*)(VT + row * VROW + ch * 16) = vreg[0]; }
            __syncthreads(); }
        f32x16 p[2];
#pragma unroll
        for (int kh = 0; kh < 2; ++kh) {
#pragma unroll
            for (int r = 0; r < 16; ++r) p[kh][r] = 0.f;
#pragma unroll
            for (int d0 = 0; d0 < DH / 16; ++d0) { const bf16x8 a = *(const LAS bf16x8*)(KS + bo + (32 * kh + r32) * KROW + (16 * d0 + 8 * hi) * 2);
                p[kh] = __builtin_amdgcn_mfma_f32_32x32x16_bf16(a, qr[d0], p[kh], 0, 0, 0); }
        }
        const bool diag = FOX && (j * 64 + 63 > q0);
        float mx = -1e30f;
        if (diag) {
#pragma unroll
            for (int kh = 0; kh < 2; ++kh)
#pragma unroll
                for (int g = 0; g < 4; ++g) { const f32x4 cb = *(const LAS f32x4*)((const LAS unsigned char*)CB + bo + (32 * kh + 8 * g + 4 * hi) * 4);
#pragma unroll
                    for (int i = 0; i < 4; ++i) { const int r = 4 * g + i; float v = p[kh][r] * scale2 + cb[i];
                        if (j * 64 + 32 * kh + 8 * g + 4 * hi + i > qpos) v = -1e30f;
                        p[kh][r] = v; mx = fmaxf(mx, v); } }
        } else if (FOX) {
#pragma unroll
            for (int kh = 0; kh < 2; ++kh)
#pragma unroll
                for (int g = 0; g < 4; ++g) { const f32x4 cb = *(const LAS f32x4*)((const LAS unsigned char*)CB + bo + (32 * kh + 8 * g + 4 * hi) * 4);
#pragma unroll
                    for (int i = 0; i < 4; ++i) { const int r = 4 * g + i; const float v = p[kh][r] * scale2 + cb[i]; p[kh][r] = v; mx = fmaxf(mx, v); } }
        } else {
#pragma unroll
            for (int kh = 0; kh < 2; ++kh)
#pragma unroll
                for (int r = 0; r < 16; ++r) mx = fmaxf(mx, p[kh][r]);
            mx *= scale2;
        }
        mx = fmaxf(mx, __shfl_xor(mx, 32));
        const float mn = (mx - m > ATT_THR) ? mx : m, corr = __builtin_amdgcn_exp2f(m - mn); m = mn;
        f32x2_t ls2 = (f32x2_t){0.f, 0.f}; const f32x2_t mn2 = (f32x2_t){mn, mn}, sc2 = (f32x2_t){scale2, scale2};
#pragma unroll
        for (int kh = 0; kh < 2; ++kh)
#pragma unroll
            for (int r = 0; r < 16; r += 2) { f32x2_t v = (f32x2_t){p[kh][r], p[kh][r + 1]}; v = (FOX || diag) ? v - mn2 : v * sc2 - mn2;
                const f32x2_t e = (f32x2_t){__builtin_amdgcn_exp2f(v.x), __builtin_amdgcn_exp2f(v.y)}; p[kh][r] = e.x; p[kh][r + 1] = e.y; ls2 += e; }
        l = l * corr + (ls2.x + ls2.y);
        if (__any(corr != 1.0f)) {
            if (hi == 0) WSF[r32] = corr;
#pragma unroll
            for (int g = 0; g < 4; ++g) { const f32x4 c4 = *(const LAS f32x4*)(WSF + 8 * g + 4 * hi);
#pragma unroll
                for (int d = 0; d < DH / 32; ++d) { o[d][4 * g] *= c4.x; o[d][4 * g + 1] *= c4.y; o[d][4 * g + 2] *= c4.z; o[d][4 * g + 3] *= c4.w; } }
        }
        bf16x8 pa[4];
#pragma unroll
        for (int s = 0; s < 4; ++s) { const int kh = s >> 1, b8 = 8 * (s & 1); v4u w;
            w.x = pg8::cvt_pk_bf16(p[kh][b8 + 0], p[kh][b8 + 1]); w.y = pg8::cvt_pk_bf16(p[kh][b8 + 2], p[kh][b8 + 3]);
            w.z = pg8::cvt_pk_bf16(p[kh][b8 + 4], p[kh][b8 + 5]); w.w = pg8::cvt_pk_bf16(p[kh][b8 + 6], p[kh][b8 + 7]);
            pa[s] = __builtin_bit_cast(bf16x8, w); }
#pragma unroll
        for (int d = 0; d < DH / 32; ++d)
#pragma unroll
            for (int s = 0; s < 4; ++s) { const LAS unsigned char* vp = VT + bo + (16 * s + 4 * hi + ((lane & 15) >> 2)) * VROW + (32 * d + 16 * ((lane >> 4) & 1) + 4 * (lane & 3)) * 2;
                const s16x4 lo = __builtin_bit_cast(s16x4, __builtin_amdgcn_ds_read_tr16_b64_v4i16((LAS v4i16_t*)vp)), hh = __builtin_bit_cast(s16x4, __builtin_amdgcn_ds_read_tr16_b64_v4i16((LAS v4i16_t*)(vp + 8 * VROW)));
                const bf16x8 vf = (bf16x8){lo[0], lo[1], lo[2], lo[3], hh[0], hh[1], hh[2], hh[3]};
                o[d] = __builtin_amdgcn_mfma_f32_32x32x16_bf16(pa[s], vf, o[d], 0, 0, 0); }
        if (PREF) { if (j + 1 < jhi) ATT_STORE(TILEB - bo); __syncthreads(); }
    }
#undef ATT_LOAD
#undef ATT_STORE
    l += __shfl_xor(l, 32);
    if (hi == 0) WSF[r32] = 1.0f / l;
    float rli[16];
#pragma unroll
    for (int g = 0; g < 4; ++g) { const f32x4 c4 = *(const LAS f32x4*)(WSF + 8 * g + 4 * hi); rli[4 * g] = c4.x; rli[4 * g + 1] = c4.y; rli[4 * g + 2] = c4.z; rli[4 * g + 3] = c4.w; }
#pragma unroll
    for (int r = 0; r < 16; ++r) { unsigned char* orow = Op + (size_t)(32 * wave + crow(r, hi)) * opitch + r32;
#pragma unroll
        for (int d = 0; d < DH / 32; ++d) { const float x = o[d][r] * rli[r]; orow[32 * d] = (unsigned char)__builtin_amdgcn_cvt_pk_fp8_f32(x, x, 0, false); } }
    __syncthreads();
}

__device__ __forceinline__ void p3_attention(const Args& A, LAS unsigned char* lds, int tid, int wave, int lane) {
    unsigned char* ws = A.ws; const bf16* P = (const bf16*)(ws + WS_P); unsigned char* MIX = ws + WS_MIX; const bf16* KVM = (const bf16*)(ws + WS_KVM); const double* C = (const double*)(ws + WS_C);
    unsigned* ctl = (unsigned*)(ws + WS_CTL); LAS int* sj = (LAS int*)(lds + 65536);
    for (;;) {
        __syncthreads();
        if (tid == 0) sj[1] = (int)__hip_atomic_fetch_add(ctl + CW_QUEUE, 1u, __ATOMIC_RELAXED, __HIP_MEMORY_SCOPE_AGENT);
        __syncthreads();
        const int u = sj[1];
        if (u >= 1536) break;
        if (u < 1024) {
#ifndef NO_FOX
            const int bh = u & 15, qb = 63 - (u >> 4), b = bh >> 3, h = bh & 7, q0 = qb * 256; const double* cs = C + (size_t)bh * T; const float* fb = (const float*)(ws + WS_FOXB) + bh * 80; const size_t rowb = (size_t)b * T;
            if (tid == 0) sj[0] = q0 / 64;
            __syncthreads();
            if (tid < q0 / 64) { const float bound = 0.25f * sqrtf(fb[qb] * __uint_as_float(ctl[CW_KMAX + bh])) + FOX_SKIP; if ((float)(cs[q0] - cs[tid * 64 + 63]) + bound >= 0.f) __hip_atomic_fetch_min(sj, tid, __ATOMIC_RELAXED, __HIP_MEMORY_SCOPE_WORKGROUP); }
            __syncthreads();
            const int jlo = sj[0];
            attn_unit<64, true>(P + (rowb + q0) * PW + C_FQ + h * 64, PW, P + rowb * PW + C_FK + h * 64, P + rowb * PW + C_FV + h * 64, PW,
                                MIX + (rowb + q0) * D + 1024 + h * 64, D, q0, jlo, q0 / 64 + 4, cs, 0.125f * LOG2E, lds, tid, wave, lane);
#endif
        } else {
#ifndef NO_MEMATT
            const int v = u - 1024, b = v >> 8, h = (v >> 6) & 3, qb = v & 63, q0 = qb * 256; const size_t rowb = (size_t)b * T;
            attn_unit<128, false>(P + (rowb + q0) * PW + C_MQ + h * 128, PW, KVM + (size_t)b * MEM_LEN * 1024 + h * 128, KVM + (size_t)b * MEM_LEN * 1024 + 512 + h * 128, 1024,
                                  MIX + (rowb + q0) * D + 1536 + h * 128, D, q0, 0, 4, nullptr, 0.08838834764831845f * LOG2E, lds, tid, wave, lane);
#endif
        }
    }
}

constexpr size_t AIN_BYTES = 73728, REC_BYTES = 62464;
constexpr size_t WS_AIN = WS_RW, WS_REC = WS_AIN + 576 * MiB, WS_YRAW = WS_REC + 488 * MiB, WS_G1 = 368 * MiB, WS_G2 = 432 * MiB;
static_assert(WS_YRAW + 64 * MiB <= WS_ACT && 8192 * REC_BYTES <= 488 * MiB && 8192 * AIN_BYTES <= 576 * MiB && WS_G2 + 64 * MiB <= WS_W2, "rwkv workspace");
constexpr int AIN_LD = 0, AIN_R = 16384, AIN_K2 = 24576, AIN_V = 32768, AIN_AV = 40960, AIN_BV = 49152, AIN_G1 = 57344, AIN_G2 = 65536;
constexpr int A0_IN = 29184, A0_INW = 13200, A0_ROWB = 400;
constexpr int REC_W = 0, REC_RT = 9216, REC_ARB = 18432, REC_BGT = 27648, REC_U0 = 36864, REC_Y0 = 45056, REC_M0 = 53248, REC_GC = 61440;
typedef float f32x4_t __attribute__((ext_vector_type(4)));

__device__ __forceinline__ float softplusf_(float x) { return fmaxf(x, 0.f) + log1pf(__expf(-fabsf(x))); }
__device__ __forceinline__ float xsum16_32(float v) { v += __shfl_xor(v, 16); v += __shfl_xor(v, 32); return v; }

__device__ __forceinline__ float fsigmoid(float x) { return __builtin_amdgcn_rcpf(1.0f + __builtin_amdgcn_exp2f(-LOG2E * x)); }
__device__ __forceinline__ float fsoftplus(float x) { return fmaxf(x, 0.f) + 0.6931471805599453f * __builtin_amdgcn_logf(1.0f + __builtin_amdgcn_exp2f(-LOG2E * fabsf(x))); }
struct A0Par { f32x4 mur, muk, muv, a0, kkw, kaw, rkw, w0, gng, gnb; };
template <bool FULL> __device__ __forceinline__ void a0_loadpar(A0Par& p, const Args& A, const float* mu, int col) {
    p.mur = *(const f32x4*)(mu + C_R + col); p.muk = *(const f32x4*)(mu + C_K + col); p.muv = *(const f32x4*)(mu + C_V + col);
    p.a0 = *(const f32x4*)(A.in[8] + col); p.kkw = *(const f32x4*)(A.in[11] + col); p.kaw = *(const f32x4*)(A.in[12] + col); p.rkw = *(const f32x4*)(A.in[13] + col);
    if constexpr (FULL) { p.w0 = *(const f32x4*)(A.in[6] + col); p.gng = *(const f32x4*)(A.in[14] + col); p.gnb = *(const f32x4*)(A.in[15] + col); }
}
template <bool FULL>
__device__ __forceinline__ void a0_mfma(f32x4 (&acc)[2][3], const bf16x8* wf, LAS unsigned char* lds, int c16, int g) {
    constexpr int KS0 = FULL ? 0 : 3, KS1 = FULL ? 14 : 6;
#pragma unroll
    for (int tt = 0; tt < 2; ++tt)
#pragma unroll
        for (int o = 0; o < 3; ++o) acc[tt][o] = (f32x4){0.f, 0.f, 0.f, 0.f};
#pragma unroll
    for (int ks = KS0; ks < KS1; ++ks) { const int o = ks < 3 ? 0 : (ks < 6 ? 1 : 2);
#pragma unroll
        for (int tt = 0; tt < 2; ++tt) { const bf16x8 b = *(const LAS bf16x8*)(lds + (16 * tt + c16) * 912 + (32 * ks + 8 * g) * 2);
            acc[tt][o] = __builtin_amdgcn_mfma_f32_16x16x32_bf16(wf[ks - KS0], b, acc[tt][o], 0, 0, 0); } }
}
template <bool FULL>
__device__ __forceinline__ void a0_ct(const f32x4 (&acc)[2][3], const A0Par& p, const LAS unsigned char* inw, unsigned char* blk,
                                      int tl0, int ct, int c16, int g, float (&ssk)[2], float (&ssb)[2]) {
#pragma unroll
    for (int tt = 0; tt < 2; ++tt) {
        const LAS unsigned char* pc = inw + (1 + 16 * tt + c16) * A0_ROWB + (16 * ct + 4 * g) * 2;
        const pg8::u32x2 r0 = *(const LAS pg8::u32x2*)pc, k0 = *(const LAS pg8::u32x2*)(pc + 128), v0 = *(const LAS pg8::u32x2*)(pc + 256);
        const pg8::u32x2 r1 = *(const LAS pg8::u32x2*)(pc - A0_ROWB), k1 = *(const LAS pg8::u32x2*)(pc - A0_ROWB + 128), v1 = *(const LAS pg8::u32x2*)(pc - A0_ROWB + 256);
        float rr[4], kk[4], vv[4];
        { const float ra[4] = {bfl(r0.x), bfh(r0.x), bfl(r0.y), bfh(r0.y)}, rb[4] = {bfl(r1.x), bfh(r1.x), bfl(r1.y), bfh(r1.y)};
          const float ka[4] = {bfl(k0.x), bfh(k0.x), bfl(k0.y), bfh(k0.y)}, kb[4] = {bfl(k1.x), bfh(k1.x), bfl(k1.y), bfh(k1.y)};
          const float va[4] = {bfl(v0.x), bfh(v0.x), bfl(v0.y), bfh(v0.y)}, vb[4] = {bfl(v1.x), bfh(v1.x), bfl(v1.y), bfh(v1.y)};
#pragma unroll
          for (int r = 0; r < 4; ++r) { rr[r] = ra[r] + p.mur[r] * (rb[r] - ra[r]); kk[r] = ka[r] + p.muk[r] * (kb[r] - ka[r]); vv[r] = va[r] + p.muv[r] * (vb[r] - va[r]); } }
        float aa[4], k2[4], kc[4];
#pragma unroll
        for (int r = 0; r < 4; ++r) { aa[r] = fsigmoid(p.a0[r] + acc[tt][1][r]); kc[r] = kk[r] * p.kkw[r]; k2[r] = kk[r] * (1.0f + (aa[r] - 1.0f) * p.kaw[r]); }
        if constexpr (!FULL) {
#pragma unroll
            for (int r = 0; r < 4; ++r) { ssk[tt] += kc[r] * kc[r]; ssb[tt] += rr[r] * k2[r] * p.rkw[r]; }
        } else {
            const int e0 = (ct * 64 + tl0 + 16 * tt + c16) * 16 + 4 * g;
            f32x4 ld; float av[4], bv[4], g1[4], g2[4];
#pragma unroll
            for (int r = 0; r < 4; ++r) { const float sp = fsoftplus(-(p.w0[r] + acc[tt][0][r])); ld[r] = -__builtin_amdgcn_exp2f(-LOG2E * (sp + 0.5f));
                const float kn = kc[r] * ssk[tt]; av[r] = -kn; bv[r] = kn * aa[r]; const float gg = acc[tt][2][r]; g1[r] = p.gng[r] * gg; g2[r] = (p.gnb[r] + ssb[tt] * vv[r]) * gg; }
            *(f32x4*)(blk + AIN_LD + e0 * 4) = ld;
            *(pg8::u32x2*)(blk + AIN_R + e0 * 2) = (pg8::u32x2){pk2(rr[0], rr[1]), pk2(rr[2], rr[3])};
            *(pg8::u32x2*)(blk + AIN_K2 + e0 * 2) = (pg8::u32x2){pk2(k2[0], k2[1]), pk2(k2[2], k2[3])};
            *(pg8::u32x2*)(blk + AIN_V + e0 * 2) = (pg8::u32x2){pk2(vv[0], vv[1]), pk2(vv[2], vv[3])};
            *(pg8::u32x2*)(blk + AIN_AV + e0 * 2) = (pg8::u32x2){pk2(av[0], av[1]), pk2(av[2], av[3])};
            *(pg8::u32x2*)(blk + AIN_BV + e0 * 2) = (pg8::u32x2){pk2(bv[0], bv[1]), pk2(bv[2], bv[3])};
            *(pg8::u32x2*)(blk + AIN_G1 + e0 * 2) = (pg8::u32x2){pk2(g1[0], g1[1]), pk2(g1[2], g1[3])};
            *(pg8::u32x2*)(blk + AIN_G2 + e0 * 2) = (pg8::u32x2){pk2(g2[0], g2[1]), pk2(g2[2], g2[3])};
        }
        asm volatile("" ::: "memory");
    }
}
template <int PV = 0>
__device__ __forceinline__ void p2_rwkv_tok(const Args& A, LAS unsigned char* lds, int vcu, int G, int tid, int wave, int lane) {
    unsigned char* ws = A.ws; const bf16* P = (const bf16*)(ws + WS_P); const bf16* WLT = (const bf16*)(ws + WS_WLT); const float* mu = A.in[5];
    unsigned char* AIN = ws + WS_AIN;
    const int c16 = lane & 15, g = lane >> 4;
    for (int tile = vcu; tile < NTOK / 32; tile += G) {
        const int row0 = tile * 32;
        __syncthreads();
        int tidv = tid; asm volatile("" : "+v"(tidv));
        {
#pragma unroll
            for (int bt = 0; bt < 2; ++bt) {
            v4u pt[2], pp[2]; f32x4 m0[2], m1[2];
#pragma unroll
            for (int i = 0; i < 2; ++i) { const int idx = min(tidv + NTHR * (2 * bt + i), 32 * 56 - 1), tk = idx / 56, vec = idx % 56, row = row0 + tk, col = C_DW + vec * 8;
                pt[i] = *(const v4u*)(P + (size_t)row * PW + col); pp[i] = *(const v4u*)(P + (size_t)(row - ((row % T) ? 1 : 0)) * PW + col);
                m0[i] = *(const f32x4*)(mu + col); m1[i] = *(const f32x4*)(mu + col + 4); }
#pragma unroll
            for (int i = 0; i < 2; ++i) { const int idx = tidv + NTHR * (2 * bt + i), idc = min(idx, 32 * 56 - 1), tk = idc / 56, vec = idc % 56, row = row0 + tk; const bool hp = (row % T) != 0;
                float x[8]; const unsigned tw[4] = {pt[i].x, pt[i].y, pt[i].z, pt[i].w}, pw[4] = {pp[i].x, pp[i].y, pp[i].z, pp[i].w}; const float mm[8] = {m0[i].x, m0[i].y, m0[i].z, m0[i].w, m1[i].x, m1[i].y, m1[i].z, m1[i].w};
#pragma unroll
                for (int e = 0; e < 8; ++e) { const float a = (e & 1) ? bfh(tw[e >> 1]) : bfl(tw[e >> 1]); float b = (e & 1) ? bfh(pw[e >> 1]) : bfl(pw[e >> 1]); b = hp ? b : 0.f; const float ps = a + mm[e] * (b - a);
                    x[e] = vec < 12 ? 2.0f * fsigmoid(2.0f * ps) - 1.0f : (vec < 24 ? ps : fsigmoid(ps)); }
                v4u o; o.x = pk2(x[0], x[1]); o.y = pk2(x[2], x[3]); o.z = pk2(x[4], x[5]); o.w = pk2(x[6], x[7]);
                if (idx < 32 * 56) *(LAS v4u*)(lds + tk * 912 + vec * 16) = o; }
            asm volatile("" ::: "memory"); }
        }
        __syncthreads();
#pragma unroll 1
        for (int hh = 0; hh < 2; ++hh) {
            const int h = wave * 2 + hh;
            LAS unsigned char* inw = lds + A0_IN + wave * A0_INW;
            { const bool first = (row0 % T) == 0; int lanev = lane; asm volatile("" : "+v"(lanev));
#pragma unroll
              for (int bt = 0; bt < 2; ++bt) { v4u x[7];
#pragma unroll
                for (int i = 0; i < 7; ++i) { const int idx = lanev + 64 * (7 * bt + i), seg = min(idx >> 3, 98), pc = idx & 7, r = seg / 3, a = seg - 3 * r, grow = row0 - 1 + r + ((first && r == 0) ? 1 : 0);
                    x[i] = *(const v4u*)(P + (size_t)grow * PW + a * 1024 + h * 64 + pc * 8); }
#pragma unroll
                for (int i = 0; i < 7; ++i) { const int idx = lanev + 64 * (7 * bt + i), seg = idx >> 3, pc = idx & 7, r = seg / 3, a = seg - 3 * r;
                    const v4u z = (v4u){0u, 0u, 0u, 0u}; if (seg < 99) *(LAS v4u*)(inw + r * A0_ROWB + a * 128 + pc * 16) = (first && r == 0) ? z : x[i]; }
                asm volatile("" ::: "memory"); } }
            const int tpos0 = row0 % T, b = row0 / T; unsigned char* blk = AIN + (size_t)((b * 16 + h) * 256 + (tpos0 >> 6)) * AIN_BYTES; const int tl0 = tpos0 & 63;
            float ssk[2] = {0.f, 0.f}, ssb[2] = {0.f, 0.f};
            const bf16* wbase = WLT + (size_t)(h * 64 + c16) * 448 + 8 * g; const int colb = h * 64 + 4 * g;
            if constexpr (PV != 2) { bf16x8 w0[3]; A0Par pn;
#pragma unroll
              for (int ks = 0; ks < 3; ++ks) w0[ks] = *(const bf16x8*)(wbase + 32 * (3 + ks));
              a0_loadpar<false>(pn, A, mu, colb);
#pragma unroll 1
              for (int ct = 0; ct < 4; ++ct) { f32x4 acc[2][3]; a0_mfma<false>(acc, w0, lds, c16, g); const A0Par p = pn;
                  if (ct < 3) {
#pragma unroll
                      for (int ks = 0; ks < 3; ++ks) w0[ks] = *(const bf16x8*)(wbase + (size_t)(ct + 1) * 16 * 448 + 32 * (3 + ks));
                      a0_loadpar<false>(pn, A, mu, colb + 16 * (ct + 1)); }
                  asm volatile("" ::: "memory");
                  a0_ct<false>(acc, p, inw, blk, tl0, ct, c16, g, ssk, ssb); asm volatile("" ::: "memory"); } }
#pragma unroll
            for (int tt = 0; tt < 2; ++tt) { ssk[tt] = 1.0f / fmaxf(sqrtf(xsum16_32(ssk[tt])), 1e-12f); ssb[tt] = xsum16_32(ssb[tt]); }
            if constexpr (PV != 0) { if (ssk[0] + ssb[1] == 1234.5f) *(float*)blk = ssk[0]; }
            if constexpr (PV == 0) { bf16x8 w1[14]; A0Par pn;
#pragma unroll
              for (int ks = 0; ks < 14; ++ks) w1[ks] = *(const bf16x8*)(wbase + 32 * ks);
              a0_loadpar<true>(pn, A, mu, colb);
#pragma unroll 1
              for (int ct = 0; ct < 4; ++ct) { f32x4 acc[2][3]; a0_mfma<true>(acc, w1, lds, c16, g); const A0Par p = pn;
                  if (ct < 3) {
#pragma unroll
                      for (int ks = 0; ks < 14; ++ks) w1[ks] = *(const bf16x8*)(wbase + (size_t)(ct + 1) * 16 * 448 + 32 * ks);
                      a0_loadpar<true>(pn, A, mu, colb + 16 * (ct + 1)); }
                  asm volatile("" ::: "memory");
                  a0_ct<true>(acc, p, inw, blk, tl0, ct, c16, g, ssk, ssb);
                  asm volatile("" ::: "memory"); } }
        }
    }
}

constexpr int LA_CL = 0, LA_AS = 16640, LA_BS = 25856, LA_KS = 35072, LA_RS = 44288, LA_KGT = 53504, LA_BGT = 62720, LA_VT = 71936, LA_NS = 81152, LA_XU = 98560, LA_WS = 115968, LA_TOT = 125184, LA_SCR = 126208, LA_TS = 134400;
__device__ __forceinline__ f32x16 gtile32(LAS unsigned char* lds, int offA, int si, int offB, int ti, int r32, int hi) {
    f32x16 c;
#pragma unroll
    for (int r = 0; r < 16; ++r) c[r] = 0.f;
#pragma unroll
    for (int ks = 0; ks < 4; ++ks) { const bf16x8 a = *(const LAS bf16x8*)(lds + offA + (32 * si + r32) * 144 + (16 * ks + 8 * hi) * 2), b = *(const LAS bf16x8*)(lds + offB + (32 * ti + r32) * 144 + (16 * ks + 8 * hi) * 2);
        c = __builtin_amdgcn_mfma_f32_32x32x16_bf16(a, b, c, 0, 0, 0); }
    return c;
}
template <bool INCL> __device__ __forceinline__ void mask_lower(f32x16& c, int r32, int hi) {
#pragma unroll
    for (int r = 0; r < 16; ++r) { const int s = crow(r, hi); if (INCL ? (s > r32) : (s >= r32)) c[r] = 0.f; }
}
__device__ __forceinline__ float xcomb(float v) {
    { auto r = __builtin_amdgcn_permlane16_swap(__float_as_uint(v), __float_as_uint(v), false, false); v = __uint_as_float(r[0]) + __uint_as_float(r[1]); }
    { auto r = __builtin_amdgcn_permlane32_swap(__float_as_uint(v), __float_as_uint(v), false, false); v = __uint_as_float(r[0]) + __uint_as_float(r[1]); }
    return v;
}
__device__ __forceinline__ void gv_acc(f32x16& o, const f32x16& G, LAS unsigned char* lds, int si, int ib, int r32, int hi) {
#pragma unroll
    for (int sp = 0; sp < 2; ++sp) { v4u w; const int b8 = 8 * sp;
        w.x = pg8::cvt_pk_bf16(G[b8 + 0], G[b8 + 1]); w.y = pg8::cvt_pk_bf16(G[b8 + 2], G[b8 + 3]); w.z = pg8::cvt_pk_bf16(G[b8 + 4], G[b8 + 5]); w.w = pg8::cvt_pk_bf16(G[b8 + 6], G[b8 + 7]);
        const LAS unsigned char* vp = lds + LA_VT + (32 * ib + r32) * 144 + (32 * si + 16 * sp + 4 * hi) * 2;
        const s16x4 lo = *(const LAS s16x4*)vp, hh = *(const LAS s16x4*)(vp + 16);
        o = __builtin_amdgcn_mfma_f32_32x32x16_bf16(__builtin_bit_cast(bf16x8, w), (bf16x8){lo[0], lo[1], lo[2], lo[3], hh[0], hh[1], hh[2], hh[3]}, o, 0, 0, 0); }
}
__device__ __forceinline__ void p3_rwkv_chunk(const Args& A, LAS unsigned char* lds, int vcu, int G, int tid, int wave, int lane) {
    unsigned char* ws = A.ws;
    const int r32 = lane & 31, hi = lane >> 5, c16 = lane & 15, g = lane >> 4;
    LAS float* CL = (LAS float*)(lds + LA_CL); LAS float* TOT = (LAS float*)(lds + LA_TOT);
    const int t = tid >> 3, j0 = (tid & 7) * 8;
    const int e0 = ((j0 >> 4) * 64 + t) * 16 + (j0 & 15);
    f32x4 l0, l1; v4u vr, vk, vv, va, vb;
#define PA_LOAD_LD(ucx) do { const unsigned char* blk_ = ws + WS_AIN + (size_t)(ucx) * AIN_BYTES; l0 = *(const f32x4*)(blk_ + AIN_LD + e0 * 4); l1 = *(const f32x4*)(blk_ + AIN_LD + (e0 + 4) * 4); } while (0)
#define PA_LOAD(ucx) do { const unsigned char* blk_ = ws + WS_AIN + (size_t)(ucx) * AIN_BYTES; \
        vr = *(const v4u*)(blk_ + AIN_R + e0 * 2); vk = *(const v4u*)(blk_ + AIN_K2 + e0 * 2); vv = *(const v4u*)(blk_ + AIN_V + e0 * 2); \
        va = *(const v4u*)(blk_ + AIN_AV + e0 * 2); vb = *(const v4u*)(blk_ + AIN_BV + e0 * 2); } while (0)
    PA_LOAD_LD(min(vcu, 8191));
    for (int uc = vcu; uc < 8192; uc += G) {
        unsigned char* rec = ws + WS_REC + (size_t)uc * REC_BYTES;
        __syncthreads();
        PA_LOAD(uc);
        { LAS float* c = CL + t * 65 + j0; c[0] = l0.x; c[1] = l0.y; c[2] = l0.z; c[3] = l0.w; c[4] = l1.x; c[5] = l1.y; c[6] = l1.z; c[7] = l1.w; }
        __syncthreads();
        float xs[16];
        if (tid < 256) { const int j = tid & 63, q = tid >> 6; float run = 0.f;
#pragma unroll
            for (int e = 0; e < 16; ++e) { run += CL[(16 * q + e) * 65 + j]; xs[e] = run; }
            TOT[q * 64 + j] = run; }
        __syncthreads();
        if (tid < 256) { const int j = tid & 63, q = tid >> 6; float off = 0.f; for (int qq = 0; qq < q; ++qq) off += TOT[qq * 64 + j];
#pragma unroll
            for (int e = 0; e < 16; ++e) CL[(16 * q + e) * 65 + j] = off + xs[e]; }
        __syncthreads();
        {   const unsigned wr[4] = {vr.x, vr.y, vr.z, vr.w}, wk[4] = {vk.x, vk.y, vk.z, vk.w}, wv[4] = {vv.x, vv.y, vv.z, vv.w}, wa[4] = {va.x, va.y, va.z, va.w}, wb[4] = {vb.x, vb.y, vb.z, vb.w};
            float at[8], bt[8], kt[8], rt_[8], kg[8], bg[8], gc[8];
#pragma unroll
            for (int e = 0; e < 8; ++e) { const float ct = CL[t * 65 + j0 + e], cp = t ? CL[(t - 1) * 65 + j0 + e] : 0.f, cL = CL[63 * 65 + j0 + e];
                const float r_ = (e & 1) ? bfh(wr[e >> 1]) : bfl(wr[e >> 1]), k_ = (e & 1) ? bfh(wk[e >> 1]) : bfl(wk[e >> 1]), a_ = (e & 1) ? bfh(wa[e >> 1]) : bfl(wa[e >> 1]), b_ = (e & 1) ? bfh(wb[e >> 1]) : bfl(wb[e >> 1]);
                const float eg = __expf(ct), egi = __expf(-ct), ep = __expf(cp), eL = __expf(cL - ct);
                at[e] = a_ * ep; bt[e] = b_ * egi; kt[e] = k_ * egi; rt_[e] = r_ * eg; kg[e] = k_ * eL; bg[e] = b_ * eL; gc[e] = __expf(cL); }
            v4u o;
            o.x = pk2(at[0], at[1]); o.y = pk2(at[2], at[3]); o.z = pk2(at[4], at[5]); o.w = pk2(at[6], at[7]); *(LAS v4u*)(lds + LA_AS + t * 144 + j0 * 2) = o;
            o.x = pk2(bt[0], bt[1]); o.y = pk2(bt[2], bt[3]); o.z = pk2(bt[4], bt[5]); o.w = pk2(bt[6], bt[7]); *(LAS v4u*)(lds + LA_BS + t * 144 + j0 * 2) = o;
            o.x = pk2(kt[0], kt[1]); o.y = pk2(kt[2], kt[3]); o.z = pk2(kt[4], kt[5]); o.w = pk2(kt[6], kt[7]); *(LAS v4u*)(lds + LA_KS + t * 144 + j0 * 2) = o;
            o.x = pk2(rt_[0], rt_[1]); o.y = pk2(rt_[2], rt_[3]); o.z = pk2(rt_[4], rt_[5]); o.w = pk2(rt_[6], rt_[7]); *(LAS v4u*)(lds + LA_RS + t * 144 + j0 * 2) = o;
            *(v4u*)(rec + REC_RT + t * 144 + j0 * 2) = o;
#pragma unroll
            for (int e = 0; e < 8; ++e) { *(LAS bf16*)(lds + LA_KGT + (j0 + e) * 144 + t * 2) = (bf16)f2bf(kg[e]); *(LAS bf16*)(lds + LA_BGT + (j0 + e) * 144 + t * 2) = (bf16)f2bf(bg[e]);
                *(LAS bf16*)(lds + LA_VT + (j0 + e) * 144 + t * 2) = (bf16)((e & 1) ? (wv[e >> 1] >> 16) : (wv[e >> 1] & 0xffffu)); }
            if (t == 63) { *(f32x4*)(rec + REC_GC + j0 * 4) = (f32x4){gc[0], gc[1], gc[2], gc[3]}; *(f32x4*)(rec + REC_GC + (j0 + 4) * 4) = (f32x4){gc[4], gc[5], gc[6], gc[7]}; }
        }
        __syncthreads();
        if (wave < 4) {
            const int ib = wave & 1; const bool isY = wave >= 2; const int offX = isY ? LA_RS : LA_AS;
            f32x16 o;
#pragma unroll
            for (int r = 0; r < 16; ++r) o[r] = 0.f;
            { f32x16 Gt = gtile32(lds, LA_KS, 0, offX, 1, r32, hi); gv_acc(o, Gt, lds, 0, ib, r32, hi); }
            { f32x16 Gt = gtile32(lds, LA_KS, 1, offX, 1, r32, hi); if (isY) mask_lower<true>(Gt, r32, hi); else mask_lower<false>(Gt, r32, hi); gv_acc(o, Gt, lds, 1, ib, r32, hi); }
            if (!isY) {
#pragma unroll
                for (int r = 0; r < 16; ++r) *(LAS float*)(lds + LA_XU + ((32 + crow(r, hi)) * 68 + 32 * ib + r32) * 4) = o[r];
            } else {
#pragma unroll
                for (int u = 0; u < 4; ++u) { const int m = 2 + (u >> 1), lp = (r32 & 15) + 16 * (2 * (u & 1) + hi), vs = 2 * ib + (r32 >> 4);
                    *(pg8::u32x2*)(rec + REC_Y0 + ((vs * 4 + m) * 64 + lp) * 8) = (pg8::u32x2){pk2(o[4 * u], o[4 * u + 1]), pk2(o[4 * u + 2], o[4 * u + 3])}; }
            }
        } else if (wave < 6) {
            const bool isY = wave == 5; const int offX = isY ? LA_RS : LA_AS;
            f32x16 Gt = gtile32(lds, LA_KS, 0, offX, 0, r32, hi); if (isY) mask_lower<true>(Gt, r32, hi); else mask_lower<false>(Gt, r32, hi);
#pragma unroll
            for (int ib = 0; ib < 2; ++ib) { f32x16 o;
#pragma unroll
                for (int r = 0; r < 16; ++r) o[r] = 0.f;
                gv_acc(o, Gt, lds, 0, ib, r32, hi);
                if (!isY) {
#pragma unroll
                    for (int r = 0; r < 16; ++r) *(LAS float*)(lds + LA_XU + (crow(r, hi) * 68 + 32 * ib + r32) * 4) = o[r];
                } else {
#pragma unroll
                    for (int u = 0; u < 4; ++u) { const int m = (u >> 1), lp = (r32 & 15) + 16 * (2 * (u & 1) + hi), vs = 2 * ib + (r32 >> 4);
                        *(pg8::u32x2*)(rec + REC_Y0 + ((vs * 4 + m) * 64 + lp) * 8) = (pg8::u32x2){pk2(o[4 * u], o[4 * u + 1]), pk2(o[4 * u + 2], o[4 * u + 3])}; }
                } }
            const int hf = wave - 4;
#pragma unroll
            for (int jj = 0; jj < 2; ++jj)
#pragma unroll
                for (int vs = 0; vs < 4; ++vs) { const int jt = 2 * hf + jj; f32x4 acc = (f32x4){0.f, 0.f, 0.f, 0.f};
#pragma unroll
                    for (int ks = 0; ks < 2; ++ks) { const bf16x8 a = *(const LAS bf16x8*)(lds + LA_KGT + (16 * jt + c16) * 144 + (32 * ks + 8 * g) * 2), b = *(const LAS bf16x8*)(lds + LA_VT + (16 * vs + c16) * 144 + (32 * ks + 8 * g) * 2);
                        acc = __builtin_amdgcn_mfma_f32_16x16x32_bf16(a, b, acc, 0, 0, 0); }
                    *(pg8::u32x2*)(rec + REC_M0 + ((vs * 4 + jt) * 64 + lane) * 8) = (pg8::u32x2){pk2(acc[0], acc[1]), pk2(acc[2], acc[3])}; }
        } else {
            const bool isR = wave == 7; const int offX = isR ? LA_RS : LA_AS;
#pragma unroll
            for (int k = 0; k < 3; ++k) { const int si = k == 2 ? 1 : 0, ti = k == 0 ? 0 : 1;
                f32x16 Gt = gtile32(lds, LA_BS, si, offX, ti, r32, hi);
                if (si == ti) { if (isR) mask_lower<true>(Gt, r32, hi); else mask_lower<false>(Gt, r32, hi); }
#pragma unroll
                for (int u = 0; u < 4; ++u) {
                    if (!isR) *(LAS f32x4*)(lds + LA_NS + (32 * ti + r32) * 272 + (32 * si + 8 * u + 4 * hi) * 4) = (f32x4){Gt[4 * u], Gt[4 * u + 1], Gt[4 * u + 2], Gt[4 * u + 3]};
                    else *(pg8::u32x2*)(rec + REC_ARB + (32 * ti + r32) * 144 + (32 * si + 8 * u + 4 * hi) * 2) = (pg8::u32x2){pk2(Gt[4 * u], Gt[4 * u + 1]), pk2(Gt[4 * u + 2], Gt[4 * u + 3])}; }
            }
            if (isR) { const v4u z = (v4u){0u, 0u, 0u, 0u}; *(v4u*)(rec + REC_ARB + r32 * 144 + (32 + 16 * hi) * 2) = z; *(v4u*)(rec + REC_ARB + r32 * 144 + (40 + 16 * hi) * 2) = z; }
        }
        __syncthreads();
        const v4u vg1 = *(const v4u*)(ws + WS_AIN + (size_t)uc * AIN_BYTES + AIN_G1 + e0 * 2), vg2 = *(const v4u*)(ws + WS_AIN + (size_t)uc * AIN_BYTES + AIN_G2 + e0 * 2);
        PA_LOAD_LD(min(uc + G, 8191));
        if (wave < 4 && lane < 16) { const int bb = wave; float tc[16];
#pragma unroll
            for (int t2 = 0; t2 < 16; ++t2) { float v = (t2 == lane) ? 1.f : 0.f;
#pragma unroll
                for (int s4 = 0; s4 < (t2 + 3) / 4; ++s4) { const f32x4 n4 = *(const LAS f32x4*)(lds + LA_NS + (16 * bb + t2) * 272 + (16 * bb + 4 * s4) * 4);
#pragma unroll
                    for (int e = 0; e < 4; ++e) if (4 * s4 + e < t2) v += n4[e] * tc[4 * s4 + e]; }
                tc[t2] = v; *(LAS float*)(lds + LA_TS + ((bb * 16 + t2) * 16 + lane) * 4) = v; if ((t2 & 3) == 3) asm volatile("" ::: "memory"); } }
        __syncthreads();
        {   const bool isW = wave < 4; const int colw = 16 * (wave & 3) + c16;
            LAS float* RS = (LAS float*)(lds + LA_SCR + wave * 1024);
#pragma unroll 1
            for (int bb = 0; bb < 4; ++bb) {
                f32x4 acc;
#pragma unroll
                for (int r = 0; r < 4; ++r) acc[r] = isW ? bf1(*(const LAS bf16*)(lds + LA_AS + (16 * bb + 4 * g + r) * 144 + colw * 2)) : *(const LAS float*)(lds + LA_XU + ((16 * bb + 4 * g + r) * 68 + colw) * 4);
#pragma unroll 4
                for (int kk = 0; kk < 4 * bb; ++kk) { const float av = *(const LAS float*)(lds + LA_NS + (16 * bb + c16) * 272 + (4 * kk + g) * 4);
                    const float bv = isW ? CL[(4 * kk + g) * 65 + colw] : *(const LAS float*)(lds + LA_XU + ((4 * kk + g) * 68 + colw) * 4);
                    acc = __builtin_amdgcn_mfma_f32_16x16x4f32(av, bv, acc, 0, 0, 0); }
#pragma unroll
                for (int r = 0; r < 4; ++r) RS[(4 * g + r) * 16 + c16] = acc[r];
                f32x4 xa = (f32x4){0.f, 0.f, 0.f, 0.f};
#pragma unroll
                for (int kk = 0; kk < 4; ++kk) { const float av = *(const LAS float*)(lds + LA_TS + ((bb * 16 + c16) * 16 + 4 * kk + g) * 4); const float bv = RS[(4 * kk + g) * 16 + c16];
                    xa = __builtin_amdgcn_mfma_f32_16x16x4f32(av, bv, xa, 0, 0, 0); }
#pragma unroll
                for (int r = 0; r < 4; ++r) { if (isW) CL[(16 * bb + 4 * g + r) * 65 + colw] = xa[r]; else *(LAS float*)(lds + LA_XU + ((16 * bb + 4 * g + r) * 68 + colw) * 4) = xa[r]; }
                if (isW) {
#pragma unroll
                    for (int r = 0; r < 4; ++r) *(LAS bf16*)(lds + LA_WS + (16 * bb + 4 * g + r) * 144 + colw * 2) = (bf16)f2bf(xa[r]);
                } else *(pg8::u32x2*)(rec + REC_U0 + (((wave & 3) * 4 + bb) * 64 + lane) * 8) = (pg8::u32x2){pk2(xa[0], xa[1]), pk2(xa[2], xa[3])};
            }
        }
        __syncthreads();
        { const int bh = uc >> 8, row = (bh >> 4) * T + (uc & 255) * 64 + t; const size_t go = (size_t)row * 1024 + (bh & 15) * 64 + j0;
          *(v4u*)((bf16*)(ws + WS_G1) + go) = vg1; *(v4u*)((bf16*)(ws + WS_G2) + go) = vg2; }
        for (int i = tid; i < 576; i += NTHR) { *(v4u*)(rec + REC_W + i * 16) = *(const LAS v4u*)(lds + LA_WS + i * 16); *(v4u*)(rec + REC_BGT + i * 16) = *(const LAS v4u*)(lds + LA_BGT + i * 16); }
    }
}

#undef PA_LOAD
#undef PA_LOAD_LD
__device__ __forceinline__ bf16x8 afrag16(const LAS unsigned char* base, int row, int s, int g) {
    const LAS unsigned char* p = base + row * 144 + (32 * s + 4 * g) * 2; const s16x4 lo = *(const LAS s16x4*)p, hh = *(const LAS s16x4*)(p + 32);
    return (bf16x8){lo[0], lo[1], lo[2], lo[3], hh[0], hh[1], hh[2], hh[3]};
}
__device__ __forceinline__ bf16x8 pack_cc(const f32x4& a, const f32x4& b) { v4u w; w.x = pg8::cvt_pk_bf16(a[0], a[1]); w.y = pg8::cvt_pk_bf16(a[2], a[3]); w.z = pg8::cvt_pk_bf16(b[0], b[1]); w.w = pg8::cvt_pk_bf16(b[2], b[3]); return __builtin_bit_cast(bf16x8, w); }
__device__ __forceinline__ f32x4 cfrag(const LAS unsigned char* base, int vs, int m, int lane) { const pg8::u32x2 u = *(const LAS pg8::u32x2*)(base + ((vs * 4 + m) * 64 + lane) * 8); return (f32x4){bfl(u.x), bfh(u.x), bfl(u.y), bfh(u.y)}; }
constexpr int B_SLOT = 44032, B_NP = 43;
__device__ __forceinline__ void b_issue(const unsigned char* rec, LAS unsigned char* slot, int vs, int lw, int lane) {
    for (int p = lw; p < B_NP; p += 4) {
        const int src = p < 36 ? p * 1024 : (p < 42 ? REC_U0 + ((p - 36) >> 1) * 8192 + vs * 2048 + ((p - 36) & 1) * 1024 : REC_GC);
        __builtin_amdgcn_global_load_lds((const unsigned*)(rec + src + lane * 16), (LAS unsigned*)(slot + p * 1024), 16, 0, 0); }
}
__device__ __forceinline__ void p4_rwkv_seq(const Args& A, LAS unsigned char* lds, int q, int wave, int lane) {
    unsigned char* ws = A.ws; const int bh = q >> 2, vs = q & 3;
    const unsigned char* REC = ws + WS_REC + (size_t)bh * 256 * REC_BYTES; bf16* YR = (bf16*)(ws + WS_YRAW);
    const int b = bh >> 4, h = bh & 15, c16 = lane & 15, g = lane >> 4, lw = wave - 4;
    const bool many = ((B_NP - 1 - lw) / 4 + 1) == 11;
    LAS unsigned char* XH = lds + 3 * B_SLOT; LAS unsigned char* XU = XH + 4096; volatile LAS int* FLG = (volatile LAS int*)(XU + 4096);
    if (wave >= 4) { b_issue(REC, lds, vs, lw, lane); b_issue(REC + REC_BYTES, lds + B_SLOT, vs, lw, lane);
        if (many) asm volatile("s_waitcnt vmcnt(11)" ::: "memory"); else asm volatile("s_waitcnt vmcnt(10)" ::: "memory"); }
    if (wave == 0) { if (lane == 0) *FLG = 0; const v4u z = (v4u){0u, 0u, 0u, 0u}; *(LAS v4u*)(XH + lane * 32) = z; *(LAS v4u*)(XH + lane * 32 + 16) = z; }
    __syncthreads();
    f32x4 H[4]; bf16x8 hb[2];
#pragma unroll
    for (int jt = 0; jt < 4; ++jt) H[jt] = (f32x4){0.f, 0.f, 0.f, 0.f};
    hb[0] = pack_cc(H[0], H[1]); hb[1] = hb[0];
#pragma unroll 1
    for (int c = 0; c < 256; ++c) {
        const LAS unsigned char* buf = lds + (c % 3) * B_SLOT;
        const LAS unsigned char* qb = buf + 36864;
        if (wave >= 4) {
            if (c + 2 < 256) { b_issue(REC + (size_t)(c + 2) * REC_BYTES, lds + ((c + 2) % 3) * B_SLOT, vs, lw, lane);
                if (many) asm volatile("s_waitcnt vmcnt(11)" ::: "memory"); else asm volatile("s_waitcnt vmcnt(10)" ::: "memory"); }
            else asm volatile("s_waitcnt vmcnt(0)" ::: "memory");
        } else if (wave == 0) {
            bf16x8 wf[4][2], bf[4][2]; f32x4 U[4], mz[4], gcv[4];
#pragma unroll
            for (int m = 0; m < 4; ++m) { U[m] = cfrag(qb, 0, m, lane);
#pragma unroll
                for (int s = 0; s < 2; ++s) wf[m][s] = afrag16(buf + REC_W, 16 * m + c16, s, g); }
#pragma unroll
            for (int jt = 0; jt < 4; ++jt) { gcv[jt] = *(const LAS f32x4*)(qb + 6144 + (16 * jt + 4 * g) * 4); mz[jt] = cfrag(qb + 4096, 0, jt, lane);
#pragma unroll
                for (int s = 0; s < 2; ++s) bf[jt][s] = afrag16(buf + REC_BGT, 16 * jt + c16, s, g); }
            asm volatile("" ::: "memory");
#pragma unroll
            for (int s = 0; s < 2; ++s)
#pragma unroll
                for (int m = 0; m < 4; ++m) U[m] = __builtin_amdgcn_mfma_f32_16x16x32_bf16(wf[m][s], hb[s], U[m], 0, 0, 0);
            bf16x8 ub[2]; ub[0] = pack_cc(U[0], U[1]); ub[1] = pack_cc(U[2], U[3]);
            { LAS unsigned char* xu = XU + (c & 1) * 2048 + lane * 32; *(LAS bf16x8*)xu = ub[0]; *(LAS bf16x8*)(xu + 16) = ub[1]; }
            f32x4 hn[4];
#pragma unroll
            for (int jt = 0; jt < 4; ++jt) hn[jt] = H[jt] * gcv[jt] + mz[jt];
            asm volatile("s_waitcnt lgkmcnt(0)" ::: "memory");
            if (lane == 0) *FLG = c + 1;
#pragma unroll
            for (int s = 0; s < 2; ++s)
#pragma unroll
                for (int jt = 0; jt < 4; ++jt) hn[jt] = __builtin_amdgcn_mfma_f32_16x16x32_bf16(bf[jt][s], ub[s], hn[jt], 0, 0, 0);
#pragma unroll
            for (int jt = 0; jt < 4; ++jt) H[jt] = hn[jt];
            hb[0] = pack_cc(H[0], H[1]); hb[1] = pack_cc(H[2], H[3]);
            { LAS unsigned char* xh = XH + ((c + 1) & 1) * 2048 + lane * 32; *(LAS bf16x8*)xh = hb[0]; *(LAS bf16x8*)(xh + 16) = hb[1]; }
        } else if (wave == 1) {
            bf16x8 hh[2], rf[4][2], af[4][2]; f32x4 y[4];
            { const LAS unsigned char* xh = XH + (c & 1) * 2048 + lane * 32; hh[0] = *(const LAS bf16x8*)xh; hh[1] = *(const LAS bf16x8*)(xh + 16); }
#pragma unroll
            for (int m = 0; m < 4; ++m) { y[m] = cfrag(qb + 2048, 0, m, lane);
#pragma unroll
                for (int s = 0; s < 2; ++s) { rf[m][s] = afrag16(buf + REC_RT, 16 * m + c16, s, g); af[m][s] = afrag16(buf + REC_ARB, 16 * m + c16, s, g); } }
            asm volatile("" ::: "memory");
#pragma unroll
            for (int s = 0; s < 2; ++s)
#pragma unroll
                for (int m = 0; m < 4; ++m) y[m] = __builtin_amdgcn_mfma_f32_16x16x32_bf16(rf[m][s], hh[s], y[m], 0, 0, 0);
            { unsigned sp = 0u; while (*FLG <= c) { __builtin_amdgcn_s_sleep(1); if (++sp > (1u << 22)) break; } }
            asm volatile("" ::: "memory");
            bf16x8 uu[2]; { const LAS unsigned char* xu = XU + (c & 1) * 2048 + lane * 32; uu[0] = *(const LAS bf16x8*)xu; uu[1] = *(const LAS bf16x8*)(xu + 16); }
#pragma unroll
            for (int s = 0; s < 2; ++s)
#pragma unroll
                for (int m = 0; m < 4; ++m) y[m] = __builtin_amdgcn_mfma_f32_16x16x32_bf16(af[m][s], uu[s], y[m], 0, 0, 0);
#pragma unroll
            for (int m = 0; m < 4; ++m) { bf16* yp = YR + (size_t)(b * T + 64 * c + 16 * m + 4 * g) * 1024 + h * 64 + 16 * vs + c16;
                yp[0] = (bf16)f2bf(y[m][0]); yp[1024] = (bf16)f2bf(y[m][1]); yp[2048] = (bf16)f2bf(y[m][2]); yp[3072] = (bf16)f2bf(y[m][3]); }
        }
        asm volatile("s_waitcnt lgkmcnt(0)" ::: "memory"); __builtin_amdgcn_s_barrier(); asm volatile("" ::: "memory");
    }
    asm volatile("s_waitcnt vmcnt(0)" ::: "memory");
    __syncthreads();
}
__device__ __forceinline__ void p5_rwkv_final(const Args& A, int vcu, int G, int wave, int lane) {
    const bf16* YR = (const bf16*)(A.ws + WS_YRAW); const bf16* G1 = (const bf16*)(A.ws + WS_G1); const bf16* G2 = (const bf16*)(A.ws + WS_G2); unsigned char* MIX = A.ws + WS_MIX;
    const int gw = vcu * NWAVES + wave, NGW = G * NWAVES, pr = lane >> 3, oct = lane & 7;
    for (int it0 = gw * 8 + pr; it0 < NTOK * 16; it0 += NGW * 8 * 4) {
        v4u y[4], a[4], c[4];
#pragma unroll
        for (int k = 0; k < 4; ++k) { const int it = min(it0 + k * NGW * 8, NTOK * 16 - 1); const size_t o = (size_t)(it >> 4) * 1024 + (it & 15) * 64 + oct * 8;
            y[k] = *(const v4u*)(YR + o); a[k] = *(const v4u*)(G1 + o); c[k] = *(const v4u*)(G2 + o); }
#pragma unroll
        for (int k = 0; k < 4; ++k) { const int it = it0 + k * NGW * 8;
            const unsigned yw[4] = {y[k].x, y[k].y, y[k].z, y[k].w}, aw[4] = {a[k].x, a[k].y, a[k].z, a[k].w}, cw[4] = {c[k].x, c[k].y, c[k].z, c[k].w};
            float v[8]; float sm = 0.f;
#pragma unroll
            for (int e = 0; e < 4; ++e) { v[2 * e] = bfl(yw[e]); v[2 * e + 1] = bfh(yw[e]); sm += v[2 * e] + v[2 * e + 1]; }
            sm += __shfl_xor(sm, 1); sm += __shfl_xor(sm, 2); sm += __shfl_xor(sm, 4);
            const float mean = sm * (1.f / 64.f); float sq = 0.f;
#pragma unroll
            for (int e = 0; e < 8; ++e) { v[e] -= mean; sq += v[e] * v[e]; }
            sq += __shfl_xor(sq, 1); sq += __shfl_xor(sq, 2); sq += __shfl_xor(sq, 4);
            const float rstd = 1.0f / sqrtf(sq * (1.f / 64.f) + GN_EPS);
            float ov[8];
#pragma unroll
            for (int e = 0; e < 4; ++e) { ov[2 * e] = v[2 * e] * rstd * bfl(aw[e]) + bfl(cw[e]); ov[2 * e + 1] = v[2 * e + 1] * rstd * bfh(aw[e]) + bfh(cw[e]); }
            pg8::u32x2 o2; o2.x = pg8::pk4_fp8(ov[0], ov[1], ov[2], ov[3]); o2.y = pg8::pk4_fp8(ov[4], ov[5], ov[6], ov[7]);
            if (it < NTOK * 16) *(pg8::u32x2*)(MIX + (size_t)(it >> 4) * D + (it & 15) * 64 + oct * 8) = o2; }
    }
}

__device__ __forceinline__ void p5_ln_router(const Args& A, LAS unsigned char* lds, int vcu, int G, int tid, int wave, int lane) {
    unsigned char* ws = A.ws; const bf16* Z1 = (const bf16*)(ws + WS_Z1); bf16* H1 = (bf16*)(ws + WS_H1); const bf16* RWF = (const bf16*)(ws + WS_RWT);
    int* TOPI = (int*)(ws + RT_TOPI); float* TOPG = (float*)(ws + RT_TOPG); int* CNT = (int*)(ws + RT_CNT);
    LAS int* hist = (LAS int*)lds; const int c16 = lane & 15, g = lane >> 4;
    const float* gam = A.in[21]; const float* bet = A.in[22];
    for (int batch = vcu; batch < NTOK / 128; batch += G) {
        __syncthreads();
        if (tid < NE) hist[tid] = 0;
        __syncthreads();
        const int row0 = batch * 128 + wave * 16; const bf16* zr = Z1 + (size_t)(row0 + c16) * D + 8 * g;
        float sm = 0.f, sq = 0.f;
        { const float* lp = (const float*)(ws + WS_LNS) + ((size_t)(row0 + c16) * 32 + 8 * g) * 2;
#pragma unroll
          for (int k = 0; k < 4; ++k) { const f32x4 v = *(const f32x4*)(lp + 4 * k); sm += v.x + v.z; sq += v.y + v.w; } }
        sm += __shfl_xor(sm, 16); sm += __shfl_xor(sm, 32); sq += __shfl_xor(sq, 16); sq += __shfl_xor(sq, 32);
        const float mean = sm * (1.f / D); const float rstd = 1.0f / sqrtf(fmaxf(sq * (1.f / D) - mean * mean, 0.f) + LN_EPS);
        f32x4 acc[2]; acc[0] = (f32x4){0.f, 0.f, 0.f, 0.f}; acc[1] = acc[0];
        bf16* hr = H1 + (size_t)(row0 + c16) * D + 8 * g; unsigned char* hq = ws + WS_H1Q + (size_t)(row0 + c16) * D + 8 * g;
#pragma unroll 2
        for (int sx = 0; sx < 64; ++sx) { const v4u z = *(const v4u*)(zr + 32 * sx); const f32x4 a = (f32x4){bfl(z.x), bfh(z.x), bfl(z.y), bfh(z.y)}, b = (f32x4){bfl(z.z), bfh(z.z), bfl(z.w), bfh(z.w)};
            const f32x4 g0 = *(const f32x4*)(gam + 32 * sx + 8 * g), g1 = *(const f32x4*)(gam + 32 * sx + 8 * g + 4), b0 = *(const f32x4*)(bet + 32 * sx + 8 * g), b1 = *(const f32x4*)(bet + 32 * sx + 8 * g + 4);
            const f32x4 h0 = (a - mean) * rstd * g0 + b0, h1 = (b - mean) * rstd * g1 + b1;
            v4u hi; hi.x = pg8::cvt_pk_bf16(h0.x, h0.y); hi.y = pg8::cvt_pk_bf16(h0.z, h0.w); hi.z = pg8::cvt_pk_bf16(h1.x, h1.y); hi.w = pg8::cvt_pk_bf16(h1.z, h1.w);
            *(v4u*)(hr + 32 * sx) = hi;
            *(pg8::u32x2*)(hq + 32 * sx) = (pg8::u32x2){pg8::pk4_fp8(h0.x, h0.y, h0.z, h0.w), pg8::pk4_fp8(h1.x, h1.y, h1.z, h1.w)};
            v4u lo; lo.x = pg8::cvt_pk_bf16(h0.x - bfl(hi.x), h0.y - bfh(hi.x)); lo.y = pg8::cvt_pk_bf16(h0.z - bfl(hi.y), h0.w - bfh(hi.y));
            lo.z = pg8::cvt_pk_bf16(h1.x - bfl(hi.z), h1.y - bfh(hi.z)); lo.w = pg8::cvt_pk_bf16(h1.z - bfl(hi.w), h1.w - bfh(hi.w));
            const bf16x8 ah = __builtin_bit_cast(bf16x8, hi), al = __builtin_bit_cast(bf16x8, lo);
#pragma unroll
            for (int nt = 0; nt < 2; ++nt) { const bf16* fp = RWF + ((size_t)((sx * 2 + nt) * 2) * 64 + lane) * 8; const bf16x8 wh = *(const bf16x8*)fp, wl = *(const bf16x8*)(fp + 512);
                acc[nt] = __builtin_amdgcn_mfma_f32_16x16x32_bf16(ah, wh, acc[nt], 0, 0, 0); acc[nt] = __builtin_amdgcn_mfma_f32_16x16x32_bf16(ah, wl, acc[nt], 0, 0, 0);
                acc[nt] = __builtin_amdgcn_mfma_f32_16x16x32_bf16(al, wh, acc[nt], 0, 0, 0); } }
        const float bia0 = A.in[24][c16], bia1 = A.in[24][16 + c16];
#pragma unroll
        for (int r = 0; r < 4; ++r) {
            float v0 = acc[0][r] + bia0, v1 = acc[1][r] + bia1; float tv[4]; int ti[4];
#pragma unroll
            for (int k = 0; k < 4; ++k) { float bv = v0; int bi = c16; if (v1 > bv) { bv = v1; bi = 16 + c16; }
#pragma unroll
                for (int o = 1; o < 16; o <<= 1) { const float ov = __shfl_xor(bv, o); const int oi = __shfl_xor(bi, o); if (ov > bv || (ov == bv && oi < bi)) { bv = ov; bi = oi; } }
                tv[k] = bv; ti[k] = bi; if (bi == c16) v0 = -INFINITY; if (bi == 16 + c16) v1 = -INFINITY; }
            const float e1 = __expf(tv[1] - tv[0]), e2 = __expf(tv[2] - tv[0]), e3 = __expf(tv[3] - tv[0]); const float inv = 1.f / (1.f + e1 + e2 + e3);
            if (c16 < 4) { const int row = row0 + 4 * g + r; const int ei = c16 == 0 ? ti[0] : c16 == 1 ? ti[1] : c16 == 2 ? ti[2] : ti[3]; const float gv = (c16 == 0 ? 1.f : c16 == 1 ? e1 : c16 == 2 ? e2 : e3) * inv;
                TOPI[row * 4 + c16] = ei; TOPG[row * 4 + c16] = gv; __hip_atomic_fetch_add(hist + ei, 1, __ATOMIC_RELAXED, __HIP_MEMORY_SCOPE_WORKGROUP); }
        }
        __syncthreads();
        if (tid < NE) CNT[batch * NE + tid] = hist[tid];
    }
}
__device__ __forceinline__ void p6_positions(const Args& A, LAS unsigned char* lds, int vcu, int G, int tid) {
    unsigned char* ws = A.ws; const int* TOPI = (const int*)(ws + RT_TOPI); const float* TOPG = (const float*)(ws + RT_TOPG); const int* CNT = (const int*)(ws + RT_CNT);
    int* POS = (int*)(ws + RT_POS); int* BTOK = (int*)(ws + RT_TOK); float* BGATE = (float*)(ws + RT_GATE); int* TILE = (int*)(ws + RT_TILE);
    LAS int* sh = (LAS int*)lds;
    for (int batch = vcu; batch < NTOK / 128; batch += G) {
        __syncthreads();
        { const int e = tid & 31, seg = tid >> 5; int sb = 0, st = 0;
          for (int q = 0; q < 16; ++q) { const int bb = seg * 16 + q; const int c = CNT[bb * NE + e]; st += c; if (bb < batch) sb += c; }
          sh[tid] = sb; sh[1152 + tid] = st; }
        sh[640 + tid] = TOPI[batch * 512 + tid];
        __syncthreads();
        if (tid < NE) { int sb = 0, st = 0; for (int s = 0; s < 16; ++s) { sb += sh[s * 32 + tid]; st += sh[1152 + s * 32 + tid]; } sh[512 + tid] = sb; sh[544 + tid] = st; }
        __syncthreads();
        const int lane = tid & 63, wave = tid >> 6; const int e = sh[640 + tid];
        if (tid < 64) { const int v = tid < NE ? (sh[544 + tid] + 255) >> 8 : 0; int inc = v;
#pragma unroll
            for (int o = 1; o < 32; o <<= 1) { const int t = __shfl_up(inc, o); if (lane >= o) inc += t; }
            if (tid < NE) sh[576 + tid] = inc - v; if (tid == NE - 1) sh[576 + NE] = inc; }
        int rw = 0, mycnt = 0; { const unsigned long long lt = (1ull << lane) - 1ull;
#pragma unroll 8
            for (int x = 0; x < NE; ++x) { const unsigned long long b = __ballot(e == x); if (e == x) rw = __popcll(b & lt); if (lane == x) mycnt = __popcll(b); } }
        if (lane < NE) sh[1664 + wave * 32 + lane] = mycnt;
        __syncthreads();
        { int rank = rw; for (int w = 0; w < wave; ++w) rank += sh[1664 + w * 32 + e];
          const int dest = sh[576 + e] * 256 + sh[512 + e] + rank;
          BTOK[dest] = batch * 128 + (tid >> 2); BGATE[dest] = TOPG[batch * 512 + tid]; POS[batch * 512 + tid] = dest; }
        if (batch < NE) { const int e = batch; const int lo = sh[576 + e] * 256 + sh[544 + e], hi = sh[576 + e + 1] * 256;
            for (int i = lo + tid; i < hi; i += NTHR) { BTOK[i] = 0; BGATE[i] = 0.f; }
            for (int rt = sh[576 + e] + tid; rt < sh[576 + e + 1]; rt += NTHR) TILE[rt] = e; }
        if (batch == 0 && tid == 0) TILE[MAXT] = sh[576 + NE];
    }
}
template <int I> __device__ __forceinline__ float fp8f_(unsigned w) { return __builtin_amdgcn_cvt_f32_fp8((int)w, I); }
#define fp8f(w, i) fp8f_<i>(w)
__device__ __forceinline__ void p9_final(const Args& A, int vcu, int G, int wave, int lane) {
    unsigned char* ws = A.ws; const bf16* H1 = (const bf16*)(ws + WS_H1); const unsigned char* Y = ws + WS_Y; const int* POS = (const int*)(ws + RT_POS);
    const int gw = vcu * NWAVES + wave, NGW = G * NWAVES;
    for (int row = gw; row < NTOK; row += NGW) {
        f32x4 v[8]; const int p0 = POS[row * 4], p1 = POS[row * 4 + 1], p2 = POS[row * 4 + 2], p3 = POS[row * 4 + 3];
#pragma unroll
        for (int j = 0; j < 8; ++j) { const int c = 4 * lane + 256 * j;
            const pg8::u32x2 h = *(const pg8::u32x2*)(H1 + (size_t)row * D + c);
            const unsigned y0 = *(const unsigned*)(Y + (size_t)p0 * D + c), y1 = *(const unsigned*)(Y + (size_t)p1 * D + c), y2 = *(const unsigned*)(Y + (size_t)p2 * D + c), y3 = *(const unsigned*)(Y + (size_t)p3 * D + c);
            const float s = 1.0f / 64.0f;
            v[j].x = ALPHA * bfl(h.x) + s * ((fp8f(y0, 0) + fp8f(y1, 0)) + (fp8f(y2, 0) + fp8f(y3, 0))); v[j].y = ALPHA * bfh(h.x) + s * ((fp8f(y0, 1) + fp8f(y1, 1)) + (fp8f(y2, 1) + fp8f(y3, 1)));
            v[j].z = ALPHA * bfl(h.y) + s * ((fp8f(y0, 2) + fp8f(y1, 2)) + (fp8f(y2, 2) + fp8f(y3, 2))); v[j].w = ALPHA * bfh(h.y) + s * ((fp8f(y0, 3) + fp8f(y1, 3)) + (fp8f(y2, 3) + fp8f(y3, 3))); }
        ln_row(v, A.in[29], A.in[30], LN_EPS, lane);
#pragma unroll
        for (int j = 0; j < 8; ++j) *(f32x4*)(A.out + (size_t)row * D + 4 * lane + 256 * j) = v[j];
    }
}

constexpr int NPH = 12;
__device__ __forceinline__ int opaque_tid() { int t = (int)threadIdx.x; asm volatile("" : "+v"(t)); return t; }
template <int PLO, int PHI>
__global__ void __launch_bounds__(NTHR, 2) fwd_kernel(Args args) {
    extern __shared__ __attribute__((aligned(16))) unsigned char lds_raw[];
    LAS unsigned char* lds = (LAS unsigned char*)lds_raw;
    const int tid = threadIdx.x, lane = tid & 63, wave = __builtin_amdgcn_readfirstlane(tid >> 6);
    const int G = gridDim.x; const int bx = blockIdx.x; const int vcu = (G % 8 == 0) ? (bx % 8) * (G / 8) + bx / 8 : bx;
    volatile LAS unsigned* MISC = (volatile LAS unsigned*)(lds + MISC_OFF);
    if (tid < 64) MISC[tid] = 0u;
    __syncthreads();
    unsigned char* ws = args.ws;
    unsigned* ctl = (unsigned*)(ws + WS_CTL);
    constexpr int lo = PLO, hi = PHI;
    XcdBarrier bar; bar.bar = ctl + CW_BAR; bar.x = 0; bar.st = nullptr;
    if (hi - lo > 1) bar = xcd_barrier_post(ctl + CW_BAR, MISC + 8);
#define IN(k) (lo <= (k) && (k) < hi)
#define PH_IDS const int tid = opaque_tid(), lane = tid & 63, wave = __builtin_amdgcn_readfirstlane(tid >> 6); (void)tid; (void)lane; (void)wave
#define SEAM(k) do { if constexpr (IN(k) && IN((k) + 1)) xcd_barrier(bar); } while (0)

    if constexpr (IN(0)) { PH_IDS; p0_prologue(args, lds, vcu, G, wave, lane); }
#if defined(REP_PHASE)
    if constexpr (REP_PHASE == 0) { __syncthreads();
    if constexpr (IN(0)) { PH_IDS; p0_prologue(args, lds, vcu, G, wave, lane); }
    }
#endif
    SEAM(0);
    if constexpr (IN(1)) { PH_IDS;
        const int ng = (G == 256) ? NG_INPROJ : G;
        if (bx < ng) { pg8::Gemm g{(const bf16*)(ws + WS_H0), (const bf16*)(ws + WS_WI), NTOK, PW, D}; pg8::StaticOrder S; S.init(NTOK, PW, ng, bx);
            pg8::EpiBf16 E{(bf16*)(ws + WS_P), PW};
            pg8::gemm_phase<pg8::EpiBf16, pg8::StaticOrder>(lds, g, S, E); }
        else { pg8::Gemm g{(const bf16*)(ws + WS_MEMN), (const bf16*)(ws + WS_WKV), NB * MEM_LEN, 1024, D}; pg8::StaticOrder S; S.init(NB * MEM_LEN, 1024, G - ng, bx - ng);
            pg8::EpiBf16 E{(bf16*)(ws + WS_KVM), 1024};
            pg8::gemm_phase<pg8::EpiBf16, pg8::StaticOrder>(lds, g, S, E); }
        conv_pull_loop(args, lds, tid, wave, lane);
    }
#if defined(REP_PHASE)
    if constexpr (REP_PHASE == 1) { __syncthreads();
    if constexpr (IN(1)) { PH_IDS;
        pg8::Gemm g{(const bf16*)(ws + WS_H0), (const bf16*)(ws + WS_WI), NTOK, PW, D}; pg8::StaticOrder S; S.init(NTOK, PW, G, bx);
        pg8::EpiBf16 E{(bf16*)(ws + WS_P), PW};
        pg8::gemm_phase<pg8::EpiBf16, pg8::StaticOrder>(lds, g, S, E);
    }
    }
#endif
    SEAM(1);
    if constexpr (IN(2)) { PH_IDS;
        if (G != 256) { pg8::Gemm g{(const bf16*)(ws + WS_MEMN), (const bf16*)(ws + WS_WKV), NB * MEM_LEN, 1024, D}; pg8::StaticOrder S; S.init(NB * MEM_LEN, 1024, G, bx);
          pg8::EpiBf16 E{(bf16*)(ws + WS_KVM), 1024};
          pg8::gemm_phase<pg8::EpiBf16, pg8::StaticOrder>(lds, g, S, E); }
        __syncthreads();
        p2_fox_cumsum(args, lds, (vcu + G - 16) % G, G, tid);
        __syncthreads();
        p2_fox_norms(args, lds, vcu, G, tid, wave, lane);
        __syncthreads();
        p2_rwkv_tok(args, lds, vcu, G, tid, wave, lane);
#if defined(REP_SUB)
        __syncthreads();
        if constexpr (REP_SUB == 0) p2_rwkv_tok(args, lds, vcu, G, tid, wave, lane);
        if constexpr (REP_SUB == 11) p2_rwkv_tok<1>(args, lds, vcu, G, tid, wave, lane);
        if constexpr (REP_SUB == 12) p2_rwkv_tok<2>(args, lds, vcu, G, tid, wave, lane);
        if constexpr (REP_SUB == 1) p2_fox_norms(args, lds, vcu, G, tid, wave, lane);
        if constexpr (REP_SUB == 2) p2_fox_cumsum(args, lds, (vcu + G - 16) % G, G, tid);
        if constexpr (REP_SUB == 3) { pg8::Gemm g{(const bf16*)(ws + WS_MEMN), (const bf16*)(ws + WS_WKV), NB * MEM_LEN, 1024, D}; pg8::StaticOrder S; S.init(NB * MEM_LEN, 1024, G, bx);
          pg8::EpiBf16 E{(bf16*)(ws + WS_KVM), 1024};
          pg8::gemm_phase<pg8::EpiBf16, pg8::StaticOrder>(lds, g, S, E); }
#endif
    }
#if defined(REP_PHASE)
    if constexpr (REP_PHASE == 2) { __syncthreads();
    if constexpr (IN(2)) { PH_IDS;
        { pg8::Gemm g{(const bf16*)(ws + WS_MEMN), (const bf16*)(ws + WS_WKV), NB * MEM_LEN, 1024, D}; pg8::StaticOrder S; S.init(NB * MEM_LEN, 1024, G, bx);
          pg8::EpiBf16 E{(bf16*)(ws + WS_KVM), 1024};
          pg8::gemm_phase<pg8::EpiBf16, pg8::StaticOrder>(lds, g, S, E); }
        __syncthreads();
        p2_fox_cumsum(args, lds, (vcu + G - 16) % G, G, tid);
        __syncthreads();
        p2_fox_norms(args, lds, vcu, G, tid, wave, lane);
        __syncthreads();
        p2_rwkv_tok(args, lds, vcu, G, tid, wave, lane);
    }
    }
#endif
    SEAM(2);
    if constexpr (IN(3)) { PH_IDS; p3_rwkv_chunk(args, lds, vcu, G, tid, wave, lane); }
#if defined(REP_PHASE)
    if constexpr (REP_PHASE == 3) { __syncthreads();
    if constexpr (IN(3)) { PH_IDS; p3_rwkv_chunk(args, lds, vcu, G, tid, wave, lane); }
    }
#endif
    SEAM(3);
    if constexpr (IN(4)) { PH_IDS;
        for (int q = vcu; q < 128; q += G) { __syncthreads(); p4_rwkv_seq(args, lds, q, wave, lane); }
        p3_attention(args, lds, tid, wave, lane);
    }
#if defined(REP_PHASE)
    if constexpr (REP_PHASE == 4) { __syncthreads();
    if constexpr (IN(4)) { PH_IDS;
        for (int q = vcu; q < 128; q += G) { __syncthreads(); p4_rwkv_seq(args, lds, q, wave, lane); }
        p3_attention(args, lds, tid, wave, lane);
    }
    }
#endif
    SEAM(4);
    if constexpr (IN(5)) { PH_IDS; p5_rwkv_final(args, vcu, G, wave, lane); }
#if defined(REP_PHASE)
    if constexpr (REP_PHASE == 5) { __syncthreads();
    if constexpr (IN(5)) { PH_IDS; p5_rwkv_final(args, vcu, G, wave, lane); }
    }
#endif
    SEAM(5);
    if constexpr (IN(6)) { PH_IDS;
        LAS int* tl = (LAS int*)(lds + 131072 + 2048); __syncthreads(); if (tid < NTOK / 256) tl[tid] = 0; __syncthreads();
        pg8::Gemm g{(const bf16*)(ws + WS_MIX), (const bf16*)(ws + WS_WO), NTOK, D, D / 2};
        pg8::MoeOrder<true> S{tl, nullptr, NTOK / 256, D / 256, G, bx};
        pg8::EpiResBf16 E{(bf16*)(ws + WS_Z1), (const bf16*)(ws + WS_H0), D, ALPHA, (float*)(ws + WS_LNS)};
        pg8::gemm_phase<pg8::EpiResBf16, pg8::MoeOrder<true>, true, true>(lds, g, S, E);
    }
#if defined(REP_PHASE)
    if constexpr (REP_PHASE == 6) { __syncthreads();
    if constexpr (IN(6)) { PH_IDS;
        LAS int* tl = (LAS int*)(lds + 131072 + 2048); __syncthreads(); if (tid < NTOK / 256) tl[tid] = 0; __syncthreads();
        pg8::Gemm g{(const bf16*)(ws + WS_MIX), (const bf16*)(ws + WS_WO), NTOK, D, D / 2};
        pg8::MoeOrder<true> S{tl, nullptr, NTOK / 256, D / 256, G, bx};
        pg8::EpiResBf16 E{(bf16*)(ws + WS_Z1), (const bf16*)(ws + WS_H0), D, ALPHA, (float*)(ws + WS_LNS)};
        pg8::gemm_phase<pg8::EpiResBf16, pg8::MoeOrder<true>, true, true>(lds, g, S, E);
    }
    }
#endif
    SEAM(6);
    if constexpr (IN(7)) { PH_IDS; p5_ln_router(args, lds, vcu, G, tid, wave, lane); }
#if defined(REP_PHASE)
    if constexpr (REP_PHASE == 7) { __syncthreads();
    if constexpr (IN(7)) { PH_IDS; p5_ln_router(args, lds, vcu, G, tid, wave, lane); }
    }
#endif
    SEAM(7);
    if constexpr (IN(8)) { PH_IDS; p6_positions(args, lds, vcu, G, tid); }
#if defined(REP_PHASE)
    if constexpr (REP_PHASE == 8) { __syncthreads();
    if constexpr (IN(8)) { PH_IDS; p6_positions(args, lds, vcu, G, tid); }
    }
#endif
    SEAM(8);
    if constexpr (IN(9)) { PH_IDS;
        const int* TILE = (const int*)(ws + RT_TILE); const int ntiles = __builtin_amdgcn_readfirstlane(TILE[MAXT]);
        LAS int* tl = (LAS int*)(lds + 131072 + 2048); __syncthreads(); for (int i = tid; i < MAXT; i += NTHR) tl[i] = TILE[i]; __syncthreads();
        pg8::Gemm g{(const bf16*)(ws + WS_H1Q), (const bf16*)(ws + WS_W1), CAP, NE * 4096, D / 2};
        pg8::MoeOrder<true> S{tl, (const int*)(ws + RT_TOK), ntiles, 16, G, bx};
        pg8::EpiSwiglu E{ws + WS_ACT, args.in[26], {}, {}};
        pg8::gemm_phase<pg8::EpiSwiglu, pg8::MoeOrder<true>, true, true>(lds, g, S, E);
    }
#if defined(REP_PHASE)
    if constexpr (REP_PHASE == 9) { __syncthreads();
    if constexpr (IN(9)) { PH_IDS;
        const int* TILE = (const int*)(ws + RT_TILE); const int ntiles = __builtin_amdgcn_readfirstlane(TILE[MAXT]);
        LAS int* tl = (LAS int*)(lds + 131072 + 2048); __syncthreads(); for (int i = tid; i < MAXT; i += NTHR) tl[i] = TILE[i]; __syncthreads();
        pg8::Gemm g{(const bf16*)(ws + WS_H1Q), (const bf16*)(ws + WS_W1), CAP, NE * 4096, D / 2};
        pg8::MoeOrder<true> S{tl, (const int*)(ws + RT_TOK), ntiles, 16, G, bx};
        pg8::EpiSwiglu E{ws + WS_ACT, args.in[26], {}, {}};
        pg8::gemm_phase<pg8::EpiSwiglu, pg8::MoeOrder<true>, true, true>(lds, g, S, E);
    }
    }
#endif
    SEAM(9);
    if constexpr (IN(10)) { PH_IDS;
        const int* TILE = (const int*)(ws + RT_TILE); const int ntiles = __builtin_amdgcn_readfirstlane(TILE[MAXT]);
        LAS int* tl = (LAS int*)(lds + 131072 + 2048); __syncthreads(); for (int i = tid; i < MAXT; i += NTHR) tl[i] = TILE[i]; __syncthreads();
        pg8::Gemm g{(const bf16*)(ws + WS_ACT), (const bf16*)(ws + WS_W2), CAP, NE * D, D / 2};
        pg8::MoeOrder<true> S{tl, nullptr, ntiles, 8, G, bx};
        pg8::EpiGate E{ws + WS_Y, args.in[28], (const float*)(ws + RT_GATE), {}, {}};
        pg8::gemm_phase<pg8::EpiGate, pg8::MoeOrder<true>, true, true>(lds, g, S, E);
    }
#if defined(REP_PHASE)
    if constexpr (REP_PHASE == 10) { __syncthreads();
    if constexpr (IN(10)) { PH_IDS;
        const int* TILE = (const int*)(ws + RT_TILE); const int ntiles = __builtin_amdgcn_readfirstlane(TILE[MAXT]);
        LAS int* tl = (LAS int*)(lds + 131072 + 2048); __syncthreads(); for (int i = tid; i < MAXT; i += NTHR) tl[i] = TILE[i]; __syncthreads();
        pg8::Gemm g{(const bf16*)(ws + WS_ACT), (const bf16*)(ws + WS_W2), CAP, NE * D, D / 2};
        pg8::MoeOrder<true> S{tl, nullptr, ntiles, 8, G, bx};
        pg8::EpiGate E{ws + WS_Y, args.in[28], (const float*)(ws + RT_GATE), {}, {}};
        pg8::gemm_phase<pg8::EpiGate, pg8::MoeOrder<true>, true, true>(lds, g, S, E);
    }
    }
#endif
    SEAM(10);
    if constexpr (IN(11)) { PH_IDS; p9_final(args, vcu, G, wave, lane); }
#if defined(REP_PHASE)
    if constexpr (REP_PHASE == 11) { __syncthreads();
    if constexpr (IN(11)) { PH_IDS; p9_final(args, vcu, G, wave, lane); }
    }
#endif
#undef IN
#undef SEAM
}

template <int P> static void launch_phase(int grid, hipStream_t stream, const Args& a) {
    static bool init = false;
    if (!init) { (void)hipFuncSetAttribute((const void*)fwd_kernel<P, P + 1>, hipFuncAttributeMaxDynamicSharedMemorySize, LDS_BYTES); init = true; }
    hipLaunchKernelGGL((fwd_kernel<P, P + 1>), dim3(grid), dim3(NTHR), LDS_BYTES, stream, a);
}
extern "C" void kernel_launch(void* const* d_in, const int* in_sizes, int n_in, void* d_out, int out_size, void* d_ws, size_t ws_size, hipStream_t stream) {
    static int grid = 0;
    if (grid == 0) {
        if (n_in != 31 || out_size != NTOK * D || ws_size < WS_END) { fprintf(stderr, "kernel_launch: unexpected shapes (n_in %d out %d ws %zu, need %zu)\n", n_in, out_size, ws_size, (size_t)WS_END); grid = -1; return; }
        int dev = 0, cus = 0;
        if (hipGetDevice(&dev) != hipSuccess || hipDeviceGetAttribute(&cus, hipDeviceAttributeMultiprocessorCount, dev) != hipSuccess) { grid = -1; return; }
        grid = cus;
    }
    if (grid < 0) return;
    (void)hipMemsetAsync((char*)d_ws + WS_CTL, 0, CTL_ZERO_BYTES, stream);
    Args a{};
    for (int i = 0; i < 31; ++i) a.in[i] = (const float*)d_in[i];
    a.out = (float*)d_out; a.ws = (unsigned char*)d_ws;
#ifdef ONE_LAUNCH
    { static bool init = false; if (!init) { (void)hipFuncSetAttribute((const void*)fwd_kernel<0, NPH>, hipFuncAttributeMaxDynamicSharedMemorySize, LDS_BYTES); init = true; }
      hipLaunchKernelGGL((fwd_kernel<0, NPH>), dim3(grid), dim3(NTHR), LDS_BYTES, stream, a); }
#else
    launch_phase<0>(grid, stream, a); launch_phase<1>(grid, stream, a); launch_phase<2>(grid, stream, a); launch_phase<3>(grid, stream, a);
    launch_phase<4>(grid, stream, a); launch_phase<5>(grid, stream, a); launch_phase<6>(grid, stream, a); launch_phase<7>(grid, stream, a);
    launch_phase<8>(grid, stream, a); launch_phase<9>(grid, stream, a); launch_phase<10>(grid, stream, a); launch_phase<11>(grid, stream, a);
#endif
}
```
